# Optimizing an MI355X kernel written in HIP

```python
import jax
import jax.numpy as jnp
from jax import lax
import numpy as np

D_MODEL = 1024
BATCH = 4
SEQ = 8192
DEPTH = 1

GLA_HEADS = 4
GLA_DK = 128
GLA_DV = 128
GLA_RANK = 16
GLA_TAU = 16.0
GLA_CHUNK = 16
DIL_PATTERNS = ((128, 1), (512, 4), (2048, 16))
DIL_GROUPS = 3
DIL_HEADS = 4
DIL_DH = 128
DIL_BLOCK = 128
N_GROUPS = 4
EXPERTS_PER_GROUP = 8
N_EXPERTS = N_GROUPS * EXPERTS_PER_GROUP
TOP_K = 2
D_EXPERT = 512
MOE_BLOCK = 128
EPS = 1e-6

GLA_QK_W = GLA_HEADS * GLA_DK
GLA_V_W = GLA_HEADS * GLA_DV
DIL_W = DIL_HEADS * DIL_DH
SPLIT_SIZES = (GLA_QK_W, GLA_QK_W, GLA_V_W, GLA_V_W, GLA_RANK) + (DIL_W,) * (3 * DIL_GROUPS)
IN_COLS = sum(SPLIT_SIZES)
SPLIT_POINTS = tuple(int(v) for v in np.cumsum(SPLIT_SIZES)[:-1])
ALIBI_SLOPES = tuple(2.0 ** (-8.0 * (i + 1) / (DIL_GROUPS * DIL_HEADS)) for i in range(DIL_GROUPS * DIL_HEADS))

kernel_name = 'hybrid_gla_dilated_attn_hier_moe'


def rms_norm(x, g):
    xf = x.astype(jnp.float32)
    y = xf * lax.rsqrt(jnp.mean(xf * xf, axis=-1, keepdims=True) + EPS)
    return (y * g.astype(jnp.float32)).astype(x.dtype)


def gla_chunked(q, k, v, log_a):
    B, S, H, DK = q.shape
    DV = v.shape[-1]
    C = GLA_CHUNK
    N = S // C
    def chunks(t):
        return t.astype(jnp.float32).reshape(B, N, C, H, t.shape[-1]).transpose(1, 0, 3, 2, 4)
    qc = chunks(q) * (DK ** -0.5)
    kc = chunks(k)
    vc = chunks(v)
    b = jnp.cumsum(chunks(log_a), axis=3)
    b_last = b[:, :, :, -1:, :]
    q_in = qc * jnp.exp(b)
    k_in = kc * jnp.exp(-b)
    k_end = kc * jnp.exp(b_last - b)
    causal = jnp.tril(jnp.ones((C, C), dtype=bool))
    att = jnp.where(causal, jnp.einsum('nbhik,nbhjk->nbhij', q_in, k_in), 0.0)
    o_intra = jnp.einsum('nbhij,nbhjv->nbhiv', att, vc)

    def step(state, xs):
        q_n, k_n, v_n, dec_n = xs
        o_n = jnp.einsum('bhik,bhkv->bhiv', q_n, state)
        state = dec_n[:, :, 0, :, None] * state + jnp.einsum('bhjk,bhjv->bhkv', k_n, v_n)
        return state, o_n

    state0 = jnp.zeros((B, H, DK, DV), jnp.float32)
    _, o_inter = lax.scan(step, state0, (q_in, k_end, vc, jnp.exp(b_last)))
    o = o_intra + o_inter
    return o.transpose(1, 0, 3, 2, 4).reshape(B, S, H, DV)


def dilated_group(q, k, v, slopes, window, dilation):
    B, S, H, E = q.shape
    L = S // dilation
    Q = DIL_BLOCK
    span = window // dilation
    nb = -(-L // Q)
    Lp = nb * Q

    def to_sub(t):
        t = jnp.swapaxes(t.reshape(B, L, dilation, H, E), 1, 2)
        return jnp.pad(t, ((0, 0), (0, 0), (0, Lp - L), (0, 0), (0, 0)))

    def kv_blocks(t):
        t = jnp.pad(to_sub(t), ((0, 0), (0, 0), (Q, 0), (0, 0), (0, 0))).reshape(B, dilation, nb + 1, Q, H, E)
        return jnp.concatenate([t[:, :, :-1], t[:, :, 1:]], axis=3)

    def from_sub(t):
        t = t.reshape((B, dilation, Lp) + t.shape[4:])[:, :, :L]
        t = jnp.swapaxes(t, 1, 2)
        return t.reshape((B, S) + t.shape[3:])

    qb = to_sub(q).reshape(B, dilation, nb, Q, H, E)
    kb = kv_blocks(k)
    vb = kv_blocks(v)
    s = jnp.einsum('bdnqhe,bdnkhe->bdnhqk', qb, kb, preferred_element_type=jnp.float32) * (E ** -0.5)
    dist = jnp.arange(Q)[:, None] + Q - jnp.arange(2 * Q)[None, :]
    key_pos = jnp.arange(nb)[:, None, None] * Q + jnp.arange(2 * Q)[None, None, :] - Q
    valid = (dist >= 0) & (dist <= span) & (key_pos >= 0)
    bias = -slopes[:, None, None] * (dilation * dist).astype(jnp.float32)
    s = jnp.where(valid[:, None], s + bias, -jnp.inf)
    m = jnp.max(s, axis=-1)
    p = jnp.exp(s - m[..., None])
    den = jnp.sum(p, axis=-1)
    den_t = jnp.swapaxes(den, -1, -2)
    o = jnp.einsum('bdnhqk,bdnkhe->bdnqhe', p, vb.astype(jnp.float32)) / den_t[..., None]
    return from_sub(o), from_sub(jnp.swapaxes(m, -1, -2)), from_sub(den_t)


def hier_moe(h, w_rg, b_rg, w_re, b_re, w_gate, w_up, w_down):
    B, S, D = h.shape
    T = B * S
    hf = h.reshape(T, D)
    g_logit = (hf @ w_rg).astype(jnp.float32) + b_rg
    g_prob = jax.nn.softmax(g_logit, axis=-1)
    g_sel = jnp.argmax(g_logit, axis=-1)
    g_p = jnp.take_along_axis(g_prob, g_sel[:, None], axis=-1)[:, 0]
    e_logit = ((hf @ w_re).astype(jnp.float32) + b_re).reshape(T, N_GROUPS, EXPERTS_PER_GROUP)
    e_logit = jnp.take_along_axis(e_logit, g_sel[:, None, None], axis=1)[:, 0]
    top_v, top_i = lax.top_k(e_logit, TOP_K)
    gate = jax.nn.softmax(top_v, axis=-1) * g_p[:, None]
    eid = g_sel[:, None] * EXPERTS_PER_GROUP + top_i

    A = T * TOP_K
    flat_e = eid.reshape(A).astype(jnp.int32)
    flat_w = gate.reshape(A)
    flat_t = jnp.repeat(jnp.arange(T, dtype=jnp.int32), TOP_K)
    order = jnp.argsort(flat_e)
    se, st, sw = flat_e[order], flat_t[order], flat_w[order]
    counts = jnp.bincount(flat_e, length=N_EXPERTS)
    starts = jnp.cumsum(counts) - counts
    pcounts = (counts + MOE_BLOCK - 1) // MOE_BLOCK * MOE_BLOCK
    pends = jnp.cumsum(pcounts)
    pstarts = pends - pcounts
    dest = pstarts[se] + jnp.arange(A, dtype=jnp.int32) - starts[se]
    P = A + N_EXPERTS * MOE_BLOCK
    NB = P // MOE_BLOCK
    row_t = jnp.full((P,), T, jnp.int32).at[dest].set(st)
    row_w = jnp.zeros((P,), jnp.float32).at[dest].set(sw)
    blk_e = jnp.minimum(jnp.searchsorted(pends, jnp.arange(NB, dtype=jnp.int32) * MOE_BLOCK, side='right'), N_EXPERTS - 1)
    h_pad = jnp.concatenate([hf, jnp.zeros((1, D), hf.dtype)], axis=0)
    xin = h_pad[row_t].reshape(NB, MOE_BLOCK, D)

    def expert_block(args):
        xb, e = args
        return (jax.nn.silu(xb @ w_gate[e]) * (xb @ w_up[e])) @ w_down[e]

    yb = lax.map(expert_block, (xin, blk_e)).reshape(P, D)
    out = jnp.zeros((T + 1, D), jnp.float32).at[row_t].add(yb.astype(jnp.float32) * row_w[:, None])[:T]
    return out.reshape(B, S, D).astype(h.dtype)


def setup_inputs(seed: int = 0) -> dict:
    key = jax.random.key(seed)
    ks = jax.random.split(key, 22)
    def nrm(k, shape, scale):
        return scale * jax.random.normal(k, shape, jnp.float32)
    L = DEPTH
    return {
        'x': nrm(ks[0], (BATCH, SEQ, D_MODEL), 1.0),
        'norm1_g': 1.0 + nrm(ks[1], (L, D_MODEL), 0.02),
        'w_in': nrm(ks[2], (L, D_MODEL, IN_COLS), D_MODEL ** -0.5),
        'w_gla_a2': nrm(ks[3], (L, GLA_RANK, GLA_QK_W), GLA_RANK ** -0.5),
        'b_gla_a': nrm(ks[4], (L, GLA_QK_W), 0.1),
        'gla_out_norm_g': 1.0 + nrm(ks[5], (L, GLA_DV), 0.02),
        'dil_q_norm_g': 1.0 + nrm(ks[6], (L, DIL_GROUPS, DIL_DH), 0.02),
        'dil_k_norm_g': 1.0 + nrm(ks[7], (L, DIL_GROUPS, DIL_DH), 0.02),
        'w_proj_gla': nrm(ks[8], (L, GLA_V_W, D_MODEL), GLA_V_W ** -0.5),
        'w_proj_attn': nrm(ks[9], (L, DIL_W, D_MODEL), DIL_W ** -0.5),
        'w_branch_gate': nrm(ks[10], (L, D_MODEL, 2 * D_MODEL), D_MODEL ** -0.5),
        'b_branch_gate': nrm(ks[11], (L, 2 * D_MODEL), 0.01),
        'w_out': nrm(ks[12], (L, D_MODEL, D_MODEL), D_MODEL ** -0.5),
        'norm2_g': 1.0 + nrm(ks[13], (L, D_MODEL), 0.02),
        'w_router_group': nrm(ks[14], (L, D_MODEL, N_GROUPS), D_MODEL ** -0.5),
        'b_router_group': nrm(ks[15], (L, N_GROUPS), 0.01),
        'w_router_expert': nrm(ks[16], (L, D_MODEL, N_EXPERTS), D_MODEL ** -0.5),
        'b_router_expert': nrm(ks[17], (L, N_EXPERTS), 0.01),
        'w_gate': nrm(ks[18], (L, N_EXPERTS, D_MODEL, D_EXPERT), D_MODEL ** -0.5),
        'w_up': nrm(ks[19], (L, N_EXPERTS, D_MODEL, D_EXPERT), D_MODEL ** -0.5),
        'w_down': nrm(ks[20], (L, N_EXPERTS, D_EXPERT, D_MODEL), D_EXPERT ** -0.5),
    }


def reference(x, norm1_g, w_in, w_gla_a2, b_gla_a, gla_out_norm_g, dil_q_norm_g, dil_k_norm_g,
              w_proj_gla, w_proj_attn, w_branch_gate, b_branch_gate, w_out, norm2_g,
              w_router_group, b_router_group, w_router_expert, b_router_expert, w_gate, w_up, w_down):
    B, S, D = x.shape
    slopes = jnp.asarray(ALIBI_SLOPES, jnp.float32).reshape(DIL_GROUPS, DIL_HEADS)
    def heads(t, e):
        return t.reshape(B, S, -1, e)
    for l in range(DEPTH):
        h = rms_norm(x, norm1_g[l])
        parts = jnp.split(h @ w_in[l], list(SPLIT_POINTS), axis=-1)
        gq, gk, gv, gr, ga_lr = parts[:5]
        log_a = jax.nn.log_sigmoid((ga_lr @ w_gla_a2[l] + b_gla_a[l]).astype(jnp.float32)) / GLA_TAU
        o_gla = gla_chunked(heads(gq, GLA_DK), heads(gk, GLA_DK), heads(gv, GLA_DV), heads(log_a, GLA_DK))
        o_gla = rms_norm(o_gla, gla_out_norm_g[l]).reshape(B, S, GLA_V_W) * jax.nn.silu(gr.astype(jnp.float32))
        y_gla = o_gla.astype(x.dtype) @ w_proj_gla[l]
        outs, maxes, dens = [], [], []
        for gi, (window, dilation) in enumerate(DIL_PATTERNS):
            q, k, v = parts[5 + 3 * gi: 8 + 3 * gi]
            q = rms_norm(heads(q, DIL_DH), dil_q_norm_g[l, gi])
            k = rms_norm(heads(k, DIL_DH), dil_k_norm_g[l, gi])
            o_g, m_g, d_g = dilated_group(q, k, heads(v, DIL_DH), slopes[gi], window, dilation)
            outs.append(o_g)
            maxes.append(m_g)
            dens.append(d_g)
        m_all = jnp.stack(maxes)
        wts = jnp.stack(dens) * jnp.exp(m_all - jnp.max(m_all, axis=0))
        o_att = jnp.sum(wts[..., None] * jnp.stack(outs), axis=0) / jnp.sum(wts, axis=0)[..., None]
        y_att = o_att.reshape(B, S, DIL_W).astype(x.dtype) @ w_proj_attn[l]
        g_gla, g_att = jnp.split(jax.nn.sigmoid(h @ w_branch_gate[l] + b_branch_gate[l]), 2, axis=-1)
        x = x + ((g_gla * y_gla + g_att * y_att) @ w_out[l]).astype(x.dtype)
        x = x + hier_moe(rms_norm(x, norm2_g[l]), w_router_group[l], b_router_group[l], w_router_expert[l],
                         b_router_expert[l], w_gate[l], w_up[l], w_down[l])
    return x
```

```cpp
#include <hip/hip_runtime.h>
#include <cstdio>
#include <cstdint>

#ifndef MK_N_LAUNCHES
#define MK_N_LAUNCHES 13
#endif

#define GAS __attribute__((address_space(1)))
#define LAS __attribute__((address_space(3)))
typedef unsigned short bf16;
typedef unsigned v4u __attribute__((ext_vector_type(4)));
typedef unsigned v2u __attribute__((ext_vector_type(2)));
typedef float f32x2 __attribute__((ext_vector_type(2)));
typedef float f32x4 __attribute__((ext_vector_type(4)));
typedef float f32x16 __attribute__((ext_vector_type(16)));
typedef short bf16x8 __attribute__((ext_vector_type(8)));
typedef short bf16x4 __attribute__((ext_vector_type(4)));
typedef __bf16 hbf2 __attribute__((ext_vector_type(2)));

#define DI __device__ __forceinline__
DI unsigned pk2(float lo, float hi) { f32x2 v = {lo, hi}; hbf2 r = __builtin_convertvector(v, hbf2); return __builtin_bit_cast(unsigned, r); }
DI bf16 f2bf(float f) { return (bf16)(pk2(f, 0.f) & 0xffffu); }
DI float bf2f(bf16 b) { return __builtin_bit_cast(float, ((unsigned)b) << 16); }
DI float bflo(unsigned u) { return __builtin_bit_cast(float, u << 16); }
DI float bfhi(unsigned u) { return __builtin_bit_cast(float, u & 0xffff0000u); }

constexpr int T = 32768, D = 1024, SEQ = 8192;
constexpr int N1 = 7168;
constexpr int IN_COLS = 6672;
constexpr int NSEG = 16, TSEG = SEQ / NSEG;
constexpr float EPS = 1e-6f;
constexpr float LOG2E = 1.4426950408889634f;
constexpr int PMAX = 65536 + 32 * 256;
constexpr int NBLK_MAX = PMAX / 256;

constexpr size_t MiB = 1u << 20;
constexpr size_t WS_CTL = 0, CTL_ZERO_BYTES = 256 * 1024;
constexpr size_t WS_LB = 1 * MiB;
constexpr size_t WS_W1T = 1 * MiB;
constexpr size_t WS_WBGT = 15 * MiB, WS_WPGT = 19 * MiB, WS_WPAT = 20 * MiB, WS_WOUTT = 21 * MiB, WS_WRH = 23 * MiB;
constexpr size_t WS_XN = 24 * MiB;
constexpr size_t WS_GLAQ = 88 * MiB, WS_GLAK = 120 * MiB, WS_LOGA = 152 * MiB, WS_GLAV = 184 * MiB;
constexpr size_t WS_DILQ = 216 * MiB, WS_DILK = 312 * MiB, WS_DILVT = 408 * MiB;
constexpr size_t WS_STATS = 504 * MiB;
constexpr size_t WS_LSE = WS_STATS;
constexpr size_t WS_DSEG = WS_STATS + 1536 * 1024;
constexpr size_t WS_TOKE = WS_STATS + 2 * MiB;
constexpr size_t WS_TOKW = WS_TOKE + 256 * 1024;
constexpr size_t WS_TOKR = WS_TOKW + 256 * 1024;
constexpr size_t WS_DEST = WS_TOKR + 256 * 1024;
constexpr size_t WS_ROWW = WS_DEST + 256 * 1024;
constexpr size_t WS_BLKE = WS_ROWW + 320 * 1024;
constexpr size_t WS_END = 512 * MiB;
constexpr size_t WS_GATES = 376 * MiB;
constexpr size_t WS_MERGED = 312 * MiB;
constexpr size_t WS_X1 = 88 * MiB;
constexpr size_t WS_H2 = 24 * MiB;
constexpr size_t WS_XP = 216 * MiB;
constexpr size_t WS_HBUF = 360 * MiB;
constexpr size_t WS_Y = 216 * MiB;
constexpr size_t DO_R = 0;
constexpr size_t DO_EXPGU = 32 * MiB;
constexpr size_t DO_EXPDN = 96 * MiB;
constexpr int CW_BAR = 4096;
constexpr int CW_GCNT = 16384;

constexpr int RING_OFF = 0, RING_BYTES = 131072;
constexpr int LDSCTL_OFF = RING_BYTES, MISC_OFF = LDSCTL_OFF + 320;
constexpr int LDS_BYTES = 147456;

#define XB_TMO      128
#define XB_XCNT(j)  (256  + 64 * (j))
#define XB_XSUB(j)  (1280 + 64 * (j))
#define XB_XGEN(j)  (2304 + 64 * (j))
#define XB_TOP      3328
#define XB_TOPGEN   3392
#define XCD_BAR_WORDS 3456
#define XB_SPIN_CAP (1u << 18)
DI unsigned xb_ld(unsigned* p)              { return __hip_atomic_load(p, __ATOMIC_RELAXED, __HIP_MEMORY_SCOPE_AGENT); }
DI unsigned xb_add(unsigned* p, unsigned v) { return __hip_atomic_fetch_add(p, v, __ATOMIC_RELAXED, __HIP_MEMORY_SCOPE_AGENT); }
DI unsigned xb_xcc_id() { return (unsigned)__builtin_amdgcn_s_getreg((3 << 11) | 20) & 0xFu; }
#define XB_SPIN(cond, bar) do { unsigned _sp = 0; while (cond) { __builtin_amdgcn_s_sleep(1); \
    if ((++_sp & 255u) == 0u) { if (xb_ld(&(bar)[XB_TMO])) break; if (_sp > XB_SPIN_CAP) { atomicAdd(&(bar)[XB_TMO], 1u); break; } } } } while (0)
struct XcdBarrier { unsigned* bar; unsigned x; volatile LAS unsigned* st; };
DI XcdBarrier xcd_barrier_post(unsigned* bar, volatile LAS unsigned* st) {
    XcdBarrier b; b.bar = bar; b.x = xb_xcc_id(); b.st = st;
    if (threadIdx.x == 0) (void)xb_add(&bar[XB_XCNT(b.x)], 1u);
    return b;
}
DI void xcd_barrier_complete(unsigned* bar, unsigned x, unsigned& nloc, unsigned& nx) {
    const unsigned G = gridDim.x * gridDim.y * gridDim.z;
    unsigned sum, cnt, mine, sp = 0u;
    for (;;) {
        sum = 0u; cnt = 0u; mine = 0u;
#pragma unroll
        for (unsigned j = 0; j < 16; ++j) { const unsigned c = xb_ld(&bar[XB_XCNT(j)]); sum += c; cnt += (c > 0u) ? 1u : 0u; mine = (j == x) ? c : mine; }
        if (sum == G) break;
        __builtin_amdgcn_s_sleep(1);
        if ((++sp & 255u) == 0u) { if (xb_ld(&bar[XB_TMO])) break; if (sp > XB_SPIN_CAP) { atomicAdd(&bar[XB_TMO], 1u); break; } }
    }
    nloc = mine > 0u ? mine : 1u; nx = cnt > 0u ? cnt : 1u;
}
DI void xcd_barrier(const XcdBarrier& b) {
    asm volatile("s_waitcnt vmcnt(0)" ::: "memory");
    __syncthreads();
    if (threadIdx.x == 0) {
        unsigned* bar = b.bar;
        __builtin_amdgcn_s_waitcnt(0);
        unsigned nloc = b.st[0], nx = b.st[1];
        if (nloc == 0u) { xcd_barrier_complete(bar, b.x, nloc, nx); b.st[0] = nloc; b.st[1] = nx; }
        const unsigned old = xb_add(&bar[XB_XSUB(b.x)], 1u);
        const unsigned gen = old / nloc;
        if (old + 1u == (gen + 1u) * nloc) {
            __builtin_amdgcn_fence(__ATOMIC_RELEASE, "agent");
            asm volatile("s_waitcnt vmcnt(0)" ::: "memory");
            const unsigned og = xb_add(&bar[XB_TOP], 1u);
            const unsigned tg = og / nx;
            if (og + 1u == (tg + 1u) * nx) xb_add(&bar[XB_TOPGEN], 1u);
            else XB_SPIN(xb_ld(&bar[XB_TOPGEN]) == tg, bar);
            __builtin_amdgcn_fence(__ATOMIC_ACQUIRE, "agent");
            xb_add(&bar[XB_XGEN(b.x)], 1u);
            asm volatile("s_waitcnt vmcnt(0)" ::: "memory");
        } else {
            XB_SPIN(xb_ld(&bar[XB_XGEN(b.x)]) == gen, bar);
            __builtin_amdgcn_fence(__ATOMIC_ACQUIRE, "agent");
            asm volatile("s_waitcnt vmcnt(0)" ::: "memory");
        }
    }
    __syncthreads();
}

namespace pg8 {
constexpr int BM = 256, BK = 64, HALF = 128, HTB = HALF * BK * 2, STAGE_BYTES = 8 * HTB, NXCD = 8, WGM = 8;
__host__ __device__ __forceinline__ int lds_byte(int r, int c) { const int st = (r >> 4) * 2 + (c >> 5), rr = r & 15, cc = c & 31, ob = rr * 64 + cc * 2; return st * 1024 + (ob ^ (((ob >> 9) & 1) << 5)); }
__host__ __device__ __forceinline__ void stage_rc(int b, int& R, int& C) { const int st = b / 1024, sb = b % 1024, swz = sb ^ (((sb >> 9) & 1) << 5); R = (st >> 1) * 16 + swz / 64; C = (st & 1) * 32 + (swz % 64) / 2; }
__host__ __device__ __forceinline__ int perm32(int rho) { const int n = rho >> 4, i = rho & 15; return 8 * (i >> 2) + 4 * n + (i & 3); }

struct Unit { const char* A; const char* B; int pm, pn, aux; };
struct GemmDesc { int lda, ldb, K; };

DI bool static_tile(int L, int nM, int nN, int& pm, int& pn) {
    const int nwg = nM * nN; if (L >= nwg) return false;
    int wgid = L; { const int q = nwg / NXCD, r = nwg % NXCD, xcd = wgid % NXCD, off = wgid / NXCD; wgid = (xcd < r ? xcd * (q + 1) : r * (q + 1) + (xcd - r) * q) + off; }
    const int nig = WGM * nN, gid = wgid / nig, fm = gid * WGM, gsz = (nM - fm) < WGM ? (nM - fm) : WGM;
    pm = fm + ((wgid % nig) % gsz); pn = (wgid % nig) / gsz; return true;
}
struct OrderStd {
    int nM, nN, G, c; const char* A0; const char* B0; size_t sA, sB;
    DI bool next(int i, Unit& u) const {
        int pm, pn; if (!static_tile(i * G + c, nM, nN, pm, pn)) return false;
        u.pm = pm; u.pn = pn; u.aux = 0; u.A = A0 + (size_t)pm * sA; u.B = B0 + (size_t)pn * sB; return true;
    }
};
struct OrderPair {
    int nM, nN, G, c; const char* A0; const char* A1; const char* B0; const char* B1; size_t sA, sB;
    DI bool next(int i, Unit& u) const {
        int pm, pn; if (!static_tile((i >> 1) * G + c, nM, nN, pm, pn)) return false;
        const int br = i & 1; u.pm = pm; u.pn = pn; u.aux = br; u.A = (br ? A1 : A0) + (size_t)pm * sA; u.B = (br ? B1 : B0) + (size_t)pn * sB; return true;
    }
};
struct OrderMoe {
    int nblk, G, c; const int* blke; const char* A0; const char* B0; size_t sA, sE, sB;
    DI bool next(int i, Unit& u) const {
        int rb, pn;
        if ((G & 31) == 0) { const int R = G >> 2, per = R >> 3, loc = c >> 3; rb = i * R + (c & 7) * per + (loc >> 2); pn = loc & 3; }
        else { const int L = i * G + c; rb = L >> 2; pn = L & 3; }
        if (rb >= nblk) return false;
        const int e = blke[rb];
        u.pm = rb; u.pn = pn; u.aux = 0;
        u.A = A0 + (size_t)rb * sA; u.B = B0 + (size_t)e * sE + (size_t)pn * sB; return true;
    }
};

#define PG8_LAS __attribute__((address_space(3)))
template <class Epi, class Sched, bool ALIGN_EPI = true, bool SP2 = true>
DI void gemm_phase(PG8_LAS unsigned char* lds, const GemmDesc g, const Sched& S, const Epi& E) {
    const int tid = threadIdx.x, wid = __builtin_amdgcn_readfirstlane(tid >> 6), lane = tid & 63, wr = wid >> 2, wc = wid & 3, fr = lane & 15, fq = lane >> 4;
    const int K = g.K, nt = K / BK;
    unsigned voffA[2], voffB[2];
#pragma unroll
    for (int i = 0; i < 2; ++i) { int R, C; stage_rc(tid * 16 + i * 8192, R, C); const int Rb = Epi::PERM ? ((R & ~31) + perm32(R & 31)) : R;
        voffA[i] = (unsigned)(R * g.lda + C) * 2u; voffB[i] = (unsigned)(Rb * g.ldb + C) * 2u; }
    const size_t kstep = (size_t)(BK * 2);
    const size_t hstepA = (size_t)HALF * g.lda * 2, hstepB = (size_t)HALF * g.ldb * 2;
    const unsigned ldsw = (unsigned)wid * 1024u;
    const int aoff = lds_byte(wr * 64 + fr, fq * 8), boff = lds_byte(wc * 32 + fr, fq * 8);
#define PG8_SA(b, h) (((b) * 2 + (h)) * HTB)
#define PG8_SB(b, h) ((4 + (b) * 2 + (h)) * HTB)
#define PG8_STAGE(bufoff, gbase, voff) do { _Pragma("unroll") for (int _i = 0; _i < 2; ++_i) \
        __builtin_amdgcn_global_load_lds((const unsigned*)((const char*)(gbase) + (voff)[_i]), (PG8_LAS unsigned*)(lds + (bufoff) + ldsw + _i * 8192), 16, 0, 0); } while (0)
#define PG8_LDA(dst, b, h) do { _Pragma("unroll") for (int m = 0; m < 4; ++m) _Pragma("unroll") for (int k = 0; k < 2; ++k) dst[m][k] = *(const PG8_LAS bf16x8*)(lds + PG8_SA(b, h) + aoff + m * 2048 + k * 1024); } while (0)
#define PG8_LDB(dst, b, h) do { _Pragma("unroll") for (int n = 0; n < 2; ++n) _Pragma("unroll") for (int k = 0; k < 2; ++k) dst[n][k] = *(const PG8_LAS bf16x8*)(lds + PG8_SB(b, h) + boff + n * 2048 + k * 1024); } while (0)
#define PG8_MMA(ai, bj, At, Bt) do { __builtin_amdgcn_s_setprio(1); _Pragma("unroll") for (int m = 0; m < 4; ++m) _Pragma("unroll") for (int n = 0; n < 2; ++n) _Pragma("unroll") for (int k = 0; k < 2; ++k) \
        acc[ai][bj][m][n] = __builtin_amdgcn_mfma_f32_16x16x32_bf16(Bt[n][k], At[m][k], acc[ai][bj][m][n], 0, 0, 0); __builtin_amdgcn_s_setprio(0); } while (0)
#define PG8_WAIT_V(n) asm volatile("s_waitcnt vmcnt(" #n ")" ::: "memory")
#define PG8_WAIT_L(n) asm volatile("s_waitcnt lgkmcnt(" #n ")" ::: "memory")
#define PG8_BAR __builtin_amdgcn_s_barrier()
#define PG8_SCHED __builtin_amdgcn_sched_barrier(0)
    Unit cur, nxt; int ui = 0;
    if (!S.next(0, cur)) return;
    f32x4 acc[2][2][4][2];
#pragma unroll
    for (int a = 0; a < 2; ++a)
#pragma unroll
        for (int b = 0; b < 2; ++b)
#pragma unroll
            for (int m = 0; m < 4; ++m)
#pragma unroll
                for (int n = 0; n < 2; ++n) acc[a][b][m][n] = (f32x4){0.f, 0.f, 0.f, 0.f};
    bf16x8 At[4][2], B0[2][2], B1[2][2];
    const char* cA = cur.A; const char* cB = cur.B;
    if constexpr (SP2) {
        PG8_STAGE(PG8_SB(0, 0), cB, voffB); PG8_STAGE(PG8_SB(0, 1), cB + hstepB, voffB); PG8_STAGE(PG8_SA(0, 0), cA, voffA); PG8_STAGE(PG8_SA(0, 1), cA + hstepA, voffA);
        if (wr == 1) PG8_BAR;
        PG8_WAIT_V(2); PG8_BAR;
        PG8_STAGE(PG8_SB(1, 0), cB + kstep, voffB); PG8_STAGE(PG8_SA(1, 0), cA + kstep, voffA); PG8_STAGE(PG8_SB(1, 1), cB + hstepB + kstep, voffB);
        PG8_WAIT_V(6); PG8_BAR;
    } else {
        PG8_STAGE(PG8_SB(0, 0), cB, voffB); PG8_STAGE(PG8_SA(0, 0), cA, voffA); PG8_STAGE(PG8_SB(0, 1), cB + hstepB, voffB); PG8_STAGE(PG8_SA(0, 1), cA + hstepA, voffA);
        if (wr == 1) PG8_BAR;
        PG8_WAIT_V(4); PG8_BAR;
        PG8_STAGE(PG8_SB(1, 0), cB + kstep, voffB); PG8_STAGE(PG8_SA(1, 0), cA + kstep, voffA); PG8_STAGE(PG8_SB(1, 1), cB + hstepB + kstep, voffB);
        PG8_WAIT_V(6); PG8_BAR;
    }
    for (;;) {
        const bool has_next = S.next(ui + 1, nxt);
        const char* nA = has_next ? nxt.A : cA; const char* nB = has_next ? nxt.B : cB;
        for (int t = 0; t < nt; t += 2) {
            const bool last = (t == nt - 2);
            const char* a1 = cA + (size_t)(t + 1) * kstep;
            const char* a2 = last ? nA : cA + (size_t)(t + 2) * kstep; const char* b2 = last ? nB : cB + (size_t)(t + 2) * kstep;
            const char* a3 = a2 + kstep; const char* b3 = b2 + kstep;
            if constexpr (SP2) {
            PG8_LDB(B0, 0, 0); PG8_LDB(B1, 0, 1); PG8_SCHED; PG8_LDA(At, 0, 0); PG8_STAGE(PG8_SA(1, 1), a1 + hstepA, voffA);
            PG8_WAIT_V(8); PG8_WAIT_L(0); PG8_BAR; PG8_MMA(0, 0, At, B0); PG8_MMA(0, 1, At, B1); PG8_BAR; PG8_SCHED;
            PG8_LDA(At, 0, 1); PG8_STAGE(PG8_SB(0, 0), b2, voffB); PG8_STAGE(PG8_SB(0, 1), b2 + hstepB, voffB); PG8_STAGE(PG8_SA(0, 0), a2, voffA);
            PG8_WAIT_V(8); PG8_WAIT_L(0); PG8_BAR; PG8_MMA(1, 0, At, B0); PG8_MMA(1, 1, At, B1); PG8_BAR; PG8_SCHED;
            PG8_LDB(B0, 1, 0); PG8_LDB(B1, 1, 1); PG8_SCHED; PG8_LDA(At, 1, 0); PG8_STAGE(PG8_SA(0, 1), a2 + hstepA, voffA);
            PG8_WAIT_V(8); PG8_WAIT_L(0); PG8_BAR; PG8_MMA(0, 0, At, B0); PG8_MMA(0, 1, At, B1); PG8_BAR; PG8_SCHED;
            PG8_LDA(At, 1, 1); PG8_STAGE(PG8_SB(1, 0), b3, voffB); PG8_STAGE(PG8_SB(1, 1), b3 + hstepB, voffB); PG8_STAGE(PG8_SA(1, 0), a3, voffA);
            PG8_WAIT_V(8); PG8_WAIT_L(0); PG8_BAR; PG8_MMA(1, 0, At, B0); PG8_MMA(1, 1, At, B1); PG8_BAR; PG8_SCHED;
            } else {
            PG8_LDB(B0, 0, 0); PG8_SCHED; PG8_LDA(At, 0, 0); PG8_STAGE(PG8_SA(1, 1), a1 + hstepA, voffA);
            PG8_WAIT_L(8); PG8_BAR; PG8_WAIT_L(0); PG8_MMA(0, 0, At, B0); PG8_BAR; PG8_SCHED;
            PG8_LDB(B1, 0, 1); PG8_STAGE(PG8_SB(0, 0), b2, voffB);
            PG8_BAR; PG8_WAIT_L(0); PG8_MMA(0, 1, At, B1); PG8_BAR;
            PG8_LDA(At, 0, 1); PG8_STAGE(PG8_SA(0, 0), a2, voffA);
            PG8_BAR; PG8_WAIT_L(0); PG8_MMA(1, 0, At, B0); PG8_BAR; PG8_SCHED;
            PG8_STAGE(PG8_SB(0, 1), b2 + hstepB, voffB);
            PG8_WAIT_V(6); PG8_BAR; PG8_MMA(1, 1, At, B1); PG8_BAR;
            PG8_LDB(B0, 1, 0); PG8_SCHED; PG8_LDA(At, 1, 0); PG8_STAGE(PG8_SA(0, 1), a2 + hstepA, voffA);
            PG8_WAIT_L(8); PG8_BAR; PG8_WAIT_L(0); PG8_MMA(0, 0, At, B0); PG8_BAR; PG8_SCHED;
            PG8_LDB(B1, 1, 1); PG8_STAGE(PG8_SB(1, 0), b3, voffB);
            PG8_BAR; PG8_WAIT_L(0); PG8_MMA(0, 1, At, B1); PG8_BAR;
            PG8_LDA(At, 1, 1); PG8_STAGE(PG8_SA(1, 0), a3, voffA);
            PG8_BAR; PG8_WAIT_L(0); PG8_MMA(1, 0, At, B0); PG8_BAR; PG8_SCHED;
            PG8_STAGE(PG8_SB(1, 1), b3 + hstepB, voffB);
            PG8_WAIT_V(6); PG8_BAR; PG8_MMA(1, 1, At, B1); PG8_BAR;
            }
        }
        if constexpr (ALIGN_EPI) { if (wr == 0) PG8_BAR; }
        E(acc, cur, wr, wc, fr, fq);
        if (!has_next) break;
#pragma unroll
        for (int a = 0; a < 2; ++a)
#pragma unroll
            for (int b = 0; b < 2; ++b)
#pragma unroll
                for (int m = 0; m < 4; ++m)
#pragma unroll
                    for (int n = 0; n < 2; ++n) acc[a][b][m][n] = (f32x4){0.f, 0.f, 0.f, 0.f};
        cur = nxt; cA = nA; cB = nB; ++ui;
        if constexpr (ALIGN_EPI) { if (wr == 1) PG8_BAR; }
    }
    PG8_WAIT_V(0);
    if constexpr (!ALIGN_EPI) { if (wr == 0) PG8_BAR; }
    PG8_BAR;
#undef PG8_SA
#undef PG8_SB
#undef PG8_STAGE
#undef PG8_LDA
#undef PG8_LDB
#undef PG8_MMA
#undef PG8_WAIT_V
#undef PG8_WAIT_L
#undef PG8_BAR
#undef PG8_SCHED
}

typedef f32x4 AccT[2][2][4][2];
DI float silu_f(float v) { return v / (1.f + __expf(-v)); }
DI float sigmoid_f(float v) { return 1.f / (1.f + __expf(-v)); }
DI float logsig16(float v) { return (fminf(v, 0.f) - __logf(1.f + __expf(-fabsf(v)))) * 0.0625f; }
DI v4u pack8(f32x4 a, f32x4 b) { v4u w; w.x = pk2(a[0], a[1]); w.y = pk2(a[2], a[3]); w.z = pk2(b[0], b[1]); w.w = pk2(b[2], b[3]); return w; }

struct EpiP1 {
    static constexpr bool PERM = true;
    bf16 *glaq, *glak, *glav, *r, *loga, *dilq, *dilk, *dilvt; const float* b_a;
    DI void operator()(const AccT& acc, const Unit& u, int wr, int wc, int fr, int fq) const {
        const int pn = u.pn, row0 = u.pm * BM + wr * 64 + fr, cl = wc * 32 + 8 * fq;
        if (pn < 10 || ((pn - 10) % 6) < 4) {
            bf16* dst; int mode = 0; int colbase = (pn & 1) * 256;
            if (pn < 2) dst = glaq; else if (pn < 4) dst = glak; else if (pn < 6) dst = glav; else if (pn < 8) { dst = r; mode = 1; } else if (pn < 10) { dst = loga; mode = 2; }
            else { const int gi = (pn - 10) / 6, rem = (pn - 10) % 6; dst = (rem < 2 ? dilq : dilk) + (size_t)gi * T * 512; }
            f32x4 bv[2][2];
#pragma unroll
            for (int bj = 0; bj < 2; ++bj)
#pragma unroll
                for (int n = 0; n < 2; ++n) bv[bj][n] = (mode == 2) ? *(const f32x4*)(b_a + colbase + bj * HALF + cl + 4 * n) : (f32x4){0.f, 0.f, 0.f, 0.f};
#pragma unroll
            for (int ai = 0; ai < 2; ++ai)
#pragma unroll
                for (int m = 0; m < 4; ++m) { bf16* rowp = dst + (size_t)(row0 + ai * HALF + m * 16) * 512 + colbase + cl;
#pragma unroll
                    for (int bj = 0; bj < 2; ++bj) { f32x4 v0 = acc[ai][bj][m][0] + bv[bj][0], v1 = acc[ai][bj][m][1] + bv[bj][1];
                        if (mode == 1) {
#pragma unroll
                            for (int j = 0; j < 4; ++j) { v0[j] = silu_f(v0[j]); v1[j] = silu_f(v1[j]); } }
                        if (mode == 2) {
#pragma unroll
                            for (int j = 0; j < 4; ++j) { v0[j] = logsig16(v0[j]); v1[j] = logsig16(v1[j]); } }
                        *(v4u*)(rowp + bj * HALF) = pack8(v0, v1); } }
        } else {
            const int gi = (pn - 10) / 6, half = (pn - 10) % 6 - 4, sh = 2 * gi, dm = (1 << sh) - 1;
            bf16* vt = dilvt + (size_t)gi * T * 512;
#pragma unroll
            for (int ai = 0; ai < 2; ++ai)
#pragma unroll
                for (int m = 0; m < 4; ++m) { const int t = row0 + ai * HALF + m * 16, b = t >> 13, s = t & 8191;
                    const int uu = ((s & dm) << (13 - sh)) | (s >> sh), pos = (uu & ~12) | ((uu & 4) << 1) | ((uu & 8) >> 1);
#pragma unroll
                    for (int bj = 0; bj < 2; ++bj) { bf16* hp = vt + ((size_t)((b * 4 + half * 2 + bj) * 128 + cl) << 13) + pos;
#pragma unroll
                        for (int n = 0; n < 2; ++n)
#pragma unroll
                            for (int j = 0; j < 4; ++j) hp[(size_t)(4 * n + j) << 13] = f2bf(acc[ai][bj][m][n][j]); } }
        }
    }
};
struct EpiGate {
    static constexpr bool PERM = true;
    bf16* G; const float* bias;
    DI void operator()(const AccT& acc, const Unit& u, int wr, int wc, int fr, int fq) const {
        const int row0 = u.pm * BM + wr * 64 + fr, col0 = u.pn * BM + wc * 32 + 8 * fq;
        f32x4 bv[2][2];
#pragma unroll
        for (int bj = 0; bj < 2; ++bj)
#pragma unroll
            for (int n = 0; n < 2; ++n) bv[bj][n] = *(const f32x4*)(bias + col0 + bj * HALF + 4 * n);
#pragma unroll
        for (int ai = 0; ai < 2; ++ai)
#pragma unroll
            for (int m = 0; m < 4; ++m) { bf16* rowp = G + (size_t)(row0 + ai * HALF + m * 16) * 2048 + col0;
#pragma unroll
                for (int bj = 0; bj < 2; ++bj) { f32x4 v0 = acc[ai][bj][m][0] + bv[bj][0], v1 = acc[ai][bj][m][1] + bv[bj][1];
#pragma unroll
                    for (int j = 0; j < 4; ++j) { v0[j] = sigmoid_f(v0[j]); v1[j] = sigmoid_f(v1[j]); }
                    *(v4u*)(rowp + bj * HALF) = pack8(v0, v1); } }
    }
};
struct EpiMerge {
    static constexpr bool PERM = true;
    bf16* Mg; const bf16* G;
    DI void operator()(const AccT& acc, const Unit& u, int wr, int wc, int fr, int fq) const {
        const int row0 = u.pm * BM + wr * 64 + fr, col0 = u.pn * BM + wc * 32 + 8 * fq, br = u.aux;
#pragma unroll
        for (int ai = 0; ai < 2; ++ai)
#pragma unroll
            for (int m = 0; m < 4; ++m) { const size_t row = (size_t)(row0 + ai * HALF + m * 16);
#pragma unroll
                for (int bj = 0; bj < 2; ++bj) { const int col = col0 + bj * HALF;
                    const v4u g = *(const v4u*)(G + row * 2048 + br * 1024 + col);
                    f32x4 v0 = acc[ai][bj][m][0], v1 = acc[ai][bj][m][1];
                    v0[0] *= bflo(g.x); v0[1] *= bfhi(g.x); v0[2] *= bflo(g.y); v0[3] *= bfhi(g.y); v1[0] *= bflo(g.z); v1[1] *= bfhi(g.z); v1[2] *= bflo(g.w); v1[3] *= bfhi(g.w);
                    bf16* p = Mg + row * 1024 + col;
                    if (br) { const v4u o = *(const v4u*)p;
                        v0[0] += bflo(o.x); v0[1] += bfhi(o.x); v0[2] += bflo(o.y); v0[3] += bfhi(o.y); v1[0] += bflo(o.z); v1[1] += bfhi(o.z); v1[2] += bflo(o.w); v1[3] += bfhi(o.w); }
                    *(v4u*)p = pack8(v0, v1); } }
    }
};
struct EpiX1 {
    static constexpr bool PERM = false;
    float* X1; const float* X;
    DI void operator()(const AccT& acc, const Unit& u, int wr, int wc, int fr, int fq) const {
        const int row0 = u.pm * BM + wr * 64 + fr, col0 = u.pn * BM + wc * 32 + 4 * fq;
#pragma unroll
        for (int ai = 0; ai < 2; ++ai)
#pragma unroll
            for (int m = 0; m < 4; ++m) { const size_t ro = (size_t)(row0 + ai * HALF + m * 16) * 1024 + col0;
#pragma unroll
                for (int bj = 0; bj < 2; ++bj)
#pragma unroll
                    for (int n = 0; n < 2; ++n) *(f32x4*)(X1 + ro + bj * HALF + n * 16) = acc[ai][bj][m][n] + *(const f32x4*)(X + ro + bj * HALF + n * 16); }
    }
};
struct EpiGU {
    static constexpr bool PERM = true;
    bf16* H; const float* roww;
    DI void operator()(const AccT& acc, const Unit& u, int wr, int wc, int fr, int fq) const {
        if (u.aux) return;
        const int row0 = u.pm * BM + wr * 64 + fr, hc0 = u.pn * 128 + wc * 16 + 4 * fq;
#pragma unroll
        for (int ai = 0; ai < 2; ++ai)
#pragma unroll
            for (int m = 0; m < 4; ++m) { const int row = row0 + ai * HALF + m * 16; const float w = roww[row];
#pragma unroll
                for (int bj = 0; bj < 2; ++bj) { const f32x4 g = acc[ai][bj][m][0], up = acc[ai][bj][m][1];
                    v2u o; o.x = pk2(w * silu_f(g[0]) * up[0], w * silu_f(g[1]) * up[1]); o.y = pk2(w * silu_f(g[2]) * up[2], w * silu_f(g[3]) * up[3]);
                    *(v2u*)(H + (size_t)row * 512 + hc0 + bj * 64) = o; } }
    }
};
struct EpiY {
    static constexpr bool PERM = true;
    bf16* Y;
    DI void operator()(const AccT& acc, const Unit& u, int wr, int wc, int fr, int fq) const {
        if (u.aux) return;
        const int row0 = u.pm * BM + wr * 64 + fr, col0 = u.pn * BM + wc * 32 + 8 * fq;
#pragma unroll
        for (int ai = 0; ai < 2; ++ai)
#pragma unroll
            for (int m = 0; m < 4; ++m) { bf16* rowp = Y + (size_t)(row0 + ai * HALF + m * 16) * 1024 + col0;
#pragma unroll
                for (int bj = 0; bj < 2; ++bj) *(v4u*)(rowp + bj * HALF) = pack8(acc[ai][bj][m][0], acc[ai][bj][m][1]); }
    }
};
}

constexpr int NWAVES = 8, NTHR = 512;
struct Frame {
    LAS unsigned char* lds;
    int tid, lane, wave, vcu, G;
    unsigned char* ws; unsigned char* dout;
};
#define LDS_WAIT() asm volatile("s_waitcnt lgkmcnt(0)" ::: "memory")
DI float wave_sum(float v) {
#pragma unroll
    for (int o = 1; o < 64; o <<= 1) v += __shfl_xor(v, o);
    return v;
}
#define MFMA16(a, b, c) __builtin_amdgcn_mfma_f32_16x16x32_bf16((a), (b), (c), 0, 0, 0)
#define MFMA32(a, b, c) __builtin_amdgcn_mfma_f32_32x32x16_bf16((a), (b), (c), 0, 0, 0)

template <class RowMap>
DI void transpose_item(const float* W, int ldw, int k0, int c0, bf16* dst, int ldd, RowMap rowmap, LAS float* scr, int lane) {
#pragma unroll 8
    for (int i = 0; i < 32; ++i) { const int kk = 2 * i + (lane >> 5); scr[kk * 33 + (lane & 31)] = W[(size_t)(k0 + kk) * ldw + c0 + (lane & 31)]; }
    LDS_WAIT(); asm volatile("" ::: "memory");
    const int c = lane & 7;
#pragma unroll
    for (int j = 0; j < 4; ++j) { const int n = (lane >> 3) + 8 * j; const LAS float* s = scr + (8 * c) * 33 + n;
        v4u o; o.x = pk2(s[0 * 33], s[1 * 33]); o.y = pk2(s[2 * 33], s[3 * 33]); o.z = pk2(s[4 * 33], s[5 * 33]); o.w = pk2(s[6 * 33], s[7 * 33]);
        *(v4u*)(dst + (size_t)rowmap(n) * ldd + k0 + 8 * c) = o; }
    LDS_WAIT(); asm volatile("" ::: "memory");
}
struct Ins { const float* in[21]; };
DI void p0_prologue(const Frame& F, const Ins& I) {
    LAS float* scr = (LAS float*)(F.lds + RING_OFF + F.wave * 16384);
    const int gw = F.vcu * NWAVES + F.wave, NGW = F.G * NWAVES, lane = F.lane;
    bf16* W1T = (bf16*)(F.ws + WS_W1T); bf16* WBGT = (bf16*)(F.ws + WS_WBGT); bf16* WPGT = (bf16*)(F.ws + WS_WPGT); bf16* WPAT = (bf16*)(F.ws + WS_WPAT); bf16* WOUTT = (bf16*)(F.ws + WS_WOUTT);
    bf16* EXPGU = (bf16*)(F.dout + DO_EXPGU); bf16* EXPDN = (bf16*)(F.dout + DO_EXPDN);
    constexpr int I_IN = 16 * 208, I_BG = 16 * 64, I_PG = 8 * 32, I_PA = 8 * 32, I_OUT = 16 * 32, I_GU = 32 * 2 * 16 * 16, I_DN = 32 * 8 * 32;
    constexpr int NITEMS = I_IN + I_BG + I_PG + I_PA + I_OUT + I_GU + I_DN;
    for (int it = gw; it < NITEMS; it += NGW) {
        int r = it;
        if (r < I_IN) { const int kb = r / 208, nb = r % 208; const int n0 = nb < 64 ? nb * 32 : (nb - 64) * 32 + 2560; const int c0 = nb < 64 ? n0 : n0 - 496;
            transpose_item(I.in[2], IN_COLS, kb * 64, c0, W1T, 1024, [=](int n) { return n0 + n; }, scr, lane); continue; } r -= I_IN;
        if (r < I_BG) { const int kb = r / 64, nb = r % 64; transpose_item(I.in[10], 2048, kb * 64, nb * 32, WBGT, 1024, [=](int n) { return nb * 32 + n; }, scr, lane); continue; } r -= I_BG;
        if (r < I_PG) { const int kb = r / 32, nb = r % 32; transpose_item(I.in[8], 1024, kb * 64, nb * 32, WPGT, 512, [=](int n) { return nb * 32 + n; }, scr, lane); continue; } r -= I_PG;
        if (r < I_PA) { const int kb = r / 32, nb = r % 32; transpose_item(I.in[9], 1024, kb * 64, nb * 32, WPAT, 512, [=](int n) { return nb * 32 + n; }, scr, lane); continue; } r -= I_PA;
        if (r < I_OUT) { const int kb = r / 32, nb = r % 32; transpose_item(I.in[12], 1024, kb * 64, nb * 32, WOUTT, 1024, [=](int n) { return nb * 32 + n; }, scr, lane); continue; } r -= I_OUT;
        if (r < I_GU) { const int e = r / 512, q = r % 512, up = q >> 8, kb = (q >> 4) & 15, nb = q & 15;
            const float* src = (up ? I.in[19] : I.in[18]) + (size_t)e * 1024 * 512;
            transpose_item(src, 512, kb * 64, nb * 32, EXPGU + (size_t)e * 1024 * 1024, 1024, [=](int n) { const int c = nb * 32 + n; return (c >> 2) * 8 + (c & 3) + 4 * up; }, scr, lane); continue; } r -= I_GU;
        { const int e = r / 256, q = r % 256, kb = q / 32, nb = q % 32;
            transpose_item(I.in[20] + (size_t)e * 512 * 1024, 1024, kb * 64, nb * 32, EXPDN + (size_t)e * 1024 * 512, 512, [=](int n) { return nb * 32 + n; }, scr, lane); }
    }
    { const float* win = I.in[2]; const float* wa2 = I.in[3];
      for (int e = (F.vcu * NTHR + F.tid); e < 512 * 1024; e += F.G * NTHR) { const int k = e & 1023, n = e >> 10; const float* wr = win + (size_t)k * IN_COLS + 2048;
          float s = 0.f;
#pragma unroll
          for (int j = 0; j < 16; ++j) s += wr[j] * wa2[j * 512 + n];
          W1T[(size_t)(2048 + n) * 1024 + k] = f2bf(s); } }
    { bf16* WRH = (bf16*)(F.ws + WS_WRH); bf16* WRL = WRH + 48 * 1024; const float* wrg = I.in[14]; const float* wre = I.in[16];
      for (int e = (F.vcu * NTHR + F.tid); e < 48 * 1024; e += F.G * NTHR) { const int k = e & 1023, n = e >> 10;
          const float w = n < 4 ? wrg[k * 4 + n] : (n < 36 ? wre[k * 32 + n - 4] : 0.f); const bf16 h = f2bf(w); WRH[e] = h; WRL[e] = f2bf(w - bf2f(h)); } }
    { const float* x = I.in[0]; const float* g1 = I.in[1]; bf16* XN = (bf16*)(F.ws + WS_XN);
      f32x4 gv[4];
#pragma unroll
      for (int j = 0; j < 4; ++j) gv[j] = *(const f32x4*)(g1 + 4 * lane + 256 * j);
      for (int m = gw; m < T; m += NGW) { const f32x4* xr = (const f32x4*)(x + (size_t)m * D) + lane; f32x4 v[4]; float s = 0.f;
#pragma unroll
          for (int j = 0; j < 4; ++j) { v[j] = xr[64 * j]; s += (v[j].x * v[j].x + v[j].y * v[j].y) + (v[j].z * v[j].z + v[j].w * v[j].w); }
          const float rinv = __frsqrt_rn(wave_sum(s) * (1.f / D) + EPS);
          v2u* o8 = (v2u*)(XN + (size_t)m * D) + lane;
#pragma unroll
          for (int j = 0; j < 4; ++j) { v2u o; o.x = pk2(v[j].x * rinv * gv[j].x, v[j].y * rinv * gv[j].y); o.y = pk2(v[j].z * rinv * gv[j].z, v[j].w * rinv * gv[j].w); o8[64 * j] = o; } } }
}

DI void qk_norm_phase(const Frame& F, const float* gq, const float* gk) {
    const int gw = F.vcu * NWAVES + F.wave, NGW = F.G * NWAVES, lane = F.lane;
    bf16* Q = (bf16*)(F.ws + WS_DILQ);
    for (int rr = gw; rr < 6 * T; rr += NGW) { const int which = rr / T; const int gi = which % 3; const bool isq = which < 3;
        bf16* p = Q + (size_t)rr * 512 + 8 * lane; const v4u v = *(const v4u*)p;
        float x[8] = {bflo(v.x), bfhi(v.x), bflo(v.y), bfhi(v.y), bflo(v.z), bfhi(v.z), bflo(v.w), bfhi(v.w)};
        float s = 0.f;
#pragma unroll
        for (int j = 0; j < 8; ++j) s += x[j] * x[j];
        s += __shfl_xor(s, 1); s += __shfl_xor(s, 2); s += __shfl_xor(s, 4); s += __shfl_xor(s, 8);
        const float rinv = __frsqrt_rn(s * (1.f / 128.f) + EPS) * (isq ? 0.08838834764831845f * LOG2E : 1.f);
        const float* g = (isq ? gq : gk) + gi * 128 + (8 * lane & 127);
        const f32x4 g0 = *(const f32x4*)g, g1 = *(const f32x4*)(g + 4);
        v4u o; o.x = pk2(x[0] * rinv * g0.x, x[1] * rinv * g0.y); o.y = pk2(x[2] * rinv * g0.z, x[3] * rinv * g0.w); o.z = pk2(x[4] * rinv * g1.x, x[5] * rinv * g1.y); o.w = pk2(x[6] * rinv * g1.z, x[7] * rinv * g1.w);
        *(v4u*)p = o; }
}

DI int crow(int i, int h) { return (i & 3) + 8 * (i >> 2) + 4 * h; }
DI void attn_job(const Frame& F, int job) {
    const int lane = F.lane, r = lane & 31, h = lane >> 5;
    const int gi = job >> 12; int rem = job & 4095;
    const int sh = 2 * gi, d = 1 << sh, L = SEQ >> sh, nqt = L >> 5;
    const int qt = rem % nqt; rem /= nqt; const int res = rem & (d - 1); rem >>= sh; const int head = rem & 3, b = rem >> 2;
    const int p0 = qt * 32;
    const float slope = exp2f(-8.f * (float)(gi * 4 + head + 1) / 12.f) * LOG2E * (float)d;
    bf16* Qg = (bf16*)(F.ws + WS_DILQ) + (size_t)gi * T * 512;
    const bf16* Kg = (const bf16*)(F.ws + WS_DILK) + (size_t)gi * T * 512;
    const bf16* VT = (const bf16*)(F.ws + WS_DILVT) + (size_t)gi * T * 512 + ((size_t)(b * 4 + head) * 128 << 13) + (size_t)res * L;
    const size_t qtok = (size_t)b * SEQ + (size_t)(p0 + r) * d + res;
    bf16x8 qf[8];
#pragma unroll
    for (int ks = 0; ks < 8; ++ks) qf[ks] = *(const bf16x8*)(Qg + qtok * 512 + head * 128 + 16 * ks + 8 * h);
    f32x16 O[4];
#pragma unroll
    for (int db = 0; db < 4; ++db)
#pragma unroll
        for (int i = 0; i < 16; ++i) O[db][i] = 0.f;
    float m = -1e30f, l = 0.f;
#pragma unroll 1
    for (int kt = 0; kt < 5; ++kt) { const int kb = p0 - 128 + 32 * kt; if (kb < 0) continue;
        const size_t ktok = (size_t)b * SEQ + (size_t)(kb + r) * d + res;
        f32x16 s;
#pragma unroll
        for (int i = 0; i < 16; ++i) s[i] = 0.f;
#pragma unroll
        for (int ks = 0; ks < 8; ++ks) { const bf16x8 kf = *(const bf16x8*)(Kg + ktok * 512 + head * 128 + 16 * ks + 8 * h); s = MFMA32(kf, qf[ks], s); }
        float mx = -1e30f; const int dq = p0 + r - kb;
#pragma unroll
        for (int i = 0; i < 16; ++i) { const int dist = dq - crow(i, h); const bool ok = dist >= 0 && dist <= 128; const float sv = ok ? s[i] - slope * (float)dist : -1e30f; s[i] = sv; mx = fmaxf(mx, sv); }
        mx = fmaxf(mx, __shfl_xor(mx, 32));
        const float mn = fmaxf(m, mx), alpha = exp2f(m - mn); m = mn;
        float ps = 0.f;
#pragma unroll
        for (int i = 0; i < 16; ++i) { const float p = s[i] > -1e29f ? exp2f(s[i] - mn) : 0.f; s[i] = p; ps += p; }
        l = l * alpha + ps;
#pragma unroll
        for (int db = 0; db < 4; ++db)
#pragma unroll
            for (int i = 0; i < 16; ++i) O[db][i] *= alpha;
        bf16x8 pb[2];
#pragma unroll
        for (int si = 0; si < 2; ++si) { v4u w; w.x = pk2(s[8 * si], s[8 * si + 1]); w.y = pk2(s[8 * si + 2], s[8 * si + 3]); w.z = pk2(s[8 * si + 4], s[8 * si + 5]); w.w = pk2(s[8 * si + 6], s[8 * si + 7]); pb[si] = __builtin_bit_cast(bf16x8, w); }
#pragma unroll
        for (int db = 0; db < 4; ++db)
#pragma unroll
            for (int si = 0; si < 2; ++si) { const bf16x8 vf = *(const bf16x8*)(VT + ((size_t)(32 * db + r) << 13) + kb + 16 * si + 8 * h); O[db] = MFMA32(vf, pb[si], O[db]); }
    }
    const float lt = l + __shfl_xor(l, 32), inv = 1.f / lt;
    bf16* op = Qg + qtok * 512 + head * 128 + 4 * h;
#pragma unroll
    for (int db = 0; db < 4; ++db)
#pragma unroll
        for (int q4 = 0; q4 < 4; ++q4) { v2u o; o.x = pk2(O[db][4 * q4] * inv, O[db][4 * q4 + 1] * inv); o.y = pk2(O[db][4 * q4 + 2] * inv, O[db][4 * q4 + 3] * inv); *(v2u*)(op + 32 * db + 8 * q4) = o; }
    if (h == 0) ((float*)(F.ws + WS_LSE))[(size_t)gi * T * 4 + qtok * 4 + head] = m + log2f(lt);
}

constexpr int G_QS = 0, G_KS = 17408, G_KET = 34816, G_VT = 53248, G_ATT = 71680, G_TOT = 80896, G_DL = 82944, G_OS = 84992;
constexpr int QS_LD = 136, KT_LD = 72, OS_LD = 132;
DI void gla_pass1(const Frame& F, int item) {
    const int tid = F.tid, lane = F.lane, w = F.wave, fr = lane & 15, g = lane >> 4;
    const int seg = item & (NSEG - 1), bh = item >> 4, hh = bh & 3, b = bh >> 2;
    const int dk = tid & 127, qr = tid >> 7;
    LAS bf16* Qs = (LAS bf16*)(F.lds + G_QS); LAS bf16* Ks = (LAS bf16*)(F.lds + G_KS); LAS bf16* KEt = (LAS bf16*)(F.lds + G_KET); LAS bf16* Vt = (LAS bf16*)(F.lds + G_VT);
    LAS bf16* Att = (LAS bf16*)(F.lds + G_ATT); LAS float* tot = (LAS float*)(F.lds + G_TOT); LAS float* Dl = (LAS float*)(F.lds + G_DL);
    const bf16* GQ = (const bf16*)(F.ws + WS_GLAQ); const bf16* GK = (const bf16*)(F.ws + WS_GLAK); const bf16* LA = (const bf16*)(F.ws + WS_LOGA); bf16* GV = (bf16*)(F.ws + WS_GLAV);
    f32x4 S[8];
#pragma unroll
    for (int a = 0; a < 8; ++a) S[a] = (f32x4){0.f, 0.f, 0.f, 0.f};
    float Btot = 0.f;
    const int dv0 = 16 * w;
#pragma unroll 1
    for (int ch = 0; ch < TSEG / 64; ++ch) {
        const size_t tokbase = (size_t)b * SEQ + seg * TSEG + ch * 64;
        const size_t gofs = (tokbase + 16 * qr) * 512 + hh * 128 + dk;
        float la[16], qv[16], kv[16]; bf16 vv[16];
#pragma unroll
        for (int i4 = 0; i4 < 4; ++i4) { const bf16* pl = LA + gofs + (size_t)i4 * 2048; const bf16* pq = GQ + gofs + (size_t)i4 * 2048; const bf16* pk = GK + gofs + (size_t)i4 * 2048; const bf16* pv = GV + gofs + (size_t)i4 * 2048;
#pragma unroll
            for (int j = 0; j < 4; ++j) { la[4 * i4 + j] = bf2f(pl[j * 512]); qv[4 * i4 + j] = bf2f(pq[j * 512]); kv[4 * i4 + j] = bf2f(pk[j * 512]); vv[4 * i4 + j] = pv[j * 512]; } }
#pragma unroll
        for (int i = 1; i < 16; ++i) la[i] += la[i - 1];
        tot[qr * 128 + dk] = la[15];
        { v4u v0, v1; v0.x = vv[0] | ((unsigned)vv[1] << 16); v0.y = vv[2] | ((unsigned)vv[3] << 16); v0.z = vv[4] | ((unsigned)vv[5] << 16); v0.w = vv[6] | ((unsigned)vv[7] << 16);
          v1.x = vv[8] | ((unsigned)vv[9] << 16); v1.y = vv[10] | ((unsigned)vv[11] << 16); v1.z = vv[12] | ((unsigned)vv[13] << 16); v1.w = vv[14] | ((unsigned)vv[15] << 16);
          *(LAS v4u*)(Vt + dk * KT_LD + 16 * qr) = v0; *(LAS v4u*)(Vt + dk * KT_LD + 16 * qr + 8) = v1; }
        __syncthreads();
        const float t0 = tot[dk], t1 = tot[128 + dk], t2 = tot[256 + dk], t3 = tot[384 + dk];
        const float base = (qr > 0 ? t0 : 0.f) + (qr > 1 ? t1 : 0.f) + (qr > 2 ? t2 : 0.f), blast = (t0 + t1) + (t2 + t3);
        Btot += blast;
        if (qr == 0) Dl[dk] = __expf(blast);
        { unsigned ke[8];
#pragma unroll
          for (int i = 0; i < 16; i += 2) { const float b0 = base + la[i], b1 = base + la[i + 1]; const float e0 = __expf(b0), e1 = __expf(b1);
              Qs[(16 * qr + i) * QS_LD + dk] = f2bf(qv[i] * 0.08838834764831845f * e0); Qs[(16 * qr + i + 1) * QS_LD + dk] = f2bf(qv[i + 1] * 0.08838834764831845f * e1);
              Ks[(16 * qr + i) * QS_LD + dk] = f2bf(kv[i] / e0); Ks[(16 * qr + i + 1) * QS_LD + dk] = f2bf(kv[i + 1] / e1);
              ke[i >> 1] = pk2(kv[i] * __expf(blast - b0), kv[i + 1] * __expf(blast - b1)); }
          v4u k0 = {ke[0], ke[1], ke[2], ke[3]}, k1 = {ke[4], ke[5], ke[6], ke[7]};
          *(LAS v4u*)(KEt + dk * KT_LD + 16 * qr) = k0; *(LAS v4u*)(KEt + dk * KT_LD + 16 * qr + 8) = k1; }
        __syncthreads();
#pragma unroll
        for (int tt = 0; tt < 2; ++tt) { const int n = 2 * w + tt, jt = n >> 2, it = n & 3; f32x4 a4 = {0.f, 0.f, 0.f, 0.f};
#pragma unroll
            for (int s = 0; s < 4; ++s) { const bf16x8 ka = *(const LAS bf16x8*)(Ks + (16 * jt + fr) * QS_LD + 32 * s + 8 * g); const bf16x8 qb = *(const LAS bf16x8*)(Qs + (16 * it + fr) * QS_LD + 32 * s + 8 * g); a4 = MFMA16(ka, qb, a4); }
            const int tj = 16 * jt + 4 * g, ti = 16 * it + fr;
            v2u o; o.x = pk2(tj <= ti ? a4[0] : 0.f, tj + 1 <= ti ? a4[1] : 0.f); o.y = pk2(tj + 2 <= ti ? a4[2] : 0.f, tj + 3 <= ti ? a4[3] : 0.f);
            *(LAS v2u*)(Att + ti * KT_LD + tj) = o; }
        __syncthreads();
        bf16x8 Sb[4];
#pragma unroll
        for (int s = 0; s < 4; ++s) { v4u p; p.x = pk2(S[2 * s][0], S[2 * s][1]); p.y = pk2(S[2 * s][2], S[2 * s][3]); p.z = pk2(S[2 * s + 1][0], S[2 * s + 1][1]); p.w = pk2(S[2 * s + 1][2], S[2 * s + 1][3]); Sb[s] = __builtin_bit_cast(bf16x8, p); }
        bf16x8 Vf[2];
#pragma unroll
        for (int ks = 0; ks < 2; ++ks) Vf[ks] = *(const LAS bf16x8*)(Vt + (dv0 + fr) * KT_LD + 32 * ks + 8 * g);
#pragma unroll
        for (int it = 0; it < 4; ++it) { f32x4 o = {0.f, 0.f, 0.f, 0.f};
#pragma unroll
            for (int s = 0; s < 4; ++s) { const bf16x4 lo = *(const LAS bf16x4*)(Qs + (16 * it + fr) * QS_LD + 32 * s + 4 * g); const bf16x4 hi = *(const LAS bf16x4*)(Qs + (16 * it + fr) * QS_LD + 32 * s + 16 + 4 * g);
                const bf16x8 qa = __builtin_shufflevector(lo, hi, 0, 1, 2, 3, 4, 5, 6, 7); o = MFMA16(qa, Sb[s], o); }
#pragma unroll
            for (int ks = 0; ks < 2; ++ks) { const bf16x8 aa = *(const LAS bf16x8*)(Att + (16 * it + fr) * KT_LD + 32 * ks + 8 * g); o = MFMA16(aa, Vf[ks], o); }
            bf16* op = GV + (tokbase + 16 * it + 4 * g) * 512 + hh * 128 + dv0 + fr;
#pragma unroll
            for (int rr = 0; rr < 4; ++rr) op[(size_t)rr * 512] = f2bf(o[rr]); }
#pragma unroll
        for (int a = 0; a < 8; ++a) { const f32x4 dsc = *(const LAS f32x4*)(Dl + 16 * a + 4 * g); S[a] = S[a] * dsc;
#pragma unroll
            for (int ks = 0; ks < 2; ++ks) { const bf16x8 ka = *(const LAS bf16x8*)(KEt + (16 * a + fr) * KT_LD + 32 * ks + 8 * g); S[a] = MFMA16(ka, Vf[ks], S[a]); } }
        __syncthreads();
    }
    v2u* LB = (v2u*)(F.ws + WS_LB) + (size_t)item * 4096 + w * 512 + lane;
#pragma unroll
    for (int a = 0; a < 8; ++a) { v2u o; o.x = pk2(S[a][0], S[a][1]); o.y = pk2(S[a][2], S[a][3]); LB[a * 64] = o; }
    if (qr == 0) ((float*)(F.ws + WS_DSEG))[item * 128 + dk] = __expf(Btot);
}

DI void gla_pass2(const Frame& F, int item, const float* gnorm) {
    const int tid = F.tid, lane = F.lane, w = F.wave, fr = lane & 15, g = lane >> 4;
    const int seg = item & (NSEG - 1), bh = item >> 4, hh = bh & 3, b = bh >> 2;
    const int dk = tid & 127, qr = tid >> 7, dv0 = 16 * w;
    LAS bf16* Qs = (LAS bf16*)(F.lds + G_QS); LAS float* tot = (LAS float*)(F.lds + G_TOT); LAS float* Os = (LAS float*)(F.lds + G_OS);
    const bf16* GQ = (const bf16*)(F.ws + WS_GLAQ); const bf16* LA = (const bf16*)(F.ws + WS_LOGA); bf16* GV = (bf16*)(F.ws + WS_GLAV); const bf16* R = (const bf16*)(F.dout + DO_R);
    f32x4 Sc[8];
#pragma unroll
    for (int a = 0; a < 8; ++a) Sc[a] = (f32x4){0.f, 0.f, 0.f, 0.f};
#pragma unroll 1
    for (int sp = 0; sp < seg; ++sp) { const int it2 = bh * NSEG + sp; const v2u* LB = (const v2u*)(F.ws + WS_LB) + (size_t)it2 * 4096 + w * 512 + lane; const float* DS = (const float*)(F.ws + WS_DSEG) + it2 * 128 + 4 * g;
#pragma unroll
        for (int a = 0; a < 8; ++a) { const f32x4 dsc = *(const f32x4*)(DS + 16 * a); const v2u lv = LB[a * 64];
            Sc[a][0] = Sc[a][0] * dsc[0] + bflo(lv.x); Sc[a][1] = Sc[a][1] * dsc[1] + bfhi(lv.x); Sc[a][2] = Sc[a][2] * dsc[2] + bflo(lv.y); Sc[a][3] = Sc[a][3] * dsc[3] + bfhi(lv.y); } }
    bf16x8 Sb[4];
#pragma unroll
    for (int s = 0; s < 4; ++s) { v4u p; p.x = pk2(Sc[2 * s][0], Sc[2 * s][1]); p.y = pk2(Sc[2 * s][2], Sc[2 * s][3]); p.z = pk2(Sc[2 * s + 1][0], Sc[2 * s + 1][1]); p.w = pk2(Sc[2 * s + 1][2], Sc[2 * s + 1][3]); Sb[s] = __builtin_bit_cast(bf16x8, p); }
    float Bcum = 0.f;
    const int tk = tid >> 3, pc = tid & 7;
    f32x4 gn[4];
#pragma unroll
    for (int j = 0; j < 4; ++j) gn[j] = *(const f32x4*)(gnorm + 16 * pc + 4 * j);
#pragma unroll 1
    for (int ch = 0; ch < TSEG / 64; ++ch) {
        const size_t tokbase = (size_t)b * SEQ + seg * TSEG + ch * 64;
        const size_t gofs = (tokbase + 16 * qr) * 512 + hh * 128 + dk;
        float la[16], qv[16];
#pragma unroll
        for (int i4 = 0; i4 < 4; ++i4) { const bf16* pl = LA + gofs + (size_t)i4 * 2048; const bf16* pq = GQ + gofs + (size_t)i4 * 2048;
#pragma unroll
            for (int j = 0; j < 4; ++j) { la[4 * i4 + j] = bf2f(pl[j * 512]); qv[4 * i4 + j] = bf2f(pq[j * 512]); } }
#pragma unroll
        for (int i = 1; i < 16; ++i) la[i] += la[i - 1];
        tot[qr * 128 + dk] = la[15];
        __syncthreads();
        const float t0 = tot[dk], t1 = tot[128 + dk], t2 = tot[256 + dk], t3 = tot[384 + dk];
        const float base = Bcum + (qr > 0 ? t0 : 0.f) + (qr > 1 ? t1 : 0.f) + (qr > 2 ? t2 : 0.f);
        Bcum += (t0 + t1) + (t2 + t3);
#pragma unroll
        for (int i = 0; i < 16; ++i) Qs[(16 * qr + i) * QS_LD + dk] = f2bf(qv[i] * 0.08838834764831845f * __expf(base + la[i]));
        __syncthreads();
#pragma unroll
        for (int it = 0; it < 4; ++it) { f32x4 o = {0.f, 0.f, 0.f, 0.f};
            if (seg > 0) {
#pragma unroll
                for (int s = 0; s < 4; ++s) { const bf16x4 lo = *(const LAS bf16x4*)(Qs + (16 * it + fr) * QS_LD + 32 * s + 4 * g); const bf16x4 hi = *(const LAS bf16x4*)(Qs + (16 * it + fr) * QS_LD + 32 * s + 16 + 4 * g);
                    const bf16x8 qa = __builtin_shufflevector(lo, hi, 0, 1, 2, 3, 4, 5, 6, 7); o = MFMA16(qa, Sb[s], o); } }
            const bf16* op = GV + (tokbase + 16 * it + 4 * g) * 512 + hh * 128 + dv0 + fr;
#pragma unroll
            for (int rr = 0; rr < 4; ++rr) Os[(16 * it + 4 * g + rr) * OS_LD + dv0 + fr] = o[rr] + bf2f(op[(size_t)rr * 512]); }
        __syncthreads();
        { f32x4 v[4]; float ss = 0.f;
#pragma unroll
          for (int j = 0; j < 4; ++j) { v[j] = *(const LAS f32x4*)(Os + tk * OS_LD + 16 * pc + 4 * j); ss += (v[j].x * v[j].x + v[j].y * v[j].y) + (v[j].z * v[j].z + v[j].w * v[j].w); }
          ss += __shfl_xor(ss, 1); ss += __shfl_xor(ss, 2); ss += __shfl_xor(ss, 4);
          const float rinv = __frsqrt_rn(ss * (1.f / 128.f) + EPS);
          const size_t ofs = (tokbase + tk) * 512 + hh * 128 + 16 * pc;
          const v4u r0 = *(const v4u*)(R + ofs), r1 = *(const v4u*)(R + ofs + 8);
          v4u o0, o1;
          o0.x = pk2(v[0].x * rinv * gn[0].x * bflo(r0.x), v[0].y * rinv * gn[0].y * bfhi(r0.x)); o0.y = pk2(v[0].z * rinv * gn[0].z * bflo(r0.y), v[0].w * rinv * gn[0].w * bfhi(r0.y));
          o0.z = pk2(v[1].x * rinv * gn[1].x * bflo(r0.z), v[1].y * rinv * gn[1].y * bfhi(r0.z)); o0.w = pk2(v[1].z * rinv * gn[1].z * bflo(r0.w), v[1].w * rinv * gn[1].w * bfhi(r0.w));
          o1.x = pk2(v[2].x * rinv * gn[2].x * bflo(r1.x), v[2].y * rinv * gn[2].y * bfhi(r1.x)); o1.y = pk2(v[2].z * rinv * gn[2].z * bflo(r1.y), v[2].w * rinv * gn[2].w * bfhi(r1.y));
          o1.z = pk2(v[3].x * rinv * gn[3].x * bflo(r1.z), v[3].y * rinv * gn[3].y * bfhi(r1.z)); o1.w = pk2(v[3].z * rinv * gn[3].z * bflo(r1.w), v[3].w * rinv * gn[3].w * bfhi(r1.w));
          *(v4u*)(GV + ofs) = o0; *(v4u*)(GV + ofs + 8) = o1; }
        __syncthreads();
    }
}
DI void attn_merge_phase(const Frame& F) {
    const int gw = F.vcu * NWAVES + F.wave, NGW = F.G * NWAVES, lane = F.lane, head = lane >> 4;
    bf16* O0 = (bf16*)(F.ws + WS_DILQ); const float* LSE = (const float*)(F.ws + WS_LSE);
    for (int t = gw; t < T; t += NGW) {
        const float l0 = LSE[(size_t)t * 4 + head], l1 = LSE[(size_t)T * 4 + (size_t)t * 4 + head], l2 = LSE[(size_t)2 * T * 4 + (size_t)t * 4 + head];
        const float M = fmaxf(l0, fmaxf(l1, l2)); float w0 = exp2f(l0 - M), w1 = exp2f(l1 - M), w2 = exp2f(l2 - M); const float inv = 1.f / (w0 + w1 + w2); w0 *= inv; w1 *= inv; w2 *= inv;
        bf16* p = O0 + (size_t)t * 512 + 8 * lane; const v4u a = *(const v4u*)p, bq = *(const v4u*)(p + (size_t)T * 512), c = *(const v4u*)(p + (size_t)2 * T * 512);
        v4u o;
        o.x = pk2(w0 * bflo(a.x) + w1 * bflo(bq.x) + w2 * bflo(c.x), w0 * bfhi(a.x) + w1 * bfhi(bq.x) + w2 * bfhi(c.x));
        o.y = pk2(w0 * bflo(a.y) + w1 * bflo(bq.y) + w2 * bflo(c.y), w0 * bfhi(a.y) + w1 * bfhi(bq.y) + w2 * bfhi(c.y));
        o.z = pk2(w0 * bflo(a.z) + w1 * bflo(bq.z) + w2 * bflo(c.z), w0 * bfhi(a.z) + w1 * bfhi(bq.z) + w2 * bfhi(c.z));
        o.w = pk2(w0 * bflo(a.w) + w1 * bflo(bq.w) + w2 * bflo(c.w), w0 * bfhi(a.w) + w1 * bfhi(bq.w) + w2 * bfhi(c.w));
        *(v4u*)p = o; }
}

DI void router_phase(const Frame& F, const float* g2, const float* brg, const float* bre, unsigned* gcnt) {
    const int lane = F.lane, w = F.wave, fr = lane & 15, g = lane >> 4;
    const float* X1 = (const float*)(F.ws + WS_X1); bf16* H2 = (bf16*)(F.ws + WS_H2);
    const bf16* WRH = (const bf16*)(F.ws + WS_WRH); const bf16* WRL = WRH + 48 * 1024;
    int* TOKE = (int*)(F.ws + WS_TOKE); float* TOKW = (float*)(F.ws + WS_TOKW); int* TOKR = (int*)(F.ws + WS_TOKR);
    LAS float* lg = (LAS float*)(F.lds + w * 4096);
    LAS int* cnt = (LAS int*)(F.lds + 65536); LAS int* basev = cnt + 32;
    for (int it = 0; it * F.G * 128 < T; ++it) {
        const int tok0 = (it * F.G + F.vcu) * 128 + w * 16;
        if (F.tid < 32) cnt[F.tid] = 0;
        __syncthreads();
        f32x4 acc[3]; acc[0] = acc[1] = acc[2] = (f32x4){0.f, 0.f, 0.f, 0.f};
        float ss = 0.f;
        const float* xr = X1 + (size_t)(tok0 + fr) * D + 8 * g;
        for (int s = 0; s < 32; ++s) {
            const f32x4 xa = *(const f32x4*)(xr + 32 * s), xb = *(const f32x4*)(xr + 32 * s + 4);
            const f32x4 ga = *(const f32x4*)(g2 + 32 * s + 8 * g), gb = *(const f32x4*)(g2 + 32 * s + 8 * g + 4);
            ss += (xa.x * xa.x + xa.y * xa.y) + (xa.z * xa.z + xa.w * xa.w) + (xb.x * xb.x + xb.y * xb.y) + (xb.z * xb.z + xb.w * xb.w);
            const f32x4 ya = xa * ga, yb = xb * gb;
            v4u hi; hi.x = pk2(ya.x, ya.y); hi.y = pk2(ya.z, ya.w); hi.z = pk2(yb.x, yb.y); hi.w = pk2(yb.z, yb.w);
            v4u lo; lo.x = pk2(ya.x - bflo(hi.x), ya.y - bfhi(hi.x)); lo.y = pk2(ya.z - bflo(hi.y), ya.w - bfhi(hi.y)); lo.z = pk2(yb.x - bflo(hi.z), yb.y - bfhi(hi.z)); lo.w = pk2(yb.z - bflo(hi.w), yb.w - bfhi(hi.w));
            const bf16x8 ah = __builtin_bit_cast(bf16x8, hi), al = __builtin_bit_cast(bf16x8, lo);
#pragma unroll
            for (int nt = 0; nt < 3; ++nt) { const bf16x8 bh = *(const bf16x8*)(WRH + (size_t)(16 * nt + fr) * 1024 + 32 * s + 8 * g), bl = *(const bf16x8*)(WRL + (size_t)(16 * nt + fr) * 1024 + 32 * s + 8 * g);
                acc[nt] = MFMA16(ah, bh, acc[nt]); acc[nt] = MFMA16(ah, bl, acc[nt]); acc[nt] = MFMA16(al, bh, acc[nt]); }
        }
        ss += __shfl_xor(ss, 16); ss += __shfl_xor(ss, 32);
        const float rinv = __frsqrt_rn(ss * (1.f / D) + EPS);
#pragma unroll
        for (int rr = 0; rr < 4; ++rr) { const float ri = __shfl(rinv, 4 * g + rr);
#pragma unroll
            for (int nt = 0; nt < 3; ++nt) lg[(4 * g + rr) * 48 + 16 * nt + fr] = acc[nt][rr] * ri; }
        { bf16* hr = H2 + (size_t)(tok0 + fr) * D + 8 * g;
          for (int s = 0; s < 32; ++s) { const f32x4 xa = *(const f32x4*)(xr + 32 * s), xb = *(const f32x4*)(xr + 32 * s + 4);
              const f32x4 ga = *(const f32x4*)(g2 + 32 * s + 8 * g), gb = *(const f32x4*)(g2 + 32 * s + 8 * g + 4);
              v4u o; o.x = pk2(xa.x * rinv * ga.x, xa.y * rinv * ga.y); o.y = pk2(xa.z * rinv * ga.z, xa.w * rinv * ga.w); o.z = pk2(xb.x * rinv * gb.x, xb.y * rinv * gb.y); o.w = pk2(xb.z * rinv * gb.z, xb.w * rinv * gb.w);
              *(v4u*)(hr + 32 * s) = o; } }
        LDS_WAIT(); asm volatile("" ::: "memory");
        int e1 = 0, e2 = 0, lr1 = 0, lr2 = 0; float w1 = 0.f, w2 = 0.f;
        if (lane < 16) { const LAS float* q = lg + lane * 48;
            float gl[4]; int gs = 0; float gm = -3.0e38f;
#pragma unroll
            for (int j = 0; j < 4; ++j) { gl[j] = q[j] + brg[j]; if (gl[j] > gm) { gm = gl[j]; gs = j; } }
            float gsum = 0.f;
#pragma unroll
            for (int j = 0; j < 4; ++j) gsum += __expf(gl[j] - gm);
            const float gp = 1.f / gsum;
            float el[8]; int i1 = 0; float v1 = -3.0e38f;
#pragma unroll
            for (int j = 0; j < 8; ++j) { el[j] = q[4 + 8 * gs + j] + bre[8 * gs + j]; if (el[j] > v1) { v1 = el[j]; i1 = j; } }
            int i2 = 0; float v2 = -3.0e38f;
#pragma unroll
            for (int j = 0; j < 8; ++j) if (j != i1 && el[j] > v2) { v2 = el[j]; i2 = j; }
            const float p2 = 1.f / (1.f + __expf(v1 - v2)), p1 = 1.f - p2;
            e1 = 8 * gs + i1; e2 = 8 * gs + i2; w1 = p1 * gp; w2 = p2 * gp;
            lr1 = __hip_atomic_fetch_add(&cnt[e1], 1, __ATOMIC_RELAXED, __HIP_MEMORY_SCOPE_WORKGROUP); lr2 = __hip_atomic_fetch_add(&cnt[e2], 1, __ATOMIC_RELAXED, __HIP_MEMORY_SCOPE_WORKGROUP); }
        __syncthreads();
        if (F.tid < 32) basev[F.tid] = (int)atomicAdd(&gcnt[64 * F.tid], (unsigned)cnt[F.tid]);
        __syncthreads();
        if (lane < 16) { const int t = tok0 + lane; TOKE[2 * t] = e1; TOKE[2 * t + 1] = e2; TOKW[2 * t] = w1; TOKW[2 * t + 1] = w2; TOKR[2 * t] = basev[e1] + lr1; TOKR[2 * t + 1] = basev[e2] + lr2; }
        __syncthreads();
    }
}
DI void moe_assign_phase(const Frame& F, unsigned* gcnt) {
    LAS int* pst = (LAS int*)(F.lds + 65536);
    if (F.tid == 0) { int p = 0; int* BLKE = (int*)(F.ws + WS_BLKE);
        for (int e = 0; e < 32; ++e) { pst[e] = p; const int c = (int)__hip_atomic_load(&gcnt[64 * e], __ATOMIC_RELAXED, __HIP_MEMORY_SCOPE_AGENT); const int nb = (c + 255) >> 8;
            if (F.vcu == 0) for (int j = 0; j < nb; ++j) BLKE[(p >> 8) + j] = e;
            p += nb << 8; }
        if (F.vcu == 0) BLKE[NBLK_MAX] = p >> 8; }
    __syncthreads();
    const int gw = F.vcu * NWAVES + F.wave, NGW = F.G * NWAVES, lane = F.lane;
    const int* TOKE = (const int*)(F.ws + WS_TOKE); const float* TOKW = (const float*)(F.ws + WS_TOKW); const int* TOKR = (const int*)(F.ws + WS_TOKR);
    int* DEST = (int*)(F.ws + WS_DEST); float* ROWW = (float*)(F.ws + WS_ROWW);
    const bf16* H2 = (const bf16*)(F.ws + WS_H2); bf16* XP = (bf16*)(F.ws + WS_XP);
    for (int p = gw; p < 2 * T; p += NGW) { const int e = TOKE[p], dest = pst[e] + TOKR[p], t = p >> 1;
        if (lane == 0) { DEST[p] = dest; ROWW[dest] = TOKW[p]; }
        const v4u* s = (const v4u*)(H2 + (size_t)t * D); v4u* d = (v4u*)(XP + (size_t)dest * D);
        d[lane] = s[lane]; d[64 + lane] = s[64 + lane]; }
}
DI void combine_phase(const Frame& F, float* out) {
    const int gw = F.vcu * NWAVES + F.wave, NGW = F.G * NWAVES, lane = F.lane;
    const float* X1 = (const float*)(F.ws + WS_X1); const bf16* Y = (const bf16*)(F.ws + WS_Y); const int* DEST = (const int*)(F.ws + WS_DEST);
    for (int t = gw; t < T; t += NGW) { const int d0 = DEST[2 * t], d1 = DEST[2 * t + 1];
#pragma unroll
        for (int j = 0; j < 2; ++j) { const int c = 8 * lane + 512 * j;
            const f32x4 xa = *(const f32x4*)(X1 + (size_t)t * D + c), xb = *(const f32x4*)(X1 + (size_t)t * D + c + 4);
            const v4u a = *(const v4u*)(Y + (size_t)d0 * D + c), b = *(const v4u*)(Y + (size_t)d1 * D + c);
            f32x4 oa, ob;
            oa.x = xa.x + bflo(a.x) + bflo(b.x); oa.y = xa.y + bfhi(a.x) + bfhi(b.x); oa.z = xa.z + bflo(a.y) + bflo(b.y); oa.w = xa.w + bfhi(a.y) + bfhi(b.y);
            ob.x = xb.x + bflo(a.z) + bflo(b.z); ob.y = xb.y + bfhi(a.z) + bfhi(b.z); ob.z = xb.z + bflo(a.w) + bflo(b.w); ob.w = xb.w + bfhi(a.w) + bfhi(b.w);
            *(f32x4*)(out + (size_t)t * D + c) = oa; *(f32x4*)(out + (size_t)t * D + c + 4) = ob; } }
}

constexpr int PER_PHASE = 13;
struct Args { Ins I; float* out; unsigned char* ws; int ph_lo, ph_hi, li, pad; };
__global__ void __launch_bounds__(NTHR, 2) fwd_kernel(Args args) {
    extern __shared__ __attribute__((aligned(16))) unsigned char lds[];
    Frame F;
    F.lds = (LAS unsigned char*)lds;
    F.tid = threadIdx.x; F.lane = F.tid & 63; F.wave = __builtin_amdgcn_readfirstlane(F.tid >> 6);
    F.G = gridDim.x; { const int bx = blockIdx.x; F.vcu = (F.G % 8 == 0) ? (bx % 8) * (F.G / 8) + bx / 8 : bx; }
    F.ws = args.ws; F.dout = (unsigned char*)args.out;
    unsigned* ctl = (unsigned*)(args.ws + WS_CTL);
    volatile LAS unsigned* MISC = (volatile LAS unsigned*)(F.lds + MISC_OFF);
    for (int u = F.tid; u < (LDS_BYTES - LDSCTL_OFF) / 4; u += NTHR) ((LAS unsigned*)(F.lds + LDSCTL_OFF))[u] = 0u;
    __syncthreads();
    XcdBarrier bar; bar.bar = ctl + CW_BAR; bar.x = 0; bar.st = nullptr;
    if (MK_N_LAUNCHES == 1) bar = xcd_barrier_post(ctl + CW_BAR, MISC + 8);
    const int lo = args.ph_lo, hi = args.ph_hi;
#ifdef ONLY_PHASE
#define IN(k) ((k) == ONLY_PHASE && lo <= (k) && (k) < hi)
#else
#define IN(k) (lo <= (k) && (k) < hi)
#endif
#define SEAM(k) do { if (IN(k) && IN((k) + 1)) xcd_barrier(bar); } while (0)
    const Ins& I = args.I;
    unsigned char* ws = args.ws;

    if (IN(0)) { p0_prologue(F, I); SEAM(0); }

    if (IN(1)) {
        pg8::GemmDesc g{1024, 1024, 1024};
        pg8::OrderStd S{T / 256, N1 / 256, F.G, (int)blockIdx.x, (const char*)(ws + WS_XN), (const char*)(ws + WS_W1T), (size_t)256 * 1024 * 2, (size_t)256 * 1024 * 2};
        pg8::EpiP1 E{(bf16*)(ws + WS_GLAQ), (bf16*)(ws + WS_GLAK), (bf16*)(ws + WS_GLAV), (bf16*)(F.dout + DO_R), (bf16*)(ws + WS_LOGA), (bf16*)(ws + WS_DILQ), (bf16*)(ws + WS_DILK), (bf16*)(ws + WS_DILVT), I.in[4]};
        pg8::gemm_phase<pg8::EpiP1, pg8::OrderStd>(F.lds + RING_OFF, g, S, E);
        SEAM(1);
    }
    if (IN(2)) { qk_norm_phase(F, I.in[6], I.in[7]); SEAM(2); }
    if (IN(3)) {
        for (int it = F.vcu; it < 16 * NSEG; it += F.G) gla_pass1(F, it);
        const int gw = F.vcu * NWAVES + F.wave, NGW = F.G * NWAVES;
        for (int j = gw; j < 3 * 4096; j += NGW) attn_job(F, j);
        SEAM(3);
    }
    if (IN(4)) {
        for (int it = F.vcu; it < 16 * NSEG; it += F.G) gla_pass2(F, it, I.in[5]);
        attn_merge_phase(F);
        SEAM(4);
    }
    if (IN(5)) {
        pg8::GemmDesc g{1024, 1024, 1024};
        pg8::OrderStd S{T / 256, 2048 / 256, F.G, (int)blockIdx.x, (const char*)(ws + WS_XN), (const char*)(ws + WS_WBGT), (size_t)256 * 1024 * 2, (size_t)256 * 1024 * 2};
        pg8::EpiGate E{(bf16*)(ws + WS_GATES), I.in[11]};
        pg8::gemm_phase<pg8::EpiGate, pg8::OrderStd>(F.lds + RING_OFF, g, S, E);
        SEAM(5);
    }
    if (IN(6)) {
        pg8::GemmDesc g{512, 512, 512};
        pg8::OrderPair S{T / 256, 4, F.G, (int)blockIdx.x, (const char*)(ws + WS_GLAV), (const char*)(ws + WS_DILQ), (const char*)(ws + WS_WPGT), (const char*)(ws + WS_WPAT), (size_t)256 * 512 * 2, (size_t)256 * 512 * 2};
        pg8::EpiMerge E{(bf16*)(ws + WS_MERGED), (const bf16*)(ws + WS_GATES)};
        pg8::gemm_phase<pg8::EpiMerge, pg8::OrderPair>(F.lds + RING_OFF, g, S, E);
        SEAM(6);
    }
    if (IN(7)) {
        pg8::GemmDesc g{1024, 1024, 1024};
        pg8::OrderStd S{T / 256, 4, F.G, (int)blockIdx.x, (const char*)(ws + WS_MERGED), (const char*)(ws + WS_WOUTT), (size_t)256 * 1024 * 2, (size_t)256 * 1024 * 2};
        pg8::EpiX1 E{(float*)(ws + WS_X1), I.in[0]};
        pg8::gemm_phase<pg8::EpiX1, pg8::OrderStd>(F.lds + RING_OFF, g, S, E);
        SEAM(7);
    }
    if (IN(8)) { router_phase(F, I.in[13], I.in[15], I.in[17], ctl + CW_GCNT); SEAM(8); }
    if (IN(9)) { moe_assign_phase(F, ctl + CW_GCNT); SEAM(9); }
    if (IN(10)) {
        const int* BLKE = (const int*)(ws + WS_BLKE); const int nblk = BLKE[NBLK_MAX];
        pg8::GemmDesc g{1024, 1024, 1024};
        pg8::OrderMoe S{nblk, F.G, (int)blockIdx.x, BLKE, (const char*)(ws + WS_XP), (const char*)(F.dout + DO_EXPGU), (size_t)256 * 1024 * 2, (size_t)1024 * 1024 * 2, (size_t)256 * 1024 * 2};
        pg8::EpiGU E{(bf16*)(ws + WS_HBUF), (const float*)(ws + WS_ROWW)};
        pg8::gemm_phase<pg8::EpiGU, pg8::OrderMoe>(F.lds + RING_OFF, g, S, E);
        SEAM(10);
    }
    if (IN(11)) {
        const int* BLKE = (const int*)(ws + WS_BLKE); const int nblk = BLKE[NBLK_MAX];
        pg8::GemmDesc g{512, 512, 512};
        pg8::OrderMoe S{nblk, F.G, (int)blockIdx.x, BLKE, (const char*)(ws + WS_HBUF), (const char*)(F.dout + DO_EXPDN), (size_t)256 * 512 * 2, (size_t)1024 * 512 * 2, (size_t)256 * 512 * 2};
        pg8::EpiY E{(bf16*)(ws + WS_Y)};
        pg8::gemm_phase<pg8::EpiY, pg8::OrderMoe>(F.lds + RING_OFF, g, S, E);
        SEAM(11);
    }
    if (IN(12)) { combine_phase(F, args.out); }
#undef IN
#undef SEAM
}

extern "C" void kernel_launch(void* const* d_in, const int* in_sizes, int n_in, void* d_out, int out_size, void* d_ws, size_t ws_size, hipStream_t stream) {
    static int grid = 0;
    if (grid == 0) {
        if (n_in != 21 || out_size != T * D || ws_size < WS_END) { fprintf(stderr, "kernel_launch: unexpected shapes (n_in %d out %d ws %zu)\n", n_in, out_size, ws_size); grid = -1; return; }
        int dev = 0, cus = 0, per_cu = 0;
        if (hipGetDevice(&dev) != hipSuccess || hipDeviceGetAttribute(&cus, hipDeviceAttributeMultiprocessorCount, dev) != hipSuccess) { grid = -1; return; }
        if (hipFuncSetAttribute((const void*)fwd_kernel, hipFuncAttributeMaxDynamicSharedMemorySize, LDS_BYTES) != hipSuccess) { fprintf(stderr, "kernel_launch: hipFuncSetAttribute failed\n"); grid = -1; return; }
        if (hipOccupancyMaxActiveBlocksPerMultiprocessor(&per_cu, (const void*)fwd_kernel, NTHR, LDS_BYTES) != hipSuccess || per_cu < 1) fprintf(stderr, "kernel_launch: occupancy query reports %d\n", per_cu);
        (void)hipGetLastError();
        grid = cus;
    }
    if (grid < 0) return;
    if (hipMemsetAsync((char*)d_ws + WS_CTL, 0, CTL_ZERO_BYTES, stream) != hipSuccess) return;
    Args a{};
    for (int i = 0; i < 21; ++i) a.I.in[i] = (const float*)d_in[i];
    a.out = (float*)d_out; a.ws = (unsigned char*)d_ws;
    if (MK_N_LAUNCHES == 1) { a.ph_lo = 0; a.ph_hi = PER_PHASE; a.li = 0; hipLaunchKernelGGL(fwd_kernel, dim3(grid), dim3(NTHR), LDS_BYTES, stream, a); }
    else for (int li = 0; li < PER_PHASE; ++li) { a.ph_lo = li; a.ph_hi = li + 1; a.li = li; hipLaunchKernelGGL(fwd_kernel, dim3(grid), dim3(NTHR), LDS_BYTES, stream, a); }
}
```

```cpp
#include <hip/hip_runtime.h>
#include <cstdio>
#include <cstdint>

#ifndef MK_N_LAUNCHES
#define MK_N_LAUNCHES 1
#endif

#define GAS __attribute__((address_space(1)))
#define LAS __attribute__((address_space(3)))
typedef unsigned short bf16;
typedef unsigned v4u __attribute__((ext_vector_type(4)));
typedef unsigned v2u __attribute__((ext_vector_type(2)));
typedef float f32x2 __attribute__((ext_vector_type(2)));
typedef float f32x4 __attribute__((ext_vector_type(4)));
typedef float f32x16 __attribute__((ext_vector_type(16)));
typedef short bf16x8 __attribute__((ext_vector_type(8)));
typedef short bf16x4 __attribute__((ext_vector_type(4)));
typedef __bf16 hbf2 __attribute__((ext_vector_type(2)));

#define DI __device__ __forceinline__
DI unsigned pk2(float lo, float hi) { f32x2 v = {lo, hi}; hbf2 r = __builtin_convertvector(v, hbf2); return __builtin_bit_cast(unsigned, r); }
DI bf16 f2bf(float f) { return (bf16)(pk2(f, 0.f) & 0xffffu); }
DI float bf2f(bf16 b) { return __builtin_bit_cast(float, ((unsigned)b) << 16); }
DI float bflo(unsigned u) { return __builtin_bit_cast(float, u << 16); }
DI float bfhi(unsigned u) { return __builtin_bit_cast(float, u & 0xffff0000u); }

constexpr int T = 32768, D = 1024, SEQ = 8192;
constexpr int N1 = 7168;
constexpr int IN_COLS = 6672;
constexpr int NSEG = 16, TSEG = SEQ / NSEG;
constexpr float EPS = 1e-6f;
constexpr float LOG2E = 1.4426950408889634f;
constexpr int PMAX = 65536 + 32 * 256;
constexpr int NBLK_MAX = PMAX / 256;

constexpr size_t MiB = 1u << 20;
constexpr size_t WS_CTL = 0, CTL_ZERO_BYTES = 256 * 1024;
constexpr size_t WS_LB = 1 * MiB;
constexpr size_t WS_W1T = 1 * MiB;
constexpr size_t WS_WBGT = 15 * MiB, WS_WPGT = 19 * MiB, WS_WPAT = 20 * MiB, WS_WOUTT = 21 * MiB, WS_WRH = 23 * MiB;
constexpr size_t WS_XN = 24 * MiB;
constexpr size_t WS_GLAQ = 88 * MiB, WS_GLAK = 120 * MiB, WS_LOGA = 152 * MiB, WS_GLAV = 184 * MiB;
constexpr size_t WS_DILQ = 216 * MiB, WS_DILK = 312 * MiB, WS_DILVT = 408 * MiB;
constexpr size_t WS_STATS = 504 * MiB;
constexpr size_t WS_LSE = WS_STATS;
constexpr size_t WS_DSEG = WS_STATS + 1536 * 1024;
constexpr size_t WS_TOKE = WS_STATS + 2 * MiB;
constexpr size_t WS_TOKW = WS_TOKE + 256 * 1024;
constexpr size_t WS_TOKR = WS_TOKW + 256 * 1024;
constexpr size_t WS_DEST = WS_TOKR + 256 * 1024;
constexpr size_t WS_ROWW = WS_DEST + 256 * 1024;
constexpr size_t WS_BLKE = WS_ROWW + 320 * 1024;
constexpr size_t WS_END = 512 * MiB;
constexpr size_t WS_GATES = 376 * MiB;
constexpr size_t WS_MERGED = 312 * MiB;
constexpr size_t WS_X1 = 88 * MiB;
constexpr size_t WS_H2 = 24 * MiB;
constexpr size_t WS_XP = 216 * MiB;
constexpr size_t WS_HBUF = 360 * MiB;
constexpr size_t WS_Y = 216 * MiB;
constexpr size_t DO_R = 0;
constexpr size_t DO_EXPGU = 32 * MiB;
constexpr size_t DO_EXPDN = 96 * MiB;
constexpr int CW_BAR = 4096;
constexpr int CW_GCNT = 16384;

constexpr int RING_OFF = 0, RING_BYTES = 131072;
constexpr int LDSCTL_OFF = RING_BYTES, MISC_OFF = LDSCTL_OFF + 320;
constexpr int LDS_BYTES = 147456;

#define XB_TMO      128
#define XB_XCNT(j)  (256  + 64 * (j))
#define XB_XSUB(j)  (1280 + 64 * (j))
#define XB_XGEN(j)  (2304 + 64 * (j))
#define XB_TOP      3328
#define XB_TOPGEN   3392
#define XCD_BAR_WORDS 3456
#define XB_SPIN_CAP (1u << 18)
DI unsigned xb_ld(unsigned* p)              { return __hip_atomic_load(p, __ATOMIC_RELAXED, __HIP_MEMORY_SCOPE_AGENT); }
DI unsigned xb_add(unsigned* p, unsigned v) { return __hip_atomic_fetch_add(p, v, __ATOMIC_RELAXED, __HIP_MEMORY_SCOPE_AGENT); }
DI unsigned xb_xcc_id() { return (unsigned)__builtin_amdgcn_s_getreg((3 << 11) | 20) & 0xFu; }
#define XB_SPIN(cond, bar) do { unsigned _sp = 0; while (cond) { __builtin_amdgcn_s_sleep(1); \
    if ((++_sp & 255u) == 0u) { if (xb_ld(&(bar)[XB_TMO])) break; if (_sp > XB_SPIN_CAP) { atomicAdd(&(bar)[XB_TMO], 1u); break; } } } } while (0)
struct XcdBarrier { unsigned* bar; unsigned x; volatile LAS unsigned* st; };
DI XcdBarrier xcd_barrier_post(unsigned* bar, volatile LAS unsigned* st) {
    XcdBarrier b; b.bar = bar; b.x = xb_xcc_id(); b.st = st;
    if (threadIdx.x == 0) (void)xb_add(&bar[XB_XCNT(b.x)], 1u);
    return b;
}
DI void xcd_barrier_complete(unsigned* bar, unsigned x, unsigned& nloc, unsigned& nx) {
    const unsigned G = gridDim.x * gridDim.y * gridDim.z;
    unsigned sum, cnt, mine, sp = 0u;
    for (;;) {
        sum = 0u; cnt = 0u; mine = 0u;
#pragma unroll
        for (unsigned j = 0; j < 16; ++j) { const unsigned c = xb_ld(&bar[XB_XCNT(j)]); sum += c; cnt += (c > 0u) ? 1u : 0u; mine = (j == x) ? c : mine; }
        if (sum == G) break;
        __builtin_amdgcn_s_sleep(1);
        if ((++sp & 255u) == 0u) { if (xb_ld(&bar[XB_TMO])) break; if (sp > XB_SPIN_CAP) { atomicAdd(&bar[XB_TMO], 1u); break; } }
    }
    nloc = mine > 0u ? mine : 1u; nx = cnt > 0u ? cnt : 1u;
}
DI void xcd_barrier(const XcdBarrier& b) {
    asm volatile("s_waitcnt vmcnt(0)" ::: "memory");
    __syncthreads();
    if (threadIdx.x == 0) {
        unsigned* bar = b.bar;
        __builtin_amdgcn_s_waitcnt(0);
        unsigned nloc = b.st[0], nx = b.st[1];
        if (nloc == 0u) { xcd_barrier_complete(bar, b.x, nloc, nx); b.st[0] = nloc; b.st[1] = nx; }
        const unsigned old = xb_add(&bar[XB_XSUB(b.x)], 1u);
        const unsigned gen = old / nloc;
        if (old + 1u == (gen + 1u) * nloc) {
            __builtin_amdgcn_fence(__ATOMIC_RELEASE, "agent");
            asm volatile("s_waitcnt vmcnt(0)" ::: "memory");
            const unsigned og = xb_add(&bar[XB_TOP], 1u);
            const unsigned tg = og / nx;
            if (og + 1u == (tg + 1u) * nx) xb_add(&bar[XB_TOPGEN], 1u);
            else XB_SPIN(xb_ld(&bar[XB_TOPGEN]) == tg, bar);
            __builtin_amdgcn_fence(__ATOMIC_ACQUIRE, "agent");
            xb_add(&bar[XB_XGEN(b.x)], 1u);
            asm volatile("s_waitcnt vmcnt(0)" ::: "memory");
        } else {
            XB_SPIN(xb_ld(&bar[XB_XGEN(b.x)]) == gen, bar);
            __builtin_amdgcn_fence(__ATOMIC_ACQUIRE, "agent");
            asm volatile("s_waitcnt vmcnt(0)" ::: "memory");
        }
    }
    __syncthreads();
}

namespace pg8 {
constexpr int BM = 256, BK = 64, HALF = 128, HTB = HALF * BK * 2, STAGE_BYTES = 8 * HTB, NXCD = 8, WGM = 8;
__host__ __device__ __forceinline__ int lds_byte(int r, int c) { const int st = (r >> 4) * 2 + (c >> 5), rr = r & 15, cc = c & 31, ob = rr * 64 + cc * 2; return st * 1024 + (ob ^ (((ob >> 9) & 1) << 5)); }
__host__ __device__ __forceinline__ void stage_rc(int b, int& R, int& C) { const int st = b / 1024, sb = b % 1024, swz = sb ^ (((sb >> 9) & 1) << 5); R = (st >> 1) * 16 + swz / 64; C = (st & 1) * 32 + (swz % 64) / 2; }
__host__ __device__ __forceinline__ int perm32(int rho) { const int n = rho >> 4, i = rho & 15; return 8 * (i >> 2) + 4 * n + (i & 3); }

struct Unit { const char* A; const char* B; int pm, pn, aux; };
struct GemmDesc { int lda, ldb, K; };

DI bool static_tile(int L, int nM, int nN, int& pm, int& pn) {
    const int nwg = nM * nN; if (L >= nwg) return false;
    int wgid = L; { const int q = nwg / NXCD, r = nwg % NXCD, xcd = wgid % NXCD, off = wgid / NXCD; wgid = (xcd < r ? xcd * (q + 1) : r * (q + 1) + (xcd - r) * q) + off; }
    const int nig = WGM * nN, gid = wgid / nig, fm = gid * WGM, gsz = (nM - fm) < WGM ? (nM - fm) : WGM;
    pm = fm + ((wgid % nig) % gsz); pn = (wgid % nig) / gsz; return true;
}
struct OrderStd {
    int nM, nN, G, c; const char* A0; const char* B0; size_t sA, sB;
    DI bool next(int i, Unit& u) const {
        int pm, pn; if (!static_tile(i * G + c, nM, nN, pm, pn)) return false;
        u.pm = pm; u.pn = pn; u.aux = 0; u.A = A0 + (size_t)pm * sA; u.B = B0 + (size_t)pn * sB; return true;
    }
};
struct OrderPair {
    int nM, nN, G, c; const char* A0; const char* A1; const char* B0; const char* B1; size_t sA, sB;
    DI bool next(int i, Unit& u) const {
        int pm, pn; if (!static_tile((i >> 1) * G + c, nM, nN, pm, pn)) return false;
        const int br = i & 1; u.pm = pm; u.pn = pn; u.aux = br; u.A = (br ? A1 : A0) + (size_t)pm * sA; u.B = (br ? B1 : B0) + (size_t)pn * sB; return true;
    }
};
struct OrderMoe {
    int nblk, G, c; const int* blke; const char* A0; const char* B0; size_t sA, sE, sB;
    DI bool next(int i, Unit& u) const {
        int rb, pn;
        if ((G & 31) == 0) { const int R = G >> 2, per = R >> 3, loc = c >> 3; rb = i * R + (c & 7) * per + (loc >> 2); pn = loc & 3; }
        else { const int L = i * G + c; rb = L >> 2; pn = L & 3; }
        if (rb >= nblk) return false;
        const int e = blke[rb];
        u.pm = rb; u.pn = pn; u.aux = 0;
        u.A = A0 + (size_t)rb * sA; u.B = B0 + (size_t)e * sE + (size_t)pn * sB; return true;
    }
};

#define PG8_LAS __attribute__((address_space(3)))
template <class Epi, class Sched, bool ALIGN_EPI = true, bool SP2 = true>
DI void gemm_phase(PG8_LAS unsigned char* lds, const GemmDesc g, const Sched& S, const Epi& E) {
    const int tid = threadIdx.x, wid = __builtin_amdgcn_readfirstlane(tid >> 6), lane = tid & 63, wr = wid >> 2, wc = wid & 3, fr = lane & 15, fq = lane >> 4;
    const int K = g.K, nt = K / BK;
    unsigned voffA[2], voffB[2];
#pragma unroll
    for (int i = 0; i < 2; ++i) { int R, C; stage_rc(tid * 16 + i * 8192, R, C); const int Rb = Epi::PERM ? ((R & ~31) + perm32(R & 31)) : R;
        voffA[i] = (unsigned)(R * g.lda + C) * 2u; voffB[i] = (unsigned)(Rb * g.ldb + C) * 2u; }
    const size_t kstep = (size_t)(BK * 2);
    const size_t hstepA = (size_t)HALF * g.lda * 2, hstepB = (size_t)HALF * g.ldb * 2;
    const unsigned ldsw = (unsigned)wid * 1024u;
    const int aoff = lds_byte(wr * 64 + fr, fq * 8), boff = lds_byte(wc * 32 + fr, fq * 8);
#define PG8_SA(b, h) (((b) * 2 + (h)) * HTB)
#define PG8_SB(b, h) ((4 + (b) * 2 + (h)) * HTB)
#define PG8_STAGE(bufoff, gbase, voff) do { _Pragma("unroll") for (int _i = 0; _i < 2; ++_i) \
        __builtin_amdgcn_global_load_lds((const unsigned*)((const char*)(gbase) + (voff)[_i]), (PG8_LAS unsigned*)(lds + (bufoff) + ldsw + _i * 8192), 16, 0, 0); } while (0)
#define PG8_LDA(dst, b, h) do { _Pragma("unroll") for (int m = 0; m < 4; ++m) _Pragma("unroll") for (int k = 0; k < 2; ++k) dst[m][k] = *(const PG8_LAS bf16x8*)(lds + PG8_SA(b, h) + aoff + m * 2048 + k * 1024); } while (0)
#define PG8_LDB(dst, b, h) do { _Pragma("unroll") for (int n = 0; n < 2; ++n) _Pragma("unroll") for (int k = 0; k < 2; ++k) dst[n][k] = *(const PG8_LAS bf16x8*)(lds + PG8_SB(b, h) + boff + n * 2048 + k * 1024); } while (0)
#define PG8_MMA(ai, bj, At, Bt) do { __builtin_amdgcn_s_setprio(1); _Pragma("unroll") for (int m = 0; m < 4; ++m) _Pragma("unroll") for (int n = 0; n < 2; ++n) _Pragma("unroll") for (int k = 0; k < 2; ++k) \
        acc[ai][bj][m][n] = __builtin_amdgcn_mfma_f32_16x16x32_bf16(Bt[n][k], At[m][k], acc[ai][bj][m][n], 0, 0, 0); __builtin_amdgcn_s_setprio(0); } while (0)
#define PG8_WAIT_V(n) asm volatile("s_waitcnt vmcnt(" #n ")" ::: "memory")
#define PG8_WAIT_L(n) asm volatile("s_waitcnt lgkmcnt(" #n ")" ::: "memory")
#define PG8_BAR __builtin_amdgcn_s_barrier()
#define PG8_SCHED __builtin_amdgcn_sched_barrier(0)
    Unit cur, nxt; int ui = 0;
    if (!S.next(0, cur)) return;
    f32x4 acc[2][2][4][2];
#pragma unroll
    for (int a = 0; a < 2; ++a)
#pragma unroll
        for (int b = 0; b < 2; ++b)
#pragma unroll
            for (int m = 0; m < 4; ++m)
#pragma unroll
                for (int n = 0; n < 2; ++n) acc[a][b][m][n] = (f32x4){0.f, 0.f, 0.f, 0.f};
    bf16x8 At[4][2], B0[2][2], B1[2][2];
    const char* cA = cur.A; const char* cB = cur.B;
    if constexpr (SP2) {
        PG8_STAGE(PG8_SB(0, 0), cB, voffB); PG8_STAGE(PG8_SB(0, 1), cB + hstepB, voffB); PG8_STAGE(PG8_SA(0, 0), cA, voffA); PG8_STAGE(PG8_SA(0, 1), cA + hstepA, voffA);
        if (wr == 1) PG8_BAR;
        PG8_WAIT_V(2); PG8_BAR;
        PG8_STAGE(PG8_SB(1, 0), cB + kstep, voffB); PG8_STAGE(PG8_SA(1, 0), cA + kstep, voffA); PG8_STAGE(PG8_SB(1, 1), cB + hstepB + kstep, voffB);
        PG8_WAIT_V(6); PG8_BAR;
    } else {
        PG8_STAGE(PG8_SB(0, 0), cB, voffB); PG8_STAGE(PG8_SA(0, 0), cA, voffA); PG8_STAGE(PG8_SB(0, 1), cB + hstepB, voffB); PG8_STAGE(PG8_SA(0, 1), cA + hstepA, voffA);
        if (wr == 1) PG8_BAR;
        PG8_WAIT_V(4); PG8_BAR;
        PG8_STAGE(PG8_SB(1, 0), cB + kstep, voffB); PG8_STAGE(PG8_SA(1, 0), cA + kstep, voffA); PG8_STAGE(PG8_SB(1, 1), cB + hstepB + kstep, voffB);
        PG8_WAIT_V(6); PG8_BAR;
    }
    for (;;) {
        const bool has_next = S.next(ui + 1, nxt);
        const char* nA = has_next ? nxt.A : cA; const char* nB = has_next ? nxt.B : cB;
        for (int t = 0; t < nt; t += 2) {
            const bool last = (t == nt - 2);
            const char* a1 = cA + (size_t)(t + 1) * kstep;
            const char* a2 = last ? nA : cA + (size_t)(t + 2) * kstep; const char* b2 = last ? nB : cB + (size_t)(t + 2) * kstep;
            const char* a3 = a2 + kstep; const char* b3 = b2 + kstep;
            if constexpr (SP2) {
            PG8_LDB(B0, 0, 0); PG8_LDB(B1, 0, 1); PG8_SCHED; PG8_LDA(At, 0, 0); PG8_STAGE(PG8_SA(1, 1), a1 + hstepA, voffA);
            PG8_WAIT_V(8); PG8_WAIT_L(0); PG8_BAR; PG8_MMA(0, 0, At, B0); PG8_MMA(0, 1, At, B1); PG8_BAR; PG8_SCHED;
            PG8_LDA(At, 0, 1); PG8_STAGE(PG8_SB(0, 0), b2, voffB); PG8_STAGE(PG8_SB(0, 1), b2 + hstepB, voffB); PG8_STAGE(PG8_SA(0, 0), a2, voffA);
            PG8_WAIT_V(8); PG8_WAIT_L(0); PG8_BAR; PG8_MMA(1, 0, At, B0); PG8_MMA(1, 1, At, B1); PG8_BAR; PG8_SCHED;
            PG8_LDB(B0, 1, 0); PG8_LDB(B1, 1, 1); PG8_SCHED; PG8_LDA(At, 1, 0); PG8_STAGE(PG8_SA(0, 1), a2 + hstepA, voffA);
            PG8_WAIT_V(8); PG8_WAIT_L(0); PG8_BAR; PG8_MMA(0, 0, At, B0); PG8_MMA(0, 1, At, B1); PG8_BAR; PG8_SCHED;
            PG8_LDA(At, 1, 1); PG8_STAGE(PG8_SB(1, 0), b3, voffB); PG8_STAGE(PG8_SB(1, 1), b3 + hstepB, voffB); PG8_STAGE(PG8_SA(1, 0), a3, voffA);
            PG8_WAIT_V(8); PG8_WAIT_L(0); PG8_BAR; PG8_MMA(1, 0, At, B0); PG8_MMA(1, 1, At, B1); PG8_BAR; PG8_SCHED;
            } else {
            PG8_LDB(B0, 0, 0); PG8_SCHED; PG8_LDA(At, 0, 0); PG8_STAGE(PG8_SA(1, 1), a1 + hstepA, voffA);
            PG8_WAIT_L(8); PG8_BAR; PG8_WAIT_L(0); PG8_MMA(0, 0, At, B0); PG8_BAR; PG8_SCHED;
            PG8_LDB(B1, 0, 1); PG8_STAGE(PG8_SB(0, 0), b2, voffB);
            PG8_BAR; PG8_WAIT_L(0); PG8_MMA(0, 1, At, B1); PG8_BAR;
            PG8_LDA(At, 0, 1); PG8_STAGE(PG8_SA(0, 0), a2, voffA);
            PG8_BAR; PG8_WAIT_L(0); PG8_MMA(1, 0, At, B0); PG8_BAR; PG8_SCHED;
            PG8_STAGE(PG8_SB(0, 1), b2 + hstepB, voffB);
            PG8_WAIT_V(6); PG8_BAR; PG8_MMA(1, 1, At, B1); PG8_BAR;
            PG8_LDB(B0, 1, 0); PG8_SCHED; PG8_LDA(At, 1, 0); PG8_STAGE(PG8_SA(0, 1), a2 + hstepA, voffA);
            PG8_WAIT_L(8); PG8_BAR; PG8_WAIT_L(0); PG8_MMA(0, 0, At, B0); PG8_BAR; PG8_SCHED;
            PG8_LDB(B1, 1, 1); PG8_STAGE(PG8_SB(1, 0), b3, voffB);
            PG8_BAR; PG8_WAIT_L(0); PG8_MMA(0, 1, At, B1); PG8_BAR;
            PG8_LDA(At, 1, 1); PG8_STAGE(PG8_SA(1, 0), a3, voffA);
            PG8_BAR; PG8_WAIT_L(0); PG8_MMA(1, 0, At, B0); PG8_BAR; PG8_SCHED;
            PG8_STAGE(PG8_SB(1, 1), b3 + hstepB, voffB);
            PG8_WAIT_V(6); PG8_BAR; PG8_MMA(1, 1, At, B1); PG8_BAR;
            }
        }
        if constexpr (ALIGN_EPI) { if (wr == 0) PG8_BAR; }
        E(acc, cur, wr, wc, fr, fq);
        if (!has_next) break;
#pragma unroll
        for (int a = 0; a < 2; ++a)
#pragma unroll
            for (int b = 0; b < 2; ++b)
#pragma unroll
                for (int m = 0; m < 4; ++m)
#pragma unroll
                    for (int n = 0; n < 2; ++n) acc[a][b][m][n] = (f32x4){0.f, 0.f, 0.f, 0.f};
        cur = nxt; cA = nA; cB = nB; ++ui;
        if constexpr (ALIGN_EPI) { if (wr == 1) PG8_BAR; }
    }
    PG8_WAIT_V(0);
    if constexpr (!ALIGN_EPI) { if (wr == 0) PG8_BAR; }
    PG8_BAR;
#undef PG8_SA
#undef PG8_SB
#undef PG8_STAGE
#undef PG8_LDA
#undef PG8_LDB
#undef PG8_MMA
#undef PG8_WAIT_V
#undef PG8_WAIT_L
#undef PG8_BAR
#undef PG8_SCHED
}

typedef f32x4 AccT[2][2][4][2];
DI float silu_f(float v) { return v / (1.f + __expf(-v)); }
DI float sigmoid_f(float v) { return 1.f / (1.f + __expf(-v)); }
DI float logsig16(float v) { return (fminf(v, 0.f) - __logf(1.f + __expf(-fabsf(v)))) * 0.0625f; }
DI v4u pack8(f32x4 a, f32x4 b) { v4u w; w.x = pk2(a[0], a[1]); w.y = pk2(a[2], a[3]); w.z = pk2(b[0], b[1]); w.w = pk2(b[2], b[3]); return w; }

struct EpiP1 {
    static constexpr bool PERM = true;
    bf16 *glaq, *glak, *glav, *r, *loga, *dilq, *dilk, *dilvt; const float* b_a;
    DI void operator()(const AccT& acc, const Unit& u, int wr, int wc, int fr, int fq) const {
        const int pn = u.pn, row0 = u.pm * BM + wr * 64 + fr, cl = wc * 32 + 8 * fq;
        if (pn < 10 || ((pn - 10) % 6) < 4) {
            bf16* dst; int mode = 0; int colbase = (pn & 1) * 256;
            if (pn < 2) dst = glaq; else if (pn < 4) dst = glak; else if (pn < 6) dst = glav; else if (pn < 8) { dst = r; mode = 1; } else if (pn < 10) { dst = loga; mode = 2; }
            else { const int gi = (pn - 10) / 6, rem = (pn - 10) % 6; dst = (rem < 2 ? dilq : dilk) + (size_t)gi * T * 512; }
            f32x4 bv[2][2];
#pragma unroll
            for (int bj = 0; bj < 2; ++bj)
#pragma unroll
                for (int n = 0; n < 2; ++n) bv[bj][n] = (mode == 2) ? *(const f32x4*)(b_a + colbase + bj * HALF + cl + 4 * n) : (f32x4){0.f, 0.f, 0.f, 0.f};
#pragma unroll
            for (int ai = 0; ai < 2; ++ai)
#pragma unroll
                for (int m = 0; m < 4; ++m) { bf16* rowp = dst + (size_t)(row0 + ai * HALF + m * 16) * 512 + colbase + cl;
#pragma unroll
                    for (int bj = 0; bj < 2; ++bj) { f32x4 v0 = acc[ai][bj][m][0] + bv[bj][0], v1 = acc[ai][bj][m][1] + bv[bj][1];
                        if (mode == 1) {
#pragma unroll
                            for (int j = 0; j < 4; ++j) { v0[j] = silu_f(v0[j]); v1[j] = silu_f(v1[j]); } }
                        if (mode == 2) {
#pragma unroll
                            for (int j = 0; j < 4; ++j) { v0[j] = logsig16(v0[j]); v1[j] = logsig16(v1[j]); } }
                        *(v4u*)(rowp + bj * HALF) = pack8(v0, v1); } }
        } else {
            const int gi = (pn - 10) / 6, half = (pn - 10) % 6 - 4, sh = 2 * gi, dm = (1 << sh) - 1;
            bf16* vt = dilvt + (size_t)gi * T * 512;
#pragma unroll
            for (int ai = 0; ai < 2; ++ai)
#pragma unroll
                for (int m = 0; m < 4; ++m) { const int t = row0 + ai * HALF + m * 16, b = t >> 13, s = t & 8191;
                    const int uu = ((s & dm) << (13 - sh)) | (s >> sh), pos = (uu & ~12) | ((uu & 4) << 1) | ((uu & 8) >> 1);
#pragma unroll
                    for (int bj = 0; bj < 2; ++bj) { bf16* hp = vt + ((size_t)((b * 4 + half * 2 + bj) * 128 + cl) << 13) + pos;
#pragma unroll
                        for (int n = 0; n < 2; ++n)
#pragma unroll
                            for (int j = 0; j < 4; ++j) hp[(size_t)(4 * n + j) << 13] = f2bf(acc[ai][bj][m][n][j]); } }
        }
    }
};
struct EpiGate {
    static constexpr bool PERM = true;
    bf16* G; const float* bias;
    DI void operator()(const AccT& acc, const Unit& u, int wr, int wc, int fr, int fq) const {
        const int row0 = u.pm * BM + wr * 64 + fr, col0 = u.pn * BM + wc * 32 + 8 * fq;
        f32x4 bv[2][2];
#pragma unroll
        for (int bj = 0; bj < 2; ++bj)
#pragma unroll
            for (int n = 0; n < 2; ++n) bv[bj][n] = *(const f32x4*)(bias + col0 + bj * HALF + 4 * n);
#pragma unroll
        for (int ai = 0; ai < 2; ++ai)
#pragma unroll
            for (int m = 0; m < 4; ++m) { bf16* rowp = G + (size_t)(row0 + ai * HALF + m * 16) * 2048 + col0;
#pragma unroll
                for (int bj = 0; bj < 2; ++bj) { f32x4 v0 = acc[ai][bj][m][0] + bv[bj][0], v1 = acc[ai][bj][m][1] + bv[bj][1];
#pragma unroll
                    for (int j = 0; j < 4; ++j) { v0[j] = sigmoid_f(v0[j]); v1[j] = sigmoid_f(v1[j]); }
                    *(v4u*)(rowp + bj * HALF) = pack8(v0, v1); } }
    }
};
struct EpiMerge {
    static constexpr bool PERM = true;
    bf16* Mg; const bf16* G;
    DI void operator()(const AccT& acc, const Unit& u, int wr, int wc, int fr, int fq) const {
        const int row0 = u.pm * BM + wr * 64 + fr, col0 = u.pn * BM + wc * 32 + 8 * fq, br = u.aux;
#pragma unroll
        for (int ai = 0; ai < 2; ++ai)
#pragma unroll
            for (int m = 0; m < 4; ++m) { const size_t row = (size_t)(row0 + ai * HALF + m * 16);
#pragma unroll
                for (int bj = 0; bj < 2; ++bj) { const int col = col0 + bj * HALF;
                    const v4u g = *(const v4u*)(G + row * 2048 + br * 1024 + col);
                    f32x4 v0 = acc[ai][bj][m][0], v1 = acc[ai][bj][m][1];
                    v0[0] *= bflo(g.x); v0[1] *= bfhi(g.x); v0[2] *= bflo(g.y); v0[3] *= bfhi(g.y); v1[0] *= bflo(g.z); v1[1] *= bfhi(g.z); v1[2] *= bflo(g.w); v1[3] *= bfhi(g.w);
                    bf16* p = Mg + row * 1024 + col;
                    if (br) { const v4u o = *(const v4u*)p;
                        v0[0] += bflo(o.x); v0[1] += bfhi(o.x); v0[2] += bflo(o.y); v0[3] += bfhi(o.y); v1[0] += bflo(o.z); v1[1] += bfhi(o.z); v1[2] += bflo(o.w); v1[3] += bfhi(o.w); }
                    *(v4u*)p = pack8(v0, v1); } }
    }
};
struct EpiX1 {
    static constexpr bool PERM = false;
    float* X1; const float* X;
    DI void operator()(const AccT& acc, const Unit& u, int wr, int wc, int fr, int fq) const {
        const int row0 = u.pm * BM + wr * 64 + fr, col0 = u.pn * BM + wc * 32 + 4 * fq;
#pragma unroll
        for (int ai = 0; ai < 2; ++ai)
#pragma unroll
            for (int m = 0; m < 4; ++m) { const size_t ro = (size_t)(row0 + ai * HALF + m * 16) * 1024 + col0;
#pragma unroll
                for (int bj = 0; bj < 2; ++bj)
#pragma unroll
                    for (int n = 0; n < 2; ++n) *(f32x4*)(X1 + ro + bj * HALF + n * 16) = acc[ai][bj][m][n] + *(const f32x4*)(X + ro + bj * HALF + n * 16); }
    }
};
struct EpiGU {
    static constexpr bool PERM = true;
    bf16* H; const float* roww;
    DI void operator()(const AccT& acc, const Unit& u, int wr, int wc, int fr, int fq) const {
        if (u.aux) return;
        const int row0 = u.pm * BM + wr * 64 + fr, hc0 = u.pn * 128 + wc * 16 + 4 * fq;
#pragma unroll
        for (int ai = 0; ai < 2; ++ai)
#pragma unroll
            for (int m = 0; m < 4; ++m) { const int row = row0 + ai * HALF + m * 16; const float w = roww[row];
#pragma unroll
                for (int bj = 0; bj < 2; ++bj) { const f32x4 g = acc[ai][bj][m][0], up = acc[ai][bj][m][1];
                    v2u o; o.x = pk2(w * silu_f(g[0]) * up[0], w * silu_f(g[1]) * up[1]); o.y = pk2(w * silu_f(g[2]) * up[2], w * silu_f(g[3]) * up[3]);
                    *(v2u*)(H + (size_t)row * 512 + hc0 + bj * 64) = o; } }
    }
};
struct EpiY {
    static constexpr bool PERM = true;
    bf16* Y;
    DI void operator()(const AccT& acc, const Unit& u, int wr, int wc, int fr, int fq) const {
        if (u.aux) return;
        const int row0 = u.pm * BM + wr * 64 + fr, col0 = u.pn * BM + wc * 32 + 8 * fq;
#pragma unroll
        for (int ai = 0; ai < 2; ++ai)
#pragma unroll
            for (int m = 0; m < 4; ++m) { bf16* rowp = Y + (size_t)(row0 + ai * HALF + m * 16) * 1024 + col0;
#pragma unroll
                for (int bj = 0; bj < 2; ++bj) *(v4u*)(rowp + bj * HALF) = pack8(acc[ai][bj][m][0], acc[ai][bj][m][1]); }
    }
};
}

constexpr int NWAVES = 8, NTHR = 512;
struct Frame {
    LAS unsigned char* lds;
    int tid, lane, wave, vcu, G;
    unsigned char* ws; unsigned char* dout;
};
#define LDS_WAIT() asm volatile("s_waitcnt lgkmcnt(0)" ::: "memory")
DI float wave_sum(float v) {
#pragma unroll
    for (int o = 1; o < 64; o <<= 1) v += __shfl_xor(v, o);
    return v;
}
#define MFMA16(a, b, c) __builtin_amdgcn_mfma_f32_16x16x32_bf16((a), (b), (c), 0, 0, 0)
#define MFMA32(a, b, c) __builtin_amdgcn_mfma_f32_32x32x16_bf16((a), (b), (c), 0, 0, 0)

template <class RowMap>
DI void transpose_item(const float* W, int ldw, int k0, int c0, bf16* dst, int ldd, RowMap rowmap, LAS float* scr, int lane) {
#pragma unroll 8
    for (int i = 0; i < 32; ++i) { const int kk = 2 * i + (lane >> 5); scr[kk * 33 + (lane & 31)] = W[(size_t)(k0 + kk) * ldw + c0 + (lane & 31)]; }
    LDS_WAIT(); asm volatile("" ::: "memory");
    const int c = lane & 7;
#pragma unroll
    for (int j = 0; j < 4; ++j) { const int n = (lane >> 3) + 8 * j; const LAS float* s = scr + (8 * c) * 33 + n;
        v4u o; o.x = pk2(s[0 * 33], s[1 * 33]); o.y = pk2(s[2 * 33], s[3 * 33]); o.z = pk2(s[4 * 33], s[5 * 33]); o.w = pk2(s[6 * 33], s[7 * 33]);
        *(v4u*)(dst + (size_t)rowmap(n) * ldd + k0 + 8 * c) = o; }
    LDS_WAIT(); asm volatile("" ::: "memory");
}
struct Ins { const float* in[21]; };
DI void p0_prologue(const Frame& F, const Ins& I) {
    LAS float* scr = (LAS float*)(F.lds + RING_OFF + F.wave * 16384);
    const int gw = F.vcu * NWAVES + F.wave, NGW = F.G * NWAVES, lane = F.lane;
    bf16* W1T = (bf16*)(F.ws + WS_W1T); bf16* WBGT = (bf16*)(F.ws + WS_WBGT); bf16* WPGT = (bf16*)(F.ws + WS_WPGT); bf16* WPAT = (bf16*)(F.ws + WS_WPAT); bf16* WOUTT = (bf16*)(F.ws + WS_WOUTT);
    bf16* EXPGU = (bf16*)(F.dout + DO_EXPGU); bf16* EXPDN = (bf16*)(F.dout + DO_EXPDN);
    constexpr int I_IN = 16 * 208, I_BG = 16 * 64, I_PG = 8 * 32, I_PA = 8 * 32, I_OUT = 16 * 32, I_GU = 32 * 2 * 16 * 16, I_DN = 32 * 8 * 32;
    constexpr int NITEMS = I_IN + I_BG + I_PG + I_PA + I_OUT + I_GU + I_DN;
    for (int it = gw; it < NITEMS; it += NGW) {
        int r = it;
        if (r < I_IN) { const int kb = r / 208, nb = r % 208; const int n0 = nb < 64 ? nb * 32 : (nb - 64) * 32 + 2560; const int c0 = nb < 64 ? n0 : n0 - 496;
            transpose_item(I.in[2], IN_COLS, kb * 64, c0, W1T, 1024, [=](int n) { return n0 + n; }, scr, lane); continue; } r -= I_IN;
        if (r < I_BG) { const int kb = r / 64, nb = r % 64; transpose_item(I.in[10], 2048, kb * 64, nb * 32, WBGT, 1024, [=](int n) { return nb * 32 + n; }, scr, lane); continue; } r -= I_BG;
        if (r < I_PG) { const int kb = r / 32, nb = r % 32; transpose_item(I.in[8], 1024, kb * 64, nb * 32, WPGT, 512, [=](int n) { return nb * 32 + n; }, scr, lane); continue; } r -= I_PG;
        if (r < I_PA) { const int kb = r / 32, nb = r % 32; transpose_item(I.in[9], 1024, kb * 64, nb * 32, WPAT, 512, [=](int n) { return nb * 32 + n; }, scr, lane); continue; } r -= I_PA;
        if (r < I_OUT) { const int kb = r / 32, nb = r % 32; transpose_item(I.in[12], 1024, kb * 64, nb * 32, WOUTT, 1024, [=](int n) { return nb * 32 + n; }, scr, lane); continue; } r -= I_OUT;
        if (r < I_GU) { const int e = r / 512, q = r % 512, up = q >> 8, kb = (q >> 4) & 15, nb = q & 15;
            const float* src = (up ? I.in[19] : I.in[18]) + (size_t)e * 1024 * 512;
            transpose_item(src, 512, kb * 64, nb * 32, EXPGU + (size_t)e * 1024 * 1024, 1024, [=](int n) { const int c = nb * 32 + n; return (c >> 2) * 8 + (c & 3) + 4 * up; }, scr, lane); continue; } r -= I_GU;
        { const int e = r / 256, q = r % 256, kb = q / 32, nb = q % 32;
            transpose_item(I.in[20] + (size_t)e * 512 * 1024, 1024, kb * 64, nb * 32, EXPDN + (size_t)e * 1024 * 512, 512, [=](int n) { return nb * 32 + n; }, scr, lane); }
    }
    { const float* win = I.in[2]; const float* wa2 = I.in[3];
      for (int e = (F.vcu * NTHR + F.tid); e < 512 * 1024; e += F.G * NTHR) { const int k = e & 1023, n = e >> 10; const float* wr = win + (size_t)k * IN_COLS + 2048;
          float s = 0.f;
#pragma unroll
          for (int j = 0; j < 16; ++j) s += wr[j] * wa2[j * 512 + n];
          W1T[(size_t)(2048 + n) * 1024 + k] = f2bf(s); } }
    { bf16* WRH = (bf16*)(F.ws + WS_WRH); bf16* WRL = WRH + 48 * 1024; const float* wrg = I.in[14]; const float* wre = I.in[16];
      for (int e = (F.vcu * NTHR + F.tid); e < 48 * 1024; e += F.G * NTHR) { const int k = e & 1023, n = e >> 10;
          const float w = n < 4 ? wrg[k * 4 + n] : (n < 36 ? wre[k * 32 + n - 4] : 0.f); const bf16 h = f2bf(w); WRH[e] = h; WRL[e] = f2bf(w - bf2f(h)); } }
    { const float* x = I.in[0]; const float* g1 = I.in[1]; bf16* XN = (bf16*)(F.ws + WS_XN);
      f32x4 gv[4];
#pragma unroll
      for (int j = 0; j < 4; ++j) gv[j] = *(const f32x4*)(g1 + 4 * lane + 256 * j);
      for (int m = gw; m < T; m += NGW) { const f32x4* xr = (const f32x4*)(x + (size_t)m * D) + lane; f32x4 v[4]; float s = 0.f;
#pragma unroll
          for (int j = 0; j < 4; ++j) { v[j] = xr[64 * j]; s += (v[j].x * v[j].x + v[j].y * v[j].y) + (v[j].z * v[j].z + v[j].w * v[j].w); }
          const float rinv = __frsqrt_rn(wave_sum(s) * (1.f / D) + EPS);
          v2u* o8 = (v2u*)(XN + (size_t)m * D) + lane;
#pragma unroll
          for (int j = 0; j < 4; ++j) { v2u o; o.x = pk2(v[j].x * rinv * gv[j].x, v[j].y * rinv * gv[j].y); o.y = pk2(v[j].z * rinv * gv[j].z, v[j].w * rinv * gv[j].w); o8[64 * j] = o; } } }
}

DI void qk_norm_phase(const Frame& F, const float* gq, const float* gk) {
    const int gw = F.vcu * NWAVES + F.wave, NGW = F.G * NWAVES, lane = F.lane;
    bf16* Q = (bf16*)(F.ws + WS_DILQ);
    for (int rr = gw; rr < 6 * T; rr += NGW) { const int which = rr / T; const int gi = which % 3; const bool isq = which < 3;
        bf16* p = Q + (size_t)rr * 512 + 8 * lane; const v4u v = *(const v4u*)p;
        float x[8] = {bflo(v.x), bfhi(v.x), bflo(v.y), bfhi(v.y), bflo(v.z), bfhi(v.z), bflo(v.w), bfhi(v.w)};
        float s = 0.f;
#pragma unroll
        for (int j = 0; j < 8; ++j) s += x[j] * x[j];
        s += __shfl_xor(s, 1); s += __shfl_xor(s, 2); s += __shfl_xor(s, 4); s += __shfl_xor(s, 8);
        const float rinv = __frsqrt_rn(s * (1.f / 128.f) + EPS) * (isq ? 0.08838834764831845f * LOG2E : 1.f);
        const float* g = (isq ? gq : gk) + gi * 128 + (8 * lane & 127);
        const f32x4 g0 = *(const f32x4*)g, g1 = *(const f32x4*)(g + 4);
        v4u o; o.x = pk2(x[0] * rinv * g0.x, x[1] * rinv * g0.y); o.y = pk2(x[2] * rinv * g0.z, x[3] * rinv * g0.w); o.z = pk2(x[4] * rinv * g1.x, x[5] * rinv * g1.y); o.w = pk2(x[6] * rinv * g1.z, x[7] * rinv * g1.w);
        *(v4u*)p = o; }
}

DI int crow(int i, int h) { return (i & 3) + 8 * (i >> 2) + 4 * h; }
DI void attn_job(const Frame& F, int job) {
    const int lane = F.lane, r = lane & 31, h = lane >> 5;
    const int gi = job >> 12; int rem = job & 4095;
    const int sh = 2 * gi, d = 1 << sh, L = SEQ >> sh, nqt = L >> 5;
    const int qt = rem % nqt; rem /= nqt; const int res = rem & (d - 1); rem >>= sh; const int head = rem & 3, b = rem >> 2;
    const int p0 = qt * 32;
    const float slope = exp2f(-8.f * (float)(gi * 4 + head + 1) / 12.f) * LOG2E * (float)d;
    bf16* Qg = (bf16*)(F.ws + WS_DILQ) + (size_t)gi * T * 512;
    const bf16* Kg = (const bf16*)(F.ws + WS_DILK) + (size_t)gi * T * 512;
    const bf16* VT = (const bf16*)(F.ws + WS_DILVT) + (size_t)gi * T * 512 + ((size_t)(b * 4 + head) * 128 << 13) + (size_t)res * L;
    const size_t qtok = (size_t)b * SEQ + (size_t)(p0 + r) * d + res;
    bf16x8 qf[8];
#pragma unroll
    for (int ks = 0; ks < 8; ++ks) qf[ks] = *(const bf16x8*)(Qg + qtok * 512 + head * 128 + 16 * ks + 8 * h);
    f32x16 O[4];
#pragma unroll
    for (int db = 0; db < 4; ++db)
#pragma unroll
        for (int i = 0; i < 16; ++i) O[db][i] = 0.f;
    float m = -1e30f, l = 0.f;
#pragma unroll 1
    for (int kt = 0; kt < 5; ++kt) { const int kb = p0 - 128 + 32 * kt; if (kb < 0) continue;
        const size_t ktok = (size_t)b * SEQ + (size_t)(kb + r) * d + res;
        f32x16 s;
#pragma unroll
        for (int i = 0; i < 16; ++i) s[i] = 0.f;
#pragma unroll
        for (int ks = 0; ks < 8; ++ks) { const bf16x8 kf = *(const bf16x8*)(Kg + ktok * 512 + head * 128 + 16 * ks + 8 * h); s = MFMA32(kf, qf[ks], s); }
        float mx = -1e30f; const int dq = p0 + r - kb;
#pragma unroll
        for (int i = 0; i < 16; ++i) { const int dist = dq - crow(i, h); const bool ok = dist >= 0 && dist <= 128; const float sv = ok ? s[i] - slope * (float)dist : -1e30f; s[i] = sv; mx = fmaxf(mx, sv); }
        mx = fmaxf(mx, __shfl_xor(mx, 32));
        const float mn = fmaxf(m, mx), alpha = exp2f(m - mn); m = mn;
        float ps = 0.f;
#pragma unroll
        for (int i = 0; i < 16; ++i) { const float p = s[i] > -1e29f ? exp2f(s[i] - mn) : 0.f; s[i] = p; ps += p; }
        l = l * alpha + ps;
#pragma unroll
        for (int db = 0; db < 4; ++db)
#pragma unroll
            for (int i = 0; i < 16; ++i) O[db][i] *= alpha;
        bf16x8 pb[2];
#pragma unroll
        for (int si = 0; si < 2; ++si) { v4u w; w.x = pk2(s[8 * si], s[8 * si + 1]); w.y = pk2(s[8 * si + 2], s[8 * si + 3]); w.z = pk2(s[8 * si + 4], s[8 * si + 5]); w.w = pk2(s[8 * si + 6], s[8 * si + 7]); pb[si] = __builtin_bit_cast(bf16x8, w); }
#pragma unroll
        for (int db = 0; db < 4; ++db)
#pragma unroll
            for (int si = 0; si < 2; ++si) { const bf16x8 vf = *(const bf16x8*)(VT + ((size_t)(32 * db + r) << 13) + kb + 16 * si + 8 * h); O[db] = MFMA32(vf, pb[si], O[db]); }
    }
    const float lt = l + __shfl_xor(l, 32), inv = 1.f / lt;
    bf16* op = Qg + qtok * 512 + head * 128 + 4 * h;
#pragma unroll
    for (int db = 0; db < 4; ++db)
#pragma unroll
        for (int q4 = 0; q4 < 4; ++q4) { v2u o; o.x = pk2(O[db][4 * q4] * inv, O[db][4 * q4 + 1] * inv); o.y = pk2(O[db][4 * q4 + 2] * inv, O[db][4 * q4 + 3] * inv); *(v2u*)(op + 32 * db + 8 * q4) = o; }
    if (h == 0) ((float*)(F.ws + WS_LSE))[(size_t)gi * T * 4 + qtok * 4 + head] = m + log2f(lt);
}

constexpr int G_QS = 0, G_KS = 17408, G_KET = 34816, G_VT = 53248, G_ATT = 71680, G_TOT = 80896, G_DL = 82944, G_OS = 84992;
constexpr int QS_LD = 136, KT_LD = 72, OS_LD = 132;
DI void gla_pass1(const Frame& F, int item) {
    const int tid = F.tid, lane = F.lane, w = F.wave, fr = lane & 15, g = lane >> 4;
    const int seg = item & (NSEG - 1), bh = item >> 4, hh = bh & 3, b = bh >> 2;
    const int dk = tid & 127, qr = tid >> 7;
    LAS bf16* Qs = (LAS bf16*)(F.lds + G_QS); LAS bf16* Ks = (LAS bf16*)(F.lds + G_KS); LAS bf16* KEt = (LAS bf16*)(F.lds + G_KET); LAS bf16* Vt = (LAS bf16*)(F.lds + G_VT);
    LAS bf16* Att = (LAS bf16*)(F.lds + G_ATT); LAS float* tot = (LAS float*)(F.lds + G_TOT); LAS float* Dl = (LAS float*)(F.lds + G_DL);
    const bf16* GQ = (const bf16*)(F.ws + WS_GLAQ); const bf16* GK = (const bf16*)(F.ws + WS_GLAK); const bf16* LA = (const bf16*)(F.ws + WS_LOGA); bf16* GV = (bf16*)(F.ws + WS_GLAV);
    f32x4 S[8];
#pragma unroll
    for (int a = 0; a < 8; ++a) S[a] = (f32x4){0.f, 0.f, 0.f, 0.f};
    float Btot = 0.f;
    const int dv0 = 16 * w;
#pragma unroll 1
    for (int ch = 0; ch < TSEG / 64; ++ch) {
        const size_t tokbase = (size_t)b * SEQ + seg * TSEG + ch * 64;
        const size_t gofs = (tokbase + 16 * qr) * 512 + hh * 128 + dk;
        float la[16], qv[16], kv[16]; bf16 vv[16];
#pragma unroll
        for (int i4 = 0; i4 < 4; ++i4) { const bf16* pl = LA + gofs + (size_t)i4 * 2048; const bf16* pq = GQ + gofs + (size_t)i4 * 2048; const bf16* pk = GK + gofs + (size_t)i4 * 2048; const bf16* pv = GV + gofs + (size_t)i4 * 2048;
#pragma unroll
            for (int j = 0; j < 4; ++j) { la[4 * i4 + j] = bf2f(pl[j * 512]); qv[4 * i4 + j] = bf2f(pq[j * 512]); kv[4 * i4 + j] = bf2f(pk[j * 512]); vv[4 * i4 + j] = pv[j * 512]; } }
#pragma unroll
        for (int i = 1; i < 16; ++i) la[i] += la[i - 1];
        tot[qr * 128 + dk] = la[15];
        { v4u v0, v1; v0.x = vv[0] | ((unsigned)vv[1] << 16); v0.y = vv[2] | ((unsigned)vv[3] << 16); v0.z = vv[4] | ((unsigned)vv[5] << 16); v0.w = vv[6] | ((unsigned)vv[7] << 16);
          v1.x = vv[8] | ((unsigned)vv[9] << 16); v1.y = vv[10] | ((unsigned)vv[11] << 16); v1.z = vv[12] | ((unsigned)vv[13] << 16); v1.w = vv[14] | ((unsigned)vv[15] << 16);
          *(LAS v4u*)(Vt + dk * KT_LD + 16 * qr) = v0; *(LAS v4u*)(Vt + dk * KT_LD + 16 * qr + 8) = v1; }
        __syncthreads();
        const float t0 = tot[dk], t1 = tot[128 + dk], t2 = tot[256 + dk], t3 = tot[384 + dk];
        const float base = (qr > 0 ? t0 : 0.f) + (qr > 1 ? t1 : 0.f) + (qr > 2 ? t2 : 0.f), blast = (t0 + t1) + (t2 + t3);
        Btot += blast;
        if (qr == 0) Dl[dk] = __expf(blast);
        { unsigned ke[8];
#pragma unroll
          for (int i = 0; i < 16; i += 2) { const float b0 = base + la[i], b1 = base + la[i + 1]; const float e0 = __expf(b0), e1 = __expf(b1);
              Qs[(16 * qr + i) * QS_LD + dk] = f2bf(qv[i] * 0.08838834764831845f * e0); Qs[(16 * qr + i + 1) * QS_LD + dk] = f2bf(qv[i + 1] * 0.08838834764831845f * e1);
              Ks[(16 * qr + i) * QS_LD + dk] = f2bf(kv[i] / e0); Ks[(16 * qr + i + 1) * QS_LD + dk] = f2bf(kv[i + 1] / e1);
              ke[i >> 1] = pk2(kv[i] * __expf(blast - b0), kv[i + 1] * __expf(blast - b1)); }
          v4u k0 = {ke[0], ke[1], ke[2], ke[3]}, k1 = {ke[4], ke[5], ke[6], ke[7]};
          *(LAS v4u*)(KEt + dk * KT_LD + 16 * qr) = k0; *(LAS v4u*)(KEt + dk * KT_LD + 16 * qr + 8) = k1; }
        __syncthreads();
#pragma unroll
        for (int tt = 0; tt < 2; ++tt) { const int n = 2 * w + tt, jt = n >> 2, it = n & 3; f32x4 a4 = {0.f, 0.f, 0.f, 0.f};
#pragma unroll
            for (int s = 0; s < 4; ++s) { const bf16x8 ka = *(const LAS bf16x8*)(Ks + (16 * jt + fr) * QS_LD + 32 * s + 8 * g); const bf16x8 qb = *(const LAS bf16x8*)(Qs + (16 * it + fr) * QS_LD + 32 * s + 8 * g); a4 = MFMA16(ka, qb, a4); }
            const int tj = 16 * jt + 4 * g, ti = 16 * it + fr;
            v2u o; o.x = pk2(tj <= ti ? a4[0] : 0.f, tj + 1 <= ti ? a4[1] : 0.f); o.y = pk2(tj + 2 <= ti ? a4[2] : 0.f, tj + 3 <= ti ? a4[3] : 0.f);
            *(LAS v2u*)(Att + ti * KT_LD + tj) = o; }
        __syncthreads();
        bf16x8 Sb[4];
#pragma unroll
        for (int s = 0; s < 4; ++s) { v4u p; p.x = pk2(S[2 * s][0], S[2 * s][1]); p.y = pk2(S[2 * s][2], S[2 * s][3]); p.z = pk2(S[2 * s + 1][0], S[2 * s + 1][1]); p.w = pk2(S[2 * s + 1][2], S[2 * s + 1][3]); Sb[s] = __builtin_bit_cast(bf16x8, p); }
        bf16x8 Vf[2];
#pragma unroll
        for (int ks = 0; ks < 2; ++ks) Vf[ks] = *(const LAS bf16x8*)(Vt + (dv0 + fr) * KT_LD + 32 * ks + 8 * g);
#pragma unroll
        for (int it = 0; it < 4; ++it) { f32x4 o = {0.f, 0.f, 0.f, 0.f};
#pragma unroll
            for (int s = 0; s < 4; ++s) { const bf16x4 lo = *(const LAS bf16x4*)(Qs + (16 * it + fr) * QS_LD + 32 * s + 4 * g); const bf16x4 hi = *(const LAS bf16x4*)(Qs + (16 * it + fr) * QS_LD + 32 * s + 16 + 4 * g);
                const bf16x8 qa = __builtin_shufflevector(lo, hi, 0, 1, 2, 3, 4, 5, 6, 7); o = MFMA16(qa, Sb[s], o); }
#pragma unroll
            for (int ks = 0; ks < 2; ++ks) { const bf16x8 aa = *(const LAS bf16x8*)(Att + (16 * it + fr) * KT_LD + 32 * ks + 8 * g); o = MFMA16(aa, Vf[ks], o); }
            bf16* op = GV + (tokbase + 16 * it + 4 * g) * 512 + hh * 128 + dv0 + fr;
#pragma unroll
            for (int rr = 0; rr < 4; ++rr) op[(size_t)rr * 512] = f2bf(o[rr]); }
#pragma unroll
        for (int a = 0; a < 8; ++a) { const f32x4 dsc = *(const LAS f32x4*)(Dl + 16 * a + 4 * g); S[a] = S[a] * dsc;
#pragma unroll
            for (int ks = 0; ks < 2; ++ks) { const bf16x8 ka = *(const LAS bf16x8*)(KEt + (16 * a + fr) * KT_LD + 32 * ks + 8 * g); S[a] = MFMA16(ka, Vf[ks], S[a]); } }
        __syncthreads();
    }
    v2u* LB = (v2u*)(F.ws + WS_LB) + (size_t)item * 4096 + w * 512 + lane;
#pragma unroll
    for (int a = 0; a < 8; ++a) { v2u o; o.x = pk2(S[a][0], S[a][1]); o.y = pk2(S[a][2], S[a][3]); LB[a * 64] = o; }
    if (qr == 0) ((float*)(F.ws + WS_DSEG))[item * 128 + dk] = __expf(Btot);
}

DI void gla_pass2(const Frame& F, int item, const float* gnorm) {
    const int tid = F.tid, lane = F.lane, w = F.wave, fr = lane & 15, g = lane >> 4;
    const int seg = item & (NSEG - 1), bh = item >> 4, hh = bh & 3, b = bh >> 2;
    const int dk = tid & 127, qr = tid >> 7, dv0 = 16 * w;
    LAS bf16* Qs = (LAS bf16*)(F.lds + G_QS); LAS float* tot = (LAS float*)(F.lds + G_TOT); LAS float* Os = (LAS float*)(F.lds + G_OS);
    const bf16* GQ = (const bf16*)(F.ws + WS_GLAQ); const bf16* LA = (const bf16*)(F.ws + WS_LOGA); bf16* GV = (bf16*)(F.ws + WS_GLAV); const bf16* R = (const bf16*)(F.dout + DO_R);
    f32x4 Sc[8];
#pragma unroll
    for (int a = 0; a < 8; ++a) Sc[a] = (f32x4){0.f, 0.f, 0.f, 0.f};
#pragma unroll 1
    for (int sp = 0; sp < seg; ++sp) { const int it2 = bh * NSEG + sp; const v2u* LB = (const v2u*)(F.ws + WS_LB) + (size_t)it2 * 4096 + w * 512 + lane; const float* DS = (const float*)(F.ws + WS_DSEG) + it2 * 128 + 4 * g;
#pragma unroll
        for (int a = 0; a < 8; ++a) { const f32x4 dsc = *(const f32x4*)(DS + 16 * a); const v2u lv = LB[a * 64];
            Sc[a][0] = Sc[a][0] * dsc[0] + bflo(lv.x); Sc[a][1] = Sc[a][1] * dsc[1] + bfhi(lv.x); Sc[a][2] = Sc[a][2] * dsc[2] + bflo(lv.y); Sc[a][3] = Sc[a][3] * dsc[3] + bfhi(lv.y); } }
    bf16x8 Sb[4];
#pragma unroll
    for (int s = 0; s < 4; ++s) { v4u p; p.x = pk2(Sc[2 * s][0], Sc[2 * s][1]); p.y = pk2(Sc[2 * s][2], Sc[2 * s][3]); p.z = pk2(Sc[2 * s + 1][0], Sc[2 * s + 1][1]); p.w = pk2(Sc[2 * s + 1][2], Sc[2 * s + 1][3]); Sb[s] = __builtin_bit_cast(bf16x8, p); }
    float Bcum = 0.f;
    const int tk = tid >> 3, pc = tid & 7;
    f32x4 gn[4];
#pragma unroll
    for (int j = 0; j < 4; ++j) gn[j] = *(const f32x4*)(gnorm + 16 * pc + 4 * j);
#pragma unroll 1
    for (int ch = 0; ch < TSEG / 64; ++ch) {
        const size_t tokbase = (size_t)b * SEQ + seg * TSEG + ch * 64;
        const size_t gofs = (tokbase + 16 * qr) * 512 + hh * 128 + dk;
        float la[16], qv[16];
#pragma unroll
        for (int i4 = 0; i4 < 4; ++i4) { const bf16* pl = LA + gofs + (size_t)i4 * 2048; const bf16* pq = GQ + gofs + (size_t)i4 * 2048;
#pragma unroll
            for (int j = 0; j < 4; ++j) { la[4 * i4 + j] = bf2f(pl[j * 512]); qv[4 * i4 + j] = bf2f(pq[j * 512]); } }
#pragma unroll
        for (int i = 1; i < 16; ++i) la[i] += la[i - 1];
        tot[qr * 128 + dk] = la[15];
        __syncthreads();
        const float t0 = tot[dk], t1 = tot[128 + dk], t2 = tot[256 + dk], t3 = tot[384 + dk];
        const float base = Bcum + (qr > 0 ? t0 : 0.f) + (qr > 1 ? t1 : 0.f) + (qr > 2 ? t2 : 0.f);
        Bcum += (t0 + t1) + (t2 + t3);
#pragma unroll
        for (int i = 0; i < 16; ++i) Qs[(16 * qr + i) * QS_LD + dk] = f2bf(qv[i] * 0.08838834764831845f * __expf(base + la[i]));
        __syncthreads();
#pragma unroll
        for (int it = 0; it < 4; ++it) { f32x4 o = {0.f, 0.f, 0.f, 0.f};
            if (seg > 0) {
#pragma unroll
                for (int s = 0; s < 4; ++s) { const bf16x4 lo = *(const LAS bf16x4*)(Qs + (16 * it + fr) * QS_LD + 32 * s + 4 * g); const bf16x4 hi = *(const LAS bf16x4*)(Qs + (16 * it + fr) * QS_LD + 32 * s + 16 + 4 * g);
                    const bf16x8 qa = __builtin_shufflevector(lo, hi, 0, 1, 2, 3, 4, 5, 6, 7); o = MFMA16(qa, Sb[s], o); } }
            const bf16* op = GV + (tokbase + 16 * it + 4 * g) * 512 + hh * 128 + dv0 + fr;
#pragma unroll
            for (int rr = 0; rr < 4; ++rr) Os[(16 * it + 4 * g + rr) * OS_LD + dv0 + fr] = o[rr] + bf2f(op[(size_t)rr * 512]); }
        __syncthreads();
        { f32x4 v[4]; float ss = 0.f;
#pragma unroll
          for (int j = 0; j < 4; ++j) { v[j] = *(const LAS f32x4*)(Os + tk * OS_LD + 16 * pc + 4 * j); ss += (v[j].x * v[j].x + v[j].y * v[j].y) + (v[j].z * v[j].z + v[j].w * v[j].w); }
          ss += __shfl_xor(ss, 1); ss += __shfl_xor(ss, 2); ss += __shfl_xor(ss, 4);
          const float rinv = __frsqrt_rn(ss * (1.f / 128.f) + EPS);
          const size_t ofs = (tokbase + tk) * 512 + hh * 128 + 16 * pc;
          const v4u r0 = *(const v4u*)(R + ofs), r1 = *(const v4u*)(R + ofs + 8);
          v4u o0, o1;
          o0.x = pk2(v[0].x * rinv * gn[0].x * bflo(r0.x), v[0].y * rinv * gn[0].y * bfhi(r0.x)); o0.y = pk2(v[0].z * rinv * gn[0].z * bflo(r0.y), v[0].w * rinv * gn[0].w * bfhi(r0.y));
          o0.z = pk2(v[1].x * rinv * gn[1].x * bflo(r0.z), v[1].y * rinv * gn[1].y * bfhi(r0.z)); o0.w = pk2(v[1].z * rinv * gn[1].z * bflo(r0.w), v[1].w * rinv * gn[1].w * bfhi(r0.w));
          o1.x = pk2(v[2].x * rinv * gn[2].x * bflo(r1.x), v[2].y * rinv * gn[2].y * bfhi(r1.x)); o1.y = pk2(v[2].z * rinv * gn[2].z * bflo(r1.y), v[2].w * rinv * gn[2].w * bfhi(r1.y));
          o1.z = pk2(v[3].x * rinv * gn[3].x * bflo(r1.z), v[3].y * rinv * gn[3].y * bfhi(r1.z)); o1.w = pk2(v[3].z * rinv * gn[3].z * bflo(r1.w), v[3].w * rinv * gn[3].w * bfhi(r1.w));
          *(v4u*)(GV + ofs) = o0; *(v4u*)(GV + ofs + 8) = o1; }
        __syncthreads();
    }
}
DI void attn_merge_phase(const Frame& F) {
    const int gw = F.vcu * NWAVES + F.wave, NGW = F.G * NWAVES, lane = F.lane, head = lane >> 4;
    bf16* O0 = (bf16*)(F.ws + WS_DILQ); const float* LSE = (const float*)(F.ws + WS_LSE);
    for (int t = gw; t < T; t += NGW) {
        const float l0 = LSE[(size_t)t * 4 + head], l1 = LSE[(size_t)T * 4 + (size_t)t * 4 + head], l2 = LSE[(size_t)2 * T * 4 + (size_t)t * 4 + head];
        const float M = fmaxf(l0, fmaxf(l1, l2)); float w0 = exp2f(l0 - M), w1 = exp2f(l1 - M), w2 = exp2f(l2 - M); const float inv = 1.f / (w0 + w1 + w2); w0 *= inv; w1 *= inv; w2 *= inv;
        bf16* p = O0 + (size_t)t * 512 + 8 * lane; const v4u a = *(const v4u*)p, bq = *(const v4u*)(p + (size_t)T * 512), c = *(const v4u*)(p + (size_t)2 * T * 512);
        v4u o;
        o.x = pk2(w0 * bflo(a.x) + w1 * bflo(bq.x) + w2 * bflo(c.x), w0 * bfhi(a.x) + w1 * bfhi(bq.x) + w2 * bfhi(c.x));
        o.y = pk2(w0 * bflo(a.y) + w1 * bflo(bq.y) + w2 * bflo(c.y), w0 * bfhi(a.y) + w1 * bfhi(bq.y) + w2 * bfhi(c.y));
        o.z = pk2(w0 * bflo(a.z) + w1 * bflo(bq.z) + w2 * bflo(c.z), w0 * bfhi(a.z) + w1 * bfhi(bq.z) + w2 * bfhi(c.z));
        o.w = pk2(w0 * bflo(a.w) + w1 * bflo(bq.w) + w2 * bflo(c.w), w0 * bfhi(a.w) + w1 * bfhi(bq.w) + w2 * bfhi(c.w));
        *(v4u*)p = o; }
}

DI void router_phase(const Frame& F, const float* g2, const float* brg, const float* bre, unsigned* gcnt) {
    const int lane = F.lane, w = F.wave, fr = lane & 15, g = lane >> 4;
    const float* X1 = (const float*)(F.ws + WS_X1); bf16* H2 = (bf16*)(F.ws + WS_H2);
    const bf16* WRH = (const bf16*)(F.ws + WS_WRH); const bf16* WRL = WRH + 48 * 1024;
    int* TOKE = (int*)(F.ws + WS_TOKE); float* TOKW = (float*)(F.ws + WS_TOKW); int* TOKR = (int*)(F.ws + WS_TOKR);
    LAS float* lg = (LAS float*)(F.lds + w * 4096);
    LAS int* cnt = (LAS int*)(F.lds + 65536); LAS int* basev = cnt + 32;
    for (int it = 0; it * F.G * 128 < T; ++it) {
        const int tok0 = (it * F.G + F.vcu) * 128 + w * 16;
        if (F.tid < 32) cnt[F.tid] = 0;
        __syncthreads();
        f32x4 acc[3]; acc[0] = acc[1] = acc[2] = (f32x4){0.f, 0.f, 0.f, 0.f};
        float ss = 0.f;
        const float* xr = X1 + (size_t)(tok0 + fr) * D + 8 * g;
        for (int s = 0; s < 32; ++s) {
            const f32x4 xa = *(const f32x4*)(xr + 32 * s), xb = *(const f32x4*)(xr + 32 * s + 4);
            const f32x4 ga = *(const f32x4*)(g2 + 32 * s + 8 * g), gb = *(const f32x4*)(g2 + 32 * s + 8 * g + 4);
            ss += (xa.x * xa.x + xa.y * xa.y) + (xa.z * xa.z + xa.w * xa.w) + (xb.x * xb.x + xb.y * xb.y) + (xb.z * xb.z + xb.w * xb.w);
            const f32x4 ya = xa * ga, yb = xb * gb;
            v4u hi; hi.x = pk2(ya.x, ya.y); hi.y = pk2(ya.z, ya.w); hi.z = pk2(yb.x, yb.y); hi.w = pk2(yb.z, yb.w);
            v4u lo; lo.x = pk2(ya.x - bflo(hi.x), ya.y - bfhi(hi.x)); lo.y = pk2(ya.z - bflo(hi.y), ya.w - bfhi(hi.y)); lo.z = pk2(yb.x - bflo(hi.z), yb.y - bfhi(hi.z)); lo.w = pk2(yb.z - bflo(hi.w), yb.w - bfhi(hi.w));
            const bf16x8 ah = __builtin_bit_cast(bf16x8, hi), al = __builtin_bit_cast(bf16x8, lo);
#pragma unroll
            for (int nt = 0; nt < 3; ++nt) { const bf16x8 bh = *(const bf16x8*)(WRH + (size_t)(16 * nt + fr) * 1024 + 32 * s + 8 * g), bl = *(const bf16x8*)(WRL + (size_t)(16 * nt + fr) * 1024 + 32 * s + 8 * g);
                acc[nt] = MFMA16(ah, bh, acc[nt]); acc[nt] = MFMA16(ah, bl, acc[nt]); acc[nt] = MFMA16(al, bh, acc[nt]); }
        }
        ss += __shfl_xor(ss, 16); ss += __shfl_xor(ss, 32);
        const float rinv = __frsqrt_rn(ss * (1.f / D) + EPS);
#pragma unroll
        for (int rr = 0; rr < 4; ++rr) { const float ri = __shfl(rinv, 4 * g + rr);
#pragma unroll
            for (int nt = 0; nt < 3; ++nt) lg[(4 * g + rr) * 48 + 16 * nt + fr] = acc[nt][rr] * ri; }
        { bf16* hr = H2 + (size_t)(tok0 + fr) * D + 8 * g;
          for (int s = 0; s < 32; ++s) { const f32x4 xa = *(const f32x4*)(xr + 32 * s), xb = *(const f32x4*)(xr + 32 * s + 4);
              const f32x4 ga = *(const f32x4*)(g2 + 32 * s + 8 * g), gb = *(const f32x4*)(g2 + 32 * s + 8 * g + 4);
              v4u o; o.x = pk2(xa.x * rinv * ga.x, xa.y * rinv * ga.y); o.y = pk2(xa.z * rinv * ga.z, xa.w * rinv * ga.w); o.z = pk2(xb.x * rinv * gb.x, xb.y * rinv * gb.y); o.w = pk2(xb.z * rinv * gb.z, xb.w * rinv * gb.w);
              *(v4u*)(hr + 32 * s) = o; } }
        LDS_WAIT(); asm volatile("" ::: "memory");
        int e1 = 0, e2 = 0, lr1 = 0, lr2 = 0; float w1 = 0.f, w2 = 0.f;
        if (lane < 16) { const LAS float* q = lg + lane * 48;
            float gl[4]; int gs = 0; float gm = -3.0e38f;
#pragma unroll
            for (int j = 0; j < 4; ++j) { gl[j] = q[j] + brg[j]; if (gl[j] > gm) { gm = gl[j]; gs = j; } }
            float gsum = 0.f;
#pragma unroll
            for (int j = 0; j < 4; ++j) gsum += __expf(gl[j] - gm);
            const float gp = 1.f / gsum;
            float el[8]; int i1 = 0; float v1 = -3.0e38f;
#pragma unroll
            for (int j = 0; j < 8; ++j) { el[j] = q[4 + 8 * gs + j] + bre[8 * gs + j]; if (el[j] > v1) { v1 = el[j]; i1 = j; } }
            int i2 = 0; float v2 = -3.0e38f;
#pragma unroll
            for (int j = 0; j < 8; ++j) if (j != i1 && el[j] > v2) { v2 = el[j]; i2 = j; }
            const float p2 = 1.f / (1.f + __expf(v1 - v2)), p1 = 1.f - p2;
            e1 = 8 * gs + i1; e2 = 8 * gs + i2; w1 = p1 * gp; w2 = p2 * gp;
            lr1 = __hip_atomic_fetch_add(&cnt[e1], 1, __ATOMIC_RELAXED, __HIP_MEMORY_SCOPE_WORKGROUP); lr2 = __hip_atomic_fetch_add(&cnt[e2], 1, __ATOMIC_RELAXED, __HIP_MEMORY_SCOPE_WORKGROUP); }
        __syncthreads();
        if (F.tid < 32) basev[F.tid] = (int)atomicAdd(&gcnt[64 * F.tid], (unsigned)cnt[F.tid]);
        __syncthreads();
        if (lane < 16) { const int t = tok0 + lane; TOKE[2 * t] = e1; TOKE[2 * t + 1] = e2; TOKW[2 * t] = w1; TOKW[2 * t + 1] = w2; TOKR[2 * t] = basev[e1] + lr1; TOKR[2 * t + 1] = basev[e2] + lr2; }
        __syncthreads();
    }
}
DI void moe_assign_phase(const Frame& F, unsigned* gcnt) {
    LAS int* pst = (LAS int*)(F.lds + 65536);
    if (F.tid == 0) { int p = 0; int* BLKE = (int*)(F.ws + WS_BLKE);
        for (int e = 0; e < 32; ++e) { pst[e] = p; const int c = (int)__hip_atomic_load(&gcnt[64 * e], __ATOMIC_RELAXED, __HIP_MEMORY_SCOPE_AGENT); const int nb = (c + 255) >> 8;
            if (F.vcu == 0) for (int j = 0; j < nb; ++j) BLKE[(p >> 8) + j] = e;
            p += nb << 8; }
        if (F.vcu == 0) BLKE[NBLK_MAX] = p >> 8; }
    __syncthreads();
    const int gw = F.vcu * NWAVES + F.wave, NGW = F.G * NWAVES, lane = F.lane;
    const int* TOKE = (const int*)(F.ws + WS_TOKE); const float* TOKW = (const float*)(F.ws + WS_TOKW); const int* TOKR = (const int*)(F.ws + WS_TOKR);
    int* DEST = (int*)(F.ws + WS_DEST); float* ROWW = (float*)(F.ws + WS_ROWW);
    const bf16* H2 = (const bf16*)(F.ws + WS_H2); bf16* XP = (bf16*)(F.ws + WS_XP);
    for (int p = gw; p < 2 * T; p += NGW) { const int e = TOKE[p], dest = pst[e] + TOKR[p], t = p >> 1;
        if (lane == 0) { DEST[p] = dest; ROWW[dest] = TOKW[p]; }
        const v4u* s = (const v4u*)(H2 + (size_t)t * D); v4u* d = (v4u*)(XP + (size_t)dest * D);
        d[lane] = s[lane]; d[64 + lane] = s[64 + lane]; }
}
DI void combine_phase(const Frame& F, float* out) {
    const int gw = F.vcu * NWAVES + F.wave, NGW = F.G * NWAVES, lane = F.lane;
    const float* X1 = (const float*)(F.ws + WS_X1); const bf16* Y = (const bf16*)(F.ws + WS_Y); const int* DEST = (const int*)(F.ws + WS_DEST);
    for (int t = gw; t < T; t += NGW) { const int d0 = DEST[2 * t], d1 = DEST[2 * t + 1];
#pragma unroll
        for (int j = 0; j < 2; ++j) { const int c = 8 * lane + 512 * j;
            const f32x4 xa = *(const f32x4*)(X1 + (size_t)t * D + c), xb = *(const f32x4*)(X1 + (size_t)t * D + c + 4);
            const v4u a = *(const v4u*)(Y + (size_t)d0 * D + c), b = *(const v4u*)(Y + (size_t)d1 * D + c);
            f32x4 oa, ob;
            oa.x = xa.x + bflo(a.x) + bflo(b.x); oa.y = xa.y + bfhi(a.x) + bfhi(b.x); oa.z = xa.z + bflo(a.y) + bflo(b.y); oa.w = xa.w + bfhi(a.y) + bfhi(b.y);
            ob.x = xb.x + bflo(a.z) + bflo(b.z); ob.y = xb.y + bfhi(a.z) + bfhi(b.z); ob.z = xb.z + bflo(a.w) + bflo(b.w); ob.w = xb.w + bfhi(a.w) + bfhi(b.w);
            *(f32x4*)(out + (size_t)t * D + c) = oa; *(f32x4*)(out + (size_t)t * D + c + 4) = ob; } }
}

constexpr int PER_PHASE = 13;
struct Args { Ins I; float* out; unsigned char* ws; int ph_lo, ph_hi, li, pad; };
__global__ void __launch_bounds__(NTHR, 2) fwd_kernel(Args args) {
    extern __shared__ __attribute__((aligned(16))) unsigned char lds[];
    Frame F;
    F.lds = (LAS unsigned char*)lds;
    F.tid = threadIdx.x; F.lane = F.tid & 63; F.wave = __builtin_amdgcn_readfirstlane(F.tid >> 6);
    F.G = gridDim.x; { const int bx = blockIdx.x; F.vcu = (F.G % 8 == 0) ? (bx % 8) * (F.G / 8) + bx / 8 : bx; }
    F.ws = args.ws; F.dout = (unsigned char*)args.out;
    unsigned* ctl = (unsigned*)(args.ws + WS_CTL);
    volatile LAS unsigned* MISC = (volatile LAS unsigned*)(F.lds + MISC_OFF);
    for (int u = F.tid; u < (LDS_BYTES - LDSCTL_OFF) / 4; u += NTHR) ((LAS unsigned*)(F.lds + LDSCTL_OFF))[u] = 0u;
    __syncthreads();
    XcdBarrier bar; bar.bar = ctl + CW_BAR; bar.x = 0; bar.st = nullptr;
    if (MK_N_LAUNCHES == 1) bar = xcd_barrier_post(ctl + CW_BAR, MISC + 8);
    const int lo = args.ph_lo, hi = args.ph_hi;
#ifdef ONLY_PHASE
#define IN(k) ((k) == ONLY_PHASE && lo <= (k) && (k) < hi)
#else
#define IN(k) (lo <= (k) && (k) < hi)
#endif
#define SEAM(k) do { if (IN(k) && IN((k) + 1)) xcd_barrier(bar); } while (0)
    const Ins& I = args.I;
    unsigned char* ws = args.ws;

    if (IN(0)) { p0_prologue(F, I); SEAM(0); }

    if (IN(1)) {
        pg8::GemmDesc g{1024, 1024, 1024};
        pg8::OrderStd S{T / 256, N1 / 256, F.G, (int)blockIdx.x, (const char*)(ws + WS_XN), (const char*)(ws + WS_W1T), (size_t)256 * 1024 * 2, (size_t)256 * 1024 * 2};
        pg8::EpiP1 E{(bf16*)(ws + WS_GLAQ), (bf16*)(ws + WS_GLAK), (bf16*)(ws + WS_GLAV), (bf16*)(F.dout + DO_R), (bf16*)(ws + WS_LOGA), (bf16*)(ws + WS_DILQ), (bf16*)(ws + WS_DILK), (bf16*)(ws + WS_DILVT), I.in[4]};
        pg8::gemm_phase<pg8::EpiP1, pg8::OrderStd>(F.lds + RING_OFF, g, S, E);
        SEAM(1);
    }
    if (IN(2)) { qk_norm_phase(F, I.in[6], I.in[7]); SEAM(2); }
    if (IN(3)) {
        for (int it = F.vcu; it < 16 * NSEG; it += F.G) gla_pass1(F, it);
        const int gw = F.vcu * NWAVES + F.wave, NGW = F.G * NWAVES;
        for (int j = gw; j < 3 * 4096; j += NGW) attn_job(F, j);
        SEAM(3);
    }
    if (IN(4)) {
        for (int it = F.vcu; it < 16 * NSEG; it += F.G) gla_pass2(F, it, I.in[5]);
        attn_merge_phase(F);
        SEAM(4);
    }
    if (IN(5)) {
        pg8::GemmDesc g{1024, 1024, 1024};
        pg8::OrderStd S{T / 256, 2048 / 256, F.G, (int)blockIdx.x, (const char*)(ws + WS_XN), (const char*)(ws + WS_WBGT), (size_t)256 * 1024 * 2, (size_t)256 * 1024 * 2};
        pg8::EpiGate E{(bf16*)(ws + WS_GATES), I.in[11]};
        pg8::gemm_phase<pg8::EpiGate, pg8::OrderStd>(F.lds + RING_OFF, g, S, E);
        SEAM(5);
    }
    if (IN(6)) {
        pg8::GemmDesc g{512, 512, 512};
        pg8::OrderPair S{T / 256, 4, F.G, (int)blockIdx.x, (const char*)(ws + WS_GLAV), (const char*)(ws + WS_DILQ), (const char*)(ws + WS_WPGT), (const char*)(ws + WS_WPAT), (size_t)256 * 512 * 2, (size_t)256 * 512 * 2};
        pg8::EpiMerge E{(bf16*)(ws + WS_MERGED), (const bf16*)(ws + WS_GATES)};
        pg8::gemm_phase<pg8::EpiMerge, pg8::OrderPair>(F.lds + RING_OFF, g, S, E);
        SEAM(6);
    }
    if (IN(7)) {
        pg8::GemmDesc g{1024, 1024, 1024};
        pg8::OrderStd S{T / 256, 4, F.G, (int)blockIdx.x, (const char*)(ws + WS_MERGED), (const char*)(ws + WS_WOUTT), (size_t)256 * 1024 * 2, (size_t)256 * 1024 * 2};
        pg8::EpiX1 E{(float*)(ws + WS_X1), I.in[0]};
        pg8::gemm_phase<pg8::EpiX1, pg8::OrderStd>(F.lds + RING_OFF, g, S, E);
        SEAM(7);
    }
    if (IN(8)) { router_phase(F, I.in[13], I.in[15], I.in[17], ctl + CW_GCNT); SEAM(8); }
    if (IN(9)) { moe_assign_phase(F, ctl + CW_GCNT); SEAM(9); }
    if (IN(10)) {
        const int* BLKE = (const int*)(ws + WS_BLKE); const int nblk = BLKE[NBLK_MAX];
        pg8::GemmDesc g{1024, 1024, 1024};
        pg8::OrderMoe S{nblk, F.G, (int)blockIdx.x, BLKE, (const char*)(ws + WS_XP), (const char*)(F.dout + DO_EXPGU), (size_t)256 * 1024 * 2, (size_t)1024 * 1024 * 2, (size_t)256 * 1024 * 2};
        pg8::EpiGU E{(bf16*)(ws + WS_HBUF), (const float*)(ws + WS_ROWW)};
        pg8::gemm_phase<pg8::EpiGU, pg8::OrderMoe>(F.lds + RING_OFF, g, S, E);
        SEAM(10);
    }
    if (IN(11)) {
        const int* BLKE = (const int*)(ws + WS_BLKE); const int nblk = BLKE[NBLK_MAX];
        pg8::GemmDesc g{512, 512, 512};
        pg8::OrderMoe S{nblk, F.G, (int)blockIdx.x, BLKE, (const char*)(ws + WS_HBUF), (const char*)(F.dout + DO_EXPDN), (size_t)256 * 512 * 2, (size_t)1024 * 512 * 2, (size_t)256 * 512 * 2};
        pg8::EpiY E{(bf16*)(ws + WS_Y)};
        pg8::gemm_phase<pg8::EpiY, pg8::OrderMoe>(F.lds + RING_OFF, g, S, E);
        SEAM(11);
    }
    if (IN(12)) { combine_phase(F, args.out); }
#undef IN
#undef SEAM
}

extern "C" void kernel_launch(void* const* d_in, const int* in_sizes, int n_in, void* d_out, int out_size, void* d_ws, size_t ws_size, hipStream_t stream) {
    static int grid = 0;
    if (grid == 0) {
        if (n_in != 21 || out_size != T * D || ws_size < WS_END) { fprintf(stderr, "kernel_launch: unexpected shapes (n_in %d out %d ws %zu)\n", n_in, out_size, ws_size); grid = -1; return; }
        int dev = 0, cus = 0, per_cu = 0;
        if (hipGetDevice(&dev) != hipSuccess || hipDeviceGetAttribute(&cus, hipDeviceAttributeMultiprocessorCount, dev) != hipSuccess) { grid = -1; return; }
        if (hipFuncSetAttribute((const void*)fwd_kernel, hipFuncAttributeMaxDynamicSharedMemorySize, LDS_BYTES) != hipSuccess) { fprintf(stderr, "kernel_launch: hipFuncSetAttribute failed\n"); grid = -1; return; }
        if (hipOccupancyMaxActiveBlocksPerMultiprocessor(&per_cu, (const void*)fwd_kernel, NTHR, LDS_BYTES) != hipSuccess || per_cu < 1) fprintf(stderr, "kernel_launch: occupancy query reports %d\n", per_cu);
        (void)hipGetLastError();
        grid = cus;
    }
    if (grid < 0) return;
    if (hipMemsetAsync((char*)d_ws + WS_CTL, 0, CTL_ZERO_BYTES, stream) != hipSuccess) return;
    Args a{};
    for (int i = 0; i < 21; ++i) a.I.in[i] = (const float*)d_in[i];
    a.out = (float*)d_out; a.ws = (unsigned char*)d_ws;
    if (MK_N_LAUNCHES == 1) { a.ph_lo = 0; a.ph_hi = PER_PHASE; a.li = 0; hipLaunchKernelGGL(fwd_kernel, dim3(grid), dim3(NTHR), LDS_BYTES, stream, a); }
    else for (int li = 0; li < PER_PHASE; ++li) { a.ph_lo = li; a.ph_hi = li + 1; a.li = li; hipLaunchKernelGGL(fwd_kernel, dim3(grid), dim3(NTHR), LDS_BYTES, stream, a); }
}
```

```cpp
#include <hip/hip_runtime.h>
#include <cstdio>
#include <cstdint>

#ifndef MK_N_LAUNCHES
#define MK_N_LAUNCHES 1
#endif

#define GAS __attribute__((address_space(1)))
#define LAS __attribute__((address_space(3)))
typedef unsigned short bf16;
typedef unsigned v4u __attribute__((ext_vector_type(4)));
typedef unsigned v2u __attribute__((ext_vector_type(2)));
typedef float f32x2 __attribute__((ext_vector_type(2)));
typedef float f32x4 __attribute__((ext_vector_type(4)));
typedef float f32x16 __attribute__((ext_vector_type(16)));
typedef short bf16x8 __attribute__((ext_vector_type(8)));
typedef short bf16x4 __attribute__((ext_vector_type(4)));
typedef __bf16 hbf2 __attribute__((ext_vector_type(2)));

#define DI __device__ __forceinline__
DI unsigned pk2(float lo, float hi) { f32x2 v = {lo, hi}; hbf2 r = __builtin_convertvector(v, hbf2); return __builtin_bit_cast(unsigned, r); }
DI bf16 f2bf(float f) { return (bf16)(pk2(f, 0.f) & 0xffffu); }
DI float bf2f(bf16 b) { return __builtin_bit_cast(float, ((unsigned)b) << 16); }
DI float bflo(unsigned u) { return __builtin_bit_cast(float, u << 16); }
DI float bfhi(unsigned u) { return __builtin_bit_cast(float, u & 0xffff0000u); }

constexpr int T = 32768, D = 1024, SEQ = 8192;
constexpr int N1 = 7168;
constexpr int IN_COLS = 6672;
constexpr int NSEG = 16, TSEG = SEQ / NSEG;
constexpr float EPS = 1e-6f;
constexpr float LOG2E = 1.4426950408889634f;
constexpr int PMAX = 65536 + 32 * 256;
constexpr int NBLK_MAX = PMAX / 256;

constexpr size_t MiB = 1u << 20;
constexpr size_t WS_CTL = 0, CTL_ZERO_BYTES = 256 * 1024;
constexpr size_t WS_LB = 1 * MiB;
constexpr size_t WS_W1T = 1 * MiB;
constexpr size_t WS_WBGT = 15 * MiB, WS_WPGT = 19 * MiB, WS_WPAT = 20 * MiB, WS_WOUTT = 21 * MiB, WS_WRH = 23 * MiB;
constexpr size_t WS_XN = 24 * MiB;
constexpr size_t WS_GLAQ = 88 * MiB, WS_GLAK = 120 * MiB, WS_LOGA = 152 * MiB, WS_GLAV = 184 * MiB;
constexpr size_t WS_DILQ = 216 * MiB, WS_DILK = 312 * MiB, WS_DILV = 408 * MiB;
constexpr size_t WS_STATS = 504 * MiB;
constexpr size_t WS_LSE = WS_STATS;
constexpr size_t WS_DSEG = WS_STATS + 1536 * 1024;
constexpr size_t WS_TOKE = WS_STATS + 2 * MiB;
constexpr size_t WS_TOKW = WS_TOKE + 256 * 1024;
constexpr size_t WS_TOKR = WS_TOKW + 256 * 1024;
constexpr size_t WS_DEST = WS_TOKR + 256 * 1024;
constexpr size_t WS_ROWW = WS_DEST + 256 * 1024;
constexpr size_t WS_BLKE = WS_ROWW + 320 * 1024;
constexpr size_t WS_END = 512 * MiB;
constexpr size_t WS_GATES = 376 * MiB;
constexpr size_t WS_MERGED = 312 * MiB;
constexpr size_t WS_X1 = 88 * MiB;
constexpr size_t WS_H2 = 24 * MiB;
constexpr size_t WS_XP = 216 * MiB;
constexpr size_t WS_HBUF = 360 * MiB;
constexpr size_t WS_Y = 216 * MiB;
constexpr size_t DO_R = 0;
constexpr size_t DO_EXPGU = 32 * MiB;
constexpr size_t DO_EXPDN = 96 * MiB;
constexpr int CW_BAR = 4096;
constexpr int CW_GCNT = 16384;

constexpr int RING_OFF = 0, RING_BYTES = 131072;
constexpr int LDSCTL_OFF = RING_BYTES, MISC_OFF = LDSCTL_OFF + 320;
constexpr int LDS_BYTES = 147456;

#define XB_TMO      128
#define XB_XCNT(j)  (256  + 64 * (j))
#define XB_XSUB(j)  (1280 + 64 * (j))
#define XB_XGEN(j)  (2304 + 64 * (j))
#define XB_TOP      3328
#define XB_TOPGEN   3392
#define XCD_BAR_WORDS 3456
#define XB_SPIN_CAP (1u << 18)
DI unsigned xb_ld(unsigned* p)              { return __hip_atomic_load(p, __ATOMIC_RELAXED, __HIP_MEMORY_SCOPE_AGENT); }
DI unsigned xb_add(unsigned* p, unsigned v) { return __hip_atomic_fetch_add(p, v, __ATOMIC_RELAXED, __HIP_MEMORY_SCOPE_AGENT); }
DI unsigned xb_xcc_id() { return (unsigned)__builtin_amdgcn_s_getreg((3 << 11) | 20) & 0xFu; }
#define XB_SPIN(cond, bar) do { unsigned _sp = 0; while (cond) { __builtin_amdgcn_s_sleep(1); \
    if ((++_sp & 255u) == 0u) { if (xb_ld(&(bar)[XB_TMO])) break; if (_sp > XB_SPIN_CAP) { atomicAdd(&(bar)[XB_TMO], 1u); break; } } } } while (0)
struct XcdBarrier { unsigned* bar; unsigned x; volatile LAS unsigned* st; };
DI XcdBarrier xcd_barrier_post(unsigned* bar, volatile LAS unsigned* st) {
    XcdBarrier b; b.bar = bar; b.x = xb_xcc_id(); b.st = st;
    if (threadIdx.x == 0) (void)xb_add(&bar[XB_XCNT(b.x)], 1u);
    return b;
}
DI void xcd_barrier_complete(unsigned* bar, unsigned x, unsigned& nloc, unsigned& nx) {
    const unsigned G = gridDim.x * gridDim.y * gridDim.z;
    unsigned sum, cnt, mine, sp = 0u;
    for (;;) {
        sum = 0u; cnt = 0u; mine = 0u;
#pragma unroll
        for (unsigned j = 0; j < 16; ++j) { const unsigned c = xb_ld(&bar[XB_XCNT(j)]); sum += c; cnt += (c > 0u) ? 1u : 0u; mine = (j == x) ? c : mine; }
        if (sum == G) break;
        __builtin_amdgcn_s_sleep(1);
        if ((++sp & 255u) == 0u) { if (xb_ld(&bar[XB_TMO])) break; if (sp > XB_SPIN_CAP) { atomicAdd(&bar[XB_TMO], 1u); break; } }
    }
    nloc = mine > 0u ? mine : 1u; nx = cnt > 0u ? cnt : 1u;
}
DI void xcd_barrier(const XcdBarrier& b) {
    asm volatile("s_waitcnt vmcnt(0)" ::: "memory");
    __syncthreads();
    if (threadIdx.x == 0) {
        unsigned* bar = b.bar;
        __builtin_amdgcn_s_waitcnt(0);
        unsigned nloc = b.st[0], nx = b.st[1];
        if (nloc == 0u) { xcd_barrier_complete(bar, b.x, nloc, nx); b.st[0] = nloc; b.st[1] = nx; }
        const unsigned old = xb_add(&bar[XB_XSUB(b.x)], 1u);
        const unsigned gen = old / nloc;
        if (old + 1u == (gen + 1u) * nloc) {
            __builtin_amdgcn_fence(__ATOMIC_RELEASE, "agent");
            asm volatile("s_waitcnt vmcnt(0)" ::: "memory");
            const unsigned og = xb_add(&bar[XB_TOP], 1u);
            const unsigned tg = og / nx;
            if (og + 1u == (tg + 1u) * nx) xb_add(&bar[XB_TOPGEN], 1u);
            else XB_SPIN(xb_ld(&bar[XB_TOPGEN]) == tg, bar);
            __builtin_amdgcn_fence(__ATOMIC_ACQUIRE, "agent");
            xb_add(&bar[XB_XGEN(b.x)], 1u);
            asm volatile("s_waitcnt vmcnt(0)" ::: "memory");
        } else {
            XB_SPIN(xb_ld(&bar[XB_XGEN(b.x)]) == gen, bar);
            __builtin_amdgcn_fence(__ATOMIC_ACQUIRE, "agent");
            asm volatile("s_waitcnt vmcnt(0)" ::: "memory");
        }
    }
    __syncthreads();
}

namespace pg8 {
constexpr int BM = 256, BK = 64, HALF = 128, HTB = HALF * BK * 2, STAGE_BYTES = 8 * HTB, NXCD = 8, WGM = 8;
__host__ __device__ __forceinline__ int lds_byte(int r, int c) { const int st = (r >> 4) * 2 + (c >> 5), rr = r & 15, cc = c & 31, ob = rr * 64 + cc * 2; return st * 1024 + (ob ^ (((ob >> 9) & 1) << 5)); }
__host__ __device__ __forceinline__ void stage_rc(int b, int& R, int& C) { const int st = b / 1024, sb = b % 1024, swz = sb ^ (((sb >> 9) & 1) << 5); R = (st >> 1) * 16 + swz / 64; C = (st & 1) * 32 + (swz % 64) / 2; }
__host__ __device__ __forceinline__ int perm32(int rho) { const int n = rho >> 4, i = rho & 15; return 8 * (i >> 2) + 4 * n + (i & 3); }

struct Unit { const char* A; const char* B; int pm, pn, aux; };
struct GemmDesc { int lda, ldb, K; };

DI bool static_tile(int L, int nM, int nN, int& pm, int& pn) {
    const int nwg = nM * nN; if (L >= nwg) return false;
    int wgid = L; { const int q = nwg / NXCD, r = nwg % NXCD, xcd = wgid % NXCD, off = wgid / NXCD; wgid = (xcd < r ? xcd * (q + 1) : r * (q + 1) + (xcd - r) * q) + off; }
    const int nig = WGM * nN, gid = wgid / nig, fm = gid * WGM, gsz = (nM - fm) < WGM ? (nM - fm) : WGM;
    pm = fm + ((wgid % nig) % gsz); pn = (wgid % nig) / gsz; return true;
}
struct OrderStd {
    int nM, nN, G, c; const char* A0; const char* B0; size_t sA, sB;
    DI bool next(int i, Unit& u) const {
        int pm, pn; if (!static_tile(i * G + c, nM, nN, pm, pn)) return false;
        u.pm = pm; u.pn = pn; u.aux = 0; u.A = A0 + (size_t)pm * sA; u.B = B0 + (size_t)pn * sB; return true;
    }
};
struct OrderPair {
    int nM, nN, G, c; const char* A0; const char* A1; const char* B0; const char* B1; size_t sA, sB;
    DI bool next(int i, Unit& u) const {
        int pm, pn; if (!static_tile((i >> 1) * G + c, nM, nN, pm, pn)) return false;
        const int br = i & 1; u.pm = pm; u.pn = pn; u.aux = br; u.A = (br ? A1 : A0) + (size_t)pm * sA; u.B = (br ? B1 : B0) + (size_t)pn * sB; return true;
    }
};
struct OrderMoe {
    int nblk, G, c; const int* blke; const char* A0; const char* B0; size_t sA, sE, sB;
    DI bool next(int i, Unit& u) const {
        int rb, pn;
        if ((G & 31) == 0) { const int R = G >> 2, per = R >> 3, loc = c >> 3; rb = i * R + (c & 7) * per + (loc >> 2); pn = loc & 3; }
        else { const int L = i * G + c; rb = L >> 2; pn = L & 3; }
        if (rb >= nblk) return false;
        const int e = blke[rb];
        u.pm = rb; u.pn = pn; u.aux = 0;
        u.A = A0 + (size_t)rb * sA; u.B = B0 + (size_t)e * sE + (size_t)pn * sB; return true;
    }
};

#define PG8_LAS __attribute__((address_space(3)))
template <class Epi, class Sched, bool ALIGN_EPI = true, bool SP2 = true>
DI void gemm_phase(PG8_LAS unsigned char* lds, const GemmDesc g, const Sched& S, const Epi& E) {
    const int tid = threadIdx.x, wid = __builtin_amdgcn_readfirstlane(tid >> 6), lane = tid & 63, wr = wid >> 2, wc = wid & 3, fr = lane & 15, fq = lane >> 4;
    const int K = g.K, nt = K / BK;
    unsigned voffA[2], voffB[2];
#pragma unroll
    for (int i = 0; i < 2; ++i) { int R, C; stage_rc(tid * 16 + i * 8192, R, C); const int Rb = Epi::PERM ? ((R & ~31) + perm32(R & 31)) : R;
        voffA[i] = (unsigned)(R * g.lda + C) * 2u; voffB[i] = (unsigned)(Rb * g.ldb + C) * 2u; }
    const size_t kstep = (size_t)(BK * 2);
    const size_t hstepA = (size_t)HALF * g.lda * 2, hstepB = (size_t)HALF * g.ldb * 2;
    const unsigned ldsw = (unsigned)wid * 1024u;
    const int aoff = lds_byte(wr * 64 + fr, fq * 8), boff = lds_byte(wc * 32 + fr, fq * 8);
#define PG8_SA(b, h) (((b) * 2 + (h)) * HTB)
#define PG8_SB(b, h) ((4 + (b) * 2 + (h)) * HTB)
#define PG8_STAGE(bufoff, gbase, voff) do { _Pragma("unroll") for (int _i = 0; _i < 2; ++_i) \
        __builtin_amdgcn_global_load_lds((const unsigned*)((const char*)(gbase) + (voff)[_i]), (PG8_LAS unsigned*)(lds + (bufoff) + ldsw + _i * 8192), 16, 0, 0); } while (0)
#define PG8_LDA(dst, b, h) do { _Pragma("unroll") for (int m = 0; m < 4; ++m) _Pragma("unroll") for (int k = 0; k < 2; ++k) dst[m][k] = *(const PG8_LAS bf16x8*)(lds + PG8_SA(b, h) + aoff + m * 2048 + k * 1024); } while (0)
#define PG8_LDB(dst, b, h) do { _Pragma("unroll") for (int n = 0; n < 2; ++n) _Pragma("unroll") for (int k = 0; k < 2; ++k) dst[n][k] = *(const PG8_LAS bf16x8*)(lds + PG8_SB(b, h) + boff + n * 2048 + k * 1024); } while (0)
#define PG8_MMA(ai, bj, At, Bt) do { __builtin_amdgcn_s_setprio(1); _Pragma("unroll") for (int m = 0; m < 4; ++m) _Pragma("unroll") for (int n = 0; n < 2; ++n) _Pragma("unroll") for (int k = 0; k < 2; ++k) \
        acc[ai][bj][m][n] = __builtin_amdgcn_mfma_f32_16x16x32_bf16(Bt[n][k], At[m][k], acc[ai][bj][m][n], 0, 0, 0); __builtin_amdgcn_s_setprio(0); } while (0)
#define PG8_WAIT_V(n) asm volatile("s_waitcnt vmcnt(" #n ")" ::: "memory")
#define PG8_WAIT_L(n) asm volatile("s_waitcnt lgkmcnt(" #n ")" ::: "memory")
#define PG8_BAR __builtin_amdgcn_s_barrier()
#define PG8_SCHED __builtin_amdgcn_sched_barrier(0)
    Unit cur, nxt; int ui = 0;
    if (!S.next(0, cur)) return;
    f32x4 acc[2][2][4][2];
#pragma unroll
    for (int a = 0; a < 2; ++a)
#pragma unroll
        for (int b = 0; b < 2; ++b)
#pragma unroll
            for (int m = 0; m < 4; ++m)
#pragma unroll
                for (int n = 0; n < 2; ++n) acc[a][b][m][n] = (f32x4){0.f, 0.f, 0.f, 0.f};
    bf16x8 At[4][2], B0[2][2], B1[2][2];
    const char* cA = cur.A; const char* cB = cur.B;
    if constexpr (SP2) {
        PG8_STAGE(PG8_SB(0, 0), cB, voffB); PG8_STAGE(PG8_SB(0, 1), cB + hstepB, voffB); PG8_STAGE(PG8_SA(0, 0), cA, voffA); PG8_STAGE(PG8_SA(0, 1), cA + hstepA, voffA);
        if (wr == 1) PG8_BAR;
        PG8_WAIT_V(2); PG8_BAR;
        PG8_STAGE(PG8_SB(1, 0), cB + kstep, voffB); PG8_STAGE(PG8_SA(1, 0), cA + kstep, voffA); PG8_STAGE(PG8_SB(1, 1), cB + hstepB + kstep, voffB);
        PG8_WAIT_V(6); PG8_BAR;
    } else {
        PG8_STAGE(PG8_SB(0, 0), cB, voffB); PG8_STAGE(PG8_SA(0, 0), cA, voffA); PG8_STAGE(PG8_SB(0, 1), cB + hstepB, voffB); PG8_STAGE(PG8_SA(0, 1), cA + hstepA, voffA);
        if (wr == 1) PG8_BAR;
        PG8_WAIT_V(4); PG8_BAR;
        PG8_STAGE(PG8_SB(1, 0), cB + kstep, voffB); PG8_STAGE(PG8_SA(1, 0), cA + kstep, voffA); PG8_STAGE(PG8_SB(1, 1), cB + hstepB + kstep, voffB);
        PG8_WAIT_V(6); PG8_BAR;
    }
    for (;;) {
        const bool has_next = S.next(ui + 1, nxt);
        const char* nA = has_next ? nxt.A : cA; const char* nB = has_next ? nxt.B : cB;
        for (int t = 0; t < nt; t += 2) {
            const bool last = (t == nt - 2);
            const char* a1 = cA + (size_t)(t + 1) * kstep;
            const char* a2 = last ? nA : cA + (size_t)(t + 2) * kstep; const char* b2 = last ? nB : cB + (size_t)(t + 2) * kstep;
            const char* a3 = a2 + kstep; const char* b3 = b2 + kstep;
            if constexpr (SP2) {
            PG8_LDB(B0, 0, 0); PG8_LDB(B1, 0, 1); PG8_SCHED; PG8_LDA(At, 0, 0); PG8_STAGE(PG8_SA(1, 1), a1 + hstepA, voffA);
            PG8_WAIT_V(8); PG8_WAIT_L(0); PG8_BAR; PG8_MMA(0, 0, At, B0); PG8_MMA(0, 1, At, B1); PG8_BAR; PG8_SCHED;
            PG8_LDA(At, 0, 1); PG8_STAGE(PG8_SB(0, 0), b2, voffB); PG8_STAGE(PG8_SB(0, 1), b2 + hstepB, voffB); PG8_STAGE(PG8_SA(0, 0), a2, voffA);
            PG8_WAIT_V(8); PG8_WAIT_L(0); PG8_BAR; PG8_MMA(1, 0, At, B0); PG8_MMA(1, 1, At, B1); PG8_BAR; PG8_SCHED;
            PG8_LDB(B0, 1, 0); PG8_LDB(B1, 1, 1); PG8_SCHED; PG8_LDA(At, 1, 0); PG8_STAGE(PG8_SA(0, 1), a2 + hstepA, voffA);
            PG8_WAIT_V(8); PG8_WAIT_L(0); PG8_BAR; PG8_MMA(0, 0, At, B0); PG8_MMA(0, 1, At, B1); PG8_BAR; PG8_SCHED;
            PG8_LDA(At, 1, 1); PG8_STAGE(PG8_SB(1, 0), b3, voffB); PG8_STAGE(PG8_SB(1, 1), b3 + hstepB, voffB); PG8_STAGE(PG8_SA(1, 0), a3, voffA);
            PG8_WAIT_V(8); PG8_WAIT_L(0); PG8_BAR; PG8_MMA(1, 0, At, B0); PG8_MMA(1, 1, At, B1); PG8_BAR; PG8_SCHED;
            } else {
            PG8_LDB(B0, 0, 0); PG8_SCHED; PG8_LDA(At, 0, 0); PG8_STAGE(PG8_SA(1, 1), a1 + hstepA, voffA);
            PG8_WAIT_L(8); PG8_BAR; PG8_WAIT_L(0); PG8_MMA(0, 0, At, B0); PG8_BAR; PG8_SCHED;
            PG8_LDB(B1, 0, 1); PG8_STAGE(PG8_SB(0, 0), b2, voffB);
            PG8_BAR; PG8_WAIT_L(0); PG8_MMA(0, 1, At, B1); PG8_BAR;
            PG8_LDA(At, 0, 1); PG8_STAGE(PG8_SA(0, 0), a2, voffA);
            PG8_BAR; PG8_WAIT_L(0); PG8_MMA(1, 0, At, B0); PG8_BAR; PG8_SCHED;
            PG8_STAGE(PG8_SB(0, 1), b2 + hstepB, voffB);
            PG8_WAIT_V(6); PG8_BAR; PG8_MMA(1, 1, At, B1); PG8_BAR;
            PG8_LDB(B0, 1, 0); PG8_SCHED; PG8_LDA(At, 1, 0); PG8_STAGE(PG8_SA(0, 1), a2 + hstepA, voffA);
            PG8_WAIT_L(8); PG8_BAR; PG8_WAIT_L(0); PG8_MMA(0, 0, At, B0); PG8_BAR; PG8_SCHED;
            PG8_LDB(B1, 1, 1); PG8_STAGE(PG8_SB(1, 0), b3, voffB);
            PG8_BAR; PG8_WAIT_L(0); PG8_MMA(0, 1, At, B1); PG8_BAR;
            PG8_LDA(At, 1, 1); PG8_STAGE(PG8_SA(1, 0), a3, voffA);
            PG8_BAR; PG8_WAIT_L(0); PG8_MMA(1, 0, At, B0); PG8_BAR; PG8_SCHED;
            PG8_STAGE(PG8_SB(1, 1), b3 + hstepB, voffB);
            PG8_WAIT_V(6); PG8_BAR; PG8_MMA(1, 1, At, B1); PG8_BAR;
            }
        }
        if constexpr (ALIGN_EPI) { if (wr == 0) PG8_BAR; }
        E(acc, cur, wr, wc, fr, fq);
        if (!has_next) break;
#pragma unroll
        for (int a = 0; a < 2; ++a)
#pragma unroll
            for (int b = 0; b < 2; ++b)
#pragma unroll
                for (int m = 0; m < 4; ++m)
#pragma unroll
                    for (int n = 0; n < 2; ++n) acc[a][b][m][n] = (f32x4){0.f, 0.f, 0.f, 0.f};
        cur = nxt; cA = nA; cB = nB; ++ui;
        if constexpr (ALIGN_EPI) { if (wr == 1) PG8_BAR; }
    }
    PG8_WAIT_V(0);
    if constexpr (!ALIGN_EPI) { if (wr == 0) PG8_BAR; }
    PG8_BAR;
#undef PG8_SA
#undef PG8_SB
#undef PG8_STAGE
#undef PG8_LDA
#undef PG8_LDB
#undef PG8_MMA
#undef PG8_WAIT_V
#undef PG8_WAIT_L
#undef PG8_BAR
#undef PG8_SCHED
}

typedef f32x4 AccT[2][2][4][2];
DI float silu_f(float v) { return v / (1.f + __expf(-v)); }
DI float sigmoid_f(float v) { return 1.f / (1.f + __expf(-v)); }
DI float logsig16(float v) { return (fminf(v, 0.f) - __logf(1.f + __expf(-fabsf(v)))) * 0.0625f; }
DI v4u pack8(f32x4 a, f32x4 b) { v4u w; w.x = pk2(a[0], a[1]); w.y = pk2(a[2], a[3]); w.z = pk2(b[0], b[1]); w.w = pk2(b[2], b[3]); return w; }

struct EpiP1 {
    static constexpr bool PERM = true;
    unsigned char* ws; unsigned char* dout; const float* b_a; const float* gq; const float* gk; LAS float* xch;
    DI void operator()(const AccT& acc, const Unit& u, int wr, int wc, int fr, int fq) const {
        const int pn = u.pn, row0 = u.pm * BM + wr * 64 + fr, cl = wc * 32 + 8 * fq;
        const int rem = pn >= 10 ? (pn - 10) % 6 : 6, gi = pn >= 10 ? (pn - 10) / 6 : 0;
        int mode = 0; const int colbase = (pn & 1) * 256; size_t off;
        if (pn < 10) { const int bi = pn >> 1; off = bi == 0 ? WS_GLAQ : (bi == 1 ? WS_GLAK : (bi == 2 ? WS_GLAV : (bi == 3 ? DO_R : WS_LOGA))); mode = bi == 3 ? 1 : (bi == 4 ? 2 : 0); }
        else { off = (rem < 2 ? WS_DILQ : (rem < 4 ? WS_DILK : WS_DILV)) + (size_t)gi * T * 1024; mode = rem < 4 ? 3 : 0; }
        bf16* dst = (bf16*)(((pn >> 1) == 3 ? dout : ws) + off);
        if (mode == 3) {
            const bool isq = rem < 2;
#pragma unroll
            for (int ai = 0; ai < 2; ++ai)
#pragma unroll
                for (int m = 0; m < 4; ++m)
#pragma unroll
                    for (int bj = 0; bj < 2; ++bj) { const f32x4 v0 = acc[ai][bj][m][0], v1 = acc[ai][bj][m][1];
                        float ss = (v0[0] * v0[0] + v0[1] * v0[1]) + (v0[2] * v0[2] + v0[3] * v0[3]) + (v1[0] * v1[0] + v1[1] * v1[1]) + (v1[2] * v1[2] + v1[3] * v1[3]);
                        ss += __shfl_xor(ss, 16); ss += __shfl_xor(ss, 32);
                        if (fq == 0) xch[(ai * 128 + wr * 64 + m * 16 + fr) * 8 + bj * 4 + wc] = ss; }
            asm volatile("s_waitcnt lgkmcnt(0)" ::: "memory"); __builtin_amdgcn_s_barrier(); asm volatile("" ::: "memory");
            const float* gp = (isq ? gq : gk) + gi * 128 + cl; const f32x4 g0 = *(const f32x4*)gp, g1 = *(const f32x4*)(gp + 4);
            const float qs = isq ? 0.08838834764831845f * LOG2E : 1.f;
#pragma unroll
            for (int ai = 0; ai < 2; ++ai)
#pragma unroll
                for (int m = 0; m < 4; ++m) { bf16* rowp = dst + (size_t)(row0 + ai * HALF + m * 16) * 512 + colbase + cl;
#pragma unroll
                    for (int bj = 0; bj < 2; ++bj) { const f32x4 t = *(const LAS f32x4*)(xch + (ai * 128 + wr * 64 + m * 16 + fr) * 8 + bj * 4);
                        const float rinv = __frsqrt_rn(((t[0] + t[1]) + (t[2] + t[3])) * (1.f / 128.f) + EPS) * qs;
                        *(v4u*)(rowp + bj * HALF) = pack8(acc[ai][bj][m][0] * rinv * g0, acc[ai][bj][m][1] * rinv * g1); } }
            return;
        }
        f32x4 bv[2][2];
#pragma unroll
        for (int bj = 0; bj < 2; ++bj)
#pragma unroll
            for (int n = 0; n < 2; ++n) bv[bj][n] = (mode == 2) ? *(const f32x4*)(b_a + colbase + bj * HALF + cl + 4 * n) : (f32x4){0.f, 0.f, 0.f, 0.f};
#pragma unroll
        for (int ai = 0; ai < 2; ++ai)
#pragma unroll
            for (int m = 0; m < 4; ++m) { bf16* rowp = dst + (size_t)(row0 + ai * HALF + m * 16) * 512 + colbase + cl;
#pragma unroll
                for (int bj = 0; bj < 2; ++bj) { f32x4 v0 = acc[ai][bj][m][0] + bv[bj][0], v1 = acc[ai][bj][m][1] + bv[bj][1];
                    if (mode == 1) {
#pragma unroll
                        for (int j = 0; j < 4; ++j) { v0[j] = silu_f(v0[j]); v1[j] = silu_f(v1[j]); } }
                    if (mode == 2) {
#pragma unroll
                        for (int j = 0; j < 4; ++j) { v0[j] = logsig16(v0[j]); v1[j] = logsig16(v1[j]); } }
                    *(v4u*)(rowp + bj * HALF) = pack8(v0, v1); } }
    }
};
struct EpiGate {
    static constexpr bool PERM = true;
    bf16* G; const float* bias;
    DI void operator()(const AccT& acc, const Unit& u, int wr, int wc, int fr, int fq) const {
        const int row0 = u.pm * BM + wr * 64 + fr, col0 = u.pn * BM + wc * 32 + 8 * fq;
        f32x4 bv[2][2];
#pragma unroll
        for (int bj = 0; bj < 2; ++bj)
#pragma unroll
            for (int n = 0; n < 2; ++n) bv[bj][n] = *(const f32x4*)(bias + col0 + bj * HALF + 4 * n);
#pragma unroll
        for (int ai = 0; ai < 2; ++ai)
#pragma unroll
            for (int m = 0; m < 4; ++m) { bf16* rowp = G + (size_t)(row0 + ai * HALF + m * 16) * 2048 + col0;
#pragma unroll
                for (int bj = 0; bj < 2; ++bj) { f32x4 v0 = acc[ai][bj][m][0] + bv[bj][0], v1 = acc[ai][bj][m][1] + bv[bj][1];
#pragma unroll
                    for (int j = 0; j < 4; ++j) { v0[j] = sigmoid_f(v0[j]); v1[j] = sigmoid_f(v1[j]); }
                    *(v4u*)(rowp + bj * HALF) = pack8(v0, v1); } }
    }
};
struct EpiMerge {
    static constexpr bool PERM = true;
    bf16* Mg; const bf16* G;
    DI void operator()(const AccT& acc, const Unit& u, int wr, int wc, int fr, int fq) const {
        const int row0 = u.pm * BM + wr * 64 + fr, col0 = u.pn * BM + wc * 32 + 8 * fq, br = u.aux;
#pragma unroll
        for (int ai = 0; ai < 2; ++ai)
#pragma unroll
            for (int m = 0; m < 4; ++m) { const size_t row = (size_t)(row0 + ai * HALF + m * 16);
#pragma unroll
                for (int bj = 0; bj < 2; ++bj) { const int col = col0 + bj * HALF;
                    const v4u g = *(const v4u*)(G + row * 2048 + br * 1024 + col);
                    f32x4 v0 = acc[ai][bj][m][0], v1 = acc[ai][bj][m][1];
                    v0[0] *= bflo(g.x); v0[1] *= bfhi(g.x); v0[2] *= bflo(g.y); v0[3] *= bfhi(g.y); v1[0] *= bflo(g.z); v1[1] *= bfhi(g.z); v1[2] *= bflo(g.w); v1[3] *= bfhi(g.w);
                    bf16* p = Mg + row * 1024 + col;
                    if (br) { const v4u o = *(const v4u*)p;
                        v0[0] += bflo(o.x); v0[1] += bfhi(o.x); v0[2] += bflo(o.y); v0[3] += bfhi(o.y); v1[0] += bflo(o.z); v1[1] += bfhi(o.z); v1[2] += bflo(o.w); v1[3] += bfhi(o.w); }
                    *(v4u*)p = pack8(v0, v1); } }
    }
};
struct EpiX1 {
    static constexpr bool PERM = false;
    float* X1; const float* X;
    DI void operator()(const AccT& acc, const Unit& u, int wr, int wc, int fr, int fq) const {
        const int row0 = u.pm * BM + wr * 64 + fr, col0 = u.pn * BM + wc * 32 + 4 * fq;
#pragma unroll
        for (int ai = 0; ai < 2; ++ai)
#pragma unroll
            for (int m = 0; m < 4; ++m) { const size_t ro = (size_t)(row0 + ai * HALF + m * 16) * 1024 + col0;
#pragma unroll
                for (int bj = 0; bj < 2; ++bj)
#pragma unroll
                    for (int n = 0; n < 2; ++n) *(f32x4*)(X1 + ro + bj * HALF + n * 16) = acc[ai][bj][m][n] + *(const f32x4*)(X + ro + bj * HALF + n * 16); }
    }
};
struct EpiGU {
    static constexpr bool PERM = true;
    bf16* H; const float* roww;
    DI void operator()(const AccT& acc, const Unit& u, int wr, int wc, int fr, int fq) const {
        if (u.aux) return;
        const int row0 = u.pm * BM + wr * 64 + fr, hc0 = u.pn * 128 + wc * 16 + 4 * fq;
#pragma unroll
        for (int ai = 0; ai < 2; ++ai)
#pragma unroll
            for (int m = 0; m < 4; ++m) { const int row = row0 + ai * HALF + m * 16; const float w = roww[row];
#pragma unroll
                for (int bj = 0; bj < 2; ++bj) { const f32x4 g = acc[ai][bj][m][0], up = acc[ai][bj][m][1];
                    v2u o; o.x = pk2(w * silu_f(g[0]) * up[0], w * silu_f(g[1]) * up[1]); o.y = pk2(w * silu_f(g[2]) * up[2], w * silu_f(g[3]) * up[3]);
                    *(v2u*)(H + (size_t)row * 512 + hc0 + bj * 64) = o; } }
    }
};
struct EpiY {
    static constexpr bool PERM = true;
    bf16* Y;
    DI void operator()(const AccT& acc, const Unit& u, int wr, int wc, int fr, int fq) const {
        if (u.aux) return;
        const int row0 = u.pm * BM + wr * 64 + fr, col0 = u.pn * BM + wc * 32 + 8 * fq;
#pragma unroll
        for (int ai = 0; ai < 2; ++ai)
#pragma unroll
            for (int m = 0; m < 4; ++m) { bf16* rowp = Y + (size_t)(row0 + ai * HALF + m * 16) * 1024 + col0;
#pragma unroll
                for (int bj = 0; bj < 2; ++bj) *(v4u*)(rowp + bj * HALF) = pack8(acc[ai][bj][m][0], acc[ai][bj][m][1]); }
    }
};
}

constexpr int NWAVES = 8, NTHR = 512;
struct Frame {
    LAS unsigned char* lds;
    int tid, lane, wave, vcu, G;
    unsigned char* ws; unsigned char* dout;
};
#define LDS_WAIT() asm volatile("s_waitcnt lgkmcnt(0)" ::: "memory")
#define LDS_BARRIER() do { asm volatile("s_waitcnt lgkmcnt(0)" ::: "memory"); __builtin_amdgcn_s_barrier(); asm volatile("" ::: "memory"); } while (0)
DI float wave_sum(float v) {
#pragma unroll
    for (int o = 1; o < 64; o <<= 1) v += __shfl_xor(v, o);
    return v;
}
#define MFMA16(a, b, c) __builtin_amdgcn_mfma_f32_16x16x32_bf16((a), (b), (c), 0, 0, 0)
#define MFMA32(a, b, c) __builtin_amdgcn_mfma_f32_32x32x16_bf16((a), (b), (c), 0, 0, 0)

template <class RowMap>
DI void transpose_item(const float* W, int ldw, int k0, int c0, bf16* dst, int ldd, RowMap rowmap, LAS float* scr, int lane) {
#pragma unroll 8
    for (int i = 0; i < 32; ++i) { const int kk = 2 * i + (lane >> 5); scr[kk * 33 + (lane & 31)] = W[(size_t)(k0 + kk) * ldw + c0 + (lane & 31)]; }
    LDS_WAIT(); asm volatile("" ::: "memory");
    const int c = lane & 7;
#pragma unroll
    for (int j = 0; j < 4; ++j) { const int n = (lane >> 3) + 8 * j; const LAS float* s = scr + (8 * c) * 33 + n;
        v4u o; o.x = pk2(s[0 * 33], s[1 * 33]); o.y = pk2(s[2 * 33], s[3 * 33]); o.z = pk2(s[4 * 33], s[5 * 33]); o.w = pk2(s[6 * 33], s[7 * 33]);
        *(v4u*)(dst + (size_t)rowmap(n) * ldd + k0 + 8 * c) = o; }
    LDS_WAIT(); asm volatile("" ::: "memory");
}
struct Ins { const float* in[21]; };
DI void p0_prologue(const Frame& F, const Ins& I) {
    LAS float* scr = (LAS float*)(F.lds + RING_OFF + F.wave * 16384);
    const int gw = F.vcu * NWAVES + F.wave, NGW = F.G * NWAVES, lane = F.lane;
    bf16* W1T = (bf16*)(F.ws + WS_W1T); bf16* WBGT = (bf16*)(F.ws + WS_WBGT); bf16* WPGT = (bf16*)(F.ws + WS_WPGT); bf16* WPAT = (bf16*)(F.ws + WS_WPAT); bf16* WOUTT = (bf16*)(F.ws + WS_WOUTT);
    bf16* EXPGU = (bf16*)(F.dout + DO_EXPGU); bf16* EXPDN = (bf16*)(F.dout + DO_EXPDN);
    constexpr int I_IN = 16 * 208, I_BG = 16 * 64, I_PG = 8 * 32, I_PA = 8 * 32, I_OUT = 16 * 32, I_GU = 32 * 2 * 16 * 16, I_DN = 32 * 8 * 32;
    constexpr int NITEMS = I_IN + I_BG + I_PG + I_PA + I_OUT + I_GU + I_DN;
    for (int it = gw; it < NITEMS; it += NGW) {
        int r = it;
        if (r < I_IN) { const int kb = r / 208, nb = r % 208; const int n0 = nb < 64 ? nb * 32 : (nb - 64) * 32 + 2560; const int c0 = nb < 64 ? n0 : n0 - 496;
            transpose_item(I.in[2], IN_COLS, kb * 64, c0, W1T, 1024, [=](int n) { return n0 + n; }, scr, lane); continue; } r -= I_IN;
        if (r < I_BG) { const int kb = r / 64, nb = r % 64; transpose_item(I.in[10], 2048, kb * 64, nb * 32, WBGT, 1024, [=](int n) { return nb * 32 + n; }, scr, lane); continue; } r -= I_BG;
        if (r < I_PG) { const int kb = r / 32, nb = r % 32; transpose_item(I.in[8], 1024, kb * 64, nb * 32, WPGT, 512, [=](int n) { return nb * 32 + n; }, scr, lane); continue; } r -= I_PG;
        if (r < I_PA) { const int kb = r / 32, nb = r % 32; transpose_item(I.in[9], 1024, kb * 64, nb * 32, WPAT, 512, [=](int n) { return nb * 32 + n; }, scr, lane); continue; } r -= I_PA;
        if (r < I_OUT) { const int kb = r / 32, nb = r % 32; transpose_item(I.in[12], 1024, kb * 64, nb * 32, WOUTT, 1024, [=](int n) { return nb * 32 + n; }, scr, lane); continue; } r -= I_OUT;
        if (r < I_GU) { const int e = r / 512, q = r % 512, up = q >> 8, kb = (q >> 4) & 15, nb = q & 15;
            const float* src = (up ? I.in[19] : I.in[18]) + (size_t)e * 1024 * 512;
            transpose_item(src, 512, kb * 64, nb * 32, EXPGU + (size_t)e * 1024 * 1024, 1024, [=](int n) { const int c = nb * 32 + n; return (c >> 2) * 8 + (c & 3) + 4 * up; }, scr, lane); continue; } r -= I_GU;
        { const int e = r / 256, q = r % 256, kb = q / 32, nb = q % 32;
            transpose_item(I.in[20] + (size_t)e * 512 * 1024, 1024, kb * 64, nb * 32, EXPDN + (size_t)e * 1024 * 512, 512, [=](int n) { return nb * 32 + n; }, scr, lane); }
    }
    { const float* win = I.in[2]; const float* wa2 = I.in[3];
      for (int e = (F.vcu * NTHR + F.tid); e < 512 * 1024; e += F.G * NTHR) { const int k = e & 1023, n = e >> 10; const float* wr = win + (size_t)k * IN_COLS + 2048;
          float s = 0.f;
#pragma unroll
          for (int j = 0; j < 16; ++j) s += wr[j] * wa2[j * 512 + n];
          W1T[(size_t)(2048 + n) * 1024 + k] = f2bf(s); } }
    { bf16* WRH = (bf16*)(F.ws + WS_WRH); bf16* WRL = WRH + 48 * 1024; const float* wrg = I.in[14]; const float* wre = I.in[16];
      for (int e = (F.vcu * NTHR + F.tid); e < 48 * 1024; e += F.G * NTHR) { const int k = e & 1023, n = e >> 10;
          const float w = n < 4 ? wrg[k * 4 + n] : (n < 36 ? wre[k * 32 + n - 4] : 0.f); const bf16 h = f2bf(w); WRH[e] = h; WRL[e] = f2bf(w - bf2f(h)); } }
    { const float* x = I.in[0]; const float* g1 = I.in[1]; bf16* XN = (bf16*)(F.ws + WS_XN);
      f32x4 gv[4];
#pragma unroll
      for (int j = 0; j < 4; ++j) gv[j] = *(const f32x4*)(g1 + 4 * lane + 256 * j);
      for (int m = gw; m < T; m += NGW) { const f32x4* xr = (const f32x4*)(x + (size_t)m * D) + lane; f32x4 v[4]; float s = 0.f;
#pragma unroll
          for (int j = 0; j < 4; ++j) { v[j] = xr[64 * j]; s += (v[j].x * v[j].x + v[j].y * v[j].y) + (v[j].z * v[j].z + v[j].w * v[j].w); }
          const float rinv = __frsqrt_rn(wave_sum(s) * (1.f / D) + EPS);
          v2u* o8 = (v2u*)(XN + (size_t)m * D) + lane;
#pragma unroll
          for (int j = 0; j < 4; ++j) { v2u o; o.x = pk2(v[j].x * rinv * gv[j].x, v[j].y * rinv * gv[j].y); o.y = pk2(v[j].z * rinv * gv[j].z, v[j].w * rinv * gv[j].w); o8[64 * j] = o; } } }
}

DI void qk_norm_phase(const Frame& F, const float* gq, const float* gk, bool dry) {
    const int gw = F.vcu * NWAVES + F.wave, NGW = F.G * NWAVES, lane = F.lane;
    bf16* Q = (bf16*)(F.ws + WS_DILQ);
    for (int rr = gw; rr < 6 * T; rr += NGW) { const int which = rr / T; const int gi = which % 3; const bool isq = which < 3;
        bf16* p = Q + (size_t)rr * 512 + 8 * lane; const v4u v = *(const v4u*)p;
        float x[8] = {bflo(v.x), bfhi(v.x), bflo(v.y), bfhi(v.y), bflo(v.z), bfhi(v.z), bflo(v.w), bfhi(v.w)};
        float s = 0.f;
#pragma unroll
        for (int j = 0; j < 8; ++j) s += x[j] * x[j];
        s += __shfl_xor(s, 1); s += __shfl_xor(s, 2); s += __shfl_xor(s, 4); s += __shfl_xor(s, 8);
        const float rinv = __frsqrt_rn(s * (1.f / 128.f) + EPS) * (isq ? 0.08838834764831845f * LOG2E : 1.f);
        const float* g = (isq ? gq : gk) + gi * 128 + (8 * lane & 127);
        const f32x4 g0 = *(const f32x4*)g, g1 = *(const f32x4*)(g + 4);
        v4u o; o.x = pk2(x[0] * rinv * g0.x, x[1] * rinv * g0.y); o.y = pk2(x[2] * rinv * g0.z, x[3] * rinv * g0.w); o.z = pk2(x[4] * rinv * g1.x, x[5] * rinv * g1.y); o.w = pk2(x[6] * rinv * g1.z, x[7] * rinv * g1.w);
        if (!dry) *(v4u*)p = o; }
}

DI int crow(int i, int h) { return (i & 3) + 8 * (i >> 2) + 4 * h; }
DI int img_off(int row, int ch) { return 256 * row + 16 * (ch ^ (((row & 3) << 2) | ((row >> 2) & 3))); }
typedef short s16x4 __attribute__((ext_vector_type(4)));
DI void attn_job(const Frame& F, int job, bool dry) {
    const int lane = F.lane, r = lane & 31, h = lane >> 5;
    const int gi = job >> 12; int rem = job & 4095;
    const int sh = 2 * gi, d = 1 << sh, L = SEQ >> sh, nqt = L >> 5;
    const int qt = rem % nqt; rem /= nqt; const int res = rem & (d - 1); rem >>= sh; const int head = rem & 3, b = rem >> 2;
    const int p0 = qt * 32;
    const float slope = exp2f(-8.f * (float)(gi * 4 + head + 1) / 12.f) * LOG2E * (float)d;
    bf16* Qg = (bf16*)(F.ws + WS_DILQ) + (size_t)gi * T * 512;
    const bf16* Kg = (const bf16*)(F.ws + WS_DILK) + (size_t)gi * T * 512 + head * 128;
    const bf16* Vg = (const bf16*)(F.ws + WS_DILV) + (size_t)gi * T * 512 + head * 128;
    LAS unsigned char* Kimg = F.lds + F.wave * 16384; LAS unsigned char* Vimg = Kimg + 8192;
    const size_t qtok = (size_t)b * SEQ + (size_t)(p0 + r) * d + res;
    bf16x8 qf[8];
#pragma unroll
    for (int ks = 0; ks < 8; ++ks) qf[ks] = *(const bf16x8*)(Qg + qtok * 512 + head * 128 + 16 * ks + 8 * h);
    f32x16 O[4];
#pragma unroll
    for (int db = 0; db < 4; ++db)
#pragma unroll
        for (int i = 0; i < 16; ++i) O[db][i] = 0.f;
    float m = -1e30f, l = 0.f;
    const int srow = lane >> 4, sslot = lane & 15;
    v4u kst[8], vst[8];
    const int kt0 = p0 >= 128 ? 0 : (128 - p0) >> 5;
#define ATT_LOAD(ktn) do { const int _kb = p0 - 128 + 32 * (ktn); _Pragma("unroll") for (int i = 0; i < 8; ++i) { const int kk = 4 * i + srow; \
        const size_t _o = ((size_t)b * SEQ + (size_t)(_kb + kk) * d + res) * 512 + 8 * (sslot ^ ((srow << 2) | (i & 3))); kst[i] = *(const v4u*)(Kg + _o); vst[i] = *(const v4u*)(Vg + _o); } } while (0)
    ATT_LOAD(kt0);
#pragma unroll 1
    for (int kt = kt0; kt < 5; ++kt) { const int kb = p0 - 128 + 32 * kt;
#pragma unroll
        for (int i = 0; i < 8; ++i) { *(LAS v4u*)(Kimg + 1024 * i + 16 * lane) = kst[i]; *(LAS v4u*)(Vimg + 1024 * i + 16 * lane) = vst[i]; }
        if (kt + 1 < 5) ATT_LOAD(kt + 1);
        f32x16 s;
#pragma unroll
        for (int i = 0; i < 16; ++i) s[i] = 0.f;
#pragma unroll
        for (int ks = 0; ks < 8; ++ks) { const bf16x8 kf = *(const LAS bf16x8*)(Kimg + img_off(r, 2 * ks + h)); s = MFMA32(kf, qf[ks], s); }
        float mx = -1e30f; const int dq = p0 + r - kb;
#pragma unroll
        for (int i = 0; i < 16; ++i) { const int dist = dq - crow(i, h); const bool ok = dist >= 0 && dist <= 128; const float sv = ok ? s[i] - slope * (float)dist : -1e30f; s[i] = sv; mx = fmaxf(mx, sv); }
        mx = fmaxf(mx, __shfl_xor(mx, 32));
        const float mn = fmaxf(m, mx), alpha = exp2f(m - mn); m = mn;
        float ps = 0.f;
#pragma unroll
        for (int i = 0; i < 16; ++i) { const float p = s[i] > -1e29f ? exp2f(s[i] - mn) : 0.f; s[i] = p; ps += p; }
        l = l * alpha + ps;
#pragma unroll
        for (int db = 0; db < 4; ++db)
#pragma unroll
            for (int i = 0; i < 16; ++i) O[db][i] *= alpha;
        bf16x8 pb[2];
#pragma unroll
        for (int si = 0; si < 2; ++si) { v4u w; w.x = pk2(s[8 * si], s[8 * si + 1]); w.y = pk2(s[8 * si + 2], s[8 * si + 3]); w.z = pk2(s[8 * si + 4], s[8 * si + 5]); w.w = pk2(s[8 * si + 6], s[8 * si + 7]); pb[si] = __builtin_bit_cast(bf16x8, w); }
        { const int i16 = lane & 15, q = i16 >> 2, p = i16 & 3, gl = (lane >> 4) & 1;
#pragma unroll
          for (int db = 0; db < 4; ++db)
#pragma unroll
            for (int si = 0; si < 2; ++si) {
                const s16x4 lo = __builtin_amdgcn_ds_read_tr16_b64_v4i16((LAS s16x4*)(Vimg + img_off(16 * si + 4 * h + q, 4 * db + 2 * gl + (p >> 1)) + 8 * (p & 1)));
                const s16x4 hi = __builtin_amdgcn_ds_read_tr16_b64_v4i16((LAS s16x4*)(Vimg + img_off(16 * si + 8 + 4 * h + q, 4 * db + 2 * gl + (p >> 1)) + 8 * (p & 1)));
                const bf16x8 vf = __builtin_shufflevector(lo, hi, 0, 1, 2, 3, 4, 5, 6, 7); O[db] = MFMA32(vf, pb[si], O[db]); } }
    }
#undef ATT_LOAD
    const float lt = l + __shfl_xor(l, 32), inv = 1.f / lt;
    bf16* op = Qg + qtok * 512 + head * 128 + 4 * h;
    if (dry) return;
#pragma unroll
    for (int db = 0; db < 4; ++db)
#pragma unroll
        for (int q4 = 0; q4 < 4; ++q4) { v2u o; o.x = pk2(O[db][4 * q4] * inv, O[db][4 * q4 + 1] * inv); o.y = pk2(O[db][4 * q4 + 2] * inv, O[db][4 * q4 + 3] * inv); *(v2u*)(op + 32 * db + 8 * q4) = o; }
    if (h == 0) ((float*)(F.ws + WS_LSE))[(size_t)gi * T * 4 + qtok * 4 + head] = m + log2f(lt);
}

constexpr int G_QS = 0, G_KS = 17408, G_KET = 34816, G_VT = 53248, G_ATT = 71680, G_TOT = 80896, G_DL = 82944, G_OS = 84992;
constexpr int QS_LD = 136, KT_LD = 72, OS_LD = 132;
DI void gla_pass1(const Frame& F, int item, bool dry) {
    const int tid = F.tid, lane = F.lane, w = F.wave, fr = lane & 15, g = lane >> 4;
    const int seg = item & (NSEG - 1), bh = item >> 4, hh = bh & 3, b = bh >> 2;
    const int dk = tid & 127, qr = tid >> 7;
    LAS bf16* Qs = (LAS bf16*)(F.lds + G_QS); LAS bf16* Ks = (LAS bf16*)(F.lds + G_KS); LAS bf16* KEt = (LAS bf16*)(F.lds + G_KET); LAS bf16* Vt = (LAS bf16*)(F.lds + G_VT);
    LAS bf16* Att = (LAS bf16*)(F.lds + G_ATT); LAS float* tot = (LAS float*)(F.lds + G_TOT); LAS float* Dl = (LAS float*)(F.lds + G_DL);
    const bf16* GQ = (const bf16*)(F.ws + WS_GLAQ); const bf16* GK = (const bf16*)(F.ws + WS_GLAK); const bf16* LA = (const bf16*)(F.ws + WS_LOGA); bf16* GV = (bf16*)(F.ws + WS_GLAV);
    f32x4 S[8];
#pragma unroll
    for (int a = 0; a < 8; ++a) S[a] = (f32x4){0.f, 0.f, 0.f, 0.f};
    float Btot = 0.f;
    const int dv0 = 16 * w;
    bf16 rl[16], rq[16], rk[16], vv[16];
#define GLA_LOAD1(chn) do { const size_t _o = ((size_t)b * SEQ + seg * TSEG + (chn) * 64 + 16 * qr) * 512 + hh * 128 + dk; \
        _Pragma("unroll") for (int i4 = 0; i4 < 4; ++i4) { const bf16* pl = LA + _o + (size_t)i4 * 2048; const bf16* pq = GQ + _o + (size_t)i4 * 2048; const bf16* pk = GK + _o + (size_t)i4 * 2048; const bf16* pv = GV + _o + (size_t)i4 * 2048; \
            _Pragma("unroll") for (int j = 0; j < 4; ++j) { rl[4 * i4 + j] = pl[j * 512]; rq[4 * i4 + j] = pq[j * 512]; rk[4 * i4 + j] = pk[j * 512]; vv[4 * i4 + j] = pv[j * 512]; } } } while (0)
    GLA_LOAD1(0);
#pragma unroll 1
    for (int ch = 0; ch < TSEG / 64; ++ch) {
        const size_t tokbase = (size_t)b * SEQ + seg * TSEG + ch * 64;
        float la[16], qv[16], kv[16];
#pragma unroll
        for (int i = 0; i < 16; ++i) { la[i] = bf2f(rl[i]); qv[i] = bf2f(rq[i]); kv[i] = bf2f(rk[i]); }
#pragma unroll
        for (int i = 1; i < 16; ++i) la[i] += la[i - 1];
        tot[qr * 128 + dk] = la[15];
        { v4u v0, v1; v0.x = vv[0] | ((unsigned)vv[1] << 16); v0.y = vv[2] | ((unsigned)vv[3] << 16); v0.z = vv[4] | ((unsigned)vv[5] << 16); v0.w = vv[6] | ((unsigned)vv[7] << 16);
          v1.x = vv[8] | ((unsigned)vv[9] << 16); v1.y = vv[10] | ((unsigned)vv[11] << 16); v1.z = vv[12] | ((unsigned)vv[13] << 16); v1.w = vv[14] | ((unsigned)vv[15] << 16);
          *(LAS v4u*)(Vt + dk * KT_LD + 16 * qr) = v0; *(LAS v4u*)(Vt + dk * KT_LD + 16 * qr + 8) = v1; }
        LDS_BARRIER();
        const float t0 = tot[dk], t1 = tot[128 + dk], t2 = tot[256 + dk], t3 = tot[384 + dk];
        const float base = (qr > 0 ? t0 : 0.f) + (qr > 1 ? t1 : 0.f) + (qr > 2 ? t2 : 0.f), blast = (t0 + t1) + (t2 + t3);
        Btot += blast;
        if (qr == 0) Dl[dk] = __expf(blast);
        { unsigned ke[8];
#pragma unroll
          for (int i = 0; i < 16; i += 2) { const float b0 = base + la[i], b1 = base + la[i + 1]; const float e0 = __expf(b0), e1 = __expf(b1);
              Qs[(16 * qr + i) * QS_LD + dk] = f2bf(qv[i] * 0.08838834764831845f * e0); Qs[(16 * qr + i + 1) * QS_LD + dk] = f2bf(qv[i + 1] * 0.08838834764831845f * e1);
              Ks[(16 * qr + i) * QS_LD + dk] = f2bf(kv[i] / e0); Ks[(16 * qr + i + 1) * QS_LD + dk] = f2bf(kv[i + 1] / e1);
              ke[i >> 1] = pk2(kv[i] * __expf(blast - b0), kv[i + 1] * __expf(blast - b1)); }
          v4u k0 = {ke[0], ke[1], ke[2], ke[3]}, k1 = {ke[4], ke[5], ke[6], ke[7]};
          *(LAS v4u*)(KEt + dk * KT_LD + 16 * qr) = k0; *(LAS v4u*)(KEt + dk * KT_LD + 16 * qr + 8) = k1; }
        LDS_BARRIER();
        if (ch + 1 < TSEG / 64) GLA_LOAD1(ch + 1);
#pragma unroll
        for (int tt = 0; tt < 2; ++tt) { const int n = 2 * w + tt, jt = n >> 2, it = n & 3; f32x4 a4 = {0.f, 0.f, 0.f, 0.f};
#pragma unroll
            for (int s = 0; s < 4; ++s) { const bf16x8 ka = *(const LAS bf16x8*)(Ks + (16 * jt + fr) * QS_LD + 32 * s + 8 * g); const bf16x8 qb = *(const LAS bf16x8*)(Qs + (16 * it + fr) * QS_LD + 32 * s + 8 * g); a4 = MFMA16(ka, qb, a4); }
            const int tj = 16 * jt + 4 * g, ti = 16 * it + fr;
            v2u o; o.x = pk2(tj <= ti ? a4[0] : 0.f, tj + 1 <= ti ? a4[1] : 0.f); o.y = pk2(tj + 2 <= ti ? a4[2] : 0.f, tj + 3 <= ti ? a4[3] : 0.f);
            *(LAS v2u*)(Att + ti * KT_LD + tj) = o; }
        LDS_BARRIER();
        bf16x8 Sb[4];
#pragma unroll
        for (int s = 0; s < 4; ++s) { v4u p; p.x = pk2(S[2 * s][0], S[2 * s][1]); p.y = pk2(S[2 * s][2], S[2 * s][3]); p.z = pk2(S[2 * s + 1][0], S[2 * s + 1][1]); p.w = pk2(S[2 * s + 1][2], S[2 * s + 1][3]); Sb[s] = __builtin_bit_cast(bf16x8, p); }
        bf16x8 Vf[2];
#pragma unroll
        for (int ks = 0; ks < 2; ++ks) Vf[ks] = *(const LAS bf16x8*)(Vt + (dv0 + fr) * KT_LD + 32 * ks + 8 * g);
#pragma unroll
        for (int it = 0; it < 4; ++it) { f32x4 o = {0.f, 0.f, 0.f, 0.f};
#pragma unroll
            for (int s = 0; s < 4; ++s) { const bf16x4 lo = *(const LAS bf16x4*)(Qs + (16 * it + fr) * QS_LD + 32 * s + 4 * g); const bf16x4 hi = *(const LAS bf16x4*)(Qs + (16 * it + fr) * QS_LD + 32 * s + 16 + 4 * g);
                const bf16x8 qa = __builtin_shufflevector(lo, hi, 0, 1, 2, 3, 4, 5, 6, 7); o = MFMA16(qa, Sb[s], o); }
#pragma unroll
            for (int ks = 0; ks < 2; ++ks) { const bf16x8 aa = *(const LAS bf16x8*)(Att + (16 * it + fr) * KT_LD + 32 * ks + 8 * g); o = MFMA16(aa, Vf[ks], o); }
            bf16* op = GV + (tokbase + 16 * it + 4 * g) * 512 + hh * 128 + dv0 + fr;
            if (!dry) {
#pragma unroll
            for (int rr = 0; rr < 4; ++rr) op[(size_t)rr * 512] = f2bf(o[rr]); } }
#pragma unroll
        for (int a = 0; a < 8; ++a) { const f32x4 dsc = *(const LAS f32x4*)(Dl + 16 * a + 4 * g); S[a] = S[a] * dsc;
#pragma unroll
            for (int ks = 0; ks < 2; ++ks) { const bf16x8 ka = *(const LAS bf16x8*)(KEt + (16 * a + fr) * KT_LD + 32 * ks + 8 * g); S[a] = MFMA16(ka, Vf[ks], S[a]); } }
        LDS_BARRIER();
    }
    v2u* LB = (v2u*)(F.ws + WS_LB) + (size_t)item * 4096 + w * 512 + lane;
#pragma unroll
    for (int a = 0; a < 8; ++a) { v2u o; o.x = pk2(S[a][0], S[a][1]); o.y = pk2(S[a][2], S[a][3]); LB[a * 64] = o; }
    if (qr == 0) ((float*)(F.ws + WS_DSEG))[item * 128 + dk] = __expf(Btot);
}

DI void gla_pass2(const Frame& F, int item, const float* gnorm, bool dry) {
    const int tid = F.tid, lane = F.lane, w = F.wave, fr = lane & 15, g = lane >> 4;
    const int seg = item & (NSEG - 1), bh = item >> 4, hh = bh & 3, b = bh >> 2;
    const int dk = tid & 127, qr = tid >> 7, dv0 = 16 * w;
    LAS bf16* Qs = (LAS bf16*)(F.lds + G_QS); LAS float* tot = (LAS float*)(F.lds + G_TOT); LAS float* Os = (LAS float*)(F.lds + G_OS);
    const bf16* GQ = (const bf16*)(F.ws + WS_GLAQ); const bf16* LA = (const bf16*)(F.ws + WS_LOGA); bf16* GV = (bf16*)(F.ws + WS_GLAV); const bf16* R = (const bf16*)(F.dout + DO_R);
    f32x4 Sc[8];
#pragma unroll
    for (int a = 0; a < 8; ++a) Sc[a] = (f32x4){0.f, 0.f, 0.f, 0.f};
#pragma unroll 1
    for (int sp = 0; sp < seg; ++sp) { const int it2 = bh * NSEG + sp; const v2u* LB = (const v2u*)(F.ws + WS_LB) + (size_t)it2 * 4096 + w * 512 + lane; const float* DS = (const float*)(F.ws + WS_DSEG) + it2 * 128 + 4 * g;
#pragma unroll
        for (int a = 0; a < 8; ++a) { const f32x4 dsc = *(const f32x4*)(DS + 16 * a); const v2u lv = LB[a * 64];
            Sc[a][0] = Sc[a][0] * dsc[0] + bflo(lv.x); Sc[a][1] = Sc[a][1] * dsc[1] + bfhi(lv.x); Sc[a][2] = Sc[a][2] * dsc[2] + bflo(lv.y); Sc[a][3] = Sc[a][3] * dsc[3] + bfhi(lv.y); } }
    bf16x8 Sb[4];
#pragma unroll
    for (int s = 0; s < 4; ++s) { v4u p; p.x = pk2(Sc[2 * s][0], Sc[2 * s][1]); p.y = pk2(Sc[2 * s][2], Sc[2 * s][3]); p.z = pk2(Sc[2 * s + 1][0], Sc[2 * s + 1][1]); p.w = pk2(Sc[2 * s + 1][2], Sc[2 * s + 1][3]); Sb[s] = __builtin_bit_cast(bf16x8, p); }
    float Bcum = 0.f;
    const int tk = tid >> 3, pc = tid & 7;
    f32x4 gn[4];
#pragma unroll
    for (int j = 0; j < 4; ++j) gn[j] = *(const f32x4*)(gnorm + 16 * pc + 4 * j);
    bf16 rl[16], rq[16]; v4u ow0, ow1, r0, r1;
#define GLA_LOAD2A(chn) do { const size_t _o = ((size_t)b * SEQ + seg * TSEG + (chn) * 64 + 16 * qr) * 512 + hh * 128 + dk; \
        _Pragma("unroll") for (int i4 = 0; i4 < 4; ++i4) { const bf16* pl = LA + _o + (size_t)i4 * 2048; const bf16* pq = GQ + _o + (size_t)i4 * 2048; \
            _Pragma("unroll") for (int j = 0; j < 4; ++j) { rl[4 * i4 + j] = pl[j * 512]; rq[4 * i4 + j] = pq[j * 512]; } } } while (0)
#define GLA_LOAD2B(chn) do { const size_t _o = ((size_t)b * SEQ + seg * TSEG + (chn) * 64 + tk) * 512 + hh * 128 + 16 * pc; \
        ow0 = *(const v4u*)(GV + _o); ow1 = *(const v4u*)(GV + _o + 8); r0 = *(const v4u*)(R + _o); r1 = *(const v4u*)(R + _o + 8); } while (0)
    GLA_LOAD2A(0); GLA_LOAD2B(0);
#pragma unroll 1
    for (int ch = 0; ch < TSEG / 64; ++ch) {
        const size_t tokbase = (size_t)b * SEQ + seg * TSEG + ch * 64;
        float la[16], qv[16];
#pragma unroll
        for (int i = 0; i < 16; ++i) { la[i] = bf2f(rl[i]); qv[i] = bf2f(rq[i]); }
#pragma unroll
        for (int i = 1; i < 16; ++i) la[i] += la[i - 1];
        tot[qr * 128 + dk] = la[15];
        LDS_BARRIER();
        const float t0 = tot[dk], t1 = tot[128 + dk], t2 = tot[256 + dk], t3 = tot[384 + dk];
        const float base = Bcum + (qr > 0 ? t0 : 0.f) + (qr > 1 ? t1 : 0.f) + (qr > 2 ? t2 : 0.f);
        Bcum += (t0 + t1) + (t2 + t3);
#pragma unroll
        for (int i = 0; i < 16; ++i) Qs[(16 * qr + i) * QS_LD + dk] = f2bf(qv[i] * 0.08838834764831845f * __expf(base + la[i]));
        if (ch + 1 < TSEG / 64) GLA_LOAD2A(ch + 1);
        LDS_BARRIER();
#pragma unroll
        for (int it = 0; it < 4; ++it) { f32x4 o = {0.f, 0.f, 0.f, 0.f};
            if (seg > 0) {
#pragma unroll
                for (int s = 0; s < 4; ++s) { const bf16x4 lo = *(const LAS bf16x4*)(Qs + (16 * it + fr) * QS_LD + 32 * s + 4 * g); const bf16x4 hi = *(const LAS bf16x4*)(Qs + (16 * it + fr) * QS_LD + 32 * s + 16 + 4 * g);
                    const bf16x8 qa = __builtin_shufflevector(lo, hi, 0, 1, 2, 3, 4, 5, 6, 7); o = MFMA16(qa, Sb[s], o); } }
#pragma unroll
            for (int rr = 0; rr < 4; ++rr) Os[(16 * it + 4 * g + rr) * OS_LD + dv0 + fr] = o[rr]; }
        LDS_BARRIER();
        { f32x4 v[4]; float ss = 0.f;
#pragma unroll
          for (int j = 0; j < 4; ++j) v[j] = *(const LAS f32x4*)(Os + tk * OS_LD + 16 * pc + 4 * j);
          v[0].x += bflo(ow0.x); v[0].y += bfhi(ow0.x); v[0].z += bflo(ow0.y); v[0].w += bfhi(ow0.y); v[1].x += bflo(ow0.z); v[1].y += bfhi(ow0.z); v[1].z += bflo(ow0.w); v[1].w += bfhi(ow0.w);
          v[2].x += bflo(ow1.x); v[2].y += bfhi(ow1.x); v[2].z += bflo(ow1.y); v[2].w += bfhi(ow1.y); v[3].x += bflo(ow1.z); v[3].y += bfhi(ow1.z); v[3].z += bflo(ow1.w); v[3].w += bfhi(ow1.w);
#pragma unroll
          for (int j = 0; j < 4; ++j) ss += (v[j].x * v[j].x + v[j].y * v[j].y) + (v[j].z * v[j].z + v[j].w * v[j].w);
          ss += __shfl_xor(ss, 1); ss += __shfl_xor(ss, 2); ss += __shfl_xor(ss, 4);
          const float rinv = __frsqrt_rn(ss * (1.f / 128.f) + EPS);
          const size_t ofs = (tokbase + tk) * 512 + hh * 128 + 16 * pc;
          v4u o0, o1;
          o0.x = pk2(v[0].x * rinv * gn[0].x * bflo(r0.x), v[0].y * rinv * gn[0].y * bfhi(r0.x)); o0.y = pk2(v[0].z * rinv * gn[0].z * bflo(r0.y), v[0].w * rinv * gn[0].w * bfhi(r0.y));
          o0.z = pk2(v[1].x * rinv * gn[1].x * bflo(r0.z), v[1].y * rinv * gn[1].y * bfhi(r0.z)); o0.w = pk2(v[1].z * rinv * gn[1].z * bflo(r0.w), v[1].w * rinv * gn[1].w * bfhi(r0.w));
          o1.x = pk2(v[2].x * rinv * gn[2].x * bflo(r1.x), v[2].y * rinv * gn[2].y * bfhi(r1.x)); o1.y = pk2(v[2].z * rinv * gn[2].z * bflo(r1.y), v[2].w * rinv * gn[2].w * bfhi(r1.y));
          o1.z = pk2(v[3].x * rinv * gn[3].x * bflo(r1.z), v[3].y * rinv * gn[3].y * bfhi(r1.z)); o1.w = pk2(v[3].z * rinv * gn[3].z * bflo(r1.w), v[3].w * rinv * gn[3].w * bfhi(r1.w));
          if (!dry) { *(v4u*)(GV + ofs) = o0; *(v4u*)(GV + ofs + 8) = o1; }
          if (ch + 1 < TSEG / 64) GLA_LOAD2B(ch + 1); }
        LDS_BARRIER();
    }
}
DI void attn_merge_phase(const Frame& F, bool dry) {
    const int gw = F.vcu * NWAVES + F.wave, NGW = F.G * NWAVES, lane = F.lane, head = lane >> 4;
    bf16* O0 = (bf16*)(F.ws + WS_DILQ); const float* LSE = (const float*)(F.ws + WS_LSE);
    for (int t = gw; t < T; t += NGW) {
        const float l0 = LSE[(size_t)t * 4 + head], l1 = LSE[(size_t)T * 4 + (size_t)t * 4 + head], l2 = LSE[(size_t)2 * T * 4 + (size_t)t * 4 + head];
        const float M = fmaxf(l0, fmaxf(l1, l2)); float w0 = exp2f(l0 - M), w1 = exp2f(l1 - M), w2 = exp2f(l2 - M); const float inv = 1.f / (w0 + w1 + w2); w0 *= inv; w1 *= inv; w2 *= inv;
        bf16* p = O0 + (size_t)t * 512 + 8 * lane; const v4u a = *(const v4u*)p, bq = *(const v4u*)(p + (size_t)T * 512), c = *(const v4u*)(p + (size_t)2 * T * 512);
        v4u o;
        o.x = pk2(w0 * bflo(a.x) + w1 * bflo(bq.x) + w2 * bflo(c.x), w0 * bfhi(a.x) + w1 * bfhi(bq.x) + w2 * bfhi(c.x));
        o.y = pk2(w0 * bflo(a.y) + w1 * bflo(bq.y) + w2 * bflo(c.y), w0 * bfhi(a.y) + w1 * bfhi(bq.y) + w2 * bfhi(c.y));
        o.z = pk2(w0 * bflo(a.z) + w1 * bflo(bq.z) + w2 * bflo(c.z), w0 * bfhi(a.z) + w1 * bfhi(bq.z) + w2 * bfhi(c.z));
        o.w = pk2(w0 * bflo(a.w) + w1 * bflo(bq.w) + w2 * bflo(c.w), w0 * bfhi(a.w) + w1 * bfhi(bq.w) + w2 * bfhi(c.w));
        if (!dry) *(v4u*)p = o; }
}

DI void router_phase(const Frame& F, const float* g2, const float* brg, const float* bre, unsigned* gcnt, bool dry) {
    const int lane = F.lane, w = F.wave, fr = lane & 15, g = lane >> 4;
    const float* X1 = (const float*)(F.ws + WS_X1); bf16* H2 = (bf16*)(F.ws + WS_H2);
    const bf16* WRH = (const bf16*)(F.ws + WS_WRH); const bf16* WRL = WRH + 48 * 1024;
    int* TOKE = (int*)(F.ws + WS_TOKE); float* TOKW = (float*)(F.ws + WS_TOKW); int* TOKR = (int*)(F.ws + WS_TOKR);
    LAS float* lg = (LAS float*)(F.lds + w * 4096);
    LAS int* cnt = (LAS int*)(F.lds + 65536); LAS int* basev = cnt + 32;
    for (int it = 0; it * F.G * 128 < T; ++it) {
        const int tok0 = (it * F.G + F.vcu) * 128 + w * 16;
        if (F.tid < 32) cnt[F.tid] = 0;
        __syncthreads();
        f32x4 acc[3]; acc[0] = acc[1] = acc[2] = (f32x4){0.f, 0.f, 0.f, 0.f};
        float ss = 0.f;
        const float* xr = X1 + (size_t)(tok0 + fr) * D + 8 * g;
        for (int s = 0; s < 32; ++s) {
            const f32x4 xa = *(const f32x4*)(xr + 32 * s), xb = *(const f32x4*)(xr + 32 * s + 4);
            const f32x4 ga = *(const f32x4*)(g2 + 32 * s + 8 * g), gb = *(const f32x4*)(g2 + 32 * s + 8 * g + 4);
            ss += (xa.x * xa.x + xa.y * xa.y) + (xa.z * xa.z + xa.w * xa.w) + (xb.x * xb.x + xb.y * xb.y) + (xb.z * xb.z + xb.w * xb.w);
            const f32x4 ya = xa * ga, yb = xb * gb;
            v4u hi; hi.x = pk2(ya.x, ya.y); hi.y = pk2(ya.z, ya.w); hi.z = pk2(yb.x, yb.y); hi.w = pk2(yb.z, yb.w);
            v4u lo; lo.x = pk2(ya.x - bflo(hi.x), ya.y - bfhi(hi.x)); lo.y = pk2(ya.z - bflo(hi.y), ya.w - bfhi(hi.y)); lo.z = pk2(yb.x - bflo(hi.z), yb.y - bfhi(hi.z)); lo.w = pk2(yb.z - bflo(hi.w), yb.w - bfhi(hi.w));
            const bf16x8 ah = __builtin_bit_cast(bf16x8, hi), al = __builtin_bit_cast(bf16x8, lo);
#pragma unroll
            for (int nt = 0; nt < 3; ++nt) { const bf16x8 bh = *(const bf16x8*)(WRH + (size_t)(16 * nt + fr) * 1024 + 32 * s + 8 * g), bl = *(const bf16x8*)(WRL + (size_t)(16 * nt + fr) * 1024 + 32 * s + 8 * g);
                acc[nt] = MFMA16(ah, bh, acc[nt]); acc[nt] = MFMA16(ah, bl, acc[nt]); acc[nt] = MFMA16(al, bh, acc[nt]); }
        }
        ss += __shfl_xor(ss, 16); ss += __shfl_xor(ss, 32);
        const float rinv = __frsqrt_rn(ss * (1.f / D) + EPS);
#pragma unroll
        for (int rr = 0; rr < 4; ++rr) { const float ri = __shfl(rinv, 4 * g + rr);
#pragma unroll
            for (int nt = 0; nt < 3; ++nt) lg[(4 * g + rr) * 48 + 16 * nt + fr] = acc[nt][rr] * ri; }
        { bf16* hr = H2 + (size_t)(tok0 + fr) * D + 8 * g;
          for (int s = 0; s < 32; ++s) { const f32x4 xa = *(const f32x4*)(xr + 32 * s), xb = *(const f32x4*)(xr + 32 * s + 4);
              const f32x4 ga = *(const f32x4*)(g2 + 32 * s + 8 * g), gb = *(const f32x4*)(g2 + 32 * s + 8 * g + 4);
              v4u o; o.x = pk2(xa.x * rinv * ga.x, xa.y * rinv * ga.y); o.y = pk2(xa.z * rinv * ga.z, xa.w * rinv * ga.w); o.z = pk2(xb.x * rinv * gb.x, xb.y * rinv * gb.y); o.w = pk2(xb.z * rinv * gb.z, xb.w * rinv * gb.w);
              if (!dry) *(v4u*)(hr + 32 * s) = o; } }
        LDS_WAIT(); asm volatile("" ::: "memory");
        int e1 = 0, e2 = 0, lr1 = 0, lr2 = 0; float w1 = 0.f, w2 = 0.f;
        if (lane < 16) { const LAS float* q = lg + lane * 48;
            float gl[4]; int gs = 0; float gm = -3.0e38f;
#pragma unroll
            for (int j = 0; j < 4; ++j) { gl[j] = q[j] + brg[j]; if (gl[j] > gm) { gm = gl[j]; gs = j; } }
            float gsum = 0.f;
#pragma unroll
            for (int j = 0; j < 4; ++j) gsum += __expf(gl[j] - gm);
            const float gp = 1.f / gsum;
            float el[8]; int i1 = 0; float v1 = -3.0e38f;
#pragma unroll
            for (int j = 0; j < 8; ++j) { el[j] = q[4 + 8 * gs + j] + bre[8 * gs + j]; if (el[j] > v1) { v1 = el[j]; i1 = j; } }
            int i2 = 0; float v2 = -3.0e38f;
#pragma unroll
            for (int j = 0; j < 8; ++j) if (j != i1 && el[j] > v2) { v2 = el[j]; i2 = j; }
            const float p2 = 1.f / (1.f + __expf(v1 - v2)), p1 = 1.f - p2;
            e1 = 8 * gs + i1; e2 = 8 * gs + i2; w1 = p1 * gp; w2 = p2 * gp;
            lr1 = __hip_atomic_fetch_add(&cnt[e1], 1, __ATOMIC_RELAXED, __HIP_MEMORY_SCOPE_WORKGROUP); lr2 = __hip_atomic_fetch_add(&cnt[e2], 1, __ATOMIC_RELAXED, __HIP_MEMORY_SCOPE_WORKGROUP); }
        __syncthreads();
        if (F.tid < 32) basev[F.tid] = dry ? 0 : (int)atomicAdd(&gcnt[64 * F.tid], (unsigned)cnt[F.tid]);
        __syncthreads();
        if (lane < 16 && !dry) { const int t = tok0 + lane; TOKE[2 * t] = e1; TOKE[2 * t + 1] = e2; TOKW[2 * t] = w1; TOKW[2 * t + 1] = w2; TOKR[2 * t] = basev[e1] + lr1; TOKR[2 * t + 1] = basev[e2] + lr2; }
        __syncthreads();
    }
}
DI void moe_assign_phase(const Frame& F, unsigned* gcnt) {
    LAS int* pst = (LAS int*)(F.lds + 65536);
    if (F.tid == 0) { int p = 0; int* BLKE = (int*)(F.ws + WS_BLKE);
        for (int e = 0; e < 32; ++e) { pst[e] = p; const int c = (int)__hip_atomic_load(&gcnt[64 * e], __ATOMIC_RELAXED, __HIP_MEMORY_SCOPE_AGENT); const int nb = (c + 255) >> 8;
            if (F.vcu == 0) for (int j = 0; j < nb; ++j) BLKE[(p >> 8) + j] = e;
            p += nb << 8; }
        if (F.vcu == 0) BLKE[NBLK_MAX] = p >> 8; }
    __syncthreads();
    const int gw = F.vcu * NWAVES + F.wave, NGW = F.G * NWAVES, lane = F.lane;
    const int* TOKE = (const int*)(F.ws + WS_TOKE); const float* TOKW = (const float*)(F.ws + WS_TOKW); const int* TOKR = (const int*)(F.ws + WS_TOKR);
    int* DEST = (int*)(F.ws + WS_DEST); float* ROWW = (float*)(F.ws + WS_ROWW);
    const bf16* H2 = (const bf16*)(F.ws + WS_H2); bf16* XP = (bf16*)(F.ws + WS_XP);
    for (int p = gw; p < 2 * T; p += NGW) { const int e = TOKE[p], dest = pst[e] + TOKR[p], t = p >> 1;
        if (lane == 0) { DEST[p] = dest; ROWW[dest] = TOKW[p]; }
        const v4u* s = (const v4u*)(H2 + (size_t)t * D); v4u* d = (v4u*)(XP + (size_t)dest * D);
        d[lane] = s[lane]; d[64 + lane] = s[64 + lane]; }
}
DI void combine_phase(const Frame& F, float* out) {
    const int gw = F.vcu * NWAVES + F.wave, NGW = F.G * NWAVES, lane = F.lane;
    const float* X1 = (const float*)(F.ws + WS_X1); const bf16* Y = (const bf16*)(F.ws + WS_Y); const int* DEST = (const int*)(F.ws + WS_DEST);
    for (int t = gw; t < T; t += NGW) { const int d0 = DEST[2 * t], d1 = DEST[2 * t + 1];
#pragma unroll
        for (int j = 0; j < 2; ++j) { const int c = 8 * lane + 512 * j;
            const f32x4 xa = *(const f32x4*)(X1 + (size_t)t * D + c), xb = *(const f32x4*)(X1 + (size_t)t * D + c + 4);
            const v4u a = *(const v4u*)(Y + (size_t)d0 * D + c), b = *(const v4u*)(Y + (size_t)d1 * D + c);
            f32x4 oa, ob;
            oa.x = xa.x + bflo(a.x) + bflo(b.x); oa.y = xa.y + bfhi(a.x) + bfhi(b.x); oa.z = xa.z + bflo(a.y) + bflo(b.y); oa.w = xa.w + bfhi(a.y) + bfhi(b.y);
            ob.x = xb.x + bflo(a.z) + bflo(b.z); ob.y = xb.y + bfhi(a.z) + bfhi(b.z); ob.z = xb.z + bflo(a.w) + bflo(b.w); ob.w = xb.w + bfhi(a.w) + bfhi(b.w);
            *(f32x4*)(out + (size_t)t * D + c) = oa; *(f32x4*)(out + (size_t)t * D + c + 4) = ob; } }
}

constexpr int PER_PHASE = 13;
struct Args { Ins I; float* out; unsigned char* ws; int ph_lo, ph_hi, li, pad; };
__global__ void __launch_bounds__(NTHR, 2) fwd_kernel(Args args) {
    extern __shared__ __attribute__((aligned(16))) unsigned char lds[];
    Frame F;
    F.lds = (LAS unsigned char*)lds;
    F.tid = threadIdx.x; F.lane = F.tid & 63; F.wave = __builtin_amdgcn_readfirstlane(F.tid >> 6);
    F.G = gridDim.x; { const int bx = blockIdx.x; F.vcu = (F.G % 8 == 0) ? (bx % 8) * (F.G / 8) + bx / 8 : bx; }
    F.ws = args.ws; F.dout = (unsigned char*)args.out;
    unsigned* ctl = (unsigned*)(args.ws + WS_CTL);
    volatile LAS unsigned* MISC = (volatile LAS unsigned*)(F.lds + MISC_OFF);
    for (int u = F.tid; u < (LDS_BYTES - LDSCTL_OFF) / 4; u += NTHR) ((LAS unsigned*)(F.lds + LDSCTL_OFF))[u] = 0u;
    __syncthreads();
    XcdBarrier bar; bar.bar = ctl + CW_BAR; bar.x = 0; bar.st = nullptr;
    if (MK_N_LAUNCHES == 1) bar = xcd_barrier_post(ctl + CW_BAR, MISC + 8);
    const int lo = args.ph_lo, hi = args.ph_hi;
#ifdef ONLY_PHASE
#define IN(k) ((k) == ONLY_PHASE && lo <= (k) && (k) < hi)
#else
#define IN(k) (lo <= (k) && (k) < hi)
#endif
#define SEAM(k) do { if (IN(k) && IN((k) + 1)) xcd_barrier(bar); } while (0)
#ifndef DUP_MASK
#define DUP_MASK 0
#endif
#define REPS(k) (((DUP_MASK >> (k)) & 1) ? 2 : 1)
    const Ins& I = args.I;
    unsigned char* ws = args.ws;

    if (IN(0)) { _Pragma("unroll 1") for (int rep = 0; rep < REPS(0); ++rep) { if (rep) xcd_barrier(bar); p0_prologue(F, I); } SEAM(0); }

    if (IN(1)) { _Pragma("unroll 1") for (int rep = 0; rep < REPS(1); ++rep) { if (rep) xcd_barrier(bar);
        pg8::GemmDesc g{1024, 1024, 1024};
        pg8::OrderStd S{T / 256, N1 / 256, F.G, (int)blockIdx.x, (const char*)(ws + WS_XN), (const char*)(ws + WS_W1T), (size_t)256 * 1024 * 2, (size_t)256 * 1024 * 2};
        pg8::EpiP1 E{ws, F.dout, I.in[4], I.in[6], I.in[7], (LAS float*)(F.lds + LDSCTL_OFF + 1024)};
        pg8::gemm_phase<pg8::EpiP1, pg8::OrderStd>(F.lds + RING_OFF, g, S, E);
}         SEAM(1);
    }
    if (IN(3)) {
        _Pragma("unroll 1") for (int rep = 0; rep < REPS(3); ++rep) { if (rep) xcd_barrier(bar);
        for (int it = F.vcu; it < 16 * NSEG; it += F.G) gla_pass1(F, it, rep + 1 < REPS(3)); }
        const int gw = F.vcu * NWAVES + F.wave, NGW = F.G * NWAVES;
        _Pragma("unroll 1") for (int rep = 0; rep < REPS(13); ++rep) { if (rep) xcd_barrier(bar);
        for (int j = gw; j < 3 * 4096; j += NGW) attn_job(F, j, rep + 1 < REPS(13)); }
        SEAM(3);
    }
    if (IN(4)) {
        _Pragma("unroll 1") for (int rep = 0; rep < REPS(4); ++rep) { if (rep) xcd_barrier(bar);
        for (int it = F.vcu; it < 16 * NSEG; it += F.G) gla_pass2(F, it, I.in[5], rep + 1 < REPS(4)); }
        _Pragma("unroll 1") for (int rep = 0; rep < REPS(14); ++rep) { if (rep) xcd_barrier(bar); attn_merge_phase(F, rep + 1 < REPS(14)); }
        SEAM(4);
    }
    if (IN(5)) { _Pragma("unroll 1") for (int rep = 0; rep < REPS(5); ++rep) { if (rep) xcd_barrier(bar);
        pg8::GemmDesc g{1024, 1024, 1024};
        pg8::OrderStd S{T / 256, 2048 / 256, F.G, (int)blockIdx.x, (const char*)(ws + WS_XN), (const char*)(ws + WS_WBGT), (size_t)256 * 1024 * 2, (size_t)256 * 1024 * 2};
        pg8::EpiGate E{(bf16*)(ws + WS_GATES), I.in[11]};
        pg8::gemm_phase<pg8::EpiGate, pg8::OrderStd>(F.lds + RING_OFF, g, S, E);
}         SEAM(5);
    }
    if (IN(6)) { _Pragma("unroll 1") for (int rep = 0; rep < REPS(6); ++rep) { if (rep) xcd_barrier(bar);
        pg8::GemmDesc g{512, 512, 512};
        pg8::OrderPair S{T / 256, 4, F.G, (int)blockIdx.x, (const char*)(ws + WS_GLAV), (const char*)(ws + WS_DILQ), (const char*)(ws + WS_WPGT), (const char*)(ws + WS_WPAT), (size_t)256 * 512 * 2, (size_t)256 * 512 * 2};
        pg8::EpiMerge E{(bf16*)(ws + WS_MERGED), (const bf16*)(ws + WS_GATES)};
        pg8::gemm_phase<pg8::EpiMerge, pg8::OrderPair>(F.lds + RING_OFF, g, S, E);
}         SEAM(6);
    }
    if (IN(7)) { _Pragma("unroll 1") for (int rep = 0; rep < REPS(7); ++rep) { if (rep) xcd_barrier(bar);
        pg8::GemmDesc g{1024, 1024, 1024};
        pg8::OrderStd S{T / 256, 4, F.G, (int)blockIdx.x, (const char*)(ws + WS_MERGED), (const char*)(ws + WS_WOUTT), (size_t)256 * 1024 * 2, (size_t)256 * 1024 * 2};
        pg8::EpiX1 E{(float*)(ws + WS_X1), I.in[0]};
        pg8::gemm_phase<pg8::EpiX1, pg8::OrderStd>(F.lds + RING_OFF, g, S, E);
}         SEAM(7);
    }
    if (IN(8)) { _Pragma("unroll 1") for (int rep = 0; rep < REPS(8); ++rep) { if (rep) xcd_barrier(bar); router_phase(F, I.in[13], I.in[15], I.in[17], ctl + CW_GCNT, rep + 1 < REPS(8)); } SEAM(8); }
    if (IN(9)) { _Pragma("unroll 1") for (int rep = 0; rep < REPS(9); ++rep) { if (rep) xcd_barrier(bar); moe_assign_phase(F, ctl + CW_GCNT); } SEAM(9); }
    if (IN(10)) { _Pragma("unroll 1") for (int rep = 0; rep < REPS(10); ++rep) { if (rep) xcd_barrier(bar);
        const int* BLKE = (const int*)(ws + WS_BLKE); const int nblk = BLKE[NBLK_MAX];
        pg8::GemmDesc g{1024, 1024, 1024};
        pg8::OrderMoe S{nblk, F.G, (int)blockIdx.x, BLKE, (const char*)(ws + WS_XP), (const char*)(F.dout + DO_EXPGU), (size_t)256 * 1024 * 2, (size_t)1024 * 1024 * 2, (size_t)256 * 1024 * 2};
        pg8::EpiGU E{(bf16*)(ws + WS_HBUF), (const float*)(ws + WS_ROWW)};
        pg8::gemm_phase<pg8::EpiGU, pg8::OrderMoe>(F.lds + RING_OFF, g, S, E);
}         SEAM(10);
    }
    if (IN(11)) { _Pragma("unroll 1") for (int rep = 0; rep < REPS(11); ++rep) { if (rep) xcd_barrier(bar);
        const int* BLKE = (const int*)(ws + WS_BLKE); const int nblk = BLKE[NBLK_MAX];
        pg8::GemmDesc g{512, 512, 512};
        pg8::OrderMoe S{nblk, F.G, (int)blockIdx.x, BLKE, (const char*)(ws + WS_HBUF), (const char*)(F.dout + DO_EXPDN), (size_t)256 * 512 * 2, (size_t)1024 * 512 * 2, (size_t)256 * 512 * 2};
        pg8::EpiY E{(bf16*)(ws + WS_Y)};
        pg8::gemm_phase<pg8::EpiY, pg8::OrderMoe>(F.lds + RING_OFF, g, S, E);
}         SEAM(11);
    }
    if (IN(12)) { _Pragma("unroll 1") for (int rep = 0; rep < REPS(12); ++rep) { if (rep) xcd_barrier(bar); combine_phase(F, args.out); } }
#undef IN
#undef SEAM
}

extern "C" void kernel_launch(void* const* d_in, const int* in_sizes, int n_in, void* d_out, int out_size, void* d_ws, size_t ws_size, hipStream_t stream) {
    static int grid = 0;
    if (grid == 0) {
        if (n_in != 21 || out_size != T * D || ws_size < WS_END) { fprintf(stderr, "kernel_launch: unexpected shapes (n_in %d out %d ws %zu)\n", n_in, out_size, ws_size); grid = -1; return; }
        int dev = 0, cus = 0, per_cu = 0;
        if (hipGetDevice(&dev) != hipSuccess || hipDeviceGetAttribute(&cus, hipDeviceAttributeMultiprocessorCount, dev) != hipSuccess) { grid = -1; return; }
        if (hipFuncSetAttribute((const void*)fwd_kernel, hipFuncAttributeMaxDynamicSharedMemorySize, LDS_BYTES) != hipSuccess) { fprintf(stderr, "kernel_launch: hipFuncSetAttribute failed\n"); grid = -1; return; }
        if (hipOccupancyMaxActiveBlocksPerMultiprocessor(&per_cu, (const void*)fwd_kernel, NTHR, LDS_BYTES) != hipSuccess || per_cu < 1) fprintf(stderr, "kernel_launch: occupancy query reports %d\n", per_cu);
        (void)hipGetLastError();
        grid = cus;
    }
    if (grid < 0) return;
    if (hipMemsetAsync((char*)d_ws + WS_CTL, 0, CTL_ZERO_BYTES, stream) != hipSuccess) return;
    Args a{};
    for (int i = 0; i < 21; ++i) a.I.in[i] = (const float*)d_in[i];
    a.out = (float*)d_out; a.ws = (unsigned char*)d_ws;
    if (MK_N_LAUNCHES == 1) { a.ph_lo = 0; a.ph_hi = PER_PHASE; a.li = 0; hipLaunchKernelGGL(fwd_kernel, dim3(grid), dim3(NTHR), LDS_BYTES, stream, a); }
    else for (int li = 0; li < PER_PHASE; ++li) { a.ph_lo = li; a.ph_hi = li + 1; a.li = li; hipLaunchKernelGGL(fwd_kernel, dim3(grid), dim3(NTHR), LDS_BYTES, stream, a); }
}
```

```cpp
#include <hip/hip_runtime.h>
#include <cstdio>
#include <cstdint>

#ifndef MK_N_LAUNCHES
#define MK_N_LAUNCHES 1
#endif

#define GAS __attribute__((address_space(1)))
#define LAS __attribute__((address_space(3)))
typedef unsigned short bf16;
typedef unsigned v4u __attribute__((ext_vector_type(4)));
typedef unsigned v2u __attribute__((ext_vector_type(2)));
typedef float f32x2 __attribute__((ext_vector_type(2)));
typedef float f32x4 __attribute__((ext_vector_type(4)));
typedef float f32x16 __attribute__((ext_vector_type(16)));
typedef short bf16x8 __attribute__((ext_vector_type(8)));
typedef short bf16x4 __attribute__((ext_vector_type(4)));
typedef __bf16 hbf2 __attribute__((ext_vector_type(2)));

#define DI __device__ __forceinline__
DI unsigned pk2(float lo, float hi) { f32x2 v = {lo, hi}; hbf2 r = __builtin_convertvector(v, hbf2); return __builtin_bit_cast(unsigned, r); }
DI bf16 f2bf(float f) { return (bf16)(pk2(f, 0.f) & 0xffffu); }
DI float bf2f(bf16 b) { return __builtin_bit_cast(float, ((unsigned)b) << 16); }
DI float bflo(unsigned u) { return __builtin_bit_cast(float, u << 16); }
DI float bfhi(unsigned u) { return __builtin_bit_cast(float, u & 0xffff0000u); }

constexpr int T = 32768, D = 1024, SEQ = 8192;
constexpr int N1 = 7168;
constexpr int IN_COLS = 6672;
constexpr int NSEG = 16, TSEG = SEQ / NSEG;
constexpr float EPS = 1e-6f;
constexpr float LOG2E = 1.4426950408889634f;
constexpr int PMAX = 65536 + 32 * 256;
constexpr int NBLK_MAX = PMAX / 256;

constexpr size_t MiB = 1u << 20;
constexpr size_t WS_CTL = 0, CTL_ZERO_BYTES = 256 * 1024;
constexpr size_t WS_LB = 1 * MiB;
constexpr size_t WS_W1T = 1 * MiB;
constexpr size_t WS_WBGT = 15 * MiB, WS_WPGT = 19 * MiB, WS_WPAT = 20 * MiB, WS_WOUTT = 21 * MiB, WS_WRH = 23 * MiB;
constexpr size_t WS_XN = 24 * MiB;
constexpr size_t WS_GLAQ = 88 * MiB, WS_GLAK = 120 * MiB, WS_LOGA = 152 * MiB, WS_GLAV = 184 * MiB;
constexpr size_t WS_DILQ = 216 * MiB, WS_DILK = 312 * MiB, WS_DILV = 408 * MiB;
constexpr size_t WS_STATS = 504 * MiB;
constexpr size_t WS_LSE = WS_STATS;
constexpr size_t WS_DSEG = WS_STATS + 1536 * 1024;
constexpr size_t WS_TOKE = WS_STATS + 2 * MiB;
constexpr size_t WS_TOKW = WS_TOKE + 256 * 1024;
constexpr size_t WS_TOKR = WS_TOKW + 256 * 1024;
constexpr size_t WS_DEST = WS_TOKR + 256 * 1024;
constexpr size_t WS_ROWW = WS_DEST + 256 * 1024;
constexpr size_t WS_BLKE = WS_ROWW + 320 * 1024;
constexpr size_t WS_END = 512 * MiB;
constexpr size_t WS_GATES = 376 * MiB;
constexpr size_t WS_MERGED = 312 * MiB;
constexpr size_t WS_X1 = 88 * MiB;
constexpr size_t WS_H2 = 24 * MiB;
constexpr size_t WS_XP = 216 * MiB;
constexpr size_t WS_HBUF = 360 * MiB;
constexpr size_t WS_Y = 216 * MiB;
constexpr size_t DO_R = 0;
constexpr size_t DO_EXPGU = 32 * MiB;
constexpr size_t DO_EXPDN = 96 * MiB;
constexpr int CW_BAR = 4096;
constexpr int CW_GCNT = 16384;

constexpr int RING_OFF = 0, RING_BYTES = 131072;
constexpr int LDSCTL_OFF = RING_BYTES, MISC_OFF = LDSCTL_OFF + 320;
constexpr int LDS_BYTES = 147456;

#define XB_TMO      128
#define XB_XCNT(j)  (256  + 64 * (j))
#define XB_XSUB(j)  (1280 + 64 * (j))
#define XB_XGEN(j)  (2304 + 64 * (j))
#define XB_TOP      3328
#define XB_TOPGEN   3392
#define XCD_BAR_WORDS 3456
#define XB_SPIN_CAP (1u << 18)
DI unsigned xb_ld(unsigned* p)              { return __hip_atomic_load(p, __ATOMIC_RELAXED, __HIP_MEMORY_SCOPE_AGENT); }
DI unsigned xb_add(unsigned* p, unsigned v) { return __hip_atomic_fetch_add(p, v, __ATOMIC_RELAXED, __HIP_MEMORY_SCOPE_AGENT); }
DI unsigned xb_xcc_id() { return (unsigned)__builtin_amdgcn_s_getreg((3 << 11) | 20) & 0xFu; }
#define XB_SPIN(cond, bar) do { unsigned _sp = 0; while (cond) { __builtin_amdgcn_s_sleep(1); \
    if ((++_sp & 255u) == 0u) { if (xb_ld(&(bar)[XB_TMO])) break; if (_sp > XB_SPIN_CAP) { atomicAdd(&(bar)[XB_TMO], 1u); break; } } } } while (0)
struct XcdBarrier { unsigned* bar; unsigned x; volatile LAS unsigned* st; };
DI XcdBarrier xcd_barrier_post(unsigned* bar, volatile LAS unsigned* st) {
    XcdBarrier b; b.bar = bar; b.x = xb_xcc_id(); b.st = st;
    if (threadIdx.x == 0) (void)xb_add(&bar[XB_XCNT(b.x)], 1u);
    return b;
}
DI void xcd_barrier_complete(unsigned* bar, unsigned x, unsigned& nloc, unsigned& nx) {
    const unsigned G = gridDim.x * gridDim.y * gridDim.z;
    unsigned sum, cnt, mine, sp = 0u;
    for (;;) {
        sum = 0u; cnt = 0u; mine = 0u;
#pragma unroll
        for (unsigned j = 0; j < 16; ++j) { const unsigned c = xb_ld(&bar[XB_XCNT(j)]); sum += c; cnt += (c > 0u) ? 1u : 0u; mine = (j == x) ? c : mine; }
        if (sum == G) break;
        __builtin_amdgcn_s_sleep(1);
        if ((++sp & 255u) == 0u) { if (xb_ld(&bar[XB_TMO])) break; if (sp > XB_SPIN_CAP) { atomicAdd(&bar[XB_TMO], 1u); break; } }
    }
    nloc = mine > 0u ? mine : 1u; nx = cnt > 0u ? cnt : 1u;
}
DI void xcd_barrier(const XcdBarrier& b) {
    asm volatile("s_waitcnt vmcnt(0)" ::: "memory");
    __syncthreads();
    if (threadIdx.x == 0) {
        unsigned* bar = b.bar;
        __builtin_amdgcn_s_waitcnt(0);
        unsigned nloc = b.st[0], nx = b.st[1];
        if (nloc == 0u) { xcd_barrier_complete(bar, b.x, nloc, nx); b.st[0] = nloc; b.st[1] = nx; }
        const unsigned old = xb_add(&bar[XB_XSUB(b.x)], 1u);
        const unsigned gen = old / nloc;
        if (old + 1u == (gen + 1u) * nloc) {
            __builtin_amdgcn_fence(__ATOMIC_RELEASE, "agent");
            asm volatile("s_waitcnt vmcnt(0)" ::: "memory");
            const unsigned og = xb_add(&bar[XB_TOP], 1u);
            const unsigned tg = og / nx;
            if (og + 1u == (tg + 1u) * nx) xb_add(&bar[XB_TOPGEN], 1u);
            else XB_SPIN(xb_ld(&bar[XB_TOPGEN]) == tg, bar);
            __builtin_amdgcn_fence(__ATOMIC_ACQUIRE, "agent");
            xb_add(&bar[XB_XGEN(b.x)], 1u);
            asm volatile("s_waitcnt vmcnt(0)" ::: "memory");
        } else {
            XB_SPIN(xb_ld(&bar[XB_XGEN(b.x)]) == gen, bar);
            __builtin_amdgcn_fence(__ATOMIC_ACQUIRE, "agent");
            asm volatile("s_waitcnt vmcnt(0)" ::: "memory");
        }
    }
    __syncthreads();
}

namespace pg8 {
constexpr int BM = 256, BK = 64, HALF = 128, HTB = HALF * BK * 2, STAGE_BYTES = 8 * HTB, NXCD = 8, WGM = 8;
__host__ __device__ __forceinline__ int lds_byte(int r, int c) { const int st = (r >> 4) * 2 + (c >> 5), rr = r & 15, cc = c & 31, ob = rr * 64 + cc * 2; return st * 1024 + (ob ^ (((ob >> 9) & 1) << 5)); }
__host__ __device__ __forceinline__ void stage_rc(int b, int& R, int& C) { const int st = b / 1024, sb = b % 1024, swz = sb ^ (((sb >> 9) & 1) << 5); R = (st >> 1) * 16 + swz / 64; C = (st & 1) * 32 + (swz % 64) / 2; }
__host__ __device__ __forceinline__ int perm32(int rho) { const int n = rho >> 4, i = rho & 15; return 8 * (i >> 2) + 4 * n + (i & 3); }

struct Unit { const char* A; const char* B; int pm, pn, aux; };
struct GemmDesc { int lda, ldb, K; };

DI bool static_tile(int L, int nM, int nN, int& pm, int& pn) {
    const int nwg = nM * nN; if (L >= nwg) return false;
    int wgid = L; { const int q = nwg / NXCD, r = nwg % NXCD, xcd = wgid % NXCD, off = wgid / NXCD; wgid = (xcd < r ? xcd * (q + 1) : r * (q + 1) + (xcd - r) * q) + off; }
    const int nig = WGM * nN, gid = wgid / nig, fm = gid * WGM, gsz = (nM - fm) < WGM ? (nM - fm) : WGM;
    pm = fm + ((wgid % nig) % gsz); pn = (wgid % nig) / gsz; return true;
}
struct OrderStd {
    int nM, nN, G, c; const char* A0; const char* B0; size_t sA, sB;
    DI bool next(int i, Unit& u) const {
        int pm, pn; if (!static_tile(i * G + c, nM, nN, pm, pn)) return false;
        u.pm = pm; u.pn = pn; u.aux = 0; u.A = A0 + (size_t)pm * sA; u.B = B0 + (size_t)pn * sB; return true;
    }
};
struct OrderPair {
    int nM, nN, G, c; const char* A0; const char* A1; const char* B0; const char* B1; size_t sA, sB;
    DI bool next(int i, Unit& u) const {
        int pm, pn; if (!static_tile((i >> 1) * G + c, nM, nN, pm, pn)) return false;
        const int br = i & 1; u.pm = pm; u.pn = pn; u.aux = br; u.A = (br ? A1 : A0) + (size_t)pm * sA; u.B = (br ? B1 : B0) + (size_t)pn * sB; return true;
    }
};
struct OrderProj2 {
    int nM, nh, G, c; const char* A0; const char* A1; const char* B0; const char* B1; size_t sA, sB;
    DI bool next(int i, Unit& u) const {
        int pm, pn; if (!static_tile(i * G + c, nM, 2 * nh, pm, pn)) return false;
        const int br = pn >= nh; u.pm = pm; u.pn = pn; u.aux = br; u.A = (br ? A1 : A0) + (size_t)pm * sA; u.B = (br ? B1 : B0) + (size_t)(pn - br * nh) * sB; return true;
    }
};
struct OrderMoe {
    int nblk, G, c; const int* blke; const char* A0; const char* B0; size_t sA, sE, sB;
    DI bool next(int i, Unit& u) const {
        int rb, pn;
        if ((G & 31) == 0) { const int R = G >> 2, per = R >> 3, loc = c >> 3; rb = i * R + (c & 7) * per + (loc >> 2); pn = loc & 3; }
        else { const int L = i * G + c; rb = L >> 2; pn = L & 3; }
        if (rb >= nblk) return false;
        const int e = blke[rb];
        u.pm = rb; u.pn = pn; u.aux = 0;
        u.A = A0 + (size_t)rb * sA; u.B = B0 + (size_t)e * sE + (size_t)pn * sB; return true;
    }
};

#define PG8_LAS __attribute__((address_space(3)))
template <class Epi, class Sched, bool ALIGN_EPI = true, bool SP2 = true>
DI void gemm_phase(PG8_LAS unsigned char* lds, const GemmDesc g, const Sched& S, const Epi& E) {
    const int tid = threadIdx.x, wid = __builtin_amdgcn_readfirstlane(tid >> 6), lane = tid & 63, wr = wid >> 2, wc = wid & 3, fr = lane & 15, fq = lane >> 4;
    const int K = g.K, nt = K / BK;
    unsigned voffA[2], voffB[2];
#pragma unroll
    for (int i = 0; i < 2; ++i) { int R, C; stage_rc(tid * 16 + i * 8192, R, C); const int Rb = Epi::PERM ? ((R & ~31) + perm32(R & 31)) : R;
        voffA[i] = (unsigned)(R * g.lda + C) * 2u; voffB[i] = (unsigned)(Rb * g.ldb + C) * 2u; }
    const size_t kstep = (size_t)(BK * 2);
    const size_t hstepA = (size_t)HALF * g.lda * 2, hstepB = (size_t)HALF * g.ldb * 2;
    const unsigned ldsw = (unsigned)wid * 1024u;
    const int aoff = lds_byte(wr * 64 + fr, fq * 8), boff = lds_byte(wc * 32 + fr, fq * 8);
#define PG8_SA(b, h) (((b) * 2 + (h)) * HTB)
#define PG8_SB(b, h) ((4 + (b) * 2 + (h)) * HTB)
#define PG8_STAGE(bufoff, gbase, voff) do { _Pragma("unroll") for (int _i = 0; _i < 2; ++_i) \
        __builtin_amdgcn_global_load_lds((const unsigned*)((const char*)(gbase) + (voff)[_i]), (PG8_LAS unsigned*)(lds + (bufoff) + ldsw + _i * 8192), 16, 0, 0); } while (0)
#define PG8_LDA(dst, b, h) do { _Pragma("unroll") for (int m = 0; m < 4; ++m) _Pragma("unroll") for (int k = 0; k < 2; ++k) dst[m][k] = *(const PG8_LAS bf16x8*)(lds + PG8_SA(b, h) + aoff + m * 2048 + k * 1024); } while (0)
#define PG8_LDB(dst, b, h) do { _Pragma("unroll") for (int n = 0; n < 2; ++n) _Pragma("unroll") for (int k = 0; k < 2; ++k) dst[n][k] = *(const PG8_LAS bf16x8*)(lds + PG8_SB(b, h) + boff + n * 2048 + k * 1024); } while (0)
#define PG8_MMA(ai, bj, At, Bt) do { __builtin_amdgcn_s_setprio(1); _Pragma("unroll") for (int m = 0; m < 4; ++m) _Pragma("unroll") for (int n = 0; n < 2; ++n) _Pragma("unroll") for (int k = 0; k < 2; ++k) \
        acc[ai][bj][m][n] = __builtin_amdgcn_mfma_f32_16x16x32_bf16(Bt[n][k], At[m][k], acc[ai][bj][m][n], 0, 0, 0); __builtin_amdgcn_s_setprio(0); } while (0)
#define PG8_WAIT_V(n) asm volatile("s_waitcnt vmcnt(" #n ")" ::: "memory")
#define PG8_WAIT_L(n) asm volatile("s_waitcnt lgkmcnt(" #n ")" ::: "memory")
#define PG8_BAR __builtin_amdgcn_s_barrier()
#define PG8_SCHED __builtin_amdgcn_sched_barrier(0)
    Unit cur, nxt; int ui = 0;
    if (!S.next(0, cur)) return;
    f32x4 acc[2][2][4][2];
#pragma unroll
    for (int a = 0; a < 2; ++a)
#pragma unroll
        for (int b = 0; b < 2; ++b)
#pragma unroll
            for (int m = 0; m < 4; ++m)
#pragma unroll
                for (int n = 0; n < 2; ++n) acc[a][b][m][n] = (f32x4){0.f, 0.f, 0.f, 0.f};
    bf16x8 At[4][2], B0[2][2], B1[2][2];
    const char* cA = cur.A; const char* cB = cur.B;
    if constexpr (SP2) {
        PG8_STAGE(PG8_SB(0, 0), cB, voffB); PG8_STAGE(PG8_SB(0, 1), cB + hstepB, voffB); PG8_STAGE(PG8_SA(0, 0), cA, voffA); PG8_STAGE(PG8_SA(0, 1), cA + hstepA, voffA);
        if (wr == 1) PG8_BAR;
        PG8_WAIT_V(2); PG8_BAR;
        PG8_STAGE(PG8_SB(1, 0), cB + kstep, voffB); PG8_STAGE(PG8_SA(1, 0), cA + kstep, voffA); PG8_STAGE(PG8_SB(1, 1), cB + hstepB + kstep, voffB);
        PG8_WAIT_V(6); PG8_BAR;
    } else {
        PG8_STAGE(PG8_SB(0, 0), cB, voffB); PG8_STAGE(PG8_SA(0, 0), cA, voffA); PG8_STAGE(PG8_SB(0, 1), cB + hstepB, voffB); PG8_STAGE(PG8_SA(0, 1), cA + hstepA, voffA);
        if (wr == 1) PG8_BAR;
        PG8_WAIT_V(4); PG8_BAR;
        PG8_STAGE(PG8_SB(1, 0), cB + kstep, voffB); PG8_STAGE(PG8_SA(1, 0), cA + kstep, voffA); PG8_STAGE(PG8_SB(1, 1), cB + hstepB + kstep, voffB);
        PG8_WAIT_V(6); PG8_BAR;
    }
    for (;;) {
        const bool has_next = S.next(ui + 1, nxt);
        const char* nA = has_next ? nxt.A : cA; const char* nB = has_next ? nxt.B : cB;
        for (int t = 0; t < nt; t += 2) {
            const bool last = (t == nt - 2);
            const char* a1 = cA + (size_t)(t + 1) * kstep;
            const char* a2 = last ? nA : cA + (size_t)(t + 2) * kstep; const char* b2 = last ? nB : cB + (size_t)(t + 2) * kstep;
            const char* a3 = a2 + kstep; const char* b3 = b2 + kstep;
            if constexpr (SP2) {
            PG8_LDB(B0, 0, 0); PG8_LDB(B1, 0, 1); PG8_SCHED; PG8_LDA(At, 0, 0); PG8_STAGE(PG8_SA(1, 1), a1 + hstepA, voffA);
            PG8_WAIT_V(8); PG8_WAIT_L(0); PG8_BAR; PG8_MMA(0, 0, At, B0); PG8_MMA(0, 1, At, B1); PG8_BAR; PG8_SCHED;
            PG8_LDA(At, 0, 1); PG8_STAGE(PG8_SB(0, 0), b2, voffB); PG8_STAGE(PG8_SB(0, 1), b2 + hstepB, voffB); PG8_STAGE(PG8_SA(0, 0), a2, voffA);
            PG8_WAIT_V(8); PG8_WAIT_L(0); PG8_BAR; PG8_MMA(1, 0, At, B0); PG8_MMA(1, 1, At, B1); PG8_BAR; PG8_SCHED;
            PG8_LDB(B0, 1, 0); PG8_LDB(B1, 1, 1); PG8_SCHED; PG8_LDA(At, 1, 0); PG8_STAGE(PG8_SA(0, 1), a2 + hstepA, voffA);
            PG8_WAIT_V(8); PG8_WAIT_L(0); PG8_BAR; PG8_MMA(0, 0, At, B0); PG8_MMA(0, 1, At, B1); PG8_BAR; PG8_SCHED;
            PG8_LDA(At, 1, 1); PG8_STAGE(PG8_SB(1, 0), b3, voffB); PG8_STAGE(PG8_SB(1, 1), b3 + hstepB, voffB); PG8_STAGE(PG8_SA(1, 0), a3, voffA);
            PG8_WAIT_V(8); PG8_WAIT_L(0); PG8_BAR; PG8_MMA(1, 0, At, B0); PG8_MMA(1, 1, At, B1); PG8_BAR; PG8_SCHED;
            } else {
            PG8_LDB(B0, 0, 0); PG8_SCHED; PG8_LDA(At, 0, 0); PG8_STAGE(PG8_SA(1, 1), a1 + hstepA, voffA);
            PG8_WAIT_L(8); PG8_BAR; PG8_WAIT_L(0); PG8_MMA(0, 0, At, B0); PG8_BAR; PG8_SCHED;
            PG8_LDB(B1, 0, 1); PG8_STAGE(PG8_SB(0, 0), b2, voffB);
            PG8_BAR; PG8_WAIT_L(0); PG8_MMA(0, 1, At, B1); PG8_BAR;
            PG8_LDA(At, 0, 1); PG8_STAGE(PG8_SA(0, 0), a2, voffA);
            PG8_BAR; PG8_WAIT_L(0); PG8_MMA(1, 0, At, B0); PG8_BAR; PG8_SCHED;
            PG8_STAGE(PG8_SB(0, 1), b2 + hstepB, voffB);
            PG8_WAIT_V(6); PG8_BAR; PG8_MMA(1, 1, At, B1); PG8_BAR;
            PG8_LDB(B0, 1, 0); PG8_SCHED; PG8_LDA(At, 1, 0); PG8_STAGE(PG8_SA(0, 1), a2 + hstepA, voffA);
            PG8_WAIT_L(8); PG8_BAR; PG8_WAIT_L(0); PG8_MMA(0, 0, At, B0); PG8_BAR; PG8_SCHED;
            PG8_LDB(B1, 1, 1); PG8_STAGE(PG8_SB(1, 0), b3, voffB);
            PG8_BAR; PG8_WAIT_L(0); PG8_MMA(0, 1, At, B1); PG8_BAR;
            PG8_LDA(At, 1, 1); PG8_STAGE(PG8_SA(1, 0), a3, voffA);
            PG8_BAR; PG8_WAIT_L(0); PG8_MMA(1, 0, At, B0); PG8_BAR; PG8_SCHED;
            PG8_STAGE(PG8_SB(1, 1), b3 + hstepB, voffB);
            PG8_WAIT_V(6); PG8_BAR; PG8_MMA(1, 1, At, B1); PG8_BAR;
            }
        }
        if constexpr (ALIGN_EPI) { if (wr == 0) PG8_BAR; }
        E(acc, cur, wr, wc, fr, fq);
        if (!has_next) break;
#pragma unroll
        for (int a = 0; a < 2; ++a)
#pragma unroll
            for (int b = 0; b < 2; ++b)
#pragma unroll
                for (int m = 0; m < 4; ++m)
#pragma unroll
                    for (int n = 0; n < 2; ++n) acc[a][b][m][n] = (f32x4){0.f, 0.f, 0.f, 0.f};
        cur = nxt; cA = nA; cB = nB; ++ui;
        if constexpr (ALIGN_EPI) { if (wr == 1) PG8_BAR; }
    }
    PG8_WAIT_V(0);
    if constexpr (!ALIGN_EPI) { if (wr == 0) PG8_BAR; }
    PG8_BAR;
#undef PG8_SA
#undef PG8_SB
#undef PG8_STAGE
#undef PG8_LDA
#undef PG8_LDB
#undef PG8_MMA
#undef PG8_WAIT_V
#undef PG8_WAIT_L
#undef PG8_BAR
#undef PG8_SCHED
}

typedef f32x4 AccT[2][2][4][2];
DI float silu_f(float v) { return v / (1.f + __expf(-v)); }
DI float sigmoid_f(float v) { return 1.f / (1.f + __expf(-v)); }
DI float logsig16(float v) { return (fminf(v, 0.f) - __logf(1.f + __expf(-fabsf(v)))) * 0.0625f; }
DI v4u pack8(f32x4 a, f32x4 b) { v4u w; w.x = pk2(a[0], a[1]); w.y = pk2(a[2], a[3]); w.z = pk2(b[0], b[1]); w.w = pk2(b[2], b[3]); return w; }

struct EpiP1 {
    static constexpr bool PERM = true;
    unsigned char* ws; unsigned char* dout; const float* b_a; const float* gq; const float* gk; LAS float* xch;
    DI void operator()(const AccT& acc, const Unit& u, int wr, int wc, int fr, int fq) const {
        const int pn = u.pn, row0 = u.pm * BM + wr * 64 + fr, cl = wc * 32 + 8 * fq;
        const int rem = pn >= 10 ? (pn - 10) % 6 : 6, gi = pn >= 10 ? (pn - 10) / 6 : 0;
        int mode = 0; const int colbase = (pn & 1) * 256; size_t off;
        if (pn < 10) { const int bi = pn >> 1; off = bi == 0 ? WS_GLAQ : (bi == 1 ? WS_GLAK : (bi == 2 ? WS_GLAV : (bi == 3 ? DO_R : WS_LOGA))); mode = bi == 3 ? 1 : (bi == 4 ? 2 : 0); }
        else { off = (rem < 2 ? WS_DILQ : (rem < 4 ? WS_DILK : WS_DILV)) + (size_t)gi * T * 1024; mode = rem < 4 ? 3 : 0; }
        bf16* dst = (bf16*)(((pn >> 1) == 3 ? dout : ws) + off);
        if (mode == 3) {
            const bool isq = rem < 2;
#pragma unroll
            for (int ai = 0; ai < 2; ++ai)
#pragma unroll
                for (int m = 0; m < 4; ++m)
#pragma unroll
                    for (int bj = 0; bj < 2; ++bj) { const f32x4 v0 = acc[ai][bj][m][0], v1 = acc[ai][bj][m][1];
                        float ss = (v0[0] * v0[0] + v0[1] * v0[1]) + (v0[2] * v0[2] + v0[3] * v0[3]) + (v1[0] * v1[0] + v1[1] * v1[1]) + (v1[2] * v1[2] + v1[3] * v1[3]);
                        ss += __shfl_xor(ss, 16); ss += __shfl_xor(ss, 32);
                        if (fq == 0) xch[(ai * 128 + wr * 64 + m * 16 + fr) * 8 + bj * 4 + wc] = ss; }
            asm volatile("s_waitcnt lgkmcnt(0)" ::: "memory"); __builtin_amdgcn_s_barrier(); asm volatile("" ::: "memory");
            const float* gp = (isq ? gq : gk) + gi * 128 + cl; const f32x4 g0 = *(const f32x4*)gp, g1 = *(const f32x4*)(gp + 4);
            const float qs = isq ? 0.08838834764831845f * LOG2E : 1.f;
#pragma unroll
            for (int ai = 0; ai < 2; ++ai)
#pragma unroll
                for (int m = 0; m < 4; ++m) { bf16* rowp = dst + (size_t)(row0 + ai * HALF + m * 16) * 512 + colbase + cl;
#pragma unroll
                    for (int bj = 0; bj < 2; ++bj) { const f32x4 t = *(const LAS f32x4*)(xch + (ai * 128 + wr * 64 + m * 16 + fr) * 8 + bj * 4);
                        const float rinv = __frsqrt_rn(((t[0] + t[1]) + (t[2] + t[3])) * (1.f / 128.f) + EPS) * qs;
                        *(v4u*)(rowp + bj * HALF) = pack8(acc[ai][bj][m][0] * rinv * g0, acc[ai][bj][m][1] * rinv * g1); } }
            return;
        }
        f32x4 bv[2][2];
#pragma unroll
        for (int bj = 0; bj < 2; ++bj)
#pragma unroll
            for (int n = 0; n < 2; ++n) bv[bj][n] = (mode == 2) ? *(const f32x4*)(b_a + colbase + bj * HALF + cl + 4 * n) : (f32x4){0.f, 0.f, 0.f, 0.f};
#pragma unroll
        for (int ai = 0; ai < 2; ++ai)
#pragma unroll
            for (int m = 0; m < 4; ++m) { bf16* rowp = dst + (size_t)(row0 + ai * HALF + m * 16) * 512 + colbase + cl;
#pragma unroll
                for (int bj = 0; bj < 2; ++bj) { f32x4 v0 = acc[ai][bj][m][0] + bv[bj][0], v1 = acc[ai][bj][m][1] + bv[bj][1];
                    if (mode == 1) {
#pragma unroll
                        for (int j = 0; j < 4; ++j) { v0[j] = silu_f(v0[j]); v1[j] = silu_f(v1[j]); } }
                    if (mode == 2) {
#pragma unroll
                        for (int j = 0; j < 4; ++j) { v0[j] = logsig16(v0[j]); v1[j] = logsig16(v1[j]); } }
                    *(v4u*)(rowp + bj * HALF) = pack8(v0, v1); } }
    }
};
struct EpiGateMerge {
    static constexpr bool PERM = true;
    bf16* Mg; const bf16* Y; const float* bias;
    DI void operator()(const AccT& acc, const Unit& u, int wr, int wc, int fr, int fq) const {
        const int row0 = u.pm * BM + wr * 64 + fr, col0 = u.pn * HALF + wc * 32 + 8 * fq;
        f32x4 bv[2][2];
#pragma unroll
        for (int bj = 0; bj < 2; ++bj)
#pragma unroll
            for (int n = 0; n < 2; ++n) bv[bj][n] = *(const f32x4*)(bias + bj * 1024 + col0 + 4 * n);
#pragma unroll
        for (int ai = 0; ai < 2; ++ai)
#pragma unroll
            for (int m = 0; m < 4; ++m) { const size_t row = (size_t)(row0 + ai * HALF + m * 16);
                const v4u yg = *(const v4u*)(Y + row * 2048 + col0), ya = *(const v4u*)(Y + row * 2048 + 1024 + col0);
                f32x4 g0 = acc[ai][0][m][0] + bv[0][0], g1 = acc[ai][0][m][1] + bv[0][1], a0 = acc[ai][1][m][0] + bv[1][0], a1 = acc[ai][1][m][1] + bv[1][1];
#pragma unroll
                for (int j = 0; j < 4; ++j) { g0[j] = sigmoid_f(g0[j]); g1[j] = sigmoid_f(g1[j]); a0[j] = sigmoid_f(a0[j]); a1[j] = sigmoid_f(a1[j]); }
                f32x4 o0, o1;
                o0[0] = g0[0] * bflo(yg.x) + a0[0] * bflo(ya.x); o0[1] = g0[1] * bfhi(yg.x) + a0[1] * bfhi(ya.x); o0[2] = g0[2] * bflo(yg.y) + a0[2] * bflo(ya.y); o0[3] = g0[3] * bfhi(yg.y) + a0[3] * bfhi(ya.y);
                o1[0] = g1[0] * bflo(yg.z) + a1[0] * bflo(ya.z); o1[1] = g1[1] * bfhi(yg.z) + a1[1] * bfhi(ya.z); o1[2] = g1[2] * bflo(yg.w) + a1[2] * bflo(ya.w); o1[3] = g1[3] * bfhi(yg.w) + a1[3] * bfhi(ya.w);
                *(v4u*)(Mg + row * 1024 + col0) = pack8(o0, o1); }
    }
};
struct EpiX1 {
    static constexpr bool PERM = false;
    float* X1; const float* X;
    DI void operator()(const AccT& acc, const Unit& u, int wr, int wc, int fr, int fq) const {
        const int row0 = u.pm * BM + wr * 64 + fr, col0 = u.pn * BM + wc * 32 + 4 * fq;
#pragma unroll
        for (int ai = 0; ai < 2; ++ai)
#pragma unroll
            for (int m = 0; m < 4; ++m) { const size_t ro = (size_t)(row0 + ai * HALF + m * 16) * 1024 + col0;
#pragma unroll
                for (int bj = 0; bj < 2; ++bj)
#pragma unroll
                    for (int n = 0; n < 2; ++n) *(f32x4*)(X1 + ro + bj * HALF + n * 16) = acc[ai][bj][m][n] + *(const f32x4*)(X + ro + bj * HALF + n * 16); }
    }
};
struct EpiGU {
    static constexpr bool PERM = true;
    bf16* H; const float* roww;
    DI void operator()(const AccT& acc, const Unit& u, int wr, int wc, int fr, int fq) const {
        const int row0 = u.pm * BM + wr * 64 + fr, hc0 = u.pn * 128 + wc * 16 + 4 * fq;
#pragma unroll
        for (int ai = 0; ai < 2; ++ai)
#pragma unroll
            for (int m = 0; m < 4; ++m) { const int row = row0 + ai * HALF + m * 16; const float w = roww[row];
#pragma unroll
                for (int bj = 0; bj < 2; ++bj) { const f32x4 g = acc[ai][bj][m][0], up = acc[ai][bj][m][1];
                    v2u o; o.x = pk2(w * silu_f(g[0]) * up[0], w * silu_f(g[1]) * up[1]); o.y = pk2(w * silu_f(g[2]) * up[2], w * silu_f(g[3]) * up[3]);
                    *(v2u*)(H + (size_t)row * 512 + hc0 + bj * 64) = o; } }
    }
};
struct EpiY {
    static constexpr bool PERM = true;
    bf16* Y; int ld;
    DI void operator()(const AccT& acc, const Unit& u, int wr, int wc, int fr, int fq) const {
        const int row0 = u.pm * BM + wr * 64 + fr, col0 = u.pn * BM + wc * 32 + 8 * fq;
#pragma unroll
        for (int ai = 0; ai < 2; ++ai)
#pragma unroll
            for (int m = 0; m < 4; ++m) { bf16* rowp = Y + (size_t)(row0 + ai * HALF + m * 16) * ld + col0;
#pragma unroll
                for (int bj = 0; bj < 2; ++bj) *(v4u*)(rowp + bj * HALF) = pack8(acc[ai][bj][m][0], acc[ai][bj][m][1]); }
    }
};
}

constexpr int NWAVES = 8, NTHR = 512;
struct Frame {
    LAS unsigned char* lds;
    int tid, lane, wave, vcu, G;
    unsigned char* ws; unsigned char* dout;
};
#define LDS_WAIT() asm volatile("s_waitcnt lgkmcnt(0)" ::: "memory")
#define LDS_BARRIER() do { asm volatile("s_waitcnt lgkmcnt(0)" ::: "memory"); __builtin_amdgcn_s_barrier(); asm volatile("" ::: "memory"); } while (0)
DI float wave_sum(float v) {
#pragma unroll
    for (int o = 1; o < 64; o <<= 1) v += __shfl_xor(v, o);
    return v;
}
#define MFMA16(a, b, c) __builtin_amdgcn_mfma_f32_16x16x32_bf16((a), (b), (c), 0, 0, 0)
#define MFMA32(a, b, c) __builtin_amdgcn_mfma_f32_32x32x16_bf16((a), (b), (c), 0, 0, 0)

struct TItem { const float* src; bf16* dst; int ldw, ldd, kind, aux; };
struct Ins { const float* in[21]; };
constexpr int I_IN = 16 * 208, I_BG = 16 * 64, I_PG = 8 * 32, I_PA = 8 * 32, I_OUT = 16 * 32, I_GU = 32 * 2 * 16 * 16, I_DN = 32 * 8 * 32;
constexpr int NITEMS = I_IN + I_BG + I_PG + I_PA + I_OUT + I_GU + I_DN;
DI TItem p0_decode(const Frame& F, const Ins& I, int it) {
    TItem t; int r = it;
    if (r < I_IN) { const int kb = r / 208, nb = r % 208; const int n0 = nb < 64 ? nb * 32 : (nb - 64) * 32 + 2560, c0 = nb < 64 ? n0 : n0 - 496;
        t.src = I.in[2] + (size_t)kb * 64 * IN_COLS + c0; t.ldw = IN_COLS; t.dst = (bf16*)(F.ws + WS_W1T) + kb * 64; t.ldd = 1024; t.kind = 0; t.aux = n0; return t; } r -= I_IN;
    if (r < I_BG) { const int kb = r / 64, nb = r % 64; t.src = I.in[10] + (size_t)kb * 64 * 2048 + nb * 32; t.ldw = 2048; t.dst = (bf16*)(F.ws + WS_WBGT) + kb * 64; t.ldd = 1024; t.kind = 1; t.aux = nb * 32; return t; } r -= I_BG;
    if (r < I_PG) { const int kb = r / 32, nb = r % 32; t.src = I.in[8] + (size_t)kb * 64 * 1024 + nb * 32; t.ldw = 1024; t.dst = (bf16*)(F.ws + WS_WPGT) + kb * 64; t.ldd = 512; t.kind = 0; t.aux = nb * 32; return t; } r -= I_PG;
    if (r < I_PA) { const int kb = r / 32, nb = r % 32; t.src = I.in[9] + (size_t)kb * 64 * 1024 + nb * 32; t.ldw = 1024; t.dst = (bf16*)(F.ws + WS_WPAT) + kb * 64; t.ldd = 512; t.kind = 0; t.aux = nb * 32; return t; } r -= I_PA;
    if (r < I_OUT) { const int kb = r / 32, nb = r % 32; t.src = I.in[12] + (size_t)kb * 64 * 1024 + nb * 32; t.ldw = 1024; t.dst = (bf16*)(F.ws + WS_WOUTT) + kb * 64; t.ldd = 1024; t.kind = 0; t.aux = nb * 32; return t; } r -= I_OUT;
    if (r < I_GU) { const int e = r / 512, q = r % 512, up = q >> 8, kb = (q >> 4) & 15, nb = q & 15;
        t.src = (up ? I.in[19] : I.in[18]) + (size_t)e * 1024 * 512 + (size_t)kb * 64 * 512 + nb * 32; t.ldw = 512; t.dst = (bf16*)(F.dout + DO_EXPGU) + (size_t)e * 1024 * 1024 + kb * 64; t.ldd = 1024; t.kind = 2; t.aux = nb * 32 * 2 + up; return t; } r -= I_GU;
    { const int e = r / 256, q = r % 256, kb = q / 32, nb = q % 32;
        t.src = I.in[20] + (size_t)e * 512 * 1024 + (size_t)kb * 64 * 1024 + nb * 32; t.ldw = 1024; t.dst = (bf16*)(F.dout + DO_EXPDN) + (size_t)e * 1024 * 512 + kb * 64; t.ldd = 512; t.kind = 0; t.aux = nb * 32; return t; }
}
DI int p0_rowmap(const TItem& t, int n) {
    if (t.kind == 0) return t.aux + n;
    if (t.kind == 1) { const int c = t.aux + n, cc = c & 1023; return (cc >> 7) * 256 + (c >> 10) * 128 + (cc & 127); }
    const int c = (t.aux >> 1) + n; return (c >> 2) * 8 + (c & 3) + 4 * (t.aux & 1);
}
DI void p0_prologue(const Frame& F, const Ins& I) {
    LAS float* scr = (LAS float*)(F.lds + RING_OFF + F.wave * 16384);
    const int gw = F.vcu * NWAVES + F.wave, NGW = F.G * NWAVES, lane = F.lane;
    bf16* W1T = (bf16*)(F.ws + WS_W1T);
    { float cur[32], nxt[32]; TItem ti = p0_decode(F, I, gw < NITEMS ? gw : 0);
#pragma unroll
      for (int i = 0; i < 32; ++i) cur[i] = ti.src[(size_t)(2 * i + (lane >> 5)) * ti.ldw + (lane & 31)];
#pragma unroll 1
      for (int it = gw; it < NITEMS; it += NGW) {
          const bool more = it + NGW < NITEMS; const TItem tn = p0_decode(F, I, more ? it + NGW : it);
#pragma unroll
          for (int i = 0; i < 32; ++i) nxt[i] = tn.src[(size_t)(2 * i + (lane >> 5)) * tn.ldw + (lane & 31)];
#pragma unroll
          for (int i = 0; i < 32; ++i) scr[(2 * i + (lane >> 5)) * 33 + (lane & 31)] = cur[i];
          LDS_WAIT(); asm volatile("" ::: "memory");
          const int c = lane & 7;
#pragma unroll
          for (int j = 0; j < 4; ++j) { const int n = (lane >> 3) + 8 * j; const LAS float* sp = scr + (8 * c) * 33 + n;
              v4u o; o.x = pk2(sp[0 * 33], sp[1 * 33]); o.y = pk2(sp[2 * 33], sp[3 * 33]); o.z = pk2(sp[4 * 33], sp[5 * 33]); o.w = pk2(sp[6 * 33], sp[7 * 33]);
              *(v4u*)(ti.dst + (size_t)p0_rowmap(ti, n) * ti.ldd + 8 * c) = o; }
          LDS_WAIT(); asm volatile("" ::: "memory");
          ti = tn;
#pragma unroll
          for (int i = 0; i < 32; ++i) cur[i] = nxt[i];
      } }
    { const float* win = I.in[2]; const float* wa2 = I.in[3];
      for (int e = (F.vcu * NTHR + F.tid); e < 512 * 1024; e += F.G * NTHR) { const int k = e & 1023, n = e >> 10; const float* wr = win + (size_t)k * IN_COLS + 2048;
          float s = 0.f;
#pragma unroll
          for (int j = 0; j < 16; ++j) s += wr[j] * wa2[j * 512 + n];
          W1T[(size_t)(2048 + n) * 1024 + k] = f2bf(s); } }
    { bf16* WRH = (bf16*)(F.ws + WS_WRH); bf16* WRL = WRH + 48 * 1024; const float* wrg = I.in[14]; const float* wre = I.in[16];
      for (int e = (F.vcu * NTHR + F.tid); e < 48 * 1024; e += F.G * NTHR) { const int k = e & 1023, n = e >> 10;
          const float w = n < 4 ? wrg[k * 4 + n] : (n < 36 ? wre[k * 32 + n - 4] : 0.f); const bf16 h = f2bf(w); WRH[e] = h; WRL[e] = f2bf(w - bf2f(h)); } }
    { const float* x = I.in[0]; const float* g1 = I.in[1]; bf16* XN = (bf16*)(F.ws + WS_XN);
      f32x4 gv[4];
#pragma unroll
      for (int j = 0; j < 4; ++j) gv[j] = *(const f32x4*)(g1 + 4 * lane + 256 * j);
      f32x4 v[4], vn[4];
      { const f32x4* xr = (const f32x4*)(x + (size_t)(gw < T ? gw : 0) * D) + lane;
#pragma unroll
        for (int j = 0; j < 4; ++j) v[j] = xr[64 * j]; }
#pragma unroll 1
      for (int m = gw; m < T; m += NGW) { const int mn = m + NGW < T ? m + NGW : m; const f32x4* xr = (const f32x4*)(x + (size_t)mn * D) + lane; float s = 0.f;
#pragma unroll
          for (int j = 0; j < 4; ++j) { vn[j] = xr[64 * j]; s += (v[j].x * v[j].x + v[j].y * v[j].y) + (v[j].z * v[j].z + v[j].w * v[j].w); }
          const float rinv = __frsqrt_rn(wave_sum(s) * (1.f / D) + EPS);
          v2u* o8 = (v2u*)(XN + (size_t)m * D) + lane;
#pragma unroll
          for (int j = 0; j < 4; ++j) { v2u o; o.x = pk2(v[j].x * rinv * gv[j].x, v[j].y * rinv * gv[j].y); o.y = pk2(v[j].z * rinv * gv[j].z, v[j].w * rinv * gv[j].w); o8[64 * j] = o; v[j] = vn[j]; } } }
}

DI void qk_norm_phase(const Frame& F, const float* gq, const float* gk, bool dry) {
    const int gw = F.vcu * NWAVES + F.wave, NGW = F.G * NWAVES, lane = F.lane;
    bf16* Q = (bf16*)(F.ws + WS_DILQ);
    for (int rr = gw; rr < 6 * T; rr += NGW) { const int which = rr / T; const int gi = which % 3; const bool isq = which < 3;
        bf16* p = Q + (size_t)rr * 512 + 8 * lane; const v4u v = *(const v4u*)p;
        float x[8] = {bflo(v.x), bfhi(v.x), bflo(v.y), bfhi(v.y), bflo(v.z), bfhi(v.z), bflo(v.w), bfhi(v.w)};
        float s = 0.f;
#pragma unroll
        for (int j = 0; j < 8; ++j) s += x[j] * x[j];
        s += __shfl_xor(s, 1); s += __shfl_xor(s, 2); s += __shfl_xor(s, 4); s += __shfl_xor(s, 8);
        const float rinv = __frsqrt_rn(s * (1.f / 128.f) + EPS) * (isq ? 0.08838834764831845f * LOG2E : 1.f);
        const float* g = (isq ? gq : gk) + gi * 128 + (8 * lane & 127);
        const f32x4 g0 = *(const f32x4*)g, g1 = *(const f32x4*)(g + 4);
        v4u o; o.x = pk2(x[0] * rinv * g0.x, x[1] * rinv * g0.y); o.y = pk2(x[2] * rinv * g0.z, x[3] * rinv * g0.w); o.z = pk2(x[4] * rinv * g1.x, x[5] * rinv * g1.y); o.w = pk2(x[6] * rinv * g1.z, x[7] * rinv * g1.w);
        if (!dry) *(v4u*)p = o; }
}

DI int crow(int i, int h) { return (i & 3) + 8 * (i >> 2) + 4 * h; }
DI int img_off(int row, int ch) { return 256 * row + 16 * (ch ^ (((row & 3) << 2) | ((row >> 2) & 3))); }
typedef short s16x4 __attribute__((ext_vector_type(4)));
DI void attn_job(const Frame& F, int job, bool dry) {
    const int lane = F.lane, r = lane & 31, h = lane >> 5;
    const int gi = job >> 12; int rem = job & 4095;
    const int sh = 2 * gi, d = 1 << sh, L = SEQ >> sh, nqt = L >> 5;
    const int qt = rem % nqt; rem /= nqt; const int res = rem & (d - 1); rem >>= sh; const int head = rem & 3, b = rem >> 2;
    const int p0 = qt * 32;
    const float slope = exp2f(-8.f * (float)(gi * 4 + head + 1) / 12.f) * LOG2E * (float)d;
    bf16* Qg = (bf16*)(F.ws + WS_DILQ) + (size_t)gi * T * 512;
    const bf16* Kg = (const bf16*)(F.ws + WS_DILK) + (size_t)gi * T * 512 + head * 128;
    const bf16* Vg = (const bf16*)(F.ws + WS_DILV) + (size_t)gi * T * 512 + head * 128;
    LAS unsigned char* Kimg = F.lds + F.wave * 16384; LAS unsigned char* Vimg = Kimg + 8192;
    const size_t qtok = (size_t)b * SEQ + (size_t)(p0 + r) * d + res;
    bf16x8 qf[8];
#pragma unroll
    for (int ks = 0; ks < 8; ++ks) qf[ks] = *(const bf16x8*)(Qg + qtok * 512 + head * 128 + 16 * ks + 8 * h);
    f32x16 O[4];
#pragma unroll
    for (int db = 0; db < 4; ++db)
#pragma unroll
        for (int i = 0; i < 16; ++i) O[db][i] = 0.f;
    float m = -1e30f, l = 0.f;
    const int srow = lane >> 4, sslot = lane & 15;
    v4u kst[8], vst[8];
    const int kt0 = p0 >= 128 ? 0 : (128 - p0) >> 5;
#define ATT_LOAD(ktn) do { const int _kb = p0 - 128 + 32 * (ktn); _Pragma("unroll") for (int i = 0; i < 8; ++i) { const int kk = 4 * i + srow; \
        const size_t _o = ((size_t)b * SEQ + (size_t)(_kb + kk) * d + res) * 512 + 8 * (sslot ^ ((srow << 2) | (i & 3))); kst[i] = *(const v4u*)(Kg + _o); vst[i] = *(const v4u*)(Vg + _o); } } while (0)
    ATT_LOAD(kt0);
#pragma unroll 1
    for (int kt = kt0; kt < 5; ++kt) { const int kb = p0 - 128 + 32 * kt;
#pragma unroll
        for (int i = 0; i < 8; ++i) { *(LAS v4u*)(Kimg + 1024 * i + 16 * lane) = kst[i]; *(LAS v4u*)(Vimg + 1024 * i + 16 * lane) = vst[i]; }
        if (kt + 1 < 5) ATT_LOAD(kt + 1);
        f32x16 s;
#pragma unroll
        for (int i = 0; i < 16; ++i) s[i] = 0.f;
#pragma unroll
        for (int ks = 0; ks < 8; ++ks) { const bf16x8 kf = *(const LAS bf16x8*)(Kimg + img_off(r, 2 * ks + h)); s = MFMA32(kf, qf[ks], s); }
        float mx = -1e30f; const int dq = p0 + r - kb;
#pragma unroll
        for (int i = 0; i < 16; ++i) { const int dist = dq - crow(i, h); const bool ok = dist >= 0 && dist <= 128; const float sv = ok ? s[i] - slope * (float)dist : -1e30f; s[i] = sv; mx = fmaxf(mx, sv); }
        mx = fmaxf(mx, __shfl_xor(mx, 32));
        const float mn = fmaxf(m, mx), alpha = exp2f(m - mn); m = mn;
        float ps = 0.f;
#pragma unroll
        for (int i = 0; i < 16; ++i) { const float p = s[i] > -1e29f ? exp2f(s[i] - mn) : 0.f; s[i] = p; ps += p; }
        l = l * alpha + ps;
#pragma unroll
        for (int db = 0; db < 4; ++db)
#pragma unroll
            for (int i = 0; i < 16; ++i) O[db][i] *= alpha;
        bf16x8 pb[2];
#pragma unroll
        for (int si = 0; si < 2; ++si) { v4u w; w.x = pk2(s[8 * si], s[8 * si + 1]); w.y = pk2(s[8 * si + 2], s[8 * si + 3]); w.z = pk2(s[8 * si + 4], s[8 * si + 5]); w.w = pk2(s[8 * si + 6], s[8 * si + 7]); pb[si] = __builtin_bit_cast(bf16x8, w); }
        { const int i16 = lane & 15, q = i16 >> 2, p = i16 & 3, gl = (lane >> 4) & 1;
#pragma unroll
          for (int db = 0; db < 4; ++db)
#pragma unroll
            for (int si = 0; si < 2; ++si) {
                const s16x4 lo = __builtin_amdgcn_ds_read_tr16_b64_v4i16((LAS s16x4*)(Vimg + img_off(16 * si + 4 * h + q, 4 * db + 2 * gl + (p >> 1)) + 8 * (p & 1)));
                const s16x4 hi = __builtin_amdgcn_ds_read_tr16_b64_v4i16((LAS s16x4*)(Vimg + img_off(16 * si + 8 + 4 * h + q, 4 * db + 2 * gl + (p >> 1)) + 8 * (p & 1)));
                const bf16x8 vf = __builtin_shufflevector(lo, hi, 0, 1, 2, 3, 4, 5, 6, 7); O[db] = MFMA32(vf, pb[si], O[db]); } }
    }
#undef ATT_LOAD
    const float lt = l + __shfl_xor(l, 32), inv = 1.f / lt;
    bf16* op = Qg + qtok * 512 + head * 128 + 4 * h;
    if (dry) return;
#pragma unroll
    for (int db = 0; db < 4; ++db)
#pragma unroll
        for (int q4 = 0; q4 < 4; ++q4) { v2u o; o.x = pk2(O[db][4 * q4] * inv, O[db][4 * q4 + 1] * inv); o.y = pk2(O[db][4 * q4 + 2] * inv, O[db][4 * q4 + 3] * inv); *(v2u*)(op + 32 * db + 8 * q4) = o; }
    if (h == 0) ((float*)(F.ws + WS_LSE))[(size_t)gi * T * 4 + qtok * 4 + head] = m + log2f(lt);
}

constexpr int G_QS = 0, G_KS = 17408, G_KET = 34816, G_VT = 53248, G_ATT = 71680, G_TOT = 80896, G_DL = 82944, G_OS = 84992;
constexpr int QS_LD = 136, KT_LD = 72, OS_LD = 132;
DI void gla_pass1(const Frame& F, int item, bool dry) {
    const int tid = F.tid, lane = F.lane, w = F.wave, fr = lane & 15, g = lane >> 4;
    const int seg = item & (NSEG - 1), bh = item >> 4, hh = bh & 3, b = bh >> 2;
    const int dk = tid & 127, qr = tid >> 7;
    LAS bf16* Qs = (LAS bf16*)(F.lds + G_QS); LAS bf16* Ks = (LAS bf16*)(F.lds + G_KS); LAS bf16* KEt = (LAS bf16*)(F.lds + G_KET); LAS bf16* Vt = (LAS bf16*)(F.lds + G_VT);
    LAS bf16* Att = (LAS bf16*)(F.lds + G_ATT); LAS float* tot = (LAS float*)(F.lds + G_TOT); LAS float* Dl = (LAS float*)(F.lds + G_DL);
    const bf16* GQ = (const bf16*)(F.ws + WS_GLAQ); const bf16* GK = (const bf16*)(F.ws + WS_GLAK); const bf16* LA = (const bf16*)(F.ws + WS_LOGA); bf16* GV = (bf16*)(F.ws + WS_GLAV);
    f32x4 S[8];
#pragma unroll
    for (int a = 0; a < 8; ++a) S[a] = (f32x4){0.f, 0.f, 0.f, 0.f};
    float Btot = 0.f;
    const int dv0 = 16 * w;
    bf16 rl[16], rq[16], rk[16], vv[16];
#define GLA_LOAD1(chn) do { const size_t _o = ((size_t)b * SEQ + seg * TSEG + (chn) * 64 + 16 * qr) * 512 + hh * 128 + dk; \
        _Pragma("unroll") for (int i4 = 0; i4 < 4; ++i4) { const bf16* pl = LA + _o + (size_t)i4 * 2048; const bf16* pq = GQ + _o + (size_t)i4 * 2048; const bf16* pk = GK + _o + (size_t)i4 * 2048; const bf16* pv = GV + _o + (size_t)i4 * 2048; \
            _Pragma("unroll") for (int j = 0; j < 4; ++j) { rl[4 * i4 + j] = pl[j * 512]; rq[4 * i4 + j] = pq[j * 512]; rk[4 * i4 + j] = pk[j * 512]; vv[4 * i4 + j] = pv[j * 512]; } } } while (0)
    GLA_LOAD1(0);
#pragma unroll 1
    for (int ch = 0; ch < TSEG / 64; ++ch) {
        const size_t tokbase = (size_t)b * SEQ + seg * TSEG + ch * 64;
        float la[16], qv[16], kv[16];
#pragma unroll
        for (int i = 0; i < 16; ++i) { la[i] = bf2f(rl[i]); qv[i] = bf2f(rq[i]); kv[i] = bf2f(rk[i]); }
#pragma unroll
        for (int i = 1; i < 16; ++i) la[i] += la[i - 1];
        tot[qr * 128 + dk] = la[15];
        { v4u v0, v1; v0.x = vv[0] | ((unsigned)vv[1] << 16); v0.y = vv[2] | ((unsigned)vv[3] << 16); v0.z = vv[4] | ((unsigned)vv[5] << 16); v0.w = vv[6] | ((unsigned)vv[7] << 16);
          v1.x = vv[8] | ((unsigned)vv[9] << 16); v1.y = vv[10] | ((unsigned)vv[11] << 16); v1.z = vv[12] | ((unsigned)vv[13] << 16); v1.w = vv[14] | ((unsigned)vv[15] << 16);
          *(LAS v4u*)(Vt + dk * KT_LD + 16 * qr) = v0; *(LAS v4u*)(Vt + dk * KT_LD + 16 * qr + 8) = v1; }
        LDS_BARRIER();
        const float t0 = tot[dk], t1 = tot[128 + dk], t2 = tot[256 + dk], t3 = tot[384 + dk];
        const float base = (qr > 0 ? t0 : 0.f) + (qr > 1 ? t1 : 0.f) + (qr > 2 ? t2 : 0.f), blast = (t0 + t1) + (t2 + t3);
        Btot += blast;
        if (qr == 0) Dl[dk] = __expf(blast);
        { unsigned ke[8];
#pragma unroll
          for (int i = 0; i < 16; i += 2) { const float b0 = base + la[i], b1 = base + la[i + 1]; const float e0 = __expf(b0), e1 = __expf(b1);
              Qs[(16 * qr + i) * QS_LD + dk] = f2bf(qv[i] * 0.08838834764831845f * e0); Qs[(16 * qr + i + 1) * QS_LD + dk] = f2bf(qv[i + 1] * 0.08838834764831845f * e1);
              Ks[(16 * qr + i) * QS_LD + dk] = f2bf(kv[i] / e0); Ks[(16 * qr + i + 1) * QS_LD + dk] = f2bf(kv[i + 1] / e1);
              ke[i >> 1] = pk2(kv[i] * __expf(blast - b0), kv[i + 1] * __expf(blast - b1)); }
          v4u k0 = {ke[0], ke[1], ke[2], ke[3]}, k1 = {ke[4], ke[5], ke[6], ke[7]};
          *(LAS v4u*)(KEt + dk * KT_LD + 16 * qr) = k0; *(LAS v4u*)(KEt + dk * KT_LD + 16 * qr + 8) = k1; }
        LDS_BARRIER();
        if (ch + 1 < TSEG / 64) GLA_LOAD1(ch + 1);
#pragma unroll
        for (int tt = 0; tt < 2; ++tt) { const int n = 2 * w + tt, jt = n >> 2, it = n & 3; f32x4 a4 = {0.f, 0.f, 0.f, 0.f};
#pragma unroll
            for (int s = 0; s < 4; ++s) { const bf16x8 ka = *(const LAS bf16x8*)(Ks + (16 * jt + fr) * QS_LD + 32 * s + 8 * g); const bf16x8 qb = *(const LAS bf16x8*)(Qs + (16 * it + fr) * QS_LD + 32 * s + 8 * g); a4 = MFMA16(ka, qb, a4); }
            const int tj = 16 * jt + 4 * g, ti = 16 * it + fr;
            v2u o; o.x = pk2(tj <= ti ? a4[0] : 0.f, tj + 1 <= ti ? a4[1] : 0.f); o.y = pk2(tj + 2 <= ti ? a4[2] : 0.f, tj + 3 <= ti ? a4[3] : 0.f);
            *(LAS v2u*)(Att + ti * KT_LD + tj) = o; }
        LDS_BARRIER();
        bf16x8 Sb[4];
#pragma unroll
        for (int s = 0; s < 4; ++s) { v4u p; p.x = pk2(S[2 * s][0], S[2 * s][1]); p.y = pk2(S[2 * s][2], S[2 * s][3]); p.z = pk2(S[2 * s + 1][0], S[2 * s + 1][1]); p.w = pk2(S[2 * s + 1][2], S[2 * s + 1][3]); Sb[s] = __builtin_bit_cast(bf16x8, p); }
        bf16x8 Vf[2];
#pragma unroll
        for (int ks = 0; ks < 2; ++ks) Vf[ks] = *(const LAS bf16x8*)(Vt + (dv0 + fr) * KT_LD + 32 * ks + 8 * g);
#pragma unroll
        for (int it = 0; it < 4; ++it) { f32x4 o = {0.f, 0.f, 0.f, 0.f};
#pragma unroll
            for (int s = 0; s < 4; ++s) { const bf16x4 lo = *(const LAS bf16x4*)(Qs + (16 * it + fr) * QS_LD + 32 * s + 4 * g); const bf16x4 hi = *(const LAS bf16x4*)(Qs + (16 * it + fr) * QS_LD + 32 * s + 16 + 4 * g);
                const bf16x8 qa = __builtin_shufflevector(lo, hi, 0, 1, 2, 3, 4, 5, 6, 7); o = MFMA16(qa, Sb[s], o); }
#pragma unroll
            for (int ks = 0; ks < 2; ++ks) { const bf16x8 aa = *(const LAS bf16x8*)(Att + (16 * it + fr) * KT_LD + 32 * ks + 8 * g); o = MFMA16(aa, Vf[ks], o); }
            bf16* op = GV + (tokbase + 16 * it + 4 * g) * 512 + hh * 128 + dv0 + fr;
            if (!dry) {
#pragma unroll
            for (int rr = 0; rr < 4; ++rr) op[(size_t)rr * 512] = f2bf(o[rr]); } }
#pragma unroll
        for (int a = 0; a < 8; ++a) { const f32x4 dsc = *(const LAS f32x4*)(Dl + 16 * a + 4 * g); S[a] = S[a] * dsc;
#pragma unroll
            for (int ks = 0; ks < 2; ++ks) { const bf16x8 ka = *(const LAS bf16x8*)(KEt + (16 * a + fr) * KT_LD + 32 * ks + 8 * g); S[a] = MFMA16(ka, Vf[ks], S[a]); } }
        LDS_BARRIER();
    }
    v2u* LB = (v2u*)(F.ws + WS_LB) + (size_t)item * 4096 + w * 512 + lane;
#pragma unroll
    for (int a = 0; a < 8; ++a) { v2u o; o.x = pk2(S[a][0], S[a][1]); o.y = pk2(S[a][2], S[a][3]); LB[a * 64] = o; }
    if (qr == 0) ((float*)(F.ws + WS_DSEG))[item * 128 + dk] = __expf(Btot);
}

DI void gla_pass2(const Frame& F, int item, const float* gnorm, bool dry) {
    const int tid = F.tid, lane = F.lane, w = F.wave, fr = lane & 15, g = lane >> 4;
    const int seg = item & (NSEG - 1), bh = item >> 4, hh = bh & 3, b = bh >> 2;
    const int dk = tid & 127, qr = tid >> 7, dv0 = 16 * w;
    LAS bf16* Qs = (LAS bf16*)(F.lds + G_QS); LAS float* tot = (LAS float*)(F.lds + G_TOT); LAS float* Os = (LAS float*)(F.lds + G_OS);
    const bf16* GQ = (const bf16*)(F.ws + WS_GLAQ); const bf16* LA = (const bf16*)(F.ws + WS_LOGA); bf16* GV = (bf16*)(F.ws + WS_GLAV); const bf16* R = (const bf16*)(F.dout + DO_R);
    f32x4 Sc[8];
#pragma unroll
    for (int a = 0; a < 8; ++a) Sc[a] = (f32x4){0.f, 0.f, 0.f, 0.f};
    { v2u lv[8], lvn[8]; f32x4 dc[8], dcn[8];
#define GLA_CLOAD(LV, DC, spn) do { const int _it2 = bh * NSEG + (spn); const v2u* _LB = (const v2u*)(F.ws + WS_LB) + (size_t)_it2 * 4096 + w * 512 + lane; const float* _DS = (const float*)(F.ws + WS_DSEG) + _it2 * 128 + 4 * g; \
        _Pragma("unroll") for (int a = 0; a < 8; ++a) { DC[a] = *(const f32x4*)(_DS + 16 * a); LV[a] = _LB[a * 64]; } } while (0)
      if (seg > 0) GLA_CLOAD(lv, dc, 0);
#pragma unroll 1
      for (int sp = 0; sp < seg; ++sp) {
          if (sp + 1 < seg) GLA_CLOAD(lvn, dcn, sp + 1);
#pragma unroll
          for (int a = 0; a < 8; ++a) { Sc[a][0] = Sc[a][0] * dc[a][0] + bflo(lv[a].x); Sc[a][1] = Sc[a][1] * dc[a][1] + bfhi(lv[a].x); Sc[a][2] = Sc[a][2] * dc[a][2] + bflo(lv[a].y); Sc[a][3] = Sc[a][3] * dc[a][3] + bfhi(lv[a].y);
              lv[a] = lvn[a]; dc[a] = dcn[a]; } }
#undef GLA_CLOAD
    }
    bf16x8 Sb[4];
#pragma unroll
    for (int s = 0; s < 4; ++s) { v4u p; p.x = pk2(Sc[2 * s][0], Sc[2 * s][1]); p.y = pk2(Sc[2 * s][2], Sc[2 * s][3]); p.z = pk2(Sc[2 * s + 1][0], Sc[2 * s + 1][1]); p.w = pk2(Sc[2 * s + 1][2], Sc[2 * s + 1][3]); Sb[s] = __builtin_bit_cast(bf16x8, p); }
    float Bcum = 0.f;
    const int tk = tid >> 3, pc = tid & 7;
    f32x4 gn[4];
#pragma unroll
    for (int j = 0; j < 4; ++j) gn[j] = *(const f32x4*)(gnorm + 16 * pc + 4 * j);
    bf16 rl[16], rq[16]; v4u ow0, ow1, r0, r1;
#define GLA_LOAD2A(chn) do { const size_t _o = ((size_t)b * SEQ + seg * TSEG + (chn) * 64 + 16 * qr) * 512 + hh * 128 + dk; \
        _Pragma("unroll") for (int i4 = 0; i4 < 4; ++i4) { const bf16* pl = LA + _o + (size_t)i4 * 2048; const bf16* pq = GQ + _o + (size_t)i4 * 2048; \
            _Pragma("unroll") for (int j = 0; j < 4; ++j) { rl[4 * i4 + j] = pl[j * 512]; rq[4 * i4 + j] = pq[j * 512]; } } } while (0)
#define GLA_LOAD2B(chn) do { const size_t _o = ((size_t)b * SEQ + seg * TSEG + (chn) * 64 + tk) * 512 + hh * 128 + 16 * pc; \
        ow0 = *(const v4u*)(GV + _o); ow1 = *(const v4u*)(GV + _o + 8); r0 = *(const v4u*)(R + _o); r1 = *(const v4u*)(R + _o + 8); } while (0)
    GLA_LOAD2A(0); GLA_LOAD2B(0);
#pragma unroll 1
    for (int ch = 0; ch < TSEG / 64; ++ch) {
        const size_t tokbase = (size_t)b * SEQ + seg * TSEG + ch * 64;
        float la[16], qv[16];
#pragma unroll
        for (int i = 0; i < 16; ++i) { la[i] = bf2f(rl[i]); qv[i] = bf2f(rq[i]); }
#pragma unroll
        for (int i = 1; i < 16; ++i) la[i] += la[i - 1];
        tot[qr * 128 + dk] = la[15];
        LDS_BARRIER();
        const float t0 = tot[dk], t1 = tot[128 + dk], t2 = tot[256 + dk], t3 = tot[384 + dk];
        const float base = Bcum + (qr > 0 ? t0 : 0.f) + (qr > 1 ? t1 : 0.f) + (qr > 2 ? t2 : 0.f);
        Bcum += (t0 + t1) + (t2 + t3);
#pragma unroll
        for (int i = 0; i < 16; ++i) Qs[(16 * qr + i) * QS_LD + dk] = f2bf(qv[i] * 0.08838834764831845f * __expf(base + la[i]));
        if (ch + 1 < TSEG / 64) GLA_LOAD2A(ch + 1);
        LDS_BARRIER();
#pragma unroll
        for (int it = 0; it < 4; ++it) { f32x4 o = {0.f, 0.f, 0.f, 0.f};
            if (seg > 0) {
#pragma unroll
                for (int s = 0; s < 4; ++s) { const bf16x4 lo = *(const LAS bf16x4*)(Qs + (16 * it + fr) * QS_LD + 32 * s + 4 * g); const bf16x4 hi = *(const LAS bf16x4*)(Qs + (16 * it + fr) * QS_LD + 32 * s + 16 + 4 * g);
                    const bf16x8 qa = __builtin_shufflevector(lo, hi, 0, 1, 2, 3, 4, 5, 6, 7); o = MFMA16(qa, Sb[s], o); } }
#pragma unroll
            for (int rr = 0; rr < 4; ++rr) Os[(16 * it + 4 * g + rr) * OS_LD + dv0 + fr] = o[rr]; }
        LDS_BARRIER();
        { f32x4 v[4]; float ss = 0.f;
#pragma unroll
          for (int j = 0; j < 4; ++j) v[j] = *(const LAS f32x4*)(Os + tk * OS_LD + 16 * pc + 4 * j);
          v[0].x += bflo(ow0.x); v[0].y += bfhi(ow0.x); v[0].z += bflo(ow0.y); v[0].w += bfhi(ow0.y); v[1].x += bflo(ow0.z); v[1].y += bfhi(ow0.z); v[1].z += bflo(ow0.w); v[1].w += bfhi(ow0.w);
          v[2].x += bflo(ow1.x); v[2].y += bfhi(ow1.x); v[2].z += bflo(ow1.y); v[2].w += bfhi(ow1.y); v[3].x += bflo(ow1.z); v[3].y += bfhi(ow1.z); v[3].z += bflo(ow1.w); v[3].w += bfhi(ow1.w);
#pragma unroll
          for (int j = 0; j < 4; ++j) ss += (v[j].x * v[j].x + v[j].y * v[j].y) + (v[j].z * v[j].z + v[j].w * v[j].w);
          ss += __shfl_xor(ss, 1); ss += __shfl_xor(ss, 2); ss += __shfl_xor(ss, 4);
          const float rinv = __frsqrt_rn(ss * (1.f / 128.f) + EPS);
          const size_t ofs = (tokbase + tk) * 512 + hh * 128 + 16 * pc;
          v4u o0, o1;
          o0.x = pk2(v[0].x * rinv * gn[0].x * bflo(r0.x), v[0].y * rinv * gn[0].y * bfhi(r0.x)); o0.y = pk2(v[0].z * rinv * gn[0].z * bflo(r0.y), v[0].w * rinv * gn[0].w * bfhi(r0.y));
          o0.z = pk2(v[1].x * rinv * gn[1].x * bflo(r0.z), v[1].y * rinv * gn[1].y * bfhi(r0.z)); o0.w = pk2(v[1].z * rinv * gn[1].z * bflo(r0.w), v[1].w * rinv * gn[1].w * bfhi(r0.w));
          o1.x = pk2(v[2].x * rinv * gn[2].x * bflo(r1.x), v[2].y * rinv * gn[2].y * bfhi(r1.x)); o1.y = pk2(v[2].z * rinv * gn[2].z * bflo(r1.y), v[2].w * rinv * gn[2].w * bfhi(r1.y));
          o1.z = pk2(v[3].x * rinv * gn[3].x * bflo(r1.z), v[3].y * rinv * gn[3].y * bfhi(r1.z)); o1.w = pk2(v[3].z * rinv * gn[3].z * bflo(r1.w), v[3].w * rinv * gn[3].w * bfhi(r1.w));
          if (!dry) { *(v4u*)(GV + ofs) = o0; *(v4u*)(GV + ofs + 8) = o1; }
          if (ch + 1 < TSEG / 64) GLA_LOAD2B(ch + 1); }
        LDS_BARRIER();
    }
}
DI void attn_merge_phase(const Frame& F, bool dry) {
    const int gw = F.vcu * NWAVES + F.wave, NGW = F.G * NWAVES, lane = F.lane, head = lane >> 4;
    bf16* O0 = (bf16*)(F.ws + WS_DILQ); const float* LSE = (const float*)(F.ws + WS_LSE);
    for (int t = gw; t < T; t += NGW) {
        const float l0 = LSE[(size_t)t * 4 + head], l1 = LSE[(size_t)T * 4 + (size_t)t * 4 + head], l2 = LSE[(size_t)2 * T * 4 + (size_t)t * 4 + head];
        const float M = fmaxf(l0, fmaxf(l1, l2)); float w0 = exp2f(l0 - M), w1 = exp2f(l1 - M), w2 = exp2f(l2 - M); const float inv = 1.f / (w0 + w1 + w2); w0 *= inv; w1 *= inv; w2 *= inv;
        bf16* p = O0 + (size_t)t * 512 + 8 * lane; const v4u a = *(const v4u*)p, bq = *(const v4u*)(p + (size_t)T * 512), c = *(const v4u*)(p + (size_t)2 * T * 512);
        v4u o;
        o.x = pk2(w0 * bflo(a.x) + w1 * bflo(bq.x) + w2 * bflo(c.x), w0 * bfhi(a.x) + w1 * bfhi(bq.x) + w2 * bfhi(c.x));
        o.y = pk2(w0 * bflo(a.y) + w1 * bflo(bq.y) + w2 * bflo(c.y), w0 * bfhi(a.y) + w1 * bfhi(bq.y) + w2 * bfhi(c.y));
        o.z = pk2(w0 * bflo(a.z) + w1 * bflo(bq.z) + w2 * bflo(c.z), w0 * bfhi(a.z) + w1 * bfhi(bq.z) + w2 * bfhi(c.z));
        o.w = pk2(w0 * bflo(a.w) + w1 * bflo(bq.w) + w2 * bflo(c.w), w0 * bfhi(a.w) + w1 * bfhi(bq.w) + w2 * bfhi(c.w));
        if (!dry) *(v4u*)p = o; }
}

DI void router_phase(const Frame& F, const float* g2, const float* brg, const float* bre, unsigned* gcnt, bool dry) {
    const int lane = F.lane, w = F.wave, fr = lane & 15, g = lane >> 4;
    const float* X1 = (const float*)(F.ws + WS_X1); bf16* H2 = (bf16*)(F.ws + WS_H2);
    const bf16* WRH = (const bf16*)(F.ws + WS_WRH); const bf16* WRL = WRH + 48 * 1024;
    int* TOKE = (int*)(F.ws + WS_TOKE); float* TOKW = (float*)(F.ws + WS_TOKW); int* TOKR = (int*)(F.ws + WS_TOKR);
    LAS float* lg = (LAS float*)(F.lds + w * 4096);
    LAS int* cnt = (LAS int*)(F.lds + 65536); LAS int* basev = cnt + 32;
    for (int it = 0; it * F.G * 128 < T; ++it) {
        const int tok0 = (it * F.G + F.vcu) * 128 + w * 16;
        if (F.tid < 32) cnt[F.tid] = 0;
        __syncthreads();
        f32x4 acc[3]; acc[0] = acc[1] = acc[2] = (f32x4){0.f, 0.f, 0.f, 0.f};
        float ss = 0.f;
        const float* xr = X1 + (size_t)(tok0 + fr) * D + 8 * g;
        for (int s = 0; s < 32; ++s) {
            const f32x4 xa = *(const f32x4*)(xr + 32 * s), xb = *(const f32x4*)(xr + 32 * s + 4);
            const f32x4 ga = *(const f32x4*)(g2 + 32 * s + 8 * g), gb = *(const f32x4*)(g2 + 32 * s + 8 * g + 4);
            ss += (xa.x * xa.x + xa.y * xa.y) + (xa.z * xa.z + xa.w * xa.w) + (xb.x * xb.x + xb.y * xb.y) + (xb.z * xb.z + xb.w * xb.w);
            const f32x4 ya = xa * ga, yb = xb * gb;
            v4u hi; hi.x = pk2(ya.x, ya.y); hi.y = pk2(ya.z, ya.w); hi.z = pk2(yb.x, yb.y); hi.w = pk2(yb.z, yb.w);
            v4u lo; lo.x = pk2(ya.x - bflo(hi.x), ya.y - bfhi(hi.x)); lo.y = pk2(ya.z - bflo(hi.y), ya.w - bfhi(hi.y)); lo.z = pk2(yb.x - bflo(hi.z), yb.y - bfhi(hi.z)); lo.w = pk2(yb.z - bflo(hi.w), yb.w - bfhi(hi.w));
            const bf16x8 ah = __builtin_bit_cast(bf16x8, hi), al = __builtin_bit_cast(bf16x8, lo);
#pragma unroll
            for (int nt = 0; nt < 3; ++nt) { const bf16x8 bh = *(const bf16x8*)(WRH + (size_t)(16 * nt + fr) * 1024 + 32 * s + 8 * g), bl = *(const bf16x8*)(WRL + (size_t)(16 * nt + fr) * 1024 + 32 * s + 8 * g);
                acc[nt] = MFMA16(ah, bh, acc[nt]); acc[nt] = MFMA16(ah, bl, acc[nt]); acc[nt] = MFMA16(al, bh, acc[nt]); }
        }
        ss += __shfl_xor(ss, 16); ss += __shfl_xor(ss, 32);
        const float rinv = __frsqrt_rn(ss * (1.f / D) + EPS);
#pragma unroll
        for (int rr = 0; rr < 4; ++rr) { const float ri = __shfl(rinv, 4 * g + rr);
#pragma unroll
            for (int nt = 0; nt < 3; ++nt) lg[(4 * g + rr) * 48 + 16 * nt + fr] = acc[nt][rr] * ri; }
        { bf16* hr = H2 + (size_t)(tok0 + fr) * D + 8 * g;
          for (int s = 0; s < 32; ++s) { const f32x4 xa = *(const f32x4*)(xr + 32 * s), xb = *(const f32x4*)(xr + 32 * s + 4);
              const f32x4 ga = *(const f32x4*)(g2 + 32 * s + 8 * g), gb = *(const f32x4*)(g2 + 32 * s + 8 * g + 4);
              v4u o; o.x = pk2(xa.x * rinv * ga.x, xa.y * rinv * ga.y); o.y = pk2(xa.z * rinv * ga.z, xa.w * rinv * ga.w); o.z = pk2(xb.x * rinv * gb.x, xb.y * rinv * gb.y); o.w = pk2(xb.z * rinv * gb.z, xb.w * rinv * gb.w);
              if (!dry) *(v4u*)(hr + 32 * s) = o; } }
        LDS_WAIT(); asm volatile("" ::: "memory");
        int e1 = 0, e2 = 0, lr1 = 0, lr2 = 0; float w1 = 0.f, w2 = 0.f;
        if (lane < 16) { const LAS float* q = lg + lane * 48;
            float gl[4]; int gs = 0; float gm = -3.0e38f;
#pragma unroll
            for (int j = 0; j < 4; ++j) { gl[j] = q[j] + brg[j]; if (gl[j] > gm) { gm = gl[j]; gs = j; } }
            float gsum = 0.f;
#pragma unroll
            for (int j = 0; j < 4; ++j) gsum += __expf(gl[j] - gm);
            const float gp = 1.f / gsum;
            float el[8]; int i1 = 0; float v1 = -3.0e38f;
#pragma unroll
            for (int j = 0; j < 8; ++j) { el[j] = q[4 + 8 * gs + j] + bre[8 * gs + j]; if (el[j] > v1) { v1 = el[j]; i1 = j; } }
            int i2 = 0; float v2 = -3.0e38f;
#pragma unroll
            for (int j = 0; j < 8; ++j) if (j != i1 && el[j] > v2) { v2 = el[j]; i2 = j; }
            const float p2 = 1.f / (1.f + __expf(v1 - v2)), p1 = 1.f - p2;
            e1 = 8 * gs + i1; e2 = 8 * gs + i2; w1 = p1 * gp; w2 = p2 * gp;
            lr1 = __hip_atomic_fetch_add(&cnt[e1], 1, __ATOMIC_RELAXED, __HIP_MEMORY_SCOPE_WORKGROUP); lr2 = __hip_atomic_fetch_add(&cnt[e2], 1, __ATOMIC_RELAXED, __HIP_MEMORY_SCOPE_WORKGROUP); }
        __syncthreads();
        if (F.tid < 32) basev[F.tid] = dry ? 0 : (int)atomicAdd(&gcnt[64 * F.tid], (unsigned)cnt[F.tid]);
        __syncthreads();
        if (lane < 16 && !dry) { const int t = tok0 + lane; TOKE[2 * t] = e1; TOKE[2 * t + 1] = e2; TOKW[2 * t] = w1; TOKW[2 * t + 1] = w2; TOKR[2 * t] = basev[e1] + lr1; TOKR[2 * t + 1] = basev[e2] + lr2; }
        __syncthreads();
    }
}
DI void moe_assign_phase(const Frame& F, unsigned* gcnt) {
    LAS int* pst = (LAS int*)(F.lds + 65536);
    if (F.tid == 0) { int p = 0; int* BLKE = (int*)(F.ws + WS_BLKE);
        for (int e = 0; e < 32; ++e) { pst[e] = p; const int c = (int)__hip_atomic_load(&gcnt[64 * e], __ATOMIC_RELAXED, __HIP_MEMORY_SCOPE_AGENT); const int nb = (c + 255) >> 8;
            if (F.vcu == 0) for (int j = 0; j < nb; ++j) BLKE[(p >> 8) + j] = e;
            p += nb << 8; }
        if (F.vcu == 0) BLKE[NBLK_MAX] = p >> 8; }
    __syncthreads();
    const int gw = F.vcu * NWAVES + F.wave, NGW = F.G * NWAVES, lane = F.lane;
    const int* TOKE = (const int*)(F.ws + WS_TOKE); const float* TOKW = (const float*)(F.ws + WS_TOKW); const int* TOKR = (const int*)(F.ws + WS_TOKR);
    int* DEST = (int*)(F.ws + WS_DEST); float* ROWW = (float*)(F.ws + WS_ROWW);
    const bf16* H2 = (const bf16*)(F.ws + WS_H2); bf16* XP = (bf16*)(F.ws + WS_XP);
    for (int p = gw; p < 2 * T; p += NGW) { const int e = TOKE[p], dest = pst[e] + TOKR[p], t = p >> 1;
        if (lane == 0) { DEST[p] = dest; ROWW[dest] = TOKW[p]; }
        const v4u* s = (const v4u*)(H2 + (size_t)t * D); v4u* d = (v4u*)(XP + (size_t)dest * D);
        d[lane] = s[lane]; d[64 + lane] = s[64 + lane]; }
}
DI void combine_phase(const Frame& F, float* out) {
    const int gw = F.vcu * NWAVES + F.wave, NGW = F.G * NWAVES, lane = F.lane;
    const float* X1 = (const float*)(F.ws + WS_X1); const bf16* Y = (const bf16*)(F.ws + WS_Y); const int* DEST = (const int*)(F.ws + WS_DEST);
    for (int t = gw; t < T; t += NGW) { const int d0 = DEST[2 * t], d1 = DEST[2 * t + 1];
#pragma unroll
        for (int j = 0; j < 2; ++j) { const int c = 8 * lane + 512 * j;
            const f32x4 xa = *(const f32x4*)(X1 + (size_t)t * D + c), xb = *(const f32x4*)(X1 + (size_t)t * D + c + 4);
            const v4u a = *(const v4u*)(Y + (size_t)d0 * D + c), b = *(const v4u*)(Y + (size_t)d1 * D + c);
            f32x4 oa, ob;
            oa.x = xa.x + bflo(a.x) + bflo(b.x); oa.y = xa.y + bfhi(a.x) + bfhi(b.x); oa.z = xa.z + bflo(a.y) + bflo(b.y); oa.w = xa.w + bfhi(a.y) + bfhi(b.y);
            ob.x = xb.x + bflo(a.z) + bflo(b.z); ob.y = xb.y + bfhi(a.z) + bfhi(b.z); ob.z = xb.z + bflo(a.w) + bflo(b.w); ob.w = xb.w + bfhi(a.w) + bfhi(b.w);
            *(f32x4*)(out + (size_t)t * D + c) = oa; *(f32x4*)(out + (size_t)t * D + c + 4) = ob; } }
}

constexpr int PER_PHASE = 13;
struct Args { Ins I; float* out; unsigned char* ws; int ph_lo, ph_hi, li, pad; };
__global__ void __launch_bounds__(NTHR, 2) fwd_kernel(Args args) {
    extern __shared__ __attribute__((aligned(16))) unsigned char lds[];
    Frame F;
    F.lds = (LAS unsigned char*)lds;
    F.tid = threadIdx.x; F.lane = F.tid & 63; F.wave = __builtin_amdgcn_readfirstlane(F.tid >> 6);
    F.G = gridDim.x; { const int bx = blockIdx.x; F.vcu = (F.G % 8 == 0) ? (bx % 8) * (F.G / 8) + bx / 8 : bx; }
    F.ws = args.ws; F.dout = (unsigned char*)args.out;
    unsigned* ctl = (unsigned*)(args.ws + WS_CTL);
    volatile LAS unsigned* MISC = (volatile LAS unsigned*)(F.lds + MISC_OFF);
    for (int u = F.tid; u < (LDS_BYTES - LDSCTL_OFF) / 4; u += NTHR) ((LAS unsigned*)(F.lds + LDSCTL_OFF))[u] = 0u;
    __syncthreads();
    XcdBarrier bar; bar.bar = ctl + CW_BAR; bar.x = 0; bar.st = nullptr;
    if (MK_N_LAUNCHES == 1) bar = xcd_barrier_post(ctl + CW_BAR, MISC + 8);
    const int lo = args.ph_lo, hi = args.ph_hi;
#ifdef ONLY_PHASE
#define IN(k) ((k) == ONLY_PHASE && lo <= (k) && (k) < hi)
#else
#define IN(k) (lo <= (k) && (k) < hi)
#endif
#define SEAM(k) do { if (IN(k) && IN((k) + 1)) xcd_barrier(bar); } while (0)
#ifndef DUP_MASK
#define DUP_MASK 0
#endif
#define REPS(k) (((DUP_MASK >> (k)) & 1) ? 2 : 1)
    const Ins& I = args.I;
    unsigned char* ws = args.ws;

    if (IN(0)) { _Pragma("unroll 1") for (int rep = 0; rep < REPS(0); ++rep) { if (rep) xcd_barrier(bar); p0_prologue(F, I); } SEAM(0); }

    if (IN(1)) { _Pragma("unroll 1") for (int rep = 0; rep < REPS(1); ++rep) { if (rep) xcd_barrier(bar);
        pg8::GemmDesc g{1024, 1024, 1024};
        pg8::OrderStd S{T / 256, N1 / 256, F.G, (int)blockIdx.x, (const char*)(ws + WS_XN), (const char*)(ws + WS_W1T), (size_t)256 * 1024 * 2, (size_t)256 * 1024 * 2};
        pg8::EpiP1 E{ws, F.dout, I.in[4], I.in[6], I.in[7], (LAS float*)(F.lds + LDSCTL_OFF + 1024)};
        pg8::gemm_phase<pg8::EpiP1, pg8::OrderStd>(F.lds + RING_OFF, g, S, E);
}         SEAM(1);
    }
    if (IN(3)) {
        _Pragma("unroll 1") for (int rep = 0; rep < REPS(3); ++rep) { if (rep) xcd_barrier(bar);
        for (int it = F.vcu; it < 16 * NSEG; it += F.G) gla_pass1(F, it, rep + 1 < REPS(3)); }
        const int gw = F.vcu * NWAVES + F.wave, NGW = F.G * NWAVES;
        _Pragma("unroll 1") for (int rep = 0; rep < REPS(13); ++rep) { if (rep) xcd_barrier(bar);
        for (int j = gw; j < 3 * 4096; j += NGW) attn_job(F, j, rep + 1 < REPS(13)); }
        SEAM(3);
    }
    if (IN(4)) {
        _Pragma("unroll 1") for (int rep = 0; rep < REPS(4); ++rep) { if (rep) xcd_barrier(bar);
        for (int it = F.vcu; it < 16 * NSEG; it += F.G) gla_pass2(F, it, I.in[5], rep + 1 < REPS(4)); }
        _Pragma("unroll 1") for (int rep = 0; rep < REPS(14); ++rep) { if (rep) xcd_barrier(bar); attn_merge_phase(F, rep + 1 < REPS(14)); }
        SEAM(4);
    }
    if (IN(5)) { _Pragma("unroll 1") for (int rep = 0; rep < REPS(5); ++rep) { if (rep) xcd_barrier(bar);
        pg8::GemmDesc g{512, 512, 512};
        pg8::OrderProj2 S{T / 256, 4, F.G, (int)blockIdx.x, (const char*)(ws + WS_GLAV), (const char*)(ws + WS_DILQ), (const char*)(ws + WS_WPGT), (const char*)(ws + WS_WPAT), (size_t)256 * 512 * 2, (size_t)256 * 512 * 2};
        pg8::EpiY E{(bf16*)(ws + WS_GATES), 2048};
        pg8::gemm_phase<pg8::EpiY, pg8::OrderProj2>(F.lds + RING_OFF, g, S, E);
}         SEAM(5);
    }
    if (IN(6)) { _Pragma("unroll 1") for (int rep = 0; rep < REPS(6); ++rep) { if (rep) xcd_barrier(bar);
        pg8::GemmDesc g{1024, 1024, 1024};
        pg8::OrderStd S{T / 256, 2048 / 256, F.G, (int)blockIdx.x, (const char*)(ws + WS_XN), (const char*)(ws + WS_WBGT), (size_t)256 * 1024 * 2, (size_t)256 * 1024 * 2};
        pg8::EpiGateMerge E{(bf16*)(ws + WS_MERGED), (const bf16*)(ws + WS_GATES), I.in[11]};
        pg8::gemm_phase<pg8::EpiGateMerge, pg8::OrderStd>(F.lds + RING_OFF, g, S, E);
}         SEAM(6);
    }
    if (IN(7)) { _Pragma("unroll 1") for (int rep = 0; rep < REPS(7); ++rep) { if (rep) xcd_barrier(bar);
        pg8::GemmDesc g{1024, 1024, 1024};
        pg8::OrderStd S{T / 256, 4, F.G, (int)blockIdx.x, (const char*)(ws + WS_MERGED), (const char*)(ws + WS_WOUTT), (size_t)256 * 1024 * 2, (size_t)256 * 1024 * 2};
        pg8::EpiX1 E{(float*)(ws + WS_X1), I.in[0]};
        pg8::gemm_phase<pg8::EpiX1, pg8::OrderStd>(F.lds + RING_OFF, g, S, E);
}         SEAM(7);
    }
    if (IN(8)) { _Pragma("unroll 1") for (int rep = 0; rep < REPS(8); ++rep) { if (rep) xcd_barrier(bar); router_phase(F, I.in[13], I.in[15], I.in[17], ctl + CW_GCNT, rep + 1 < REPS(8)); } SEAM(8); }
    if (IN(9)) { _Pragma("unroll 1") for (int rep = 0; rep < REPS(9); ++rep) { if (rep) xcd_barrier(bar); moe_assign_phase(F, ctl + CW_GCNT); } SEAM(9); }
    if (IN(10)) { _Pragma("unroll 1") for (int rep = 0; rep < REPS(10); ++rep) { if (rep) xcd_barrier(bar);
        const int* BLKE = (const int*)(ws + WS_BLKE); const int nblk = BLKE[NBLK_MAX];
        pg8::GemmDesc g{1024, 1024, 1024};
        pg8::OrderMoe S{nblk, F.G, (int)blockIdx.x, BLKE, (const char*)(ws + WS_XP), (const char*)(F.dout + DO_EXPGU), (size_t)256 * 1024 * 2, (size_t)1024 * 1024 * 2, (size_t)256 * 1024 * 2};
        pg8::EpiGU E{(bf16*)(ws + WS_HBUF), (const float*)(ws + WS_ROWW)};
        pg8::gemm_phase<pg8::EpiGU, pg8::OrderMoe>(F.lds + RING_OFF, g, S, E);
}         SEAM(10);
    }
    if (IN(11)) { _Pragma("unroll 1") for (int rep = 0; rep < REPS(11); ++rep) { if (rep) xcd_barrier(bar);
        const int* BLKE = (const int*)(ws + WS_BLKE); const int nblk = BLKE[NBLK_MAX];
        pg8::GemmDesc g{512, 512, 512};
        pg8::OrderMoe S{nblk, F.G, (int)blockIdx.x, BLKE, (const char*)(ws + WS_HBUF), (const char*)(F.dout + DO_EXPDN), (size_t)256 * 512 * 2, (size_t)1024 * 512 * 2, (size_t)256 * 512 * 2};
        pg8::EpiY E{(bf16*)(ws + WS_Y), 1024};
        pg8::gemm_phase<pg8::EpiY, pg8::OrderMoe>(F.lds + RING_OFF, g, S, E);
}         SEAM(11);
    }
    if (IN(12)) { _Pragma("unroll 1") for (int rep = 0; rep < REPS(12); ++rep) { if (rep) xcd_barrier(bar); combine_phase(F, args.out); } }
#undef IN
#undef SEAM
}

extern "C" void kernel_launch(void* const* d_in, const int* in_sizes, int n_in, void* d_out, int out_size, void* d_ws, size_t ws_size, hipStream_t stream) {
    static int grid = 0;
    if (grid == 0) {
        if (n_in != 21 || out_size != T * D || ws_size < WS_END) { fprintf(stderr, "kernel_launch: unexpected shapes (n_in %d out %d ws %zu)\n", n_in, out_size, ws_size); grid = -1; return; }
        int dev = 0, cus = 0, per_cu = 0;
        if (hipGetDevice(&dev) != hipSuccess || hipDeviceGetAttribute(&cus, hipDeviceAttributeMultiprocessorCount, dev) != hipSuccess) { grid = -1; return; }
        if (hipFuncSetAttribute((const void*)fwd_kernel, hipFuncAttributeMaxDynamicSharedMemorySize, LDS_BYTES) != hipSuccess) { fprintf(stderr, "kernel_launch: hipFuncSetAttribute failed\n"); grid = -1; return; }
        if (hipOccupancyMaxActiveBlocksPerMultiprocessor(&per_cu, (const void*)fwd_kernel, NTHR, LDS_BYTES) != hipSuccess || per_cu < 1) fprintf(stderr, "kernel_launch: occupancy query reports %d\n", per_cu);
        (void)hipGetLastError();
        grid = cus;
    }
    if (grid < 0) return;
    if (hipMemsetAsync((char*)d_ws + WS_CTL, 0, CTL_ZERO_BYTES, stream) != hipSuccess) return;
    Args a{};
    for (int i = 0; i < 21; ++i) a.I.in[i] = (const float*)d_in[i];
    a.out = (float*)d_out; a.ws = (unsigned char*)d_ws;
    if (MK_N_LAUNCHES == 1) { a.ph_lo = 0; a.ph_hi = PER_PHASE; a.li = 0; hipLaunchKernelGGL(fwd_kernel, dim3(grid), dim3(NTHR), LDS_BYTES, stream, a); }
    else for (int li = 0; li < PER_PHASE; ++li) { a.ph_lo = li; a.ph_hi = li + 1; a.li = li; hipLaunchKernelGGL(fwd_kernel, dim3(grid), dim3(NTHR), LDS_BYTES, stream, a); }
}
```

```cpp
#include <hip/hip_runtime.h>
#include <cstdio>
#include <cstdint>

#ifndef MK_N_LAUNCHES
#define MK_N_LAUNCHES 1
#endif

#define GAS __attribute__((address_space(1)))
#define LAS __attribute__((address_space(3)))
typedef unsigned short bf16;
typedef unsigned v4u __attribute__((ext_vector_type(4)));
typedef unsigned v2u __attribute__((ext_vector_type(2)));
typedef float f32x2 __attribute__((ext_vector_type(2)));
typedef float f32x4 __attribute__((ext_vector_type(4)));
typedef float f32x16 __attribute__((ext_vector_type(16)));
typedef short bf16x8 __attribute__((ext_vector_type(8)));
typedef short bf16x4 __attribute__((ext_vector_type(4)));
typedef __bf16 hbf2 __attribute__((ext_vector_type(2)));

#define DI __device__ __forceinline__
DI unsigned pk2(float lo, float hi) { f32x2 v = {lo, hi}; hbf2 r = __builtin_convertvector(v, hbf2); return __builtin_bit_cast(unsigned, r); }
DI bf16 f2bf(float f) { return (bf16)(pk2(f, 0.f) & 0xffffu); }
DI float bf2f(bf16 b) { return __builtin_bit_cast(float, ((unsigned)b) << 16); }
DI float bflo(unsigned u) { return __builtin_bit_cast(float, u << 16); }
DI float bfhi(unsigned u) { return __builtin_bit_cast(float, u & 0xffff0000u); }

constexpr int T = 32768, D = 1024, SEQ = 8192;
constexpr int N1 = 7168;
constexpr int IN_COLS = 6672;
constexpr int NSEG = 16, TSEG = SEQ / NSEG;
constexpr float EPS = 1e-6f;
constexpr float LOG2E = 1.4426950408889634f;
constexpr int PMAX = 65536 + 32 * 256;
constexpr int NBLK_MAX = PMAX / 256;

constexpr size_t MiB = 1u << 20;
constexpr size_t WS_CTL = 0, CTL_ZERO_BYTES = 256 * 1024;
constexpr size_t WS_LB = 1 * MiB;
constexpr size_t WS_W1T = 1 * MiB;
constexpr size_t WS_WBGT = 15 * MiB, WS_WPGT = 19 * MiB, WS_WPAT = 20 * MiB, WS_WOUTT = 21 * MiB, WS_WRH = 23 * MiB;
constexpr size_t WS_XN = 24 * MiB;
constexpr size_t WS_GLAQ = 88 * MiB, WS_GLAK = 120 * MiB, WS_LOGA = 152 * MiB, WS_GLAV = 184 * MiB;
constexpr size_t WS_DILQ = 216 * MiB, WS_DILK = 312 * MiB, WS_DILV = 408 * MiB;
constexpr size_t WS_STATS = 504 * MiB;
constexpr size_t WS_LSE = WS_STATS;
constexpr size_t WS_DSEG = WS_STATS + 1536 * 1024;
constexpr size_t WS_TOKE = WS_STATS + 2 * MiB;
constexpr size_t WS_TOKW = WS_TOKE + 256 * 1024;
constexpr size_t WS_TOKR = WS_TOKW + 256 * 1024;
constexpr size_t WS_DEST = WS_TOKR + 256 * 1024;
constexpr size_t WS_ROWW = WS_DEST + 256 * 1024;
constexpr size_t WS_BLKE = WS_ROWW + 320 * 1024;
constexpr size_t WS_END = 512 * MiB;
constexpr size_t WS_GATES = 376 * MiB;
constexpr size_t WS_MERGED = 312 * MiB;
constexpr size_t WS_X1 = 88 * MiB;
constexpr size_t WS_H2 = 24 * MiB;
constexpr size_t WS_XP = 216 * MiB;
constexpr size_t WS_HBUF = 360 * MiB;
constexpr size_t WS_Y = 216 * MiB;
constexpr size_t DO_R = 0;
constexpr size_t DO_EXPGU = 32 * MiB;
constexpr size_t DO_EXPDN = 96 * MiB;
constexpr int CW_BAR = 4096;
constexpr int CW_GCNT = 16384;

constexpr int RING_OFF = 0, RING_BYTES = 131072;
constexpr int LDSCTL_OFF = RING_BYTES, MISC_OFF = LDSCTL_OFF + 320;
constexpr int LDS_BYTES = 147456;

#define XB_TMO      128
#define XB_XCNT(j)  (256  + 64 * (j))
#define XB_XSUB(j)  (1280 + 64 * (j))
#define XB_XGEN(j)  (2304 + 64 * (j))
#define XB_TOP      3328
#define XB_TOPGEN   3392
#define XCD_BAR_WORDS 3456
#define XB_SPIN_CAP (1u << 18)
DI unsigned xb_ld(unsigned* p)              { return __hip_atomic_load(p, __ATOMIC_RELAXED, __HIP_MEMORY_SCOPE_AGENT); }
DI unsigned xb_add(unsigned* p, unsigned v) { return __hip_atomic_fetch_add(p, v, __ATOMIC_RELAXED, __HIP_MEMORY_SCOPE_AGENT); }
DI unsigned xb_xcc_id() { return (unsigned)__builtin_amdgcn_s_getreg((3 << 11) | 20) & 0xFu; }
#define XB_SPIN(cond, bar) do { unsigned _sp = 0; while (cond) { __builtin_amdgcn_s_sleep(1); \
    if ((++_sp & 255u) == 0u) { if (xb_ld(&(bar)[XB_TMO])) break; if (_sp > XB_SPIN_CAP) { atomicAdd(&(bar)[XB_TMO], 1u); break; } } } } while (0)
struct XcdBarrier { unsigned* bar; unsigned x; volatile LAS unsigned* st; };
DI XcdBarrier xcd_barrier_post(unsigned* bar, volatile LAS unsigned* st) {
    XcdBarrier b; b.bar = bar; b.x = xb_xcc_id(); b.st = st;
    if (threadIdx.x == 0) (void)xb_add(&bar[XB_XCNT(b.x)], 1u);
    return b;
}
DI void xcd_barrier_complete(unsigned* bar, unsigned x, unsigned& nloc, unsigned& nx) {
    const unsigned G = gridDim.x * gridDim.y * gridDim.z;
    unsigned sum, cnt, mine, sp = 0u;
    for (;;) {
        sum = 0u; cnt = 0u; mine = 0u;
#pragma unroll
        for (unsigned j = 0; j < 16; ++j) { const unsigned c = xb_ld(&bar[XB_XCNT(j)]); sum += c; cnt += (c > 0u) ? 1u : 0u; mine = (j == x) ? c : mine; }
        if (sum == G) break;
        __builtin_amdgcn_s_sleep(1);
        if ((++sp & 255u) == 0u) { if (xb_ld(&bar[XB_TMO])) break; if (sp > XB_SPIN_CAP) { atomicAdd(&bar[XB_TMO], 1u); break; } }
    }
    nloc = mine > 0u ? mine : 1u; nx = cnt > 0u ? cnt : 1u;
}
DI void xcd_barrier(const XcdBarrier& b) {
    asm volatile("s_waitcnt vmcnt(0)" ::: "memory");
    __syncthreads();
    if (threadIdx.x == 0) {
        unsigned* bar = b.bar;
        __builtin_amdgcn_s_waitcnt(0);
        unsigned nloc = b.st[0], nx = b.st[1];
        if (nloc == 0u) { xcd_barrier_complete(bar, b.x, nloc, nx); b.st[0] = nloc; b.st[1] = nx; }
        const unsigned old = xb_add(&bar[XB_XSUB(b.x)], 1u);
        const unsigned gen = old / nloc;
        if (old + 1u == (gen + 1u) * nloc) {
            __builtin_amdgcn_fence(__ATOMIC_RELEASE, "agent");
            asm volatile("s_waitcnt vmcnt(0)" ::: "memory");
            const unsigned og = xb_add(&bar[XB_TOP], 1u);
            const unsigned tg = og / nx;
            if (og + 1u == (tg + 1u) * nx) xb_add(&bar[XB_TOPGEN], 1u);
            else XB_SPIN(xb_ld(&bar[XB_TOPGEN]) == tg, bar);
            __builtin_amdgcn_fence(__ATOMIC_ACQUIRE, "agent");
            xb_add(&bar[XB_XGEN(b.x)], 1u);
            asm volatile("s_waitcnt vmcnt(0)" ::: "memory");
        } else {
            XB_SPIN(xb_ld(&bar[XB_XGEN(b.x)]) == gen, bar);
            __builtin_amdgcn_fence(__ATOMIC_ACQUIRE, "agent");
            asm volatile("s_waitcnt vmcnt(0)" ::: "memory");
        }
    }
    __syncthreads();
}

namespace pg8 {
constexpr int BM = 256, BK = 64, HALF = 128, HTB = HALF * BK * 2, STAGE_BYTES = 8 * HTB, NXCD = 8, WGM = 8;
__host__ __device__ __forceinline__ int lds_byte(int r, int c) { const int st = (r >> 4) * 2 + (c >> 5), rr = r & 15, cc = c & 31, ob = rr * 64 + cc * 2; return st * 1024 + (ob ^ (((ob >> 9) & 1) << 5)); }
__host__ __device__ __forceinline__ void stage_rc(int b, int& R, int& C) { const int st = b / 1024, sb = b % 1024, swz = sb ^ (((sb >> 9) & 1) << 5); R = (st >> 1) * 16 + swz / 64; C = (st & 1) * 32 + (swz % 64) / 2; }
__host__ __device__ __forceinline__ int perm32(int rho) { const int n = rho >> 4, i = rho & 15; return 8 * (i >> 2) + 4 * n + (i & 3); }

struct Unit { const char* A; const char* B; int pm, pn, aux; };
struct GemmDesc { int lda, ldb, K; };

DI bool static_tile(int L, int nM, int nN, int& pm, int& pn) {
    const int nwg = nM * nN; if (L >= nwg) return false;
    int wgid = L; { const int q = nwg / NXCD, r = nwg % NXCD, xcd = wgid % NXCD, off = wgid / NXCD; wgid = (xcd < r ? xcd * (q + 1) : r * (q + 1) + (xcd - r) * q) + off; }
    const int nig = WGM * nN, gid = wgid / nig, fm = gid * WGM, gsz = (nM - fm) < WGM ? (nM - fm) : WGM;
    pm = fm + ((wgid % nig) % gsz); pn = (wgid % nig) / gsz; return true;
}
struct OrderStd {
    int nM, nN, G, c; const char* A0; const char* B0; size_t sA, sB;
    DI bool next(int i, Unit& u) const {
        int pm, pn; if (!static_tile(i * G + c, nM, nN, pm, pn)) return false;
        u.pm = pm; u.pn = pn; u.aux = 0; u.A = A0 + (size_t)pm * sA; u.B = B0 + (size_t)pn * sB; return true;
    }
};
struct OrderPair {
    int nM, nN, G, c; const char* A0; const char* A1; const char* B0; const char* B1; size_t sA, sB;
    DI bool next(int i, Unit& u) const {
        int pm, pn; if (!static_tile((i >> 1) * G + c, nM, nN, pm, pn)) return false;
        const int br = i & 1; u.pm = pm; u.pn = pn; u.aux = br; u.A = (br ? A1 : A0) + (size_t)pm * sA; u.B = (br ? B1 : B0) + (size_t)pn * sB; return true;
    }
};
struct OrderProj2 {
    int nM, nh, G, c; const char* A0; const char* A1; const char* B0; const char* B1; size_t sA, sB;
    DI bool next(int i, Unit& u) const {
        int pm, pn; if (!static_tile(i * G + c, nM, 2 * nh, pm, pn)) return false;
        const int br = pn >= nh; u.pm = pm; u.pn = pn; u.aux = br; u.A = (br ? A1 : A0) + (size_t)pm * sA; u.B = (br ? B1 : B0) + (size_t)(pn - br * nh) * sB; return true;
    }
};
struct OrderMoe {
    int nblk, G, c; const int* blke; const char* A0; const char* B0; size_t sA, sE, sB;
    DI bool next(int i, Unit& u) const {
        int rb, pn;
        if ((G & 31) == 0) { const int R = G >> 2, per = R >> 3, loc = c >> 3; rb = i * R + (c & 7) * per + (loc >> 2); pn = loc & 3; }
        else { const int L = i * G + c; rb = L >> 2; pn = L & 3; }
        if (rb >= nblk) return false;
        const int e = blke[rb];
        u.pm = rb; u.pn = pn; u.aux = 0;
        u.A = A0 + (size_t)rb * sA; u.B = B0 + (size_t)e * sE + (size_t)pn * sB; return true;
    }
};

#define PG8_LAS __attribute__((address_space(3)))
template <class Epi, class Sched, bool ALIGN_EPI = true, bool SP2 = true>
DI void gemm_phase(PG8_LAS unsigned char* lds, const GemmDesc g, const Sched& S, const Epi& E) {
    const int tid = threadIdx.x, wid = __builtin_amdgcn_readfirstlane(tid >> 6), lane = tid & 63, wr = wid >> 2, wc = wid & 3, fr = lane & 15, fq = lane >> 4;
    const int K = g.K, nt = K / BK;
    unsigned voffA[2], voffB[2];
#pragma unroll
    for (int i = 0; i < 2; ++i) { int R, C; stage_rc(tid * 16 + i * 8192, R, C); const int Rb = Epi::PERM ? ((R & ~31) + perm32(R & 31)) : R;
        voffA[i] = (unsigned)(R * g.lda + C) * 2u; voffB[i] = (unsigned)(Rb * g.ldb + C) * 2u; }
    const size_t kstep = (size_t)(BK * 2);
    const size_t hstepA = (size_t)HALF * g.lda * 2, hstepB = (size_t)HALF * g.ldb * 2;
    const unsigned ldsw = (unsigned)wid * 1024u;
    const int aoff = lds_byte(wr * 64 + fr, fq * 8), boff = lds_byte(wc * 32 + fr, fq * 8);
#define PG8_SA(b, h) (((b) * 2 + (h)) * HTB)
#define PG8_SB(b, h) ((4 + (b) * 2 + (h)) * HTB)
#define PG8_STAGE(bufoff, gbase, voff) do { _Pragma("unroll") for (int _i = 0; _i < 2; ++_i) \
        __builtin_amdgcn_global_load_lds((const unsigned*)((const char*)(gbase) + (voff)[_i]), (PG8_LAS unsigned*)(lds + (bufoff) + ldsw + _i * 8192), 16, 0, 0); } while (0)
#define PG8_LDA(dst, b, h) do { _Pragma("unroll") for (int m = 0; m < 4; ++m) _Pragma("unroll") for (int k = 0; k < 2; ++k) dst[m][k] = *(const PG8_LAS bf16x8*)(lds + PG8_SA(b, h) + aoff + m * 2048 + k * 1024); } while (0)
#define PG8_LDB(dst, b, h) do { _Pragma("unroll") for (int n = 0; n < 2; ++n) _Pragma("unroll") for (int k = 0; k < 2; ++k) dst[n][k] = *(const PG8_LAS bf16x8*)(lds + PG8_SB(b, h) + boff + n * 2048 + k * 1024); } while (0)
#define PG8_MMA(ai, bj, At, Bt) do { __builtin_amdgcn_s_setprio(1); _Pragma("unroll") for (int m = 0; m < 4; ++m) _Pragma("unroll") for (int n = 0; n < 2; ++n) _Pragma("unroll") for (int k = 0; k < 2; ++k) \
        acc[ai][bj][m][n] = __builtin_amdgcn_mfma_f32_16x16x32_bf16(Bt[n][k], At[m][k], acc[ai][bj][m][n], 0, 0, 0); __builtin_amdgcn_s_setprio(0); } while (0)
#define PG8_WAIT_V(n) asm volatile("s_waitcnt vmcnt(" #n ")" ::: "memory")
#define PG8_WAIT_L(n) asm volatile("s_waitcnt lgkmcnt(" #n ")" ::: "memory")
#define PG8_BAR __builtin_amdgcn_s_barrier()
#define PG8_SCHED __builtin_amdgcn_sched_barrier(0)
    Unit cur, nxt; int ui = 0;
    if (!S.next(0, cur)) return;
    f32x4 acc[2][2][4][2];
#pragma unroll
    for (int a = 0; a < 2; ++a)
#pragma unroll
        for (int b = 0; b < 2; ++b)
#pragma unroll
            for (int m = 0; m < 4; ++m)
#pragma unroll
                for (int n = 0; n < 2; ++n) acc[a][b][m][n] = (f32x4){0.f, 0.f, 0.f, 0.f};
    bf16x8 At[4][2], B0[2][2], B1[2][2];
    const char* cA = cur.A; const char* cB = cur.B;
    if constexpr (SP2) {
        PG8_STAGE(PG8_SB(0, 0), cB, voffB); PG8_STAGE(PG8_SB(0, 1), cB + hstepB, voffB); PG8_STAGE(PG8_SA(0, 0), cA, voffA); PG8_STAGE(PG8_SA(0, 1), cA + hstepA, voffA);
        if (wr == 1) PG8_BAR;
        PG8_WAIT_V(2); PG8_BAR;
        PG8_STAGE(PG8_SB(1, 0), cB + kstep, voffB); PG8_STAGE(PG8_SA(1, 0), cA + kstep, voffA); PG8_STAGE(PG8_SB(1, 1), cB + hstepB + kstep, voffB);
        PG8_WAIT_V(6); PG8_BAR;
    } else {
        PG8_STAGE(PG8_SB(0, 0), cB, voffB); PG8_STAGE(PG8_SA(0, 0), cA, voffA); PG8_STAGE(PG8_SB(0, 1), cB + hstepB, voffB); PG8_STAGE(PG8_SA(0, 1), cA + hstepA, voffA);
        if (wr == 1) PG8_BAR;
        PG8_WAIT_V(4); PG8_BAR;
        PG8_STAGE(PG8_SB(1, 0), cB + kstep, voffB); PG8_STAGE(PG8_SA(1, 0), cA + kstep, voffA); PG8_STAGE(PG8_SB(1, 1), cB + hstepB + kstep, voffB);
        PG8_WAIT_V(6); PG8_BAR;
    }
    for (;;) {
        const bool has_next = S.next(ui + 1, nxt);
        const char* nA = has_next ? nxt.A : cA; const char* nB = has_next ? nxt.B : cB;
        for (int t = 0; t < nt; t += 2) {
            const bool last = (t == nt - 2);
            const char* a1 = cA + (size_t)(t + 1) * kstep;
            const char* a2 = last ? nA : cA + (size_t)(t + 2) * kstep; const char* b2 = last ? nB : cB + (size_t)(t + 2) * kstep;
            const char* a3 = a2 + kstep; const char* b3 = b2 + kstep;
            if constexpr (SP2) {
            PG8_LDB(B0, 0, 0); PG8_LDB(B1, 0, 1); PG8_SCHED; PG8_LDA(At, 0, 0); PG8_STAGE(PG8_SA(1, 1), a1 + hstepA, voffA);
            PG8_WAIT_V(8); PG8_WAIT_L(0); PG8_BAR; PG8_MMA(0, 0, At, B0); PG8_MMA(0, 1, At, B1); PG8_BAR; PG8_SCHED;
            PG8_LDA(At, 0, 1); PG8_STAGE(PG8_SB(0, 0), b2, voffB); PG8_STAGE(PG8_SB(0, 1), b2 + hstepB, voffB); PG8_STAGE(PG8_SA(0, 0), a2, voffA);
            PG8_WAIT_V(8); PG8_WAIT_L(0); PG8_BAR; PG8_MMA(1, 0, At, B0); PG8_MMA(1, 1, At, B1); PG8_BAR; PG8_SCHED;
            PG8_LDB(B0, 1, 0); PG8_LDB(B1, 1, 1); PG8_SCHED; PG8_LDA(At, 1, 0); PG8_STAGE(PG8_SA(0, 1), a2 + hstepA, voffA);
            PG8_WAIT_V(8); PG8_WAIT_L(0); PG8_BAR; PG8_MMA(0, 0, At, B0); PG8_MMA(0, 1, At, B1); PG8_BAR; PG8_SCHED;
            PG8_LDA(At, 1, 1); PG8_STAGE(PG8_SB(1, 0), b3, voffB); PG8_STAGE(PG8_SB(1, 1), b3 + hstepB, voffB); PG8_STAGE(PG8_SA(1, 0), a3, voffA);
            PG8_WAIT_V(8); PG8_WAIT_L(0); PG8_BAR; PG8_MMA(1, 0, At, B0); PG8_MMA(1, 1, At, B1); PG8_BAR; PG8_SCHED;
            } else {
            PG8_LDB(B0, 0, 0); PG8_SCHED; PG8_LDA(At, 0, 0); PG8_STAGE(PG8_SA(1, 1), a1 + hstepA, voffA);
            PG8_WAIT_L(8); PG8_BAR; PG8_WAIT_L(0); PG8_MMA(0, 0, At, B0); PG8_BAR; PG8_SCHED;
            PG8_LDB(B1, 0, 1); PG8_STAGE(PG8_SB(0, 0), b2, voffB);
            PG8_BAR; PG8_WAIT_L(0); PG8_MMA(0, 1, At, B1); PG8_BAR;
            PG8_LDA(At, 0, 1); PG8_STAGE(PG8_SA(0, 0), a2, voffA);
            PG8_BAR; PG8_WAIT_L(0); PG8_MMA(1, 0, At, B0); PG8_BAR; PG8_SCHED;
            PG8_STAGE(PG8_SB(0, 1), b2 + hstepB, voffB);
            PG8_WAIT_V(6); PG8_BAR; PG8_MMA(1, 1, At, B1); PG8_BAR;
            PG8_LDB(B0, 1, 0); PG8_SCHED; PG8_LDA(At, 1, 0); PG8_STAGE(PG8_SA(0, 1), a2 + hstepA, voffA);
            PG8_WAIT_L(8); PG8_BAR; PG8_WAIT_L(0); PG8_MMA(0, 0, At, B0); PG8_BAR; PG8_SCHED;
            PG8_LDB(B1, 1, 1); PG8_STAGE(PG8_SB(1, 0), b3, voffB);
            PG8_BAR; PG8_WAIT_L(0); PG8_MMA(0, 1, At, B1); PG8_BAR;
            PG8_LDA(At, 1, 1); PG8_STAGE(PG8_SA(1, 0), a3, voffA);
            PG8_BAR; PG8_WAIT_L(0); PG8_MMA(1, 0, At, B0); PG8_BAR; PG8_SCHED;
            PG8_STAGE(PG8_SB(1, 1), b3 + hstepB, voffB);
            PG8_WAIT_V(6); PG8_BAR; PG8_MMA(1, 1, At, B1); PG8_BAR;
            }
        }
        if constexpr (ALIGN_EPI) { if (wr == 0) PG8_BAR; }
        E(acc, cur, wr, wc, fr, fq);
        if (!has_next) break;
#pragma unroll
        for (int a = 0; a < 2; ++a)
#pragma unroll
            for (int b = 0; b < 2; ++b)
#pragma unroll
                for (int m = 0; m < 4; ++m)
#pragma unroll
                    for (int n = 0; n < 2; ++n) acc[a][b][m][n] = (f32x4){0.f, 0.f, 0.f, 0.f};
        cur = nxt; cA = nA; cB = nB; ++ui;
        if constexpr (ALIGN_EPI) { if (wr == 1) PG8_BAR; }
    }
    PG8_WAIT_V(0);
    if constexpr (!ALIGN_EPI) { if (wr == 0) PG8_BAR; }
    PG8_BAR;
#undef PG8_SA
#undef PG8_SB
#undef PG8_STAGE
#undef PG8_LDA
#undef PG8_LDB
#undef PG8_MMA
#undef PG8_WAIT_V
#undef PG8_WAIT_L
#undef PG8_BAR
#undef PG8_SCHED
}

typedef f32x4 AccT[2][2][4][2];
DI float silu_f(float v) { return v / (1.f + __expf(-v)); }
DI float sigmoid_f(float v) { return 1.f / (1.f + __expf(-v)); }
DI float logsig16(float v) { return (fminf(v, 0.f) - __logf(1.f + __expf(-fabsf(v)))) * 0.0625f; }
DI v4u pack8(f32x4 a, f32x4 b) { v4u w; w.x = pk2(a[0], a[1]); w.y = pk2(a[2], a[3]); w.z = pk2(b[0], b[1]); w.w = pk2(b[2], b[3]); return w; }

struct EpiP1 {
    static constexpr bool PERM = true;
    unsigned char* ws; unsigned char* dout; const float* b_a; const float* gq; const float* gk; LAS float* xch;
    DI void operator()(const AccT& acc, const Unit& u, int wr, int wc, int fr, int fq) const {
        const int pn = u.pn, row0 = u.pm * BM + wr * 64 + fr, cl = wc * 32 + 8 * fq;
        const int rem = pn >= 10 ? (pn - 10) % 6 : 6, gi = pn >= 10 ? (pn - 10) / 6 : 0;
        int mode = 0; const int colbase = (pn & 1) * 256; size_t off;
        if (pn < 10) { const int bi = pn >> 1; off = bi == 0 ? WS_GLAQ : (bi == 1 ? WS_GLAK : (bi == 2 ? WS_GLAV : (bi == 3 ? DO_R : WS_LOGA))); mode = bi == 3 ? 1 : (bi == 4 ? 2 : 0); }
        else { off = (rem < 2 ? WS_DILQ : (rem < 4 ? WS_DILK : WS_DILV)) + (size_t)gi * T * 1024; mode = rem < 4 ? 3 : 0; }
        bf16* dst = (bf16*)(((pn >> 1) == 3 ? dout : ws) + off);
        if (mode == 3) {
            const bool isq = rem < 2;
#pragma unroll
            for (int ai = 0; ai < 2; ++ai)
#pragma unroll
                for (int m = 0; m < 4; ++m)
#pragma unroll
                    for (int bj = 0; bj < 2; ++bj) { const f32x4 v0 = acc[ai][bj][m][0], v1 = acc[ai][bj][m][1];
                        float ss = (v0[0] * v0[0] + v0[1] * v0[1]) + (v0[2] * v0[2] + v0[3] * v0[3]) + (v1[0] * v1[0] + v1[1] * v1[1]) + (v1[2] * v1[2] + v1[3] * v1[3]);
                        ss += __shfl_xor(ss, 16); ss += __shfl_xor(ss, 32);
                        if (fq == 0) xch[(ai * 128 + wr * 64 + m * 16 + fr) * 8 + bj * 4 + wc] = ss; }
            asm volatile("s_waitcnt lgkmcnt(0)" ::: "memory"); __builtin_amdgcn_s_barrier(); asm volatile("" ::: "memory");
            const float* gp = (isq ? gq : gk) + gi * 128 + cl; const f32x4 g0 = *(const f32x4*)gp, g1 = *(const f32x4*)(gp + 4);
            const float qs = isq ? 0.08838834764831845f * LOG2E : 1.f;
#pragma unroll
            for (int ai = 0; ai < 2; ++ai)
#pragma unroll
                for (int m = 0; m < 4; ++m) { bf16* rowp = dst + (size_t)(row0 + ai * HALF + m * 16) * 512 + colbase + cl;
#pragma unroll
                    for (int bj = 0; bj < 2; ++bj) { const f32x4 t = *(const LAS f32x4*)(xch + (ai * 128 + wr * 64 + m * 16 + fr) * 8 + bj * 4);
                        const float rinv = __frsqrt_rn(((t[0] + t[1]) + (t[2] + t[3])) * (1.f / 128.f) + EPS) * qs;
                        *(v4u*)(rowp + bj * HALF) = pack8(acc[ai][bj][m][0] * rinv * g0, acc[ai][bj][m][1] * rinv * g1); } }
            return;
        }
        f32x4 bv[2][2];
#pragma unroll
        for (int bj = 0; bj < 2; ++bj)
#pragma unroll
            for (int n = 0; n < 2; ++n) bv[bj][n] = (mode == 2) ? *(const f32x4*)(b_a + colbase + bj * HALF + cl + 4 * n) : (f32x4){0.f, 0.f, 0.f, 0.f};
#pragma unroll
        for (int ai = 0; ai < 2; ++ai)
#pragma unroll
            for (int m = 0; m < 4; ++m) { bf16* rowp = dst + (size_t)(row0 + ai * HALF + m * 16) * 512 + colbase + cl;
#pragma unroll
                for (int bj = 0; bj < 2; ++bj) { f32x4 v0 = acc[ai][bj][m][0] + bv[bj][0], v1 = acc[ai][bj][m][1] + bv[bj][1];
                    if (mode == 1) {
#pragma unroll
                        for (int j = 0; j < 4; ++j) { v0[j] = silu_f(v0[j]); v1[j] = silu_f(v1[j]); } }
                    if (mode == 2) {
#pragma unroll
                        for (int j = 0; j < 4; ++j) { v0[j] = logsig16(v0[j]); v1[j] = logsig16(v1[j]); } }
                    *(v4u*)(rowp + bj * HALF) = pack8(v0, v1); } }
    }
};
struct EpiGateMerge {
    static constexpr bool PERM = true;
    bf16* Mg; const bf16* Y; const float* bias;
    DI void operator()(const AccT& acc, const Unit& u, int wr, int wc, int fr, int fq) const {
        const int row0 = u.pm * BM + wr * 64 + fr, col0 = u.pn * HALF + wc * 32 + 8 * fq;
        f32x4 bv[2][2];
#pragma unroll
        for (int bj = 0; bj < 2; ++bj)
#pragma unroll
            for (int n = 0; n < 2; ++n) bv[bj][n] = *(const f32x4*)(bias + bj * 1024 + col0 + 4 * n);
#pragma unroll
        for (int ai = 0; ai < 2; ++ai)
#pragma unroll
            for (int m = 0; m < 4; ++m) { const size_t row = (size_t)(row0 + ai * HALF + m * 16);
                const v4u yg = *(const v4u*)(Y + row * 2048 + col0), ya = *(const v4u*)(Y + row * 2048 + 1024 + col0);
                f32x4 g0 = acc[ai][0][m][0] + bv[0][0], g1 = acc[ai][0][m][1] + bv[0][1], a0 = acc[ai][1][m][0] + bv[1][0], a1 = acc[ai][1][m][1] + bv[1][1];
#pragma unroll
                for (int j = 0; j < 4; ++j) { g0[j] = sigmoid_f(g0[j]); g1[j] = sigmoid_f(g1[j]); a0[j] = sigmoid_f(a0[j]); a1[j] = sigmoid_f(a1[j]); }
                f32x4 o0, o1;
                o0[0] = g0[0] * bflo(yg.x) + a0[0] * bflo(ya.x); o0[1] = g0[1] * bfhi(yg.x) + a0[1] * bfhi(ya.x); o0[2] = g0[2] * bflo(yg.y) + a0[2] * bflo(ya.y); o0[3] = g0[3] * bfhi(yg.y) + a0[3] * bfhi(ya.y);
                o1[0] = g1[0] * bflo(yg.z) + a1[0] * bflo(ya.z); o1[1] = g1[1] * bfhi(yg.z) + a1[1] * bfhi(ya.z); o1[2] = g1[2] * bflo(yg.w) + a1[2] * bflo(ya.w); o1[3] = g1[3] * bfhi(yg.w) + a1[3] * bfhi(ya.w);
                *(v4u*)(Mg + row * 1024 + col0) = pack8(o0, o1); }
    }
};
struct EpiX1 {
    static constexpr bool PERM = false;
    float* X1; const float* X;
    DI void operator()(const AccT& acc, const Unit& u, int wr, int wc, int fr, int fq) const {
        const int row0 = u.pm * BM + wr * 64 + fr, col0 = u.pn * BM + wc * 32 + 4 * fq;
#pragma unroll
        for (int ai = 0; ai < 2; ++ai)
#pragma unroll
            for (int m = 0; m < 4; ++m) { const size_t ro = (size_t)(row0 + ai * HALF + m * 16) * 1024 + col0;
#pragma unroll
                for (int bj = 0; bj < 2; ++bj)
#pragma unroll
                    for (int n = 0; n < 2; ++n) *(f32x4*)(X1 + ro + bj * HALF + n * 16) = acc[ai][bj][m][n] + *(const f32x4*)(X + ro + bj * HALF + n * 16); }
    }
};
struct EpiGU {
    static constexpr bool PERM = true;
    bf16* H; const float* roww;
    DI void operator()(const AccT& acc, const Unit& u, int wr, int wc, int fr, int fq) const {
        const int row0 = u.pm * BM + wr * 64 + fr, hc0 = u.pn * 128 + wc * 16 + 4 * fq;
#pragma unroll
        for (int ai = 0; ai < 2; ++ai)
#pragma unroll
            for (int m = 0; m < 4; ++m) { const int row = row0 + ai * HALF + m * 16; const float w = roww[row];
#pragma unroll
                for (int bj = 0; bj < 2; ++bj) { const f32x4 g = acc[ai][bj][m][0], up = acc[ai][bj][m][1];
                    v2u o; o.x = pk2(w * silu_f(g[0]) * up[0], w * silu_f(g[1]) * up[1]); o.y = pk2(w * silu_f(g[2]) * up[2], w * silu_f(g[3]) * up[3]);
                    *(v2u*)(H + (size_t)row * 512 + hc0 + bj * 64) = o; } }
    }
};
struct EpiY {
    static constexpr bool PERM = true;
    bf16* Y; int ld;
    DI void operator()(const AccT& acc, const Unit& u, int wr, int wc, int fr, int fq) const {
        const int row0 = u.pm * BM + wr * 64 + fr, col0 = u.pn * BM + wc * 32 + 8 * fq;
#pragma unroll
        for (int ai = 0; ai < 2; ++ai)
#pragma unroll
            for (int m = 0; m < 4; ++m) { bf16* rowp = Y + (size_t)(row0 + ai * HALF + m * 16) * ld + col0;
#pragma unroll
                for (int bj = 0; bj < 2; ++bj) *(v4u*)(rowp + bj * HALF) = pack8(acc[ai][bj][m][0], acc[ai][bj][m][1]); }
    }
};
}

constexpr int NWAVES = 8, NTHR = 512;
struct Frame {
    LAS unsigned char* lds;
    int tid, lane, wave, vcu, G;
    unsigned char* ws; unsigned char* dout;
};
#define LDS_WAIT() asm volatile("s_waitcnt lgkmcnt(0)" ::: "memory")
#define LDS_BARRIER() do { asm volatile("s_waitcnt lgkmcnt(0)" ::: "memory"); __builtin_amdgcn_s_barrier(); asm volatile("" ::: "memory"); } while (0)
DI float wave_sum(float v) {
#pragma unroll
    for (int o = 1; o < 64; o <<= 1) v += __shfl_xor(v, o);
    return v;
}
#define MFMA16(a, b, c) __builtin_amdgcn_mfma_f32_16x16x32_bf16((a), (b), (c), 0, 0, 0)
#define MFMA32(a, b, c) __builtin_amdgcn_mfma_f32_32x32x16_bf16((a), (b), (c), 0, 0, 0)

struct TItem { const float* src; bf16* dst; int ldw, ldd, kind, aux; };
struct Ins { const float* in[21]; };
constexpr int I_IN = 16 * 208, I_BG = 16 * 64, I_PG = 8 * 32, I_PA = 8 * 32, I_OUT = 16 * 32, I_GU = 32 * 2 * 16 * 16, I_DN = 32 * 8 * 32;
constexpr int NITEMS = I_IN + I_BG + I_PG + I_PA + I_OUT + I_GU + I_DN;
DI TItem p0_decode(const Frame& F, const Ins& I, int it) {
    TItem t; int r = it;
    if (r < I_IN) { const int kb = r / 208, nb = r % 208; const int n0 = nb < 64 ? nb * 32 : (nb - 64) * 32 + 2560, c0 = nb < 64 ? n0 : n0 - 496;
        t.src = I.in[2] + (size_t)kb * 64 * IN_COLS + c0; t.ldw = IN_COLS; t.dst = (bf16*)(F.ws + WS_W1T) + kb * 64; t.ldd = 1024; t.kind = 0; t.aux = n0; return t; } r -= I_IN;
    if (r < I_BG) { const int kb = r / 64, nb = r % 64; t.src = I.in[10] + (size_t)kb * 64 * 2048 + nb * 32; t.ldw = 2048; t.dst = (bf16*)(F.ws + WS_WBGT) + kb * 64; t.ldd = 1024; t.kind = 1; t.aux = nb * 32; return t; } r -= I_BG;
    if (r < I_PG) { const int kb = r / 32, nb = r % 32; t.src = I.in[8] + (size_t)kb * 64 * 1024 + nb * 32; t.ldw = 1024; t.dst = (bf16*)(F.ws + WS_WPGT) + kb * 64; t.ldd = 512; t.kind = 0; t.aux = nb * 32; return t; } r -= I_PG;
    if (r < I_PA) { const int kb = r / 32, nb = r % 32; t.src = I.in[9] + (size_t)kb * 64 * 1024 + nb * 32; t.ldw = 1024; t.dst = (bf16*)(F.ws + WS_WPAT) + kb * 64; t.ldd = 512; t.kind = 0; t.aux = nb * 32; return t; } r -= I_PA;
    if (r < I_OUT) { const int kb = r / 32, nb = r % 32; t.src = I.in[12] + (size_t)kb * 64 * 1024 + nb * 32; t.ldw = 1024; t.dst = (bf16*)(F.ws + WS_WOUTT) + kb * 64; t.ldd = 1024; t.kind = 0; t.aux = nb * 32; return t; } r -= I_OUT;
    if (r < I_GU) { const int e = r / 512, q = r % 512, up = q >> 8, kb = (q >> 4) & 15, nb = q & 15;
        t.src = (up ? I.in[19] : I.in[18]) + (size_t)e * 1024 * 512 + (size_t)kb * 64 * 512 + nb * 32; t.ldw = 512; t.dst = (bf16*)(F.dout + DO_EXPGU) + (size_t)e * 1024 * 1024 + kb * 64; t.ldd = 1024; t.kind = 2; t.aux = nb * 32 * 2 + up; return t; } r -= I_GU;
    { const int e = r / 256, q = r % 256, kb = q / 32, nb = q % 32;
        t.src = I.in[20] + (size_t)e * 512 * 1024 + (size_t)kb * 64 * 1024 + nb * 32; t.ldw = 1024; t.dst = (bf16*)(F.dout + DO_EXPDN) + (size_t)e * 1024 * 512 + kb * 64; t.ldd = 512; t.kind = 0; t.aux = nb * 32; return t; }
}
DI int p0_rowmap(const TItem& t, int n) {
    if (t.kind == 0) return t.aux + n;
    if (t.kind == 1) { const int c = t.aux + n, cc = c & 1023; return (cc >> 7) * 256 + (c >> 10) * 128 + (cc & 127); }
    const int c = (t.aux >> 1) + n; return (c >> 2) * 8 + (c & 3) + 4 * (t.aux & 1);
}
DI void p0_prologue(const Frame& F, const Ins& I) {
    LAS float* scr = (LAS float*)(F.lds + RING_OFF + F.wave * 16384);
    const int gw = F.vcu * NWAVES + F.wave, NGW = F.G * NWAVES, lane = F.lane;
    bf16* W1T = (bf16*)(F.ws + WS_W1T);
    { float cur[32], nxt[32]; TItem ti = p0_decode(F, I, gw < NITEMS ? gw : 0);
#pragma unroll
      for (int i = 0; i < 32; ++i) cur[i] = ti.src[(size_t)(2 * i + (lane >> 5)) * ti.ldw + (lane & 31)];
#pragma unroll 1
      for (int it = gw; it < NITEMS; it += NGW) {
          const bool more = it + NGW < NITEMS; const TItem tn = p0_decode(F, I, more ? it + NGW : it);
#pragma unroll
          for (int i = 0; i < 32; ++i) nxt[i] = tn.src[(size_t)(2 * i + (lane >> 5)) * tn.ldw + (lane & 31)];
#pragma unroll
          for (int i = 0; i < 32; ++i) scr[(2 * i + (lane >> 5)) * 33 + (lane & 31)] = cur[i];
          LDS_WAIT(); asm volatile("" ::: "memory");
          const int c = lane & 7;
#pragma unroll
          for (int j = 0; j < 4; ++j) { const int n = (lane >> 3) + 8 * j; const LAS float* sp = scr + (8 * c) * 33 + n;
              v4u o; o.x = pk2(sp[0 * 33], sp[1 * 33]); o.y = pk2(sp[2 * 33], sp[3 * 33]); o.z = pk2(sp[4 * 33], sp[5 * 33]); o.w = pk2(sp[6 * 33], sp[7 * 33]);
              *(v4u*)(ti.dst + (size_t)p0_rowmap(ti, n) * ti.ldd + 8 * c) = o; }
          LDS_WAIT(); asm volatile("" ::: "memory");
          ti = tn;
#pragma unroll
          for (int i = 0; i < 32; ++i) cur[i] = nxt[i];
      } }
    { const float* win = I.in[2]; const float* wa2 = I.in[3];
      for (int e = (F.vcu * NTHR + F.tid); e < 512 * 1024; e += F.G * NTHR) { const int k = e & 1023, n = e >> 10; const float* wr = win + (size_t)k * IN_COLS + 2048;
          float s = 0.f;
#pragma unroll
          for (int j = 0; j < 16; ++j) s += wr[j] * wa2[j * 512 + n];
          W1T[(size_t)(2048 + n) * 1024 + k] = f2bf(s); } }
    { bf16* WRH = (bf16*)(F.ws + WS_WRH); bf16* WRL = WRH + 48 * 1024; const float* wrg = I.in[14]; const float* wre = I.in[16];
      for (int e = (F.vcu * NTHR + F.tid); e < 48 * 1024; e += F.G * NTHR) { const int k = e & 1023, n = e >> 10;
          const float w = n < 4 ? wrg[k * 4 + n] : (n < 36 ? wre[k * 32 + n - 4] : 0.f); const bf16 h = f2bf(w); WRH[e] = h; WRL[e] = f2bf(w - bf2f(h)); } }
    { const float* x = I.in[0]; const float* g1 = I.in[1]; bf16* XN = (bf16*)(F.ws + WS_XN);
      f32x4 gv[4];
#pragma unroll
      for (int j = 0; j < 4; ++j) gv[j] = *(const f32x4*)(g1 + 4 * lane + 256 * j);
      f32x4 v[4], vn[4];
      { const f32x4* xr = (const f32x4*)(x + (size_t)(gw < T ? gw : 0) * D) + lane;
#pragma unroll
        for (int j = 0; j < 4; ++j) v[j] = xr[64 * j]; }
#pragma unroll 1
      for (int m = gw; m < T; m += NGW) { const int mn = m + NGW < T ? m + NGW : m; const f32x4* xr = (const f32x4*)(x + (size_t)mn * D) + lane; float s = 0.f;
#pragma unroll
          for (int j = 0; j < 4; ++j) { vn[j] = xr[64 * j]; s += (v[j].x * v[j].x + v[j].y * v[j].y) + (v[j].z * v[j].z + v[j].w * v[j].w); }
          const float rinv = __frsqrt_rn(wave_sum(s) * (1.f / D) + EPS);
          v2u* o8 = (v2u*)(XN + (size_t)m * D) + lane;
#pragma unroll
          for (int j = 0; j < 4; ++j) { v2u o; o.x = pk2(v[j].x * rinv * gv[j].x, v[j].y * rinv * gv[j].y); o.y = pk2(v[j].z * rinv * gv[j].z, v[j].w * rinv * gv[j].w); o8[64 * j] = o; v[j] = vn[j]; } } }
}

DI void qk_norm_phase(const Frame& F, const float* gq, const float* gk, bool dry) {
    const int gw = F.vcu * NWAVES + F.wave, NGW = F.G * NWAVES, lane = F.lane;
    bf16* Q = (bf16*)(F.ws + WS_DILQ);
    for (int rr = gw; rr < 6 * T; rr += NGW) { const int which = rr / T; const int gi = which % 3; const bool isq = which < 3;
        bf16* p = Q + (size_t)rr * 512 + 8 * lane; const v4u v = *(const v4u*)p;
        float x[8] = {bflo(v.x), bfhi(v.x), bflo(v.y), bfhi(v.y), bflo(v.z), bfhi(v.z), bflo(v.w), bfhi(v.w)};
        float s = 0.f;
#pragma unroll
        for (int j = 0; j < 8; ++j) s += x[j] * x[j];
        s += __shfl_xor(s, 1); s += __shfl_xor(s, 2); s += __shfl_xor(s, 4); s += __shfl_xor(s, 8);
        const float rinv = __frsqrt_rn(s * (1.f / 128.f) + EPS) * (isq ? 0.08838834764831845f * LOG2E : 1.f);
        const float* g = (isq ? gq : gk) + gi * 128 + (8 * lane & 127);
        const f32x4 g0 = *(const f32x4*)g, g1 = *(const f32x4*)(g + 4);
        v4u o; o.x = pk2(x[0] * rinv * g0.x, x[1] * rinv * g0.y); o.y = pk2(x[2] * rinv * g0.z, x[3] * rinv * g0.w); o.z = pk2(x[4] * rinv * g1.x, x[5] * rinv * g1.y); o.w = pk2(x[6] * rinv * g1.z, x[7] * rinv * g1.w);
        if (!dry) *(v4u*)p = o; }
}

DI int crow(int i, int h) { return (i & 3) + 8 * (i >> 2) + 4 * h; }
DI int img_off(int row, int ch) { return 256 * row + 16 * (ch ^ (((row & 3) << 2) | ((row >> 2) & 3))); }
typedef short s16x4 __attribute__((ext_vector_type(4)));
DI void attn_job(const Frame& F, int job, bool dry) {
    const int lane = F.lane, r = lane & 31, h = lane >> 5;
    const int gi = job >> 12; int rem = job & 4095;
    const int sh = 2 * gi, d = 1 << sh, L = SEQ >> sh, nqt = L >> 5;
    const int qt = rem % nqt; rem /= nqt; const int res = rem & (d - 1); rem >>= sh; const int head = rem & 3, b = rem >> 2;
    const int p0 = qt * 32;
    const float slope = exp2f(-8.f * (float)(gi * 4 + head + 1) / 12.f) * LOG2E * (float)d;
    bf16* Qg = (bf16*)(F.ws + WS_DILQ) + (size_t)gi * T * 512;
    const bf16* Kg = (const bf16*)(F.ws + WS_DILK) + (size_t)gi * T * 512 + head * 128;
    const bf16* Vg = (const bf16*)(F.ws + WS_DILV) + (size_t)gi * T * 512 + head * 128;
    LAS unsigned char* Kimg = F.lds + F.wave * 16384; LAS unsigned char* Vimg = Kimg + 8192;
    const size_t qtok = (size_t)b * SEQ + (size_t)(p0 + r) * d + res;
    bf16x8 qf[8];
#pragma unroll
    for (int ks = 0; ks < 8; ++ks) qf[ks] = *(const bf16x8*)(Qg + qtok * 512 + head * 128 + 16 * ks + 8 * h);
    f32x16 O[4];
#pragma unroll
    for (int db = 0; db < 4; ++db)
#pragma unroll
        for (int i = 0; i < 16; ++i) O[db][i] = 0.f;
    float m = -1e30f, l = 0.f;
    const int srow = lane >> 4, sslot = lane & 15;
    v4u kst[8], vst[8];
    const int kt0 = p0 >= 128 ? 0 : (128 - p0) >> 5;
#define ATT_LOAD(ktn) do { const int _kb = p0 - 128 + 32 * (ktn); _Pragma("unroll") for (int i = 0; i < 8; ++i) { const int kk = 4 * i + srow; \
        const size_t _o = ((size_t)b * SEQ + (size_t)(_kb + kk) * d + res) * 512 + 8 * (sslot ^ ((srow << 2) | (i & 3))); kst[i] = *(const v4u*)(Kg + _o); vst[i] = *(const v4u*)(Vg + _o); } } while (0)
    ATT_LOAD(kt0);
#pragma unroll 1
    for (int kt = kt0; kt < 5; ++kt) { const int kb = p0 - 128 + 32 * kt;
#pragma unroll
        for (int i = 0; i < 8; ++i) { *(LAS v4u*)(Kimg + 1024 * i + 16 * lane) = kst[i]; *(LAS v4u*)(Vimg + 1024 * i + 16 * lane) = vst[i]; }
        if (kt + 1 < 5) ATT_LOAD(kt + 1);
        f32x16 s;
#pragma unroll
        for (int i = 0; i < 16; ++i) s[i] = 0.f;
#pragma unroll
        for (int ks = 0; ks < 8; ++ks) { const bf16x8 kf = *(const LAS bf16x8*)(Kimg + img_off(r, 2 * ks + h)); s = MFMA32(kf, qf[ks], s); }
        float mx = -1e30f; const int dq = p0 + r - kb;
#pragma unroll
        for (int i = 0; i < 16; ++i) { const int dist = dq - crow(i, h); const bool ok = dist >= 0 && dist <= 128; const float sv = ok ? s[i] - slope * (float)dist : -1e30f; s[i] = sv; mx = fmaxf(mx, sv); }
        mx = fmaxf(mx, __shfl_xor(mx, 32));
        const float mn = fmaxf(m, mx), alpha = exp2f(m - mn); m = mn;
        float ps = 0.f;
#pragma unroll
        for (int i = 0; i < 16; ++i) { const float p = s[i] > -1e29f ? exp2f(s[i] - mn) : 0.f; s[i] = p; ps += p; }
        l = l * alpha + ps;
#pragma unroll
        for (int db = 0; db < 4; ++db)
#pragma unroll
            for (int i = 0; i < 16; ++i) O[db][i] *= alpha;
        bf16x8 pb[2];
#pragma unroll
        for (int si = 0; si < 2; ++si) { v4u w; w.x = pk2(s[8 * si], s[8 * si + 1]); w.y = pk2(s[8 * si + 2], s[8 * si + 3]); w.z = pk2(s[8 * si + 4], s[8 * si + 5]); w.w = pk2(s[8 * si + 6], s[8 * si + 7]); pb[si] = __builtin_bit_cast(bf16x8, w); }
        { const int i16 = lane & 15, q = i16 >> 2, p = i16 & 3, gl = (lane >> 4) & 1;
#pragma unroll
          for (int db = 0; db < 4; ++db)
#pragma unroll
            for (int si = 0; si < 2; ++si) {
                const s16x4 lo = __builtin_amdgcn_ds_read_tr16_b64_v4i16((LAS s16x4*)(Vimg + img_off(16 * si + 4 * h + q, 4 * db + 2 * gl + (p >> 1)) + 8 * (p & 1)));
                const s16x4 hi = __builtin_amdgcn_ds_read_tr16_b64_v4i16((LAS s16x4*)(Vimg + img_off(16 * si + 8 + 4 * h + q, 4 * db + 2 * gl + (p >> 1)) + 8 * (p & 1)));
                const bf16x8 vf = __builtin_shufflevector(lo, hi, 0, 1, 2, 3, 4, 5, 6, 7); O[db] = MFMA32(vf, pb[si], O[db]); } }
    }
#undef ATT_LOAD
    const float lt = l + __shfl_xor(l, 32), inv = 1.f / lt;
    bf16* op = Qg + qtok * 512 + head * 128 + 4 * h;
    if (dry) return;
#pragma unroll
    for (int db = 0; db < 4; ++db)
#pragma unroll
        for (int q4 = 0; q4 < 4; ++q4) { v2u o; o.x = pk2(O[db][4 * q4] * inv, O[db][4 * q4 + 1] * inv); o.y = pk2(O[db][4 * q4 + 2] * inv, O[db][4 * q4 + 3] * inv); *(v2u*)(op + 32 * db + 8 * q4) = o; }
    if (h == 0) ((float*)(F.ws + WS_LSE))[(size_t)gi * T * 4 + qtok * 4 + head] = m + log2f(lt);
}

constexpr int G_QS = 0, G_KS = 17408, G_KET = 34816, G_VT = 53248, G_ATT = 71680, G_TOT = 80896, G_DL = 82944, G_OS = 84992, G_LRAW = 83456, G_VRAW = 100864;
constexpr int QS_LD = 136, KT_LD = 72, OS_LD = 132;
DI void gla_pass1(const Frame& F, int item, bool dry) {
    const int tid = F.tid, lane = F.lane, w = F.wave, fr = lane & 15, g = lane >> 4;
    const int seg = item & (NSEG - 1), bh = item >> 4, hh = bh & 3, b = bh >> 2;
    const int dk = tid & 127, qr = tid >> 7;
    LAS bf16* Qs = (LAS bf16*)(F.lds + G_QS); LAS bf16* Ks = (LAS bf16*)(F.lds + G_KS); LAS bf16* KEt = (LAS bf16*)(F.lds + G_KET); LAS bf16* Vt = (LAS bf16*)(F.lds + G_VT);
    LAS bf16* Att = (LAS bf16*)(F.lds + G_ATT); LAS float* tot = (LAS float*)(F.lds + G_TOT); LAS float* Dl = (LAS float*)(F.lds + G_DL);
    const bf16* GQ = (const bf16*)(F.ws + WS_GLAQ); const bf16* GK = (const bf16*)(F.ws + WS_GLAK); const bf16* LA = (const bf16*)(F.ws + WS_LOGA); bf16* GV = (bf16*)(F.ws + WS_GLAV);
    f32x4 S[8];
#pragma unroll
    for (int a = 0; a < 8; ++a) S[a] = (f32x4){0.f, 0.f, 0.f, 0.f};
    float Btot = 0.f;
    const int dv0 = 16 * w;
    v4u sl[2], sq[2], sk[2], sv[2]; unsigned odef[8];
#pragma unroll
    for (int i = 0; i < 8; ++i) odef[i] = 0u;
    const int srow = tid >> 4, sch = tid & 15;
    LAS bf16* Lraw = (LAS bf16*)(F.lds + G_LRAW); LAS bf16* Vraw = (LAS bf16*)(F.lds + G_VRAW);
    const int troff = ((16 * qr + ((lane & 15) >> 2)) * QS_LD + (w & 1) * 64 + 16 * (lane >> 4) + 4 * (lane & 3)) * 2;
#define GLA_LOAD1(chn) do { const size_t _o = ((size_t)b * SEQ + seg * TSEG + (chn) * 64 + srow) * 512 + hh * 128 + 8 * sch; \
        _Pragma("unroll") for (int i = 0; i < 2; ++i) { sl[i] = *(const v4u*)(LA + _o + (size_t)i * 16384); sq[i] = *(const v4u*)(GQ + _o + (size_t)i * 16384); sk[i] = *(const v4u*)(GK + _o + (size_t)i * 16384); sv[i] = *(const v4u*)(GV + _o + (size_t)i * 16384); } } while (0)
    GLA_LOAD1(0);
#pragma unroll 1
    for (int ch = 0; ch < TSEG / 64; ++ch) {
        const size_t tokbase = (size_t)b * SEQ + seg * TSEG + ch * 64;
#pragma unroll
        for (int i = 0; i < 2; ++i) { const int o = (srow + 32 * i) * QS_LD + 8 * sch; *(LAS v4u*)(Lraw + o) = sl[i]; *(LAS v4u*)(Qs + o) = sq[i]; *(LAS v4u*)(Ks + o) = sk[i]; *(LAS v4u*)(Vraw + o) = sv[i]; }
        if (ch > 0 && !dry) { bf16* op = GV + (tokbase - 64 + 4 * g) * 512 + hh * 128 + dv0 + fr;
#pragma unroll
            for (int it = 0; it < 4; ++it) { op[(size_t)(16 * it) * 512] = (bf16)(odef[2 * it] & 0xffffu); op[(size_t)(16 * it + 1) * 512] = (bf16)(odef[2 * it] >> 16); op[(size_t)(16 * it + 2) * 512] = (bf16)(odef[2 * it + 1] & 0xffffu); op[(size_t)(16 * it + 3) * 512] = (bf16)(odef[2 * it + 1] >> 16); } }
        if (ch + 1 < TSEG / 64) GLA_LOAD1(ch + 1);
        LDS_BARRIER();
        float la[16], qv[16], kv[16]; bf16 vv[16];
#pragma unroll
        for (int k4 = 0; k4 < 4; ++k4) { const int o = troff + k4 * 4 * QS_LD * 2;
            const s16x4 a = __builtin_amdgcn_ds_read_tr16_b64_v4i16((LAS s16x4*)((LAS unsigned char*)Lraw + o)), q4 = __builtin_amdgcn_ds_read_tr16_b64_v4i16((LAS s16x4*)((LAS unsigned char*)Qs + o));
            const s16x4 k4v = __builtin_amdgcn_ds_read_tr16_b64_v4i16((LAS s16x4*)((LAS unsigned char*)Ks + o)), v4v = __builtin_amdgcn_ds_read_tr16_b64_v4i16((LAS s16x4*)((LAS unsigned char*)Vraw + o));
#pragma unroll
            for (int e = 0; e < 4; ++e) { la[4 * k4 + e] = bf2f((bf16)a[e]); qv[4 * k4 + e] = bf2f((bf16)q4[e]); kv[4 * k4 + e] = bf2f((bf16)k4v[e]); vv[4 * k4 + e] = (bf16)v4v[e]; } }
#pragma unroll
        for (int i = 1; i < 16; ++i) la[i] += la[i - 1];
        tot[qr * 128 + dk] = la[15];
        { v4u v0, v1; v0.x = vv[0] | ((unsigned)vv[1] << 16); v0.y = vv[2] | ((unsigned)vv[3] << 16); v0.z = vv[4] | ((unsigned)vv[5] << 16); v0.w = vv[6] | ((unsigned)vv[7] << 16);
          v1.x = vv[8] | ((unsigned)vv[9] << 16); v1.y = vv[10] | ((unsigned)vv[11] << 16); v1.z = vv[12] | ((unsigned)vv[13] << 16); v1.w = vv[14] | ((unsigned)vv[15] << 16);
          *(LAS v4u*)(Vt + dk * KT_LD + 16 * qr) = v0; *(LAS v4u*)(Vt + dk * KT_LD + 16 * qr + 8) = v1; }
        LDS_BARRIER();
        const float t0 = tot[dk], t1 = tot[128 + dk], t2 = tot[256 + dk], t3 = tot[384 + dk];
        const float base = (qr > 0 ? t0 : 0.f) + (qr > 1 ? t1 : 0.f) + (qr > 2 ? t2 : 0.f), blast = (t0 + t1) + (t2 + t3);
        Btot += blast;
        if (qr == 0) Dl[dk] = __expf(blast);
        { unsigned ke[8];
#pragma unroll
          for (int i = 0; i < 16; i += 2) { const float b0 = base + la[i], b1 = base + la[i + 1]; const float e0 = __expf(b0), e1 = __expf(b1);
              Qs[(16 * qr + i) * QS_LD + dk] = f2bf(qv[i] * 0.08838834764831845f * e0); Qs[(16 * qr + i + 1) * QS_LD + dk] = f2bf(qv[i + 1] * 0.08838834764831845f * e1);
              Ks[(16 * qr + i) * QS_LD + dk] = f2bf(kv[i] / e0); Ks[(16 * qr + i + 1) * QS_LD + dk] = f2bf(kv[i + 1] / e1);
              ke[i >> 1] = pk2(kv[i] * __expf(blast - b0), kv[i + 1] * __expf(blast - b1)); }
          v4u k0 = {ke[0], ke[1], ke[2], ke[3]}, k1 = {ke[4], ke[5], ke[6], ke[7]};
          *(LAS v4u*)(KEt + dk * KT_LD + 16 * qr) = k0; *(LAS v4u*)(KEt + dk * KT_LD + 16 * qr + 8) = k1; }
        LDS_BARRIER();
#pragma unroll
        for (int tt = 0; tt < 2; ++tt) { const int n = 2 * w + tt, jt = n >> 2, it = n & 3; f32x4 a4 = {0.f, 0.f, 0.f, 0.f};
#pragma unroll
            for (int s = 0; s < 4; ++s) { const bf16x8 ka = *(const LAS bf16x8*)(Ks + (16 * jt + fr) * QS_LD + 32 * s + 8 * g); const bf16x8 qb = *(const LAS bf16x8*)(Qs + (16 * it + fr) * QS_LD + 32 * s + 8 * g); a4 = MFMA16(ka, qb, a4); }
            const int tj = 16 * jt + 4 * g, ti = 16 * it + fr;
            v2u o; o.x = pk2(tj <= ti ? a4[0] : 0.f, tj + 1 <= ti ? a4[1] : 0.f); o.y = pk2(tj + 2 <= ti ? a4[2] : 0.f, tj + 3 <= ti ? a4[3] : 0.f);
            *(LAS v2u*)(Att + ti * KT_LD + tj) = o; }
        LDS_BARRIER();
        bf16x8 Sb[4];
#pragma unroll
        for (int s = 0; s < 4; ++s) { v4u p; p.x = pk2(S[2 * s][0], S[2 * s][1]); p.y = pk2(S[2 * s][2], S[2 * s][3]); p.z = pk2(S[2 * s + 1][0], S[2 * s + 1][1]); p.w = pk2(S[2 * s + 1][2], S[2 * s + 1][3]); Sb[s] = __builtin_bit_cast(bf16x8, p); }
        bf16x8 Vf[2];
#pragma unroll
        for (int ks = 0; ks < 2; ++ks) Vf[ks] = *(const LAS bf16x8*)(Vt + (dv0 + fr) * KT_LD + 32 * ks + 8 * g);
#pragma unroll
        for (int it = 0; it < 4; ++it) { f32x4 o = {0.f, 0.f, 0.f, 0.f};
#pragma unroll
            for (int s = 0; s < 4; ++s) { const bf16x4 lo = *(const LAS bf16x4*)(Qs + (16 * it + fr) * QS_LD + 32 * s + 4 * g); const bf16x4 hi = *(const LAS bf16x4*)(Qs + (16 * it + fr) * QS_LD + 32 * s + 16 + 4 * g);
                const bf16x8 qa = __builtin_shufflevector(lo, hi, 0, 1, 2, 3, 4, 5, 6, 7); o = MFMA16(qa, Sb[s], o); }
#pragma unroll
            for (int ks = 0; ks < 2; ++ks) { const bf16x8 aa = *(const LAS bf16x8*)(Att + (16 * it + fr) * KT_LD + 32 * ks + 8 * g); o = MFMA16(aa, Vf[ks], o); }
            odef[2 * it] = pk2(o[0], o[1]); odef[2 * it + 1] = pk2(o[2], o[3]); }
#pragma unroll
        for (int a = 0; a < 8; ++a) { const f32x4 dsc = *(const LAS f32x4*)(Dl + 16 * a + 4 * g); S[a] = S[a] * dsc;
#pragma unroll
            for (int ks = 0; ks < 2; ++ks) { const bf16x8 ka = *(const LAS bf16x8*)(KEt + (16 * a + fr) * KT_LD + 32 * ks + 8 * g); S[a] = MFMA16(ka, Vf[ks], S[a]); } }
        LDS_BARRIER();
    }
    if (!dry) { bf16* op = GV + ((size_t)b * SEQ + seg * TSEG + TSEG - 64 + 4 * g) * 512 + hh * 128 + dv0 + fr;
#pragma unroll
        for (int it = 0; it < 4; ++it) { op[(size_t)(16 * it) * 512] = (bf16)(odef[2 * it] & 0xffffu); op[(size_t)(16 * it + 1) * 512] = (bf16)(odef[2 * it] >> 16); op[(size_t)(16 * it + 2) * 512] = (bf16)(odef[2 * it + 1] & 0xffffu); op[(size_t)(16 * it + 3) * 512] = (bf16)(odef[2 * it + 1] >> 16); } }
    v2u* LB = (v2u*)(F.ws + WS_LB) + (size_t)item * 4096 + w * 512 + lane;
#pragma unroll
    for (int a = 0; a < 8; ++a) { v2u o; o.x = pk2(S[a][0], S[a][1]); o.y = pk2(S[a][2], S[a][3]); LB[a * 64] = o; }
    if (qr == 0) ((float*)(F.ws + WS_DSEG))[item * 128 + dk] = __expf(Btot);
}

DI void gla_pass2(const Frame& F, int item, const float* gnorm, bool dry) {
    const int tid = F.tid, lane = F.lane, w = F.wave, fr = lane & 15, g = lane >> 4;
    const int seg = item & (NSEG - 1), bh = item >> 4, hh = bh & 3, b = bh >> 2;
    const int dk = tid & 127, qr = tid >> 7, dv0 = 16 * w;
    LAS bf16* Qs = (LAS bf16*)(F.lds + G_QS); LAS float* tot = (LAS float*)(F.lds + G_TOT); LAS float* Os = (LAS float*)(F.lds + G_OS);
    const bf16* GQ = (const bf16*)(F.ws + WS_GLAQ); const bf16* LA = (const bf16*)(F.ws + WS_LOGA); bf16* GV = (bf16*)(F.ws + WS_GLAV); const bf16* R = (const bf16*)(F.dout + DO_R);
    f32x4 Sc[8];
#pragma unroll
    for (int a = 0; a < 8; ++a) Sc[a] = (f32x4){0.f, 0.f, 0.f, 0.f};
    { v2u lv[8], lvn[8]; f32x4 dc[8], dcn[8];
#define GLA_CLOAD(LV, DC, spn) do { const int _it2 = bh * NSEG + (spn); const v2u* _LB = (const v2u*)(F.ws + WS_LB) + (size_t)_it2 * 4096 + w * 512 + lane; const float* _DS = (const float*)(F.ws + WS_DSEG) + _it2 * 128 + 4 * g; \
        _Pragma("unroll") for (int a = 0; a < 8; ++a) { DC[a] = *(const f32x4*)(_DS + 16 * a); LV[a] = _LB[a * 64]; } } while (0)
      if (seg > 0) GLA_CLOAD(lv, dc, 0);
#pragma unroll 1
      for (int sp = 0; sp < seg; ++sp) {
          if (sp + 1 < seg) GLA_CLOAD(lvn, dcn, sp + 1);
#pragma unroll
          for (int a = 0; a < 8; ++a) { Sc[a][0] = Sc[a][0] * dc[a][0] + bflo(lv[a].x); Sc[a][1] = Sc[a][1] * dc[a][1] + bfhi(lv[a].x); Sc[a][2] = Sc[a][2] * dc[a][2] + bflo(lv[a].y); Sc[a][3] = Sc[a][3] * dc[a][3] + bfhi(lv[a].y);
              lv[a] = lvn[a]; dc[a] = dcn[a]; } }
#undef GLA_CLOAD
    }
    bf16x8 Sb[4];
#pragma unroll
    for (int s = 0; s < 4; ++s) { v4u p; p.x = pk2(Sc[2 * s][0], Sc[2 * s][1]); p.y = pk2(Sc[2 * s][2], Sc[2 * s][3]); p.z = pk2(Sc[2 * s + 1][0], Sc[2 * s + 1][1]); p.w = pk2(Sc[2 * s + 1][2], Sc[2 * s + 1][3]); Sb[s] = __builtin_bit_cast(bf16x8, p); }
    float Bcum = 0.f;
    const int tk = tid >> 3, pc = tid & 7;
    f32x4 gn[4];
#pragma unroll
    for (int j = 0; j < 4; ++j) gn[j] = *(const f32x4*)(gnorm + 16 * pc + 4 * j);
    v4u sl[2], sq[2], ow0, ow1, r0, r1, od0 = {0u, 0u, 0u, 0u}, od1 = {0u, 0u, 0u, 0u};
    const int srow = tid >> 4, sch = tid & 15;
    LAS bf16* Lraw = (LAS bf16*)(F.lds + G_KS);
    const int troff = ((16 * qr + ((lane & 15) >> 2)) * QS_LD + (w & 1) * 64 + 16 * (lane >> 4) + 4 * (lane & 3)) * 2;
#define GLA_LOAD2A(chn) do { const size_t _o = ((size_t)b * SEQ + seg * TSEG + (chn) * 64 + srow) * 512 + hh * 128 + 8 * sch; \
        _Pragma("unroll") for (int i = 0; i < 2; ++i) { sl[i] = *(const v4u*)(LA + _o + (size_t)i * 16384); sq[i] = *(const v4u*)(GQ + _o + (size_t)i * 16384); } } while (0)
#define GLA_LOAD2B(chn) do { const size_t _o = ((size_t)b * SEQ + seg * TSEG + (chn) * 64 + tk) * 512 + hh * 128 + 16 * pc; \
        ow0 = *(const v4u*)(GV + _o); ow1 = *(const v4u*)(GV + _o + 8); r0 = *(const v4u*)(R + _o); r1 = *(const v4u*)(R + _o + 8); } while (0)
    GLA_LOAD2A(0); GLA_LOAD2B(0);
#pragma unroll 1
    for (int ch = 0; ch < TSEG / 64; ++ch) {
        const size_t tokbase = (size_t)b * SEQ + seg * TSEG + ch * 64;
#pragma unroll
        for (int i = 0; i < 2; ++i) { const int o = (srow + 32 * i) * QS_LD + 8 * sch; *(LAS v4u*)(Lraw + o) = sl[i]; *(LAS v4u*)(Qs + o) = sq[i]; }
        if (ch > 0 && !dry) { const size_t pofs = (tokbase - 64 + tk) * 512 + hh * 128 + 16 * pc; *(v4u*)(GV + pofs) = od0; *(v4u*)(GV + pofs + 8) = od1; }
        const v4u cw0 = ow0, cw1 = ow1, cr0 = r0, cr1 = r1;
        if (ch + 1 < TSEG / 64) { GLA_LOAD2A(ch + 1); GLA_LOAD2B(ch + 1); }
        LDS_BARRIER();
        float la[16], qv[16];
#pragma unroll
        for (int k4 = 0; k4 < 4; ++k4) { const int o = troff + k4 * 4 * QS_LD * 2;
            const s16x4 a = __builtin_amdgcn_ds_read_tr16_b64_v4i16((LAS s16x4*)((LAS unsigned char*)Lraw + o)), q4 = __builtin_amdgcn_ds_read_tr16_b64_v4i16((LAS s16x4*)((LAS unsigned char*)Qs + o));
#pragma unroll
            for (int e = 0; e < 4; ++e) { la[4 * k4 + e] = bf2f((bf16)a[e]); qv[4 * k4 + e] = bf2f((bf16)q4[e]); } }
#pragma unroll
        for (int i = 1; i < 16; ++i) la[i] += la[i - 1];
        tot[qr * 128 + dk] = la[15];
        LDS_BARRIER();
        const float t0 = tot[dk], t1 = tot[128 + dk], t2 = tot[256 + dk], t3 = tot[384 + dk];
        const float base = Bcum + (qr > 0 ? t0 : 0.f) + (qr > 1 ? t1 : 0.f) + (qr > 2 ? t2 : 0.f);
        Bcum += (t0 + t1) + (t2 + t3);
#pragma unroll
        for (int i = 0; i < 16; ++i) Qs[(16 * qr + i) * QS_LD + dk] = f2bf(qv[i] * 0.08838834764831845f * __expf(base + la[i]));
        LDS_BARRIER();
#pragma unroll
        for (int it = 0; it < 4; ++it) { f32x4 o = {0.f, 0.f, 0.f, 0.f};
            if (seg > 0) {
#pragma unroll
                for (int s = 0; s < 4; ++s) { const bf16x4 lo = *(const LAS bf16x4*)(Qs + (16 * it + fr) * QS_LD + 32 * s + 4 * g); const bf16x4 hi = *(const LAS bf16x4*)(Qs + (16 * it + fr) * QS_LD + 32 * s + 16 + 4 * g);
                    const bf16x8 qa = __builtin_shufflevector(lo, hi, 0, 1, 2, 3, 4, 5, 6, 7); o = MFMA16(qa, Sb[s], o); } }
#pragma unroll
            for (int rr = 0; rr < 4; ++rr) Os[(16 * it + 4 * g + rr) * OS_LD + dv0 + fr] = o[rr]; }
        LDS_BARRIER();
        { f32x4 v[4]; float ss = 0.f;
#pragma unroll
          for (int j = 0; j < 4; ++j) v[j] = *(const LAS f32x4*)(Os + tk * OS_LD + 16 * pc + 4 * j);
          v[0].x += bflo(cw0.x); v[0].y += bfhi(cw0.x); v[0].z += bflo(cw0.y); v[0].w += bfhi(cw0.y); v[1].x += bflo(cw0.z); v[1].y += bfhi(cw0.z); v[1].z += bflo(cw0.w); v[1].w += bfhi(cw0.w);
          v[2].x += bflo(cw1.x); v[2].y += bfhi(cw1.x); v[2].z += bflo(cw1.y); v[2].w += bfhi(cw1.y); v[3].x += bflo(cw1.z); v[3].y += bfhi(cw1.z); v[3].z += bflo(cw1.w); v[3].w += bfhi(cw1.w);
#pragma unroll
          for (int j = 0; j < 4; ++j) ss += (v[j].x * v[j].x + v[j].y * v[j].y) + (v[j].z * v[j].z + v[j].w * v[j].w);
          ss += __shfl_xor(ss, 1); ss += __shfl_xor(ss, 2); ss += __shfl_xor(ss, 4);
          const float rinv = __frsqrt_rn(ss * (1.f / 128.f) + EPS);
          const size_t ofs = (tokbase + tk) * 512 + hh * 128 + 16 * pc;
          v4u o0, o1;
          o0.x = pk2(v[0].x * rinv * gn[0].x * bflo(cr0.x), v[0].y * rinv * gn[0].y * bfhi(cr0.x)); o0.y = pk2(v[0].z * rinv * gn[0].z * bflo(cr0.y), v[0].w * rinv * gn[0].w * bfhi(cr0.y));
          o0.z = pk2(v[1].x * rinv * gn[1].x * bflo(cr0.z), v[1].y * rinv * gn[1].y * bfhi(cr0.z)); o0.w = pk2(v[1].z * rinv * gn[1].z * bflo(cr0.w), v[1].w * rinv * gn[1].w * bfhi(cr0.w));
          o1.x = pk2(v[2].x * rinv * gn[2].x * bflo(cr1.x), v[2].y * rinv * gn[2].y * bfhi(cr1.x)); o1.y = pk2(v[2].z * rinv * gn[2].z * bflo(cr1.y), v[2].w * rinv * gn[2].w * bfhi(cr1.y));
          o1.z = pk2(v[3].x * rinv * gn[3].x * bflo(cr1.z), v[3].y * rinv * gn[3].y * bfhi(cr1.z)); o1.w = pk2(v[3].z * rinv * gn[3].z * bflo(cr1.w), v[3].w * rinv * gn[3].w * bfhi(cr1.w));
          od0 = o0; od1 = o1; }
        LDS_BARRIER();
    }
    if (!dry) { const size_t pofs = ((size_t)b * SEQ + seg * TSEG + TSEG - 64 + tk) * 512 + hh * 128 + 16 * pc; *(v4u*)(GV + pofs) = od0; *(v4u*)(GV + pofs + 8) = od1; }
}
DI void attn_merge_phase(const Frame& F, bool dry) {
    const int gw = F.vcu * NWAVES + F.wave, NGW = F.G * NWAVES, lane = F.lane, head = lane >> 4;
    bf16* O0 = (bf16*)(F.ws + WS_DILQ); const float* LSE = (const float*)(F.ws + WS_LSE);
    for (int t = gw; t < T; t += NGW) {
        const float l0 = LSE[(size_t)t * 4 + head], l1 = LSE[(size_t)T * 4 + (size_t)t * 4 + head], l2 = LSE[(size_t)2 * T * 4 + (size_t)t * 4 + head];
        const float M = fmaxf(l0, fmaxf(l1, l2)); float w0 = exp2f(l0 - M), w1 = exp2f(l1 - M), w2 = exp2f(l2 - M); const float inv = 1.f / (w0 + w1 + w2); w0 *= inv; w1 *= inv; w2 *= inv;
        bf16* p = O0 + (size_t)t * 512 + 8 * lane; const v4u a = *(const v4u*)p, bq = *(const v4u*)(p + (size_t)T * 512), c = *(const v4u*)(p + (size_t)2 * T * 512);
        v4u o;
        o.x = pk2(w0 * bflo(a.x) + w1 * bflo(bq.x) + w2 * bflo(c.x), w0 * bfhi(a.x) + w1 * bfhi(bq.x) + w2 * bfhi(c.x));
        o.y = pk2(w0 * bflo(a.y) + w1 * bflo(bq.y) + w2 * bflo(c.y), w0 * bfhi(a.y) + w1 * bfhi(bq.y) + w2 * bfhi(c.y));
        o.z = pk2(w0 * bflo(a.z) + w1 * bflo(bq.z) + w2 * bflo(c.z), w0 * bfhi(a.z) + w1 * bfhi(bq.z) + w2 * bfhi(c.z));
        o.w = pk2(w0 * bflo(a.w) + w1 * bflo(bq.w) + w2 * bflo(c.w), w0 * bfhi(a.w) + w1 * bfhi(bq.w) + w2 * bfhi(c.w));
        if (!dry) *(v4u*)p = o; }
}

DI void router_phase(const Frame& F, const float* g2, const float* brg, const float* bre, unsigned* gcnt, bool dry) {
    const int lane = F.lane, w = F.wave, fr = lane & 15, g = lane >> 4;
    const float* X1 = (const float*)(F.ws + WS_X1);
    const bf16* WRH = (const bf16*)(F.ws + WS_WRH); const bf16* WRL = WRH + 48 * 1024;
    int* TOKE = (int*)(F.ws + WS_TOKE); float* TOKW = (float*)(F.ws + WS_TOKW); int* TOKR = (int*)(F.ws + WS_TOKR);
    LAS float* lg = (LAS float*)(F.lds + w * 4096);
    LAS int* cnt = (LAS int*)(F.lds + 65536); LAS int* basev = cnt + 32;
    for (int it = 0; it * F.G * 128 < T; ++it) {
        const int tok0 = (it * F.G + F.vcu) * 128 + w * 16;
        if (F.tid < 32) cnt[F.tid] = 0;
        __syncthreads();
        f32x4 acc[3]; acc[0] = acc[1] = acc[2] = (f32x4){0.f, 0.f, 0.f, 0.f};
        float ss = 0.f;
        const float* xr = X1 + (size_t)(tok0 + fr) * D + 8 * g;
#pragma unroll 2
        for (int s = 0; s < 32; ++s) {
            const f32x4 xa = *(const f32x4*)(xr + 32 * s), xb = *(const f32x4*)(xr + 32 * s + 4);
            const f32x4 ga = *(const f32x4*)(g2 + 32 * s + 8 * g), gb = *(const f32x4*)(g2 + 32 * s + 8 * g + 4);
            ss += (xa.x * xa.x + xa.y * xa.y) + (xa.z * xa.z + xa.w * xa.w) + (xb.x * xb.x + xb.y * xb.y) + (xb.z * xb.z + xb.w * xb.w);
            const f32x4 ya = xa * ga, yb = xb * gb;
            v4u hi; hi.x = pk2(ya.x, ya.y); hi.y = pk2(ya.z, ya.w); hi.z = pk2(yb.x, yb.y); hi.w = pk2(yb.z, yb.w);
            v4u lo; lo.x = pk2(ya.x - bflo(hi.x), ya.y - bfhi(hi.x)); lo.y = pk2(ya.z - bflo(hi.y), ya.w - bfhi(hi.y)); lo.z = pk2(yb.x - bflo(hi.z), yb.y - bfhi(hi.z)); lo.w = pk2(yb.z - bflo(hi.w), yb.w - bfhi(hi.w));
            const bf16x8 ah = __builtin_bit_cast(bf16x8, hi), al = __builtin_bit_cast(bf16x8, lo);
#pragma unroll
            for (int nt = 0; nt < 3; ++nt) { const bf16x8 bh = *(const bf16x8*)(WRH + (size_t)(16 * nt + fr) * 1024 + 32 * s + 8 * g), bl = *(const bf16x8*)(WRL + (size_t)(16 * nt + fr) * 1024 + 32 * s + 8 * g);
                acc[nt] = MFMA16(ah, bh, acc[nt]); acc[nt] = MFMA16(ah, bl, acc[nt]); acc[nt] = MFMA16(al, bh, acc[nt]); }
        }
        ss += __shfl_xor(ss, 16); ss += __shfl_xor(ss, 32);
        const float rinv = __frsqrt_rn(ss * (1.f / D) + EPS);
#pragma unroll
        for (int rr = 0; rr < 4; ++rr) { const float ri = __shfl(rinv, 4 * g + rr);
#pragma unroll
            for (int nt = 0; nt < 3; ++nt) lg[(4 * g + rr) * 48 + 16 * nt + fr] = acc[nt][rr] * ri; }
        if (lane < 16 && !dry) ((float*)(F.ws + WS_H2))[tok0 + lane] = rinv;
        LDS_WAIT(); asm volatile("" ::: "memory");
        int e1 = 0, e2 = 0, lr1 = 0, lr2 = 0; float w1 = 0.f, w2 = 0.f;
        if (lane < 16) { const LAS float* q = lg + lane * 48;
            float gl[4]; int gs = 0; float gm = -3.0e38f;
#pragma unroll
            for (int j = 0; j < 4; ++j) { gl[j] = q[j] + brg[j]; if (gl[j] > gm) { gm = gl[j]; gs = j; } }
            float gsum = 0.f;
#pragma unroll
            for (int j = 0; j < 4; ++j) gsum += __expf(gl[j] - gm);
            const float gp = 1.f / gsum;
            float el[8]; int i1 = 0; float v1 = -3.0e38f;
#pragma unroll
            for (int j = 0; j < 8; ++j) { el[j] = q[4 + 8 * gs + j] + bre[8 * gs + j]; if (el[j] > v1) { v1 = el[j]; i1 = j; } }
            int i2 = 0; float v2 = -3.0e38f;
#pragma unroll
            for (int j = 0; j < 8; ++j) if (j != i1 && el[j] > v2) { v2 = el[j]; i2 = j; }
            const float p2 = 1.f / (1.f + __expf(v1 - v2)), p1 = 1.f - p2;
            e1 = 8 * gs + i1; e2 = 8 * gs + i2; w1 = p1 * gp; w2 = p2 * gp;
            lr1 = __hip_atomic_fetch_add(&cnt[e1], 1, __ATOMIC_RELAXED, __HIP_MEMORY_SCOPE_WORKGROUP); lr2 = __hip_atomic_fetch_add(&cnt[e2], 1, __ATOMIC_RELAXED, __HIP_MEMORY_SCOPE_WORKGROUP); }
        __syncthreads();
        if (F.tid < 32) basev[F.tid] = dry ? 0 : (int)atomicAdd(&gcnt[64 * F.tid], (unsigned)cnt[F.tid]);
        __syncthreads();
        if (lane < 16 && !dry) { const int t = tok0 + lane; TOKE[2 * t] = e1; TOKE[2 * t + 1] = e2; TOKW[2 * t] = w1; TOKW[2 * t + 1] = w2; TOKR[2 * t] = basev[e1] + lr1; TOKR[2 * t + 1] = basev[e2] + lr2; }
        __syncthreads();
    }
}
DI void moe_assign_phase(const Frame& F, unsigned* gcnt, const float* g2) {
    LAS int* pst = (LAS int*)(F.lds + 65536);
    if (F.tid == 0) { int p = 0; int* BLKE = (int*)(F.ws + WS_BLKE);
        for (int e = 0; e < 32; ++e) { pst[e] = p; const int c = (int)__hip_atomic_load(&gcnt[64 * e], __ATOMIC_RELAXED, __HIP_MEMORY_SCOPE_AGENT); const int nb = (c + 255) >> 8;
            if (F.vcu == 0) for (int j = 0; j < nb; ++j) BLKE[(p >> 8) + j] = e;
            p += nb << 8; }
        if (F.vcu == 0) BLKE[NBLK_MAX] = p >> 8; }
    __syncthreads();
    const int gw = F.vcu * NWAVES + F.wave, NGW = F.G * NWAVES, lane = F.lane;
    const int* TOKE = (const int*)(F.ws + WS_TOKE); const float* TOKW = (const float*)(F.ws + WS_TOKW); const int* TOKR = (const int*)(F.ws + WS_TOKR);
    int* DEST = (int*)(F.ws + WS_DEST); float* ROWW = (float*)(F.ws + WS_ROWW);
    const float* X1 = (const float*)(F.ws + WS_X1); const float* RINV = (const float*)(F.ws + WS_H2); bf16* XP = (bf16*)(F.ws + WS_XP);
    f32x4 gv[4], v[4], vn[4];
#pragma unroll
    for (int j = 0; j < 4; ++j) gv[j] = *(const f32x4*)(g2 + 4 * lane + 256 * j);
    { const f32x4* xr = (const f32x4*)(X1 + (size_t)(gw < T ? gw : 0) * D) + lane;
#pragma unroll
      for (int j = 0; j < 4; ++j) v[j] = xr[64 * j]; }
#pragma unroll 1
    for (int t = gw; t < T; t += NGW) { const int tn = t + NGW < T ? t + NGW : t; const f32x4* xr = (const f32x4*)(X1 + (size_t)tn * D) + lane;
#pragma unroll
        for (int j = 0; j < 4; ++j) vn[j] = xr[64 * j];
        const int d0 = pst[TOKE[2 * t]] + TOKR[2 * t], d1 = pst[TOKE[2 * t + 1]] + TOKR[2 * t + 1]; const float rinv = RINV[t];
        if (lane == 0) { DEST[2 * t] = d0; DEST[2 * t + 1] = d1; ROWW[d0] = TOKW[2 * t]; ROWW[d1] = TOKW[2 * t + 1]; }
        v2u* o0 = (v2u*)(XP + (size_t)d0 * D) + lane; v2u* o1 = (v2u*)(XP + (size_t)d1 * D) + lane;
#pragma unroll
        for (int j = 0; j < 4; ++j) { v2u o; o.x = pk2(v[j].x * rinv * gv[j].x, v[j].y * rinv * gv[j].y); o.y = pk2(v[j].z * rinv * gv[j].z, v[j].w * rinv * gv[j].w); o0[64 * j] = o; o1[64 * j] = o; v[j] = vn[j]; } }
}
DI void combine_phase(const Frame& F, float* out) {
    const int gw = F.vcu * NWAVES + F.wave, NGW = F.G * NWAVES, lane = F.lane;
    const float* X1 = (const float*)(F.ws + WS_X1); const bf16* Y = (const bf16*)(F.ws + WS_Y); const int* DEST = (const int*)(F.ws + WS_DEST);
    for (int t = gw; t < T; t += NGW) { const int d0 = DEST[2 * t], d1 = DEST[2 * t + 1];
#pragma unroll
        for (int j = 0; j < 2; ++j) { const int c = 8 * lane + 512 * j;
            const f32x4 xa = *(const f32x4*)(X1 + (size_t)t * D + c), xb = *(const f32x4*)(X1 + (size_t)t * D + c + 4);
            const v4u a = *(const v4u*)(Y + (size_t)d0 * D + c), b = *(const v4u*)(Y + (size_t)d1 * D + c);
            f32x4 oa, ob;
            oa.x = xa.x + bflo(a.x) + bflo(b.x); oa.y = xa.y + bfhi(a.x) + bfhi(b.x); oa.z = xa.z + bflo(a.y) + bflo(b.y); oa.w = xa.w + bfhi(a.y) + bfhi(b.y);
            ob.x = xb.x + bflo(a.z) + bflo(b.z); ob.y = xb.y + bfhi(a.z) + bfhi(b.z); ob.z = xb.z + bflo(a.w) + bflo(b.w); ob.w = xb.w + bfhi(a.w) + bfhi(b.w);
            *(f32x4*)(out + (size_t)t * D + c) = oa; *(f32x4*)(out + (size_t)t * D + c + 4) = ob; } }
}

constexpr int PER_PHASE = 13;
struct Args { Ins I; float* out; unsigned char* ws; int ph_lo, ph_hi, li, pad; };
__global__ void __launch_bounds__(NTHR, 2) fwd_kernel(Args args) {
    extern __shared__ __attribute__((aligned(16))) unsigned char lds[];
    Frame F;
    F.lds = (LAS unsigned char*)lds;
    F.tid = threadIdx.x; F.lane = F.tid & 63; F.wave = __builtin_amdgcn_readfirstlane(F.tid >> 6);
    F.G = gridDim.x; { const int bx = blockIdx.x; F.vcu = (F.G % 8 == 0) ? (bx % 8) * (F.G / 8) + bx / 8 : bx; }
    F.ws = args.ws; F.dout = (unsigned char*)args.out;
    unsigned* ctl = (unsigned*)(args.ws + WS_CTL);
    volatile LAS unsigned* MISC = (volatile LAS unsigned*)(F.lds + MISC_OFF);
    for (int u = F.tid; u < (LDS_BYTES - LDSCTL_OFF) / 4; u += NTHR) ((LAS unsigned*)(F.lds + LDSCTL_OFF))[u] = 0u;
    __syncthreads();
    XcdBarrier bar; bar.bar = ctl + CW_BAR; bar.x = 0; bar.st = nullptr;
    if (MK_N_LAUNCHES == 1) bar = xcd_barrier_post(ctl + CW_BAR, MISC + 8);
    const int lo = args.ph_lo, hi = args.ph_hi;
#ifdef ONLY_PHASE
#define IN(k) ((k) == ONLY_PHASE && lo <= (k) && (k) < hi)
#else
#define IN(k) (lo <= (k) && (k) < hi)
#endif
#define SEAM(k) do { if (IN(k) && IN((k) + 1)) xcd_barrier(bar); } while (0)
#ifndef DUP_MASK
#define DUP_MASK 0
#endif
#define REPS(k) (((DUP_MASK >> (k)) & 1) ? 2 : 1)
    const Ins& I = args.I;
    unsigned char* ws = args.ws;

    if (IN(0)) { _Pragma("unroll 1") for (int rep = 0; rep < REPS(0); ++rep) { if (rep) xcd_barrier(bar); p0_prologue(F, I); } SEAM(0); }

    if (IN(1)) { _Pragma("unroll 1") for (int rep = 0; rep < REPS(1); ++rep) { if (rep) xcd_barrier(bar);
        pg8::GemmDesc g{1024, 1024, 1024};
        pg8::OrderStd S{T / 256, N1 / 256, F.G, (int)blockIdx.x, (const char*)(ws + WS_XN), (const char*)(ws + WS_W1T), (size_t)256 * 1024 * 2, (size_t)256 * 1024 * 2};
        pg8::EpiP1 E{ws, F.dout, I.in[4], I.in[6], I.in[7], (LAS float*)(F.lds + LDSCTL_OFF + 1024)};
        pg8::gemm_phase<pg8::EpiP1, pg8::OrderStd>(F.lds + RING_OFF, g, S, E);
}         SEAM(1);
    }
    if (IN(3)) {
        _Pragma("unroll 1") for (int rep = 0; rep < REPS(3); ++rep) { if (rep) xcd_barrier(bar);
        for (int it = F.vcu; it < 16 * NSEG; it += F.G) gla_pass1(F, it, rep + 1 < REPS(3)); }
        const int gw = F.vcu * NWAVES + F.wave, NGW = F.G * NWAVES;
        _Pragma("unroll 1") for (int rep = 0; rep < REPS(13); ++rep) { if (rep) xcd_barrier(bar);
        for (int j = gw; j < 3 * 4096; j += NGW) attn_job(F, j, rep + 1 < REPS(13)); }
        SEAM(3);
    }
    if (IN(4)) {
        _Pragma("unroll 1") for (int rep = 0; rep < REPS(4); ++rep) { if (rep) xcd_barrier(bar);
        for (int it = F.vcu; it < 16 * NSEG; it += F.G) gla_pass2(F, it, I.in[5], rep + 1 < REPS(4)); }
        _Pragma("unroll 1") for (int rep = 0; rep < REPS(14); ++rep) { if (rep) xcd_barrier(bar); attn_merge_phase(F, rep + 1 < REPS(14)); }
        SEAM(4);
    }
    if (IN(5)) { _Pragma("unroll 1") for (int rep = 0; rep < REPS(5); ++rep) { if (rep) xcd_barrier(bar);
        pg8::GemmDesc g{512, 512, 512};
        pg8::OrderProj2 S{T / 256, 4, F.G, (int)blockIdx.x, (const char*)(ws + WS_GLAV), (const char*)(ws + WS_DILQ), (const char*)(ws + WS_WPGT), (const char*)(ws + WS_WPAT), (size_t)256 * 512 * 2, (size_t)256 * 512 * 2};
        pg8::EpiY E{(bf16*)(ws + WS_GATES), 2048};
        pg8::gemm_phase<pg8::EpiY, pg8::OrderProj2>(F.lds + RING_OFF, g, S, E);
}         SEAM(5);
    }
    if (IN(6)) { _Pragma("unroll 1") for (int rep = 0; rep < REPS(6); ++rep) { if (rep) xcd_barrier(bar);
        pg8::GemmDesc g{1024, 1024, 1024};
        pg8::OrderStd S{T / 256, 2048 / 256, F.G, (int)blockIdx.x, (const char*)(ws + WS_XN), (const char*)(ws + WS_WBGT), (size_t)256 * 1024 * 2, (size_t)256 * 1024 * 2};
        pg8::EpiGateMerge E{(bf16*)(ws + WS_MERGED), (const bf16*)(ws + WS_GATES), I.in[11]};
        pg8::gemm_phase<pg8::EpiGateMerge, pg8::OrderStd>(F.lds + RING_OFF, g, S, E);
}         SEAM(6);
    }
    if (IN(7)) { _Pragma("unroll 1") for (int rep = 0; rep < REPS(7); ++rep) { if (rep) xcd_barrier(bar);
        pg8::GemmDesc g{1024, 1024, 1024};
        pg8::OrderStd S{T / 256, 4, F.G, (int)blockIdx.x, (const char*)(ws + WS_MERGED), (const char*)(ws + WS_WOUTT), (size_t)256 * 1024 * 2, (size_t)256 * 1024 * 2};
        pg8::EpiX1 E{(float*)(ws + WS_X1), I.in[0]};
        pg8::gemm_phase<pg8::EpiX1, pg8::OrderStd>(F.lds + RING_OFF, g, S, E);
}         SEAM(7);
    }
    if (IN(8)) { _Pragma("unroll 1") for (int rep = 0; rep < REPS(8); ++rep) { if (rep) xcd_barrier(bar); router_phase(F, I.in[13], I.in[15], I.in[17], ctl + CW_GCNT, rep + 1 < REPS(8)); } SEAM(8); }
    if (IN(9)) { _Pragma("unroll 1") for (int rep = 0; rep < REPS(9); ++rep) { if (rep) xcd_barrier(bar); moe_assign_phase(F, ctl + CW_GCNT, I.in[13]); } SEAM(9); }
    if (IN(10)) { _Pragma("unroll 1") for (int rep = 0; rep < REPS(10); ++rep) { if (rep) xcd_barrier(bar);
        const int* BLKE = (const int*)(ws + WS_BLKE); const int nblk = BLKE[NBLK_MAX];
        pg8::GemmDesc g{1024, 1024, 1024};
        pg8::OrderMoe S{nblk, F.G, (int)blockIdx.x, BLKE, (const char*)(ws + WS_XP), (const char*)(F.dout + DO_EXPGU), (size_t)256 * 1024 * 2, (size_t)1024 * 1024 * 2, (size_t)256 * 1024 * 2};
        pg8::EpiGU E{(bf16*)(ws + WS_HBUF), (const float*)(ws + WS_ROWW)};
        pg8::gemm_phase<pg8::EpiGU, pg8::OrderMoe>(F.lds + RING_OFF, g, S, E);
}         SEAM(10);
    }
    if (IN(11)) { _Pragma("unroll 1") for (int rep = 0; rep < REPS(11); ++rep) { if (rep) xcd_barrier(bar);
        const int* BLKE = (const int*)(ws + WS_BLKE); const int nblk = BLKE[NBLK_MAX];
        pg8::GemmDesc g{512, 512, 512};
        pg8::OrderMoe S{nblk, F.G, (int)blockIdx.x, BLKE, (const char*)(ws + WS_HBUF), (const char*)(F.dout + DO_EXPDN), (size_t)256 * 512 * 2, (size_t)1024 * 512 * 2, (size_t)256 * 512 * 2};
        pg8::EpiY E{(bf16*)(ws + WS_Y), 1024};
        pg8::gemm_phase<pg8::EpiY, pg8::OrderMoe>(F.lds + RING_OFF, g, S, E);
}         SEAM(11);
    }
    if (IN(12)) { _Pragma("unroll 1") for (int rep = 0; rep < REPS(12); ++rep) { if (rep) xcd_barrier(bar); combine_phase(F, args.out); } }
#undef IN
#undef SEAM
}

extern "C" void kernel_launch(void* const* d_in, const int* in_sizes, int n_in, void* d_out, int out_size, void* d_ws, size_t ws_size, hipStream_t stream) {
    static int grid = 0;
    if (grid == 0) {
        if (n_in != 21 || out_size != T * D || ws_size < WS_END) { fprintf(stderr, "kernel_launch: unexpected shapes (n_in %d out %d ws %zu)\n", n_in, out_size, ws_size); grid = -1; return; }
        int dev = 0, cus = 0, per_cu = 0;
        if (hipGetDevice(&dev) != hipSuccess || hipDeviceGetAttribute(&cus, hipDeviceAttributeMultiprocessorCount, dev) != hipSuccess) { grid = -1; return; }
        if (hipFuncSetAttribute((const void*)fwd_kernel, hipFuncAttributeMaxDynamicSharedMemorySize, LDS_BYTES) != hipSuccess) { fprintf(stderr, "kernel_launch: hipFuncSetAttribute failed\n"); grid = -1; return; }
        if (hipOccupancyMaxActiveBlocksPerMultiprocessor(&per_cu, (const void*)fwd_kernel, NTHR, LDS_BYTES) != hipSuccess || per_cu < 1) fprintf(stderr, "kernel_launch: occupancy query reports %d\n", per_cu);
        (void)hipGetLastError();
        grid = cus;
    }
    if (grid < 0) return;
    if (hipMemsetAsync((char*)d_ws + WS_CTL, 0, CTL_ZERO_BYTES, stream) != hipSuccess) return;
    Args a{};
    for (int i = 0; i < 21; ++i) a.I.in[i] = (const float*)d_in[i];
    a.out = (float*)d_out; a.ws = (unsigned char*)d_ws;
    if (MK_N_LAUNCHES == 1) { a.ph_lo = 0; a.ph_hi = PER_PHASE; a.li = 0; hipLaunchKernelGGL(fwd_kernel, dim3(grid), dim3(NTHR), LDS_BYTES, stream, a); }
    else for (int li = 0; li < PER_PHASE; ++li) { a.ph_lo = li; a.ph_hi = li + 1; a.li = li; hipLaunchKernelGGL(fwd_kernel, dim3(grid), dim3(NTHR), LDS_BYTES, stream, a); }
}
```

```cpp
#include <hip/hip_runtime.h>
#include <cstdio>
#include <cstdint>

#ifndef MK_N_LAUNCHES
#define MK_N_LAUNCHES 1
#endif

#define GAS __attribute__((address_space(1)))
#define LAS __attribute__((address_space(3)))
typedef unsigned short bf16;
typedef unsigned v4u __attribute__((ext_vector_type(4)));
typedef unsigned v2u __attribute__((ext_vector_type(2)));
typedef float f32x2 __attribute__((ext_vector_type(2)));
typedef float f32x4 __attribute__((ext_vector_type(4)));
typedef float f32x16 __attribute__((ext_vector_type(16)));
typedef short bf16x8 __attribute__((ext_vector_type(8)));
typedef short bf16x4 __attribute__((ext_vector_type(4)));
typedef __bf16 hbf2 __attribute__((ext_vector_type(2)));

#define DI __device__ __forceinline__
DI unsigned pk2(float lo, float hi) { f32x2 v = {lo, hi}; hbf2 r = __builtin_convertvector(v, hbf2); return __builtin_bit_cast(unsigned, r); }
DI bf16 f2bf(float f) { return (bf16)(pk2(f, 0.f) & 0xffffu); }
DI float bf2f(bf16 b) { return __builtin_bit_cast(float, ((unsigned)b) << 16); }
DI float bflo(unsigned u) { return __builtin_bit_cast(float, u << 16); }
DI float bfhi(unsigned u) { return __builtin_bit_cast(float, u & 0xffff0000u); }

constexpr int T = 32768, D = 1024, SEQ = 8192;
constexpr int N1 = 7168;
constexpr int IN_COLS = 6672;
constexpr int NSEG = 16, TSEG = SEQ / NSEG;
constexpr float EPS = 1e-6f;
constexpr float LOG2E = 1.4426950408889634f;
constexpr int PMAX = 65536 + 32 * 256;
constexpr int NBLK_MAX = PMAX / 256;

constexpr size_t MiB = 1u << 20;
constexpr size_t WS_CTL = 0, CTL_ZERO_BYTES = 256 * 1024;
constexpr size_t WS_LB = 1 * MiB;
constexpr size_t WS_W1T = 1 * MiB;
constexpr size_t WS_WBGT = 15 * MiB, WS_WPGT = 19 * MiB, WS_WPAT = 20 * MiB, WS_WOUTT = 21 * MiB, WS_WRH = 23 * MiB;
constexpr size_t WS_XN = 24 * MiB;
constexpr size_t WS_GLAQ = 88 * MiB, WS_GLAK = 120 * MiB, WS_LOGA = 152 * MiB, WS_GLAV = 184 * MiB;
constexpr size_t WS_DILQ = 216 * MiB, WS_DILK = 312 * MiB, WS_DILV = 408 * MiB;
constexpr size_t WS_STATS = 504 * MiB;
constexpr size_t WS_LSE = WS_STATS;
constexpr size_t WS_DSEG = WS_STATS + 1536 * 1024;
constexpr size_t WS_TOKE = WS_STATS + 2 * MiB;
constexpr size_t WS_TOKW = WS_TOKE + 256 * 1024;
constexpr size_t WS_TOKR = WS_TOKW + 256 * 1024;
constexpr size_t WS_DEST = WS_TOKR + 256 * 1024;
constexpr size_t WS_ROWW = WS_DEST + 256 * 1024;
constexpr size_t WS_BLKE = WS_ROWW + 640 * 1024;
constexpr size_t WS_END = 512 * MiB;
constexpr size_t WS_GATES = 376 * MiB;
constexpr size_t WS_MERGED = 312 * MiB;
constexpr size_t WS_X1 = 88 * MiB;
constexpr size_t WS_H2 = 24 * MiB;
constexpr size_t WS_XP = 216 * MiB;
constexpr size_t WS_HBUF = 360 * MiB;
constexpr size_t WS_Y = 216 * MiB;
constexpr size_t DO_R = 0;
constexpr size_t DO_EXPGU = 32 * MiB;
constexpr size_t DO_EXPDN = 96 * MiB;
constexpr int CW_BAR = 4096;
constexpr int CW_GCNT = 16384;

constexpr int RING_OFF = 0, RING_BYTES = 131072;
constexpr int LDSCTL_OFF = RING_BYTES, MISC_OFF = LDSCTL_OFF + 320;
constexpr int LDS_BYTES = 147456;

#define XB_TMO      128
#define XB_XCNT(j)  (256  + 64 * (j))
#define XB_XSUB(j)  (1280 + 64 * (j))
#define XB_XGEN(j)  (2304 + 64 * (j))
#define XB_TOP      3328
#define XB_TOPGEN   3392
#define XCD_BAR_WORDS 3456
#define XB_SPIN_CAP (1u << 18)
DI unsigned xb_ld(unsigned* p)              { return __hip_atomic_load(p, __ATOMIC_RELAXED, __HIP_MEMORY_SCOPE_AGENT); }
DI unsigned xb_add(unsigned* p, unsigned v) { return __hip_atomic_fetch_add(p, v, __ATOMIC_RELAXED, __HIP_MEMORY_SCOPE_AGENT); }
DI unsigned xb_xcc_id() { return (unsigned)__builtin_amdgcn_s_getreg((3 << 11) | 20) & 0xFu; }
#define XB_SPIN(cond, bar) do { unsigned _sp = 0; while (cond) { __builtin_amdgcn_s_sleep(1); \
    if ((++_sp & 255u) == 0u) { if (xb_ld(&(bar)[XB_TMO])) break; if (_sp > XB_SPIN_CAP) { atomicAdd(&(bar)[XB_TMO], 1u); break; } } } } while (0)
struct XcdBarrier { unsigned* bar; unsigned x; volatile LAS unsigned* st; };
DI XcdBarrier xcd_barrier_post(unsigned* bar, volatile LAS unsigned* st) {
    XcdBarrier b; b.bar = bar; b.x = xb_xcc_id(); b.st = st;
    if (threadIdx.x == 0) (void)xb_add(&bar[XB_XCNT(b.x)], 1u);
    return b;
}
DI void xcd_barrier_complete(unsigned* bar, unsigned x, unsigned& nloc, unsigned& nx) {
    const unsigned G = gridDim.x * gridDim.y * gridDim.z;
    unsigned sum, cnt, mine, sp = 0u;
    for (;;) {
        sum = 0u; cnt = 0u; mine = 0u;
#pragma unroll
        for (unsigned j = 0; j < 16; ++j) { const unsigned c = xb_ld(&bar[XB_XCNT(j)]); sum += c; cnt += (c > 0u) ? 1u : 0u; mine = (j == x) ? c : mine; }
        if (sum == G) break;
        __builtin_amdgcn_s_sleep(1);
        if ((++sp & 255u) == 0u) { if (xb_ld(&bar[XB_TMO])) break; if (sp > XB_SPIN_CAP) { atomicAdd(&bar[XB_TMO], 1u); break; } }
    }
    nloc = mine > 0u ? mine : 1u; nx = cnt > 0u ? cnt : 1u;
}
DI void xcd_barrier(const XcdBarrier& b) {
    asm volatile("s_waitcnt vmcnt(0)" ::: "memory");
    __syncthreads();
    if (threadIdx.x == 0) {
        unsigned* bar = b.bar;
        __builtin_amdgcn_s_waitcnt(0);
        unsigned nloc = b.st[0], nx = b.st[1];
        if (nloc == 0u) { xcd_barrier_complete(bar, b.x, nloc, nx); b.st[0] = nloc; b.st[1] = nx; }
        const unsigned old = xb_add(&bar[XB_XSUB(b.x)], 1u);
        const unsigned gen = old / nloc;
        if (old + 1u == (gen + 1u) * nloc) {
            __builtin_amdgcn_fence(__ATOMIC_RELEASE, "agent");
            asm volatile("s_waitcnt vmcnt(0)" ::: "memory");
            const unsigned og = xb_add(&bar[XB_TOP], 1u);
            const unsigned tg = og / nx;
            if (og + 1u == (tg + 1u) * nx) xb_add(&bar[XB_TOPGEN], 1u);
            else XB_SPIN(xb_ld(&bar[XB_TOPGEN]) == tg, bar);
            __builtin_amdgcn_fence(__ATOMIC_ACQUIRE, "agent");
            xb_add(&bar[XB_XGEN(b.x)], 1u);
            asm volatile("s_waitcnt vmcnt(0)" ::: "memory");
        } else {
            XB_SPIN(xb_ld(&bar[XB_XGEN(b.x)]) == gen, bar);
            __builtin_amdgcn_fence(__ATOMIC_ACQUIRE, "agent");
            asm volatile("s_waitcnt vmcnt(0)" ::: "memory");
        }
    }
    __syncthreads();
}

namespace pg8 {
constexpr int BM = 256, BK = 64, HALF = 128, HTB = HALF * BK * 2, STAGE_BYTES = 8 * HTB, NXCD = 8, WGM = 8;
__host__ __device__ __forceinline__ int lds_byte(int r, int c) { const int st = (r >> 4) * 2 + (c >> 5), rr = r & 15, cc = c & 31, ob = rr * 64 + cc * 2; return st * 1024 + (ob ^ (((ob >> 9) & 1) << 5)); }
__host__ __device__ __forceinline__ void stage_rc(int b, int& R, int& C) { const int st = b / 1024, sb = b % 1024, swz = sb ^ (((sb >> 9) & 1) << 5); R = (st >> 1) * 16 + swz / 64; C = (st & 1) * 32 + (swz % 64) / 2; }
__host__ __device__ __forceinline__ int perm32(int rho) { const int n = rho >> 4, i = rho & 15; return 8 * (i >> 2) + 4 * n + (i & 3); }

struct Unit { const char* A; const char* B; int pm, pn, aux; };
struct GemmDesc { int lda, ldb, K; };

DI bool static_tile(int L, int nM, int nN, int& pm, int& pn) {
    const int nwg = nM * nN; if (L >= nwg) return false;
    int wgid = L; { const int q = nwg / NXCD, r = nwg % NXCD, xcd = wgid % NXCD, off = wgid / NXCD; wgid = (xcd < r ? xcd * (q + 1) : r * (q + 1) + (xcd - r) * q) + off; }
    const int nig = WGM * nN, gid = wgid / nig, fm = gid * WGM, gsz = (nM - fm) < WGM ? (nM - fm) : WGM;
    pm = fm + ((wgid % nig) % gsz); pn = (wgid % nig) / gsz; return true;
}
struct OrderStd {
    int nM, nN, G, c; const char* A0; const char* B0; size_t sA, sB;
    DI bool next(int i, Unit& u) const {
        int pm, pn; if (!static_tile(i * G + c, nM, nN, pm, pn)) return false;
        u.pm = pm; u.pn = pn; u.aux = 0; u.A = A0 + (size_t)pm * sA; u.B = B0 + (size_t)pn * sB; return true;
    }
};
struct OrderPair {
    int nM, nN, G, c; const char* A0; const char* A1; const char* B0; const char* B1; size_t sA, sB;
    DI bool next(int i, Unit& u) const {
        int pm, pn; if (!static_tile((i >> 1) * G + c, nM, nN, pm, pn)) return false;
        const int br = i & 1; u.pm = pm; u.pn = pn; u.aux = br; u.A = (br ? A1 : A0) + (size_t)pm * sA; u.B = (br ? B1 : B0) + (size_t)pn * sB; return true;
    }
};
struct OrderProj2 {
    int nM, nh, G, c; const char* A0; const char* A1; const char* B0; const char* B1; size_t sA, sB;
    DI bool next(int i, Unit& u) const {
        int pm, pn; if (!static_tile(i * G + c, nM, 2 * nh, pm, pn)) return false;
        const int br = pn >= nh; u.pm = pm; u.pn = pn; u.aux = br; u.A = (br ? A1 : A0) + (size_t)pm * sA; u.B = (br ? B1 : B0) + (size_t)(pn - br * nh) * sB; return true;
    }
};
struct OrderMoe {
    int nblk, G, c; const int* blke; const char* A0; const char* B0; size_t sA, sE, sB;
    DI bool next(int i, Unit& u) const {
        int rb, pn;
        if ((G & 31) == 0) { const int R = G >> 2, per = R >> 3, loc = c >> 3; rb = i * R + (c & 7) * per + (loc >> 2); pn = loc & 3; }
        else { const int L = i * G + c; rb = L >> 2; pn = L & 3; }
        if (rb >= nblk) return false;
        const int e = blke[rb];
        u.pm = rb; u.pn = pn; u.aux = 0;
        u.A = A0 + (size_t)rb * sA; u.B = B0 + (size_t)e * sE + (size_t)pn * sB; return true;
    }
};

#define PG8_LAS __attribute__((address_space(3)))
template <class Epi, class Sched, bool ALIGN_EPI = true, bool SP2 = true>
DI void gemm_phase(PG8_LAS unsigned char* lds, const GemmDesc g, const Sched& S, const Epi& E) {
    const int tid = threadIdx.x, wid = __builtin_amdgcn_readfirstlane(tid >> 6), lane = tid & 63, wr = wid >> 2, wc = wid & 3, fr = lane & 15, fq = lane >> 4;
    const int K = g.K, nt = K / BK;
    unsigned voffA[2], voffB[2];
#pragma unroll
    for (int i = 0; i < 2; ++i) { int R, C; stage_rc(tid * 16 + i * 8192, R, C); const int Rb = Epi::PERM ? ((R & ~31) + perm32(R & 31)) : R;
        voffA[i] = (unsigned)(R * g.lda + C) * 2u; voffB[i] = (unsigned)(Rb * g.ldb + C) * 2u; }
    const size_t kstep = (size_t)(BK * 2);
    const size_t hstepA = (size_t)HALF * g.lda * 2, hstepB = (size_t)HALF * g.ldb * 2;
    const unsigned ldsw = (unsigned)wid * 1024u;
    const int aoff = lds_byte(wr * 64 + fr, fq * 8), boff = lds_byte(wc * 32 + fr, fq * 8);
#define PG8_SA(b, h) (((b) * 2 + (h)) * HTB)
#define PG8_SB(b, h) ((4 + (b) * 2 + (h)) * HTB)
#define PG8_STAGE(bufoff, gbase, voff) do { _Pragma("unroll") for (int _i = 0; _i < 2; ++_i) \
        __builtin_amdgcn_global_load_lds((const unsigned*)((const char*)(gbase) + (voff)[_i]), (PG8_LAS unsigned*)(lds + (bufoff) + ldsw + _i * 8192), 16, 0, 0); } while (0)
#define PG8_LDA(dst, b, h) do { _Pragma("unroll") for (int m = 0; m < 4; ++m) _Pragma("unroll") for (int k = 0; k < 2; ++k) dst[m][k] = *(const PG8_LAS bf16x8*)(lds + PG8_SA(b, h) + aoff + m * 2048 + k * 1024); } while (0)
#define PG8_LDB(dst, b, h) do { _Pragma("unroll") for (int n = 0; n < 2; ++n) _Pragma("unroll") for (int k = 0; k < 2; ++k) dst[n][k] = *(const PG8_LAS bf16x8*)(lds + PG8_SB(b, h) + boff + n * 2048 + k * 1024); } while (0)
#define PG8_MMA(ai, bj, At, Bt) do { __builtin_amdgcn_s_setprio(1); _Pragma("unroll") for (int m = 0; m < 4; ++m) _Pragma("unroll") for (int n = 0; n < 2; ++n) _Pragma("unroll") for (int k = 0; k < 2; ++k) \
        acc[ai][bj][m][n] = __builtin_amdgcn_mfma_f32_16x16x32_bf16(Bt[n][k], At[m][k], acc[ai][bj][m][n], 0, 0, 0); __builtin_amdgcn_s_setprio(0); } while (0)
#define PG8_WAIT_V(n) asm volatile("s_waitcnt vmcnt(" #n ")" ::: "memory")
#define PG8_WAIT_L(n) asm volatile("s_waitcnt lgkmcnt(" #n ")" ::: "memory")
#define PG8_BAR __builtin_amdgcn_s_barrier()
#define PG8_SCHED __builtin_amdgcn_sched_barrier(0)
    Unit cur, nxt; int ui = 0;
    if (!S.next(0, cur)) return;
    f32x4 acc[2][2][4][2];
#pragma unroll
    for (int a = 0; a < 2; ++a)
#pragma unroll
        for (int b = 0; b < 2; ++b)
#pragma unroll
            for (int m = 0; m < 4; ++m)
#pragma unroll
                for (int n = 0; n < 2; ++n) acc[a][b][m][n] = (f32x4){0.f, 0.f, 0.f, 0.f};
    bf16x8 At[4][2], B0[2][2], B1[2][2];
    const char* cA = cur.A; const char* cB = cur.B;
    if constexpr (SP2) {
        PG8_STAGE(PG8_SB(0, 0), cB, voffB); PG8_STAGE(PG8_SB(0, 1), cB + hstepB, voffB); PG8_STAGE(PG8_SA(0, 0), cA, voffA); PG8_STAGE(PG8_SA(0, 1), cA + hstepA, voffA);
        if (wr == 1) PG8_BAR;
        PG8_WAIT_V(2); PG8_BAR;
        PG8_STAGE(PG8_SB(1, 0), cB + kstep, voffB); PG8_STAGE(PG8_SA(1, 0), cA + kstep, voffA); PG8_STAGE(PG8_SB(1, 1), cB + hstepB + kstep, voffB);
        PG8_WAIT_V(6); PG8_BAR;
    } else {
        PG8_STAGE(PG8_SB(0, 0), cB, voffB); PG8_STAGE(PG8_SA(0, 0), cA, voffA); PG8_STAGE(PG8_SB(0, 1), cB + hstepB, voffB); PG8_STAGE(PG8_SA(0, 1), cA + hstepA, voffA);
        if (wr == 1) PG8_BAR;
        PG8_WAIT_V(4); PG8_BAR;
        PG8_STAGE(PG8_SB(1, 0), cB + kstep, voffB); PG8_STAGE(PG8_SA(1, 0), cA + kstep, voffA); PG8_STAGE(PG8_SB(1, 1), cB + hstepB + kstep, voffB);
        PG8_WAIT_V(6); PG8_BAR;
    }
    for (;;) {
        const bool has_next = S.next(ui + 1, nxt);
        const char* nA = has_next ? nxt.A : cA; const char* nB = has_next ? nxt.B : cB;
        for (int t = 0; t < nt; t += 2) {
            const bool last = (t == nt - 2);
            const char* a1 = cA + (size_t)(t + 1) * kstep;
            const char* a2 = last ? nA : cA + (size_t)(t + 2) * kstep; const char* b2 = last ? nB : cB + (size_t)(t + 2) * kstep;
            const char* a3 = a2 + kstep; const char* b3 = b2 + kstep;
            if constexpr (SP2) {
            PG8_LDB(B0, 0, 0); PG8_LDB(B1, 0, 1); PG8_SCHED; PG8_LDA(At, 0, 0); PG8_STAGE(PG8_SA(1, 1), a1 + hstepA, voffA);
            PG8_WAIT_V(8); PG8_WAIT_L(0); PG8_BAR; PG8_MMA(0, 0, At, B0); PG8_MMA(0, 1, At, B1); PG8_BAR; PG8_SCHED;
            PG8_LDA(At, 0, 1); PG8_STAGE(PG8_SB(0, 0), b2, voffB); PG8_STAGE(PG8_SB(0, 1), b2 + hstepB, voffB); PG8_STAGE(PG8_SA(0, 0), a2, voffA);
            PG8_WAIT_V(8); PG8_WAIT_L(0); PG8_BAR; PG8_MMA(1, 0, At, B0); PG8_MMA(1, 1, At, B1); PG8_BAR; PG8_SCHED;
            PG8_LDB(B0, 1, 0); PG8_LDB(B1, 1, 1); PG8_SCHED; PG8_LDA(At, 1, 0); PG8_STAGE(PG8_SA(0, 1), a2 + hstepA, voffA);
            PG8_WAIT_V(8); PG8_WAIT_L(0); PG8_BAR; PG8_MMA(0, 0, At, B0); PG8_MMA(0, 1, At, B1); PG8_BAR; PG8_SCHED;
            PG8_LDA(At, 1, 1); PG8_STAGE(PG8_SB(1, 0), b3, voffB); PG8_STAGE(PG8_SB(1, 1), b3 + hstepB, voffB); PG8_STAGE(PG8_SA(1, 0), a3, voffA);
            PG8_WAIT_V(8); PG8_WAIT_L(0); PG8_BAR; PG8_MMA(1, 0, At, B0); PG8_MMA(1, 1, At, B1); PG8_BAR; PG8_SCHED;
            } else {
            PG8_LDB(B0, 0, 0); PG8_SCHED; PG8_LDA(At, 0, 0); PG8_STAGE(PG8_SA(1, 1), a1 + hstepA, voffA);
            PG8_WAIT_L(8); PG8_BAR; PG8_WAIT_L(0); PG8_MMA(0, 0, At, B0); PG8_BAR; PG8_SCHED;
            PG8_LDB(B1, 0, 1); PG8_STAGE(PG8_SB(0, 0), b2, voffB);
            PG8_BAR; PG8_WAIT_L(0); PG8_MMA(0, 1, At, B1); PG8_BAR;
            PG8_LDA(At, 0, 1); PG8_STAGE(PG8_SA(0, 0), a2, voffA);
            PG8_BAR; PG8_WAIT_L(0); PG8_MMA(1, 0, At, B0); PG8_BAR; PG8_SCHED;
            PG8_STAGE(PG8_SB(0, 1), b2 + hstepB, voffB);
            PG8_WAIT_V(6); PG8_BAR; PG8_MMA(1, 1, At, B1); PG8_BAR;
            PG8_LDB(B0, 1, 0); PG8_SCHED; PG8_LDA(At, 1, 0); PG8_STAGE(PG8_SA(0, 1), a2 + hstepA, voffA);
            PG8_WAIT_L(8); PG8_BAR; PG8_WAIT_L(0); PG8_MMA(0, 0, At, B0); PG8_BAR; PG8_SCHED;
            PG8_LDB(B1, 1, 1); PG8_STAGE(PG8_SB(1, 0), b3, voffB);
            PG8_BAR; PG8_WAIT_L(0); PG8_MMA(0, 1, At, B1); PG8_BAR;
            PG8_LDA(At, 1, 1); PG8_STAGE(PG8_SA(1, 0), a3, voffA);
            PG8_BAR; PG8_WAIT_L(0); PG8_MMA(1, 0, At, B0); PG8_BAR; PG8_SCHED;
            PG8_STAGE(PG8_SB(1, 1), b3 + hstepB, voffB);
            PG8_WAIT_V(6); PG8_BAR; PG8_MMA(1, 1, At, B1); PG8_BAR;
            }
        }
        if constexpr (ALIGN_EPI) { if (wr == 0) PG8_BAR; }
        E(acc, cur, wr, wc, fr, fq);
        if (!has_next) break;
#pragma unroll
        for (int a = 0; a < 2; ++a)
#pragma unroll
            for (int b = 0; b < 2; ++b)
#pragma unroll
                for (int m = 0; m < 4; ++m)
#pragma unroll
                    for (int n = 0; n < 2; ++n) acc[a][b][m][n] = (f32x4){0.f, 0.f, 0.f, 0.f};
        cur = nxt; cA = nA; cB = nB; ++ui;
        if constexpr (ALIGN_EPI) { if (wr == 1) PG8_BAR; }
    }
    PG8_WAIT_V(0);
    if constexpr (!ALIGN_EPI) { if (wr == 0) PG8_BAR; }
    PG8_BAR;
#undef PG8_SA
#undef PG8_SB
#undef PG8_STAGE
#undef PG8_LDA
#undef PG8_LDB
#undef PG8_MMA
#undef PG8_WAIT_V
#undef PG8_WAIT_L
#undef PG8_BAR
#undef PG8_SCHED
}

typedef f32x4 AccT[2][2][4][2];
DI float sigmoid_f(float v) { return __builtin_amdgcn_rcpf(1.f + __expf(-v)); }
DI float silu_f(float v) { return v * sigmoid_f(v); }
DI float logsig16(float v) { return (fminf(v, 0.f) - __logf(1.f + __expf(-fabsf(v)))) * 0.0625f; }
DI v4u pack8(f32x4 a, f32x4 b) { v4u w; w.x = pk2(a[0], a[1]); w.y = pk2(a[2], a[3]); w.z = pk2(b[0], b[1]); w.w = pk2(b[2], b[3]); return w; }

struct EpiP1 {
    static constexpr bool PERM = true;
    unsigned char* ws; unsigned char* dout; const float* b_a; const float* gq; const float* gk; LAS float* xch;
    DI void operator()(const AccT& acc, const Unit& u, int wr, int wc, int fr, int fq) const {
        const int pn = u.pn, row0 = u.pm * BM + wr * 64 + fr, cl = wc * 32 + 8 * fq;
        const int rem = pn >= 10 ? (pn - 10) % 6 : 6, gi = pn >= 10 ? (pn - 10) / 6 : 0;
        int mode = 0; const int colbase = (pn & 1) * 256; size_t off;
        if (pn < 10) { const int bi = pn >> 1; off = bi == 0 ? WS_GLAQ : (bi == 1 ? WS_GLAK : (bi == 2 ? WS_GLAV : (bi == 3 ? DO_R : WS_LOGA))); mode = bi == 3 ? 1 : (bi == 4 ? 2 : 0); }
        else { off = (rem < 2 ? WS_DILQ : (rem < 4 ? WS_DILK : WS_DILV)) + (size_t)gi * T * 1024; mode = rem < 4 ? 3 : 0; }
        bf16* dst = (bf16*)(((pn >> 1) == 3 ? dout : ws) + off);
        if (mode == 3) {
            const bool isq = rem < 2;
#pragma unroll
            for (int ai = 0; ai < 2; ++ai)
#pragma unroll
                for (int m = 0; m < 4; ++m)
#pragma unroll
                    for (int bj = 0; bj < 2; ++bj) { const f32x4 v0 = acc[ai][bj][m][0], v1 = acc[ai][bj][m][1];
                        float ss = (v0[0] * v0[0] + v0[1] * v0[1]) + (v0[2] * v0[2] + v0[3] * v0[3]) + (v1[0] * v1[0] + v1[1] * v1[1]) + (v1[2] * v1[2] + v1[3] * v1[3]);
                        ss += __shfl_xor(ss, 16); ss += __shfl_xor(ss, 32);
                        if (fq == 0) xch[(ai * 128 + wr * 64 + m * 16 + fr) * 8 + bj * 4 + wc] = ss; }
            asm volatile("s_waitcnt lgkmcnt(0)" ::: "memory"); __builtin_amdgcn_s_barrier(); asm volatile("" ::: "memory");
            const float* gp = (isq ? gq : gk) + gi * 128 + cl; const f32x4 g0 = *(const f32x4*)gp, g1 = *(const f32x4*)(gp + 4);
            const float qs = isq ? 0.08838834764831845f * LOG2E : 1.f;
#pragma unroll
            for (int ai = 0; ai < 2; ++ai)
#pragma unroll
                for (int m = 0; m < 4; ++m) { bf16* rowp = dst + (size_t)(row0 + ai * HALF + m * 16) * 512 + colbase + cl;
#pragma unroll
                    for (int bj = 0; bj < 2; ++bj) { const f32x4 t = *(const LAS f32x4*)(xch + (ai * 128 + wr * 64 + m * 16 + fr) * 8 + bj * 4);
                        const float rinv = __frsqrt_rn(((t[0] + t[1]) + (t[2] + t[3])) * (1.f / 128.f) + EPS) * qs;
                        *(v4u*)(rowp + bj * HALF) = pack8(acc[ai][bj][m][0] * rinv * g0, acc[ai][bj][m][1] * rinv * g1); } }
            return;
        }
        f32x4 bv[2][2];
#pragma unroll
        for (int bj = 0; bj < 2; ++bj)
#pragma unroll
            for (int n = 0; n < 2; ++n) bv[bj][n] = (mode == 2) ? *(const f32x4*)(b_a + colbase + bj * HALF + cl + 4 * n) : (f32x4){0.f, 0.f, 0.f, 0.f};
#pragma unroll
        for (int ai = 0; ai < 2; ++ai)
#pragma unroll
            for (int m = 0; m < 4; ++m) { bf16* rowp = dst + (size_t)(row0 + ai * HALF + m * 16) * 512 + colbase + cl;
#pragma unroll
                for (int bj = 0; bj < 2; ++bj) { f32x4 v0 = acc[ai][bj][m][0] + bv[bj][0], v1 = acc[ai][bj][m][1] + bv[bj][1];
                    if (mode == 1) {
#pragma unroll
                        for (int j = 0; j < 4; ++j) { v0[j] = silu_f(v0[j]); v1[j] = silu_f(v1[j]); } }
                    if (mode == 2) {
#pragma unroll
                        for (int j = 0; j < 4; ++j) { v0[j] = logsig16(v0[j]); v1[j] = logsig16(v1[j]); } }
                    *(v4u*)(rowp + bj * HALF) = pack8(v0, v1); } }
    }
};
struct EpiGateMerge {
    static constexpr bool PERM = true;
    bf16* Mg; const bf16* Y; const float* bias;
    DI void operator()(const AccT& acc, const Unit& u, int wr, int wc, int fr, int fq) const {
        const int row0 = u.pm * BM + wr * 64 + fr, col0 = u.pn * HALF + wc * 32 + 8 * fq;
        f32x4 bv[2][2];
#pragma unroll
        for (int bj = 0; bj < 2; ++bj)
#pragma unroll
            for (int n = 0; n < 2; ++n) bv[bj][n] = *(const f32x4*)(bias + bj * 1024 + col0 + 4 * n);
#pragma unroll
        for (int ai = 0; ai < 2; ++ai)
#pragma unroll
            for (int m = 0; m < 4; ++m) { const size_t row = (size_t)(row0 + ai * HALF + m * 16);
                const v4u yg = *(const v4u*)(Y + row * 2048 + col0), ya = *(const v4u*)(Y + row * 2048 + 1024 + col0);
                f32x4 g0 = acc[ai][0][m][0] + bv[0][0], g1 = acc[ai][0][m][1] + bv[0][1], a0 = acc[ai][1][m][0] + bv[1][0], a1 = acc[ai][1][m][1] + bv[1][1];
#pragma unroll
                for (int j = 0; j < 4; ++j) { g0[j] = sigmoid_f(g0[j]); g1[j] = sigmoid_f(g1[j]); a0[j] = sigmoid_f(a0[j]); a1[j] = sigmoid_f(a1[j]); }
                f32x4 o0, o1;
                o0[0] = g0[0] * bflo(yg.x) + a0[0] * bflo(ya.x); o0[1] = g0[1] * bfhi(yg.x) + a0[1] * bfhi(ya.x); o0[2] = g0[2] * bflo(yg.y) + a0[2] * bflo(ya.y); o0[3] = g0[3] * bfhi(yg.y) + a0[3] * bfhi(ya.y);
                o1[0] = g1[0] * bflo(yg.z) + a1[0] * bflo(ya.z); o1[1] = g1[1] * bfhi(yg.z) + a1[1] * bfhi(ya.z); o1[2] = g1[2] * bflo(yg.w) + a1[2] * bflo(ya.w); o1[3] = g1[3] * bfhi(yg.w) + a1[3] * bfhi(ya.w);
                *(v4u*)(Mg + row * 1024 + col0) = pack8(o0, o1); }
    }
};
struct EpiX1 {
    static constexpr bool PERM = true;
    bf16* X1; const float* X;
    DI void operator()(const AccT& acc, const Unit& u, int wr, int wc, int fr, int fq) const {
        const int row0 = u.pm * BM + wr * 64 + fr, col0 = u.pn * BM + wc * 32 + 8 * fq;
#pragma unroll
        for (int ai = 0; ai < 2; ++ai)
#pragma unroll
            for (int m = 0; m < 4; ++m) { const size_t ro = (size_t)(row0 + ai * HALF + m * 16) * 1024 + col0;
#pragma unroll
                for (int bj = 0; bj < 2; ++bj) *(v4u*)(X1 + ro + bj * HALF) = pack8(acc[ai][bj][m][0] + *(const f32x4*)(X + ro + bj * HALF), acc[ai][bj][m][1] + *(const f32x4*)(X + ro + bj * HALF + 4)); }
    }
};
struct EpiGU {
    static constexpr bool PERM = true;
    bf16* H; const f32x2* roww;
    DI void operator()(const AccT& acc, const Unit& u, int wr, int wc, int fr, int fq) const {
        const int row0 = u.pm * BM + wr * 64 + fr, hc0 = u.pn * 128 + wc * 16 + 4 * fq;
#pragma unroll
        for (int ai = 0; ai < 2; ++ai)
#pragma unroll
            for (int m = 0; m < 4; ++m) { const int row = row0 + ai * HALF + m * 16; const f32x2 wv = roww[row]; const float ri = wv.y, w = wv.x * ri;
#pragma unroll
                for (int bj = 0; bj < 2; ++bj) { const f32x4 g = acc[ai][bj][m][0] * ri, up = acc[ai][bj][m][1];
                    v2u o; o.x = pk2(w * silu_f(g[0]) * up[0], w * silu_f(g[1]) * up[1]); o.y = pk2(w * silu_f(g[2]) * up[2], w * silu_f(g[3]) * up[3]);
                    *(v2u*)(H + (size_t)row * 512 + hc0 + bj * 64) = o; } }
    }
};
struct EpiY {
    static constexpr bool PERM = true;
    bf16* Y; int ld;
    DI void operator()(const AccT& acc, const Unit& u, int wr, int wc, int fr, int fq) const {
        const int row0 = u.pm * BM + wr * 64 + fr, col0 = u.pn * BM + wc * 32 + 8 * fq;
#pragma unroll
        for (int ai = 0; ai < 2; ++ai)
#pragma unroll
            for (int m = 0; m < 4; ++m) { bf16* rowp = Y + (size_t)(row0 + ai * HALF + m * 16) * ld + col0;
#pragma unroll
                for (int bj = 0; bj < 2; ++bj) *(v4u*)(rowp + bj * HALF) = pack8(acc[ai][bj][m][0], acc[ai][bj][m][1]); }
    }
};
}

constexpr int NWAVES = 8, NTHR = 512;
struct Frame {
    LAS unsigned char* lds;
    int tid, lane, wave, vcu, G;
    unsigned char* ws; unsigned char* dout;
};
#define LDS_WAIT() asm volatile("s_waitcnt lgkmcnt(0)" ::: "memory")
#define LDS_BARRIER() do { asm volatile("s_waitcnt lgkmcnt(0)" ::: "memory"); __builtin_amdgcn_s_barrier(); asm volatile("" ::: "memory"); } while (0)
DI float wave_sum(float v) {
#pragma unroll
    for (int o = 1; o < 64; o <<= 1) v += __shfl_xor(v, o);
    return v;
}
#define MFMA16(a, b, c) __builtin_amdgcn_mfma_f32_16x16x32_bf16((a), (b), (c), 0, 0, 0)
#define MFMA32(a, b, c) __builtin_amdgcn_mfma_f32_32x32x16_bf16((a), (b), (c), 0, 0, 0)

struct TItem { const float* src; bf16* dst; const float* gain; int ldw, ldd, kind, aux; };
struct Ins { const float* in[21]; };
constexpr int I_IN = 16 * 208, I_BG = 16 * 64, I_PG = 8 * 32, I_PA = 8 * 32, I_OUT = 16 * 32, I_GU = 32 * 2 * 16 * 16, I_DN = 32 * 8 * 32;
constexpr int NITEMS = I_IN + I_BG + I_PG + I_PA + I_OUT + I_GU + I_DN;
DI TItem p0_decode(const Frame& F, const Ins& I, int it) {
    TItem t; int r = it; t.gain = nullptr;
    if (r < I_IN) { const int kb = r / 208, nb = r % 208; const int n0 = nb < 64 ? nb * 32 : (nb - 64) * 32 + 2560, c0 = nb < 64 ? n0 : n0 - 496;
        t.src = I.in[2] + (size_t)kb * 64 * IN_COLS + c0; t.ldw = IN_COLS; t.dst = (bf16*)(F.ws + WS_W1T) + kb * 64; t.ldd = 1024; t.kind = 0; t.aux = n0; return t; } r -= I_IN;
    if (r < I_BG) { const int kb = r / 64, nb = r % 64; t.src = I.in[10] + (size_t)kb * 64 * 2048 + nb * 32; t.ldw = 2048; t.dst = (bf16*)(F.ws + WS_WBGT) + kb * 64; t.ldd = 1024; t.kind = 1; t.aux = nb * 32; return t; } r -= I_BG;
    if (r < I_PG) { const int kb = r / 32, nb = r % 32; t.src = I.in[8] + (size_t)kb * 64 * 1024 + nb * 32; t.ldw = 1024; t.dst = (bf16*)(F.ws + WS_WPGT) + kb * 64; t.ldd = 512; t.kind = 0; t.aux = nb * 32; return t; } r -= I_PG;
    if (r < I_PA) { const int kb = r / 32, nb = r % 32; t.src = I.in[9] + (size_t)kb * 64 * 1024 + nb * 32; t.ldw = 1024; t.dst = (bf16*)(F.ws + WS_WPAT) + kb * 64; t.ldd = 512; t.kind = 0; t.aux = nb * 32; return t; } r -= I_PA;
    if (r < I_OUT) { const int kb = r / 32, nb = r % 32; t.src = I.in[12] + (size_t)kb * 64 * 1024 + nb * 32; t.ldw = 1024; t.dst = (bf16*)(F.ws + WS_WOUTT) + kb * 64; t.ldd = 1024; t.kind = 0; t.aux = nb * 32; return t; } r -= I_OUT;
    if (r < I_GU) { const int e = r / 512, q = r % 512, up = q >> 8, kb = (q >> 4) & 15, nb = q & 15;
        t.src = (up ? I.in[19] : I.in[18]) + (size_t)e * 1024 * 512 + (size_t)kb * 64 * 512 + nb * 32; t.ldw = 512; t.dst = (bf16*)(F.dout + DO_EXPGU) + (size_t)e * 1024 * 1024 + kb * 64; t.ldd = 1024; t.kind = 2; t.aux = nb * 32 * 2 + up; t.gain = I.in[13] + kb * 64; return t; } r -= I_GU;
    { const int e = r / 256, q = r % 256, kb = q / 32, nb = q % 32;
        t.src = I.in[20] + (size_t)e * 512 * 1024 + (size_t)kb * 64 * 1024 + nb * 32; t.ldw = 1024; t.dst = (bf16*)(F.dout + DO_EXPDN) + (size_t)e * 1024 * 512 + kb * 64; t.ldd = 512; t.kind = 0; t.aux = nb * 32; return t; }
}
DI int p0_rowmap(const TItem& t, int n) {
    if (t.kind == 0) return t.aux + n;
    if (t.kind == 1) { const int c = t.aux + n, cc = c & 1023; return (cc >> 7) * 256 + (c >> 10) * 128 + (cc & 127); }
    const int c = (t.aux >> 1) + n; return (c >> 2) * 8 + (c & 3) + 4 * (t.aux & 1);
}
DI void p0_prologue(const Frame& F, const Ins& I) {
    LAS float* scr = (LAS float*)(F.lds + RING_OFF + F.wave * 16384);
    const int gw = F.vcu * NWAVES + F.wave, NGW = F.G * NWAVES, lane = F.lane;
    bf16* W1T = (bf16*)(F.ws + WS_W1T);
    { float cur[32], nxt[32]; TItem ti = p0_decode(F, I, gw < NITEMS ? gw : 0);
#pragma unroll
      for (int i = 0; i < 32; ++i) cur[i] = ti.src[(size_t)(2 * i + (lane >> 5)) * ti.ldw + (lane & 31)];
#pragma unroll 1
      for (int it = gw; it < NITEMS; it += NGW) {
          const bool more = it + NGW < NITEMS; const TItem tn = p0_decode(F, I, more ? it + NGW : it);
#pragma unroll
          for (int i = 0; i < 32; ++i) nxt[i] = tn.src[(size_t)(2 * i + (lane >> 5)) * tn.ldw + (lane & 31)];
          if (ti.gain) {
#pragma unroll
              for (int i = 0; i < 32; ++i) cur[i] *= ti.gain[2 * i + (lane >> 5)]; }
#pragma unroll
          for (int i = 0; i < 32; ++i) scr[(2 * i + (lane >> 5)) * 33 + (lane & 31)] = cur[i];
          LDS_WAIT(); asm volatile("" ::: "memory");
          const int c = lane & 7;
#pragma unroll
          for (int j = 0; j < 4; ++j) { const int n = (lane >> 3) + 8 * j; const LAS float* sp = scr + (8 * c) * 33 + n;
              v4u o; o.x = pk2(sp[0 * 33], sp[1 * 33]); o.y = pk2(sp[2 * 33], sp[3 * 33]); o.z = pk2(sp[4 * 33], sp[5 * 33]); o.w = pk2(sp[6 * 33], sp[7 * 33]);
              *(v4u*)(ti.dst + (size_t)p0_rowmap(ti, n) * ti.ldd + 8 * c) = o; }
          LDS_WAIT(); asm volatile("" ::: "memory");
          ti = tn;
#pragma unroll
          for (int i = 0; i < 32; ++i) cur[i] = nxt[i];
      } }
    { const float* win = I.in[2]; const float* wa2 = I.in[3];
      for (int e = (F.vcu * NTHR + F.tid); e < 512 * 1024; e += F.G * NTHR) { const int k = e & 1023, n = e >> 10; const float* wr = win + (size_t)k * IN_COLS + 2048;
          float s = 0.f;
#pragma unroll
          for (int j = 0; j < 16; ++j) s += wr[j] * wa2[j * 512 + n];
          W1T[(size_t)(2048 + n) * 1024 + k] = f2bf(s); } }
    { bf16* WRH = (bf16*)(F.ws + WS_WRH); bf16* WRL = WRH + 48 * 1024; const float* wrg = I.in[14]; const float* wre = I.in[16];
      for (int e = (F.vcu * NTHR + F.tid); e < 48 * 1024; e += F.G * NTHR) { const int k = e & 1023, n = e >> 10;
          const float w = (n < 4 ? wrg[k * 4 + n] : (n < 36 ? wre[k * 32 + n - 4] : 0.f)) * I.in[13][k]; const bf16 h = f2bf(w); WRH[e] = h; WRL[e] = f2bf(w - bf2f(h)); } }
    { const float* x = I.in[0]; const float* g1 = I.in[1]; bf16* XN = (bf16*)(F.ws + WS_XN);
      f32x4 gv[4];
#pragma unroll
      for (int j = 0; j < 4; ++j) gv[j] = *(const f32x4*)(g1 + 4 * lane + 256 * j);
      f32x4 v[4], vn[4];
      { const f32x4* xr = (const f32x4*)(x + (size_t)(gw < T ? gw : 0) * D) + lane;
#pragma unroll
        for (int j = 0; j < 4; ++j) v[j] = xr[64 * j]; }
#pragma unroll 1
      for (int m = gw; m < T; m += NGW) { const int mn = m + NGW < T ? m + NGW : m; const f32x4* xr = (const f32x4*)(x + (size_t)mn * D) + lane; float s = 0.f;
#pragma unroll
          for (int j = 0; j < 4; ++j) { vn[j] = xr[64 * j]; s += (v[j].x * v[j].x + v[j].y * v[j].y) + (v[j].z * v[j].z + v[j].w * v[j].w); }
          const float rinv = __frsqrt_rn(wave_sum(s) * (1.f / D) + EPS);
          v2u* o8 = (v2u*)(XN + (size_t)m * D) + lane;
#pragma unroll
          for (int j = 0; j < 4; ++j) { v2u o; o.x = pk2(v[j].x * rinv * gv[j].x, v[j].y * rinv * gv[j].y); o.y = pk2(v[j].z * rinv * gv[j].z, v[j].w * rinv * gv[j].w); o8[64 * j] = o; v[j] = vn[j]; } } }
}

DI void qk_norm_phase(const Frame& F, const float* gq, const float* gk, bool dry) {
    const int gw = F.vcu * NWAVES + F.wave, NGW = F.G * NWAVES, lane = F.lane;
    bf16* Q = (bf16*)(F.ws + WS_DILQ);
    for (int rr = gw; rr < 6 * T; rr += NGW) { const int which = rr / T; const int gi = which % 3; const bool isq = which < 3;
        bf16* p = Q + (size_t)rr * 512 + 8 * lane; const v4u v = *(const v4u*)p;
        float x[8] = {bflo(v.x), bfhi(v.x), bflo(v.y), bfhi(v.y), bflo(v.z), bfhi(v.z), bflo(v.w), bfhi(v.w)};
        float s = 0.f;
#pragma unroll
        for (int j = 0; j < 8; ++j) s += x[j] * x[j];
        s += __shfl_xor(s, 1); s += __shfl_xor(s, 2); s += __shfl_xor(s, 4); s += __shfl_xor(s, 8);
        const float rinv = __frsqrt_rn(s * (1.f / 128.f) + EPS) * (isq ? 0.08838834764831845f * LOG2E : 1.f);
        const float* g = (isq ? gq : gk) + gi * 128 + (8 * lane & 127);
        const f32x4 g0 = *(const f32x4*)g, g1 = *(const f32x4*)(g + 4);
        v4u o; o.x = pk2(x[0] * rinv * g0.x, x[1] * rinv * g0.y); o.y = pk2(x[2] * rinv * g0.z, x[3] * rinv * g0.w); o.z = pk2(x[4] * rinv * g1.x, x[5] * rinv * g1.y); o.w = pk2(x[6] * rinv * g1.z, x[7] * rinv * g1.w);
        if (!dry) *(v4u*)p = o; }
}

DI int crow(int i, int h) { return (i & 3) + 8 * (i >> 2) + 4 * h; }
DI int img_off(int row, int ch) { return 256 * row + 16 * (ch ^ (((row & 3) << 2) | ((row >> 2) & 3))); }
typedef short s16x4 __attribute__((ext_vector_type(4)));
DI void attn_job(const Frame& F, int job, bool dry) {
    const int lane = F.lane, r = lane & 31, h = lane >> 5;
    const int gi = job >> 12; int rem = job & 4095;
    const int sh = 2 * gi, d = 1 << sh, L = SEQ >> sh, nqt = L >> 5;
    const int qt = rem % nqt; rem /= nqt; const int res = rem & (d - 1); rem >>= sh; const int head = rem & 3, b = rem >> 2;
    const int p0 = qt * 32;
    const float slope = exp2f(-8.f * (float)(gi * 4 + head + 1) / 12.f) * LOG2E * (float)d;
    bf16* Qg = (bf16*)(F.ws + WS_DILQ) + (size_t)gi * T * 512;
    const bf16* Kg = (const bf16*)(F.ws + WS_DILK) + (size_t)gi * T * 512 + head * 128;
    const bf16* Vg = (const bf16*)(F.ws + WS_DILV) + (size_t)gi * T * 512 + head * 128;
    LAS unsigned char* Kimg = F.lds + F.wave * 16384; LAS unsigned char* Vimg = Kimg + 8192;
    const size_t qtok = (size_t)b * SEQ + (size_t)(p0 + r) * d + res;
    bf16x8 qf[8];
#pragma unroll
    for (int ks = 0; ks < 8; ++ks) qf[ks] = *(const bf16x8*)(Qg + qtok * 512 + head * 128 + 16 * ks + 8 * h);
    f32x16 O[4];
#pragma unroll
    for (int db = 0; db < 4; ++db)
#pragma unroll
        for (int i = 0; i < 16; ++i) O[db][i] = 0.f;
    float m = -1e30f, l = 0.f;
    const int srow = lane >> 4, sslot = lane & 15;
    v4u kst[8], vst[8];
    const int kt0 = p0 >= 128 ? 0 : (128 - p0) >> 5;
#define ATT_LOAD(ktn) do { const int _kb = p0 - 128 + 32 * (ktn); _Pragma("unroll") for (int i = 0; i < 8; ++i) { const int kk = 4 * i + srow; \
        const size_t _o = ((size_t)b * SEQ + (size_t)(_kb + kk) * d + res) * 512 + 8 * (sslot ^ ((srow << 2) | (i & 3))); kst[i] = *(const v4u*)(Kg + _o); vst[i] = *(const v4u*)(Vg + _o); } } while (0)
    ATT_LOAD(kt0);
#pragma unroll 1
    for (int kt = kt0; kt < 5; ++kt) { const int kb = p0 - 128 + 32 * kt;
#pragma unroll
        for (int i = 0; i < 8; ++i) { *(LAS v4u*)(Kimg + 1024 * i + 16 * lane) = kst[i]; *(LAS v4u*)(Vimg + 1024 * i + 16 * lane) = vst[i]; }
        if (kt + 1 < 5) ATT_LOAD(kt + 1);
        f32x16 s;
#pragma unroll
        for (int i = 0; i < 16; ++i) s[i] = 0.f;
#pragma unroll
        for (int ks = 0; ks < 8; ++ks) { const bf16x8 kf = *(const LAS bf16x8*)(Kimg + img_off(r, 2 * ks + h)); s = MFMA32(kf, qf[ks], s); }
        float mx = -1e30f; const int dq = p0 + r - kb;
#pragma unroll
        for (int i = 0; i < 16; ++i) { const int dist = dq - crow(i, h); const bool ok = dist >= 0 && dist <= 128; const float sv = ok ? s[i] - slope * (float)dist : -1e30f; s[i] = sv; mx = fmaxf(mx, sv); }
        mx = fmaxf(mx, __shfl_xor(mx, 32));
        const float mn = fmaxf(m, mx), alpha = exp2f(m - mn); m = mn;
        float ps = 0.f;
#pragma unroll
        for (int i = 0; i < 16; ++i) { const float p = s[i] > -1e29f ? exp2f(s[i] - mn) : 0.f; s[i] = p; ps += p; }
        l = l * alpha + ps;
#pragma unroll
        for (int db = 0; db < 4; ++db)
#pragma unroll
            for (int i = 0; i < 16; ++i) O[db][i] *= alpha;
        bf16x8 pb[2];
#pragma unroll
        for (int si = 0; si < 2; ++si) { v4u w; w.x = pk2(s[8 * si], s[8 * si + 1]); w.y = pk2(s[8 * si + 2], s[8 * si + 3]); w.z = pk2(s[8 * si + 4], s[8 * si + 5]); w.w = pk2(s[8 * si + 6], s[8 * si + 7]); pb[si] = __builtin_bit_cast(bf16x8, w); }
        { const int i16 = lane & 15, q = i16 >> 2, p = i16 & 3, gl = (lane >> 4) & 1;
#pragma unroll
          for (int db = 0; db < 4; ++db)
#pragma unroll
            for (int si = 0; si < 2; ++si) {
                const s16x4 lo = __builtin_amdgcn_ds_read_tr16_b64_v4i16((LAS s16x4*)(Vimg + img_off(16 * si + 4 * h + q, 4 * db + 2 * gl + (p >> 1)) + 8 * (p & 1)));
                const s16x4 hi = __builtin_amdgcn_ds_read_tr16_b64_v4i16((LAS s16x4*)(Vimg + img_off(16 * si + 8 + 4 * h + q, 4 * db + 2 * gl + (p >> 1)) + 8 * (p & 1)));
                const bf16x8 vf = __builtin_shufflevector(lo, hi, 0, 1, 2, 3, 4, 5, 6, 7); O[db] = MFMA32(vf, pb[si], O[db]); } }
    }
#undef ATT_LOAD
    const float lt = l + __shfl_xor(l, 32), inv = 1.f / lt;
    bf16* op = Qg + qtok * 512 + head * 128 + 4 * h;
    if (dry) return;
#pragma unroll
    for (int db = 0; db < 4; ++db)
#pragma unroll
        for (int q4 = 0; q4 < 4; ++q4) { v2u o; o.x = pk2(O[db][4 * q4] * inv, O[db][4 * q4 + 1] * inv); o.y = pk2(O[db][4 * q4 + 2] * inv, O[db][4 * q4 + 3] * inv); *(v2u*)(op + 32 * db + 8 * q4) = o; }
    if (h == 0) ((float*)(F.ws + WS_LSE))[(size_t)gi * T * 4 + qtok * 4 + head] = m + log2f(lt);
}

constexpr int G_QS = 0, G_KS = 17408, G_KET = 34816, G_VT = 53248, G_ATT = 71680, G_TOT = 80896, G_DL = 82944, G_OS = 84992, G_LRAW = 83456, G_VRAW = 100864;
constexpr int QS_LD = 136, KT_LD = 72, OS_LD = 132;
DI void gla_pass1(const Frame& F, int item, bool dry) {
    const int tid = F.tid, lane = F.lane, w = F.wave, fr = lane & 15, g = lane >> 4;
    const int seg = item & (NSEG - 1), bh = item >> 4, hh = bh & 3, b = bh >> 2;
    const int dk = tid & 127, qr = tid >> 7;
    LAS bf16* Qs = (LAS bf16*)(F.lds + G_QS); LAS bf16* Ks = (LAS bf16*)(F.lds + G_KS); LAS bf16* KEt = (LAS bf16*)(F.lds + G_KET); LAS bf16* Vt = (LAS bf16*)(F.lds + G_VT);
    LAS bf16* Att = (LAS bf16*)(F.lds + G_ATT); LAS float* tot = (LAS float*)(F.lds + G_TOT); LAS float* Dl = (LAS float*)(F.lds + G_DL);
    const bf16* GQ = (const bf16*)(F.ws + WS_GLAQ); const bf16* GK = (const bf16*)(F.ws + WS_GLAK); const bf16* LA = (const bf16*)(F.ws + WS_LOGA); bf16* GV = (bf16*)(F.ws + WS_GLAV);
    f32x4 S[8];
#pragma unroll
    for (int a = 0; a < 8; ++a) S[a] = (f32x4){0.f, 0.f, 0.f, 0.f};
    float Btot = 0.f;
    const int dv0 = 16 * w;
    v4u sl[2], sq[2], sk[2], sv[2]; unsigned odef[8];
#pragma unroll
    for (int i = 0; i < 8; ++i) odef[i] = 0u;
    const int srow = tid >> 4, sch = tid & 15;
    LAS bf16* Lraw = (LAS bf16*)(F.lds + G_LRAW); LAS bf16* Vraw = (LAS bf16*)(F.lds + G_VRAW);
    const int troff = ((16 * qr + ((lane & 15) >> 2)) * QS_LD + (w & 1) * 64 + 16 * (lane >> 4) + 4 * (lane & 3)) * 2;
#define GLA_LOAD1(chn) do { const size_t _o = ((size_t)b * SEQ + seg * TSEG + (chn) * 64 + srow) * 512 + hh * 128 + 8 * sch; \
        _Pragma("unroll") for (int i = 0; i < 2; ++i) { sl[i] = *(const v4u*)(LA + _o + (size_t)i * 16384); sq[i] = *(const v4u*)(GQ + _o + (size_t)i * 16384); sk[i] = *(const v4u*)(GK + _o + (size_t)i * 16384); sv[i] = *(const v4u*)(GV + _o + (size_t)i * 16384); } } while (0)
    GLA_LOAD1(0);
#pragma unroll 1
    for (int ch = 0; ch < TSEG / 64; ++ch) {
        const size_t tokbase = (size_t)b * SEQ + seg * TSEG + ch * 64;
#pragma unroll
        for (int i = 0; i < 2; ++i) { const int o = (srow + 32 * i) * QS_LD + 8 * sch; *(LAS v4u*)(Lraw + o) = sl[i]; *(LAS v4u*)(Qs + o) = sq[i]; *(LAS v4u*)(Ks + o) = sk[i]; *(LAS v4u*)(Vraw + o) = sv[i]; }
        if (ch > 0 && !dry) { bf16* op = GV + (tokbase - 64 + 4 * g) * 512 + hh * 128 + dv0 + fr;
#pragma unroll
            for (int it = 0; it < 4; ++it) { op[(size_t)(16 * it) * 512] = (bf16)(odef[2 * it] & 0xffffu); op[(size_t)(16 * it + 1) * 512] = (bf16)(odef[2 * it] >> 16); op[(size_t)(16 * it + 2) * 512] = (bf16)(odef[2 * it + 1] & 0xffffu); op[(size_t)(16 * it + 3) * 512] = (bf16)(odef[2 * it + 1] >> 16); } }
        if (ch + 1 < TSEG / 64) GLA_LOAD1(ch + 1);
        LDS_BARRIER();
        float la[16], qv[16], kv[16]; bf16 vv[16];
#pragma unroll
        for (int k4 = 0; k4 < 4; ++k4) { const int o = troff + k4 * 4 * QS_LD * 2;
            const s16x4 a = __builtin_amdgcn_ds_read_tr16_b64_v4i16((LAS s16x4*)((LAS unsigned char*)Lraw + o)), q4 = __builtin_amdgcn_ds_read_tr16_b64_v4i16((LAS s16x4*)((LAS unsigned char*)Qs + o));
            const s16x4 k4v = __builtin_amdgcn_ds_read_tr16_b64_v4i16((LAS s16x4*)((LAS unsigned char*)Ks + o)), v4v = __builtin_amdgcn_ds_read_tr16_b64_v4i16((LAS s16x4*)((LAS unsigned char*)Vraw + o));
#pragma unroll
            for (int e = 0; e < 4; ++e) { la[4 * k4 + e] = bf2f((bf16)a[e]); qv[4 * k4 + e] = bf2f((bf16)q4[e]); kv[4 * k4 + e] = bf2f((bf16)k4v[e]); vv[4 * k4 + e] = (bf16)v4v[e]; } }
#pragma unroll
        for (int i = 1; i < 16; ++i) la[i] += la[i - 1];
        tot[qr * 128 + dk] = la[15];
        { v4u v0, v1; v0.x = vv[0] | ((unsigned)vv[1] << 16); v0.y = vv[2] | ((unsigned)vv[3] << 16); v0.z = vv[4] | ((unsigned)vv[5] << 16); v0.w = vv[6] | ((unsigned)vv[7] << 16);
          v1.x = vv[8] | ((unsigned)vv[9] << 16); v1.y = vv[10] | ((unsigned)vv[11] << 16); v1.z = vv[12] | ((unsigned)vv[13] << 16); v1.w = vv[14] | ((unsigned)vv[15] << 16);
          *(LAS v4u*)(Vt + dk * KT_LD + 16 * qr) = v0; *(LAS v4u*)(Vt + dk * KT_LD + 16 * qr + 8) = v1; }
        LDS_BARRIER();
        const float t0 = tot[dk], t1 = tot[128 + dk], t2 = tot[256 + dk], t3 = tot[384 + dk];
        const float base = (qr > 0 ? t0 : 0.f) + (qr > 1 ? t1 : 0.f) + (qr > 2 ? t2 : 0.f), blast = (t0 + t1) + (t2 + t3);
        Btot += blast;
        if (qr == 0) Dl[dk] = __expf(blast);
        { unsigned ke[8];
#pragma unroll
          for (int i = 0; i < 16; i += 2) { const float b0 = base + la[i], b1 = base + la[i + 1]; const float e0 = __expf(b0), e1 = __expf(b1);
              Qs[(16 * qr + i) * QS_LD + dk] = f2bf(qv[i] * 0.08838834764831845f * e0); Qs[(16 * qr + i + 1) * QS_LD + dk] = f2bf(qv[i + 1] * 0.08838834764831845f * e1);
              Ks[(16 * qr + i) * QS_LD + dk] = f2bf(kv[i] / e0); Ks[(16 * qr + i + 1) * QS_LD + dk] = f2bf(kv[i + 1] / e1);
              ke[i >> 1] = pk2(kv[i] * __expf(blast - b0), kv[i + 1] * __expf(blast - b1)); }
          v4u k0 = {ke[0], ke[1], ke[2], ke[3]}, k1 = {ke[4], ke[5], ke[6], ke[7]};
          *(LAS v4u*)(KEt + dk * KT_LD + 16 * qr) = k0; *(LAS v4u*)(KEt + dk * KT_LD + 16 * qr + 8) = k1; }
        LDS_BARRIER();
#pragma unroll
        for (int tt = 0; tt < 2; ++tt) { const int n = 2 * w + tt, jt = n >> 2, it = n & 3; f32x4 a4 = {0.f, 0.f, 0.f, 0.f};
#pragma unroll
            for (int s = 0; s < 4; ++s) { const bf16x8 ka = *(const LAS bf16x8*)(Ks + (16 * jt + fr) * QS_LD + 32 * s + 8 * g); const bf16x8 qb = *(const LAS bf16x8*)(Qs + (16 * it + fr) * QS_LD + 32 * s + 8 * g); a4 = MFMA16(ka, qb, a4); }
            const int tj = 16 * jt + 4 * g, ti = 16 * it + fr;
            v2u o; o.x = pk2(tj <= ti ? a4[0] : 0.f, tj + 1 <= ti ? a4[1] : 0.f); o.y = pk2(tj + 2 <= ti ? a4[2] : 0.f, tj + 3 <= ti ? a4[3] : 0.f);
            *(LAS v2u*)(Att + ti * KT_LD + tj) = o; }
        LDS_BARRIER();
        bf16x8 Sb[4];
#pragma unroll
        for (int s = 0; s < 4; ++s) { v4u p; p.x = pk2(S[2 * s][0], S[2 * s][1]); p.y = pk2(S[2 * s][2], S[2 * s][3]); p.z = pk2(S[2 * s + 1][0], S[2 * s + 1][1]); p.w = pk2(S[2 * s + 1][2], S[2 * s + 1][3]); Sb[s] = __builtin_bit_cast(bf16x8, p); }
        bf16x8 Vf[2];
#pragma unroll
        for (int ks = 0; ks < 2; ++ks) Vf[ks] = *(const LAS bf16x8*)(Vt + (dv0 + fr) * KT_LD + 32 * ks + 8 * g);
#pragma unroll
        for (int it = 0; it < 4; ++it) { f32x4 o = {0.f, 0.f, 0.f, 0.f};
#pragma unroll
            for (int s = 0; s < 4; ++s) { const bf16x4 lo = *(const LAS bf16x4*)(Qs + (16 * it + fr) * QS_LD + 32 * s + 4 * g); const bf16x4 hi = *(const LAS bf16x4*)(Qs + (16 * it + fr) * QS_LD + 32 * s + 16 + 4 * g);
                const bf16x8 qa = __builtin_shufflevector(lo, hi, 0, 1, 2, 3, 4, 5, 6, 7); o = MFMA16(qa, Sb[s], o); }
#pragma unroll
            for (int ks = 0; ks < 2; ++ks) { const bf16x8 aa = *(const LAS bf16x8*)(Att + (16 * it + fr) * KT_LD + 32 * ks + 8 * g); o = MFMA16(aa, Vf[ks], o); }
            odef[2 * it] = pk2(o[0], o[1]); odef[2 * it + 1] = pk2(o[2], o[3]); }
#pragma unroll
        for (int a = 0; a < 8; ++a) { const f32x4 dsc = *(const LAS f32x4*)(Dl + 16 * a + 4 * g); S[a] = S[a] * dsc;
#pragma unroll
            for (int ks = 0; ks < 2; ++ks) { const bf16x8 ka = *(const LAS bf16x8*)(KEt + (16 * a + fr) * KT_LD + 32 * ks + 8 * g); S[a] = MFMA16(ka, Vf[ks], S[a]); } }
        LDS_BARRIER();
    }
    if (!dry) { bf16* op = GV + ((size_t)b * SEQ + seg * TSEG + TSEG - 64 + 4 * g) * 512 + hh * 128 + dv0 + fr;
#pragma unroll
        for (int it = 0; it < 4; ++it) { op[(size_t)(16 * it) * 512] = (bf16)(odef[2 * it] & 0xffffu); op[(size_t)(16 * it + 1) * 512] = (bf16)(odef[2 * it] >> 16); op[(size_t)(16 * it + 2) * 512] = (bf16)(odef[2 * it + 1] & 0xffffu); op[(size_t)(16 * it + 3) * 512] = (bf16)(odef[2 * it + 1] >> 16); } }
    v2u* LB = (v2u*)(F.ws + WS_LB) + (size_t)item * 4096 + w * 512 + lane;
#pragma unroll
    for (int a = 0; a < 8; ++a) { v2u o; o.x = pk2(S[a][0], S[a][1]); o.y = pk2(S[a][2], S[a][3]); LB[a * 64] = o; }
    if (qr == 0) ((float*)(F.ws + WS_DSEG))[item * 128 + dk] = __expf(Btot);
}

DI void gla_pass2(const Frame& F, int item, const float* gnorm, bool dry) {
    const int tid = F.tid, lane = F.lane, w = F.wave, fr = lane & 15, g = lane >> 4;
    const int seg = item & (NSEG - 1), bh = item >> 4, hh = bh & 3, b = bh >> 2;
    const int dk = tid & 127, qr = tid >> 7, dv0 = 16 * w;
    LAS bf16* Qs = (LAS bf16*)(F.lds + G_QS); LAS float* tot = (LAS float*)(F.lds + G_TOT); LAS float* Os = (LAS float*)(F.lds + G_OS);
    const bf16* GQ = (const bf16*)(F.ws + WS_GLAQ); const bf16* LA = (const bf16*)(F.ws + WS_LOGA); bf16* GV = (bf16*)(F.ws + WS_GLAV); const bf16* R = (const bf16*)(F.dout + DO_R);
    f32x4 Sc[8];
#pragma unroll
    for (int a = 0; a < 8; ++a) Sc[a] = (f32x4){0.f, 0.f, 0.f, 0.f};
    { v2u lv[8], lvn[8]; f32x4 dc[8], dcn[8];
#define GLA_CLOAD(LV, DC, spn) do { const int _it2 = bh * NSEG + (spn); const v2u* _LB = (const v2u*)(F.ws + WS_LB) + (size_t)_it2 * 4096 + w * 512 + lane; const float* _DS = (const float*)(F.ws + WS_DSEG) + _it2 * 128 + 4 * g; \
        _Pragma("unroll") for (int a = 0; a < 8; ++a) { DC[a] = *(const f32x4*)(_DS + 16 * a); LV[a] = _LB[a * 64]; } } while (0)
      if (seg > 0) GLA_CLOAD(lv, dc, 0);
#pragma unroll 1
      for (int sp = 0; sp < seg; ++sp) {
          if (sp + 1 < seg) GLA_CLOAD(lvn, dcn, sp + 1);
#pragma unroll
          for (int a = 0; a < 8; ++a) { Sc[a][0] = Sc[a][0] * dc[a][0] + bflo(lv[a].x); Sc[a][1] = Sc[a][1] * dc[a][1] + bfhi(lv[a].x); Sc[a][2] = Sc[a][2] * dc[a][2] + bflo(lv[a].y); Sc[a][3] = Sc[a][3] * dc[a][3] + bfhi(lv[a].y);
              lv[a] = lvn[a]; dc[a] = dcn[a]; } }
#undef GLA_CLOAD
    }
    bf16x8 Sb[4];
#pragma unroll
    for (int s = 0; s < 4; ++s) { v4u p; p.x = pk2(Sc[2 * s][0], Sc[2 * s][1]); p.y = pk2(Sc[2 * s][2], Sc[2 * s][3]); p.z = pk2(Sc[2 * s + 1][0], Sc[2 * s + 1][1]); p.w = pk2(Sc[2 * s + 1][2], Sc[2 * s + 1][3]); Sb[s] = __builtin_bit_cast(bf16x8, p); }
    float Bcum = 0.f;
    const int tk = tid >> 3, pc = tid & 7;
    f32x4 gn[4];
#pragma unroll
    for (int j = 0; j < 4; ++j) gn[j] = *(const f32x4*)(gnorm + 16 * pc + 4 * j);
    v4u sl[2], sq[2], ow0, ow1, r0, r1, od0 = {0u, 0u, 0u, 0u}, od1 = {0u, 0u, 0u, 0u};
    const int srow = tid >> 4, sch = tid & 15;
    LAS bf16* Lraw = (LAS bf16*)(F.lds + G_KS);
    const int troff = ((16 * qr + ((lane & 15) >> 2)) * QS_LD + (w & 1) * 64 + 16 * (lane >> 4) + 4 * (lane & 3)) * 2;
#define GLA_LOAD2A(chn) do { const size_t _o = ((size_t)b * SEQ + seg * TSEG + (chn) * 64 + srow) * 512 + hh * 128 + 8 * sch; \
        _Pragma("unroll") for (int i = 0; i < 2; ++i) { sl[i] = *(const v4u*)(LA + _o + (size_t)i * 16384); sq[i] = *(const v4u*)(GQ + _o + (size_t)i * 16384); } } while (0)
#define GLA_LOAD2B(chn) do { const size_t _o = ((size_t)b * SEQ + seg * TSEG + (chn) * 64 + tk) * 512 + hh * 128 + 16 * pc; \
        ow0 = *(const v4u*)(GV + _o); ow1 = *(const v4u*)(GV + _o + 8); r0 = *(const v4u*)(R + _o); r1 = *(const v4u*)(R + _o + 8); } while (0)
    GLA_LOAD2A(0); GLA_LOAD2B(0);
#pragma unroll 1
    for (int ch = 0; ch < TSEG / 64; ++ch) {
        const size_t tokbase = (size_t)b * SEQ + seg * TSEG + ch * 64;
#pragma unroll
        for (int i = 0; i < 2; ++i) { const int o = (srow + 32 * i) * QS_LD + 8 * sch; *(LAS v4u*)(Lraw + o) = sl[i]; *(LAS v4u*)(Qs + o) = sq[i]; }
        if (ch > 0 && !dry) { const size_t pofs = (tokbase - 64 + tk) * 512 + hh * 128 + 16 * pc; *(v4u*)(GV + pofs) = od0; *(v4u*)(GV + pofs + 8) = od1; }
        const v4u cw0 = ow0, cw1 = ow1, cr0 = r0, cr1 = r1;
        if (ch + 1 < TSEG / 64) { GLA_LOAD2A(ch + 1); GLA_LOAD2B(ch + 1); }
        LDS_BARRIER();
        float la[16], qv[16];
#pragma unroll
        for (int k4 = 0; k4 < 4; ++k4) { const int o = troff + k4 * 4 * QS_LD * 2;
            const s16x4 a = __builtin_amdgcn_ds_read_tr16_b64_v4i16((LAS s16x4*)((LAS unsigned char*)Lraw + o)), q4 = __builtin_amdgcn_ds_read_tr16_b64_v4i16((LAS s16x4*)((LAS unsigned char*)Qs + o));
#pragma unroll
            for (int e = 0; e < 4; ++e) { la[4 * k4 + e] = bf2f((bf16)a[e]); qv[4 * k4 + e] = bf2f((bf16)q4[e]); } }
#pragma unroll
        for (int i = 1; i < 16; ++i) la[i] += la[i - 1];
        tot[qr * 128 + dk] = la[15];
        LDS_BARRIER();
        const float t0 = tot[dk], t1 = tot[128 + dk], t2 = tot[256 + dk], t3 = tot[384 + dk];
        const float base = Bcum + (qr > 0 ? t0 : 0.f) + (qr > 1 ? t1 : 0.f) + (qr > 2 ? t2 : 0.f);
        Bcum += (t0 + t1) + (t2 + t3);
#pragma unroll
        for (int i = 0; i < 16; ++i) Qs[(16 * qr + i) * QS_LD + dk] = f2bf(qv[i] * 0.08838834764831845f * __expf(base + la[i]));
        LDS_BARRIER();
#pragma unroll
        for (int it = 0; it < 4; ++it) { f32x4 o = {0.f, 0.f, 0.f, 0.f};
            if (seg > 0) {
#pragma unroll
                for (int s = 0; s < 4; ++s) { const bf16x4 lo = *(const LAS bf16x4*)(Qs + (16 * it + fr) * QS_LD + 32 * s + 4 * g); const bf16x4 hi = *(const LAS bf16x4*)(Qs + (16 * it + fr) * QS_LD + 32 * s + 16 + 4 * g);
                    const bf16x8 qa = __builtin_shufflevector(lo, hi, 0, 1, 2, 3, 4, 5, 6, 7); o = MFMA16(qa, Sb[s], o); } }
#pragma unroll
            for (int rr = 0; rr < 4; ++rr) Os[(16 * it + 4 * g + rr) * OS_LD + dv0 + fr] = o[rr]; }
        LDS_BARRIER();
        { f32x4 v[4]; float ss = 0.f;
#pragma unroll
          for (int j = 0; j < 4; ++j) v[j] = *(const LAS f32x4*)(Os + tk * OS_LD + 16 * pc + 4 * j);
          v[0].x += bflo(cw0.x); v[0].y += bfhi(cw0.x); v[0].z += bflo(cw0.y); v[0].w += bfhi(cw0.y); v[1].x += bflo(cw0.z); v[1].y += bfhi(cw0.z); v[1].z += bflo(cw0.w); v[1].w += bfhi(cw0.w);
          v[2].x += bflo(cw1.x); v[2].y += bfhi(cw1.x); v[2].z += bflo(cw1.y); v[2].w += bfhi(cw1.y); v[3].x += bflo(cw1.z); v[3].y += bfhi(cw1.z); v[3].z += bflo(cw1.w); v[3].w += bfhi(cw1.w);
#pragma unroll
          for (int j = 0; j < 4; ++j) ss += (v[j].x * v[j].x + v[j].y * v[j].y) + (v[j].z * v[j].z + v[j].w * v[j].w);
          ss += __shfl_xor(ss, 1); ss += __shfl_xor(ss, 2); ss += __shfl_xor(ss, 4);
          const float rinv = __frsqrt_rn(ss * (1.f / 128.f) + EPS);
          const size_t ofs = (tokbase + tk) * 512 + hh * 128 + 16 * pc;
          v4u o0, o1;
          o0.x = pk2(v[0].x * rinv * gn[0].x * bflo(cr0.x), v[0].y * rinv * gn[0].y * bfhi(cr0.x)); o0.y = pk2(v[0].z * rinv * gn[0].z * bflo(cr0.y), v[0].w * rinv * gn[0].w * bfhi(cr0.y));
          o0.z = pk2(v[1].x * rinv * gn[1].x * bflo(cr0.z), v[1].y * rinv * gn[1].y * bfhi(cr0.z)); o0.w = pk2(v[1].z * rinv * gn[1].z * bflo(cr0.w), v[1].w * rinv * gn[1].w * bfhi(cr0.w));
          o1.x = pk2(v[2].x * rinv * gn[2].x * bflo(cr1.x), v[2].y * rinv * gn[2].y * bfhi(cr1.x)); o1.y = pk2(v[2].z * rinv * gn[2].z * bflo(cr1.y), v[2].w * rinv * gn[2].w * bfhi(cr1.y));
          o1.z = pk2(v[3].x * rinv * gn[3].x * bflo(cr1.z), v[3].y * rinv * gn[3].y * bfhi(cr1.z)); o1.w = pk2(v[3].z * rinv * gn[3].z * bflo(cr1.w), v[3].w * rinv * gn[3].w * bfhi(cr1.w));
          od0 = o0; od1 = o1; }
        LDS_BARRIER();
    }
    if (!dry) { const size_t pofs = ((size_t)b * SEQ + seg * TSEG + TSEG - 64 + tk) * 512 + hh * 128 + 16 * pc; *(v4u*)(GV + pofs) = od0; *(v4u*)(GV + pofs + 8) = od1; }
}
DI void attn_merge_phase(const Frame& F, bool dry) {
    const int gw = F.vcu * NWAVES + F.wave, NGW = F.G * NWAVES, lane = F.lane, head = lane >> 4;
    bf16* O0 = (bf16*)(F.ws + WS_DILQ); const float* LSE = (const float*)(F.ws + WS_LSE);
    for (int t = gw; t < T; t += NGW) {
        const float l0 = LSE[(size_t)t * 4 + head], l1 = LSE[(size_t)T * 4 + (size_t)t * 4 + head], l2 = LSE[(size_t)2 * T * 4 + (size_t)t * 4 + head];
        const float M = fmaxf(l0, fmaxf(l1, l2)); float w0 = exp2f(l0 - M), w1 = exp2f(l1 - M), w2 = exp2f(l2 - M); const float inv = 1.f / (w0 + w1 + w2); w0 *= inv; w1 *= inv; w2 *= inv;
        bf16* p = O0 + (size_t)t * 512 + 8 * lane; const v4u a = *(const v4u*)p, bq = *(const v4u*)(p + (size_t)T * 512), c = *(const v4u*)(p + (size_t)2 * T * 512);
        v4u o;
        o.x = pk2(w0 * bflo(a.x) + w1 * bflo(bq.x) + w2 * bflo(c.x), w0 * bfhi(a.x) + w1 * bfhi(bq.x) + w2 * bfhi(c.x));
        o.y = pk2(w0 * bflo(a.y) + w1 * bflo(bq.y) + w2 * bflo(c.y), w0 * bfhi(a.y) + w1 * bfhi(bq.y) + w2 * bfhi(c.y));
        o.z = pk2(w0 * bflo(a.z) + w1 * bflo(bq.z) + w2 * bflo(c.z), w0 * bfhi(a.z) + w1 * bfhi(bq.z) + w2 * bfhi(c.z));
        o.w = pk2(w0 * bflo(a.w) + w1 * bflo(bq.w) + w2 * bflo(c.w), w0 * bfhi(a.w) + w1 * bfhi(bq.w) + w2 * bfhi(c.w));
        if (!dry) *(v4u*)p = o; }
}

DI void router_phase(const Frame& F, const float* brg, const float* bre, unsigned* gcnt, bool dry) {
    const int lane = F.lane, w = F.wave, fr = lane & 15, g = lane >> 4;
    const bf16* X1 = (const bf16*)(F.ws + WS_X1);
    const bf16* WRH = (const bf16*)(F.ws + WS_WRH); const bf16* WRL = WRH + 48 * 1024;
    int* TOKE = (int*)(F.ws + WS_TOKE); float* TOKW = (float*)(F.ws + WS_TOKW); int* TOKR = (int*)(F.ws + WS_TOKR);
    LAS float* lg = (LAS float*)(F.lds + w * 4096);
    LAS int* cnt = (LAS int*)(F.lds + 65536); LAS int* basev = cnt + 32;
    for (int it = 0; it * F.G * 128 < T; ++it) {
        const int tok0 = (it * F.G + F.vcu) * 128 + w * 16;
        if (F.tid < 32) cnt[F.tid] = 0;
        __syncthreads();
        f32x4 acc[3]; acc[0] = acc[1] = acc[2] = (f32x4){0.f, 0.f, 0.f, 0.f};
        float ss = 0.f;
        const bf16* xr = X1 + (size_t)(tok0 + fr) * D + 8 * g;
#pragma unroll 4
        for (int s = 0; s < 32; ++s) {
            const v4u xv = *(const v4u*)(xr + 32 * s);
            ss += (bflo(xv.x) * bflo(xv.x) + bfhi(xv.x) * bfhi(xv.x)) + (bflo(xv.y) * bflo(xv.y) + bfhi(xv.y) * bfhi(xv.y)) + (bflo(xv.z) * bflo(xv.z) + bfhi(xv.z) * bfhi(xv.z)) + (bflo(xv.w) * bflo(xv.w) + bfhi(xv.w) * bfhi(xv.w));
            const bf16x8 ah = __builtin_bit_cast(bf16x8, xv);
#pragma unroll
            for (int nt = 0; nt < 3; ++nt) { const bf16x8 bh = *(const bf16x8*)(WRH + (size_t)(16 * nt + fr) * 1024 + 32 * s + 8 * g), bl = *(const bf16x8*)(WRL + (size_t)(16 * nt + fr) * 1024 + 32 * s + 8 * g);
                acc[nt] = MFMA16(ah, bh, acc[nt]); acc[nt] = MFMA16(ah, bl, acc[nt]); }
        }
        ss += __shfl_xor(ss, 16); ss += __shfl_xor(ss, 32);
        const float rinv = __frsqrt_rn(ss * (1.f / D) + EPS);
#pragma unroll
        for (int rr = 0; rr < 4; ++rr) { const float ri = __shfl(rinv, 4 * g + rr);
#pragma unroll
            for (int nt = 0; nt < 3; ++nt) lg[(4 * g + rr) * 48 + 16 * nt + fr] = acc[nt][rr] * ri; }
        if (lane < 16 && !dry) ((float*)(F.ws + WS_H2))[tok0 + lane] = rinv;
        LDS_WAIT(); asm volatile("" ::: "memory");
        int e1 = 0, e2 = 0, lr1 = 0, lr2 = 0; float w1 = 0.f, w2 = 0.f;
        if (lane < 16) { const LAS float* q = lg + lane * 48;
            float gl[4]; int gs = 0; float gm = -3.0e38f;
#pragma unroll
            for (int j = 0; j < 4; ++j) { gl[j] = q[j] + brg[j]; if (gl[j] > gm) { gm = gl[j]; gs = j; } }
            float gsum = 0.f;
#pragma unroll
            for (int j = 0; j < 4; ++j) gsum += __expf(gl[j] - gm);
            const float gp = 1.f / gsum;
            float el[8]; int i1 = 0; float v1 = -3.0e38f;
#pragma unroll
            for (int j = 0; j < 8; ++j) { el[j] = q[4 + 8 * gs + j] + bre[8 * gs + j]; if (el[j] > v1) { v1 = el[j]; i1 = j; } }
            int i2 = 0; float v2 = -3.0e38f;
#pragma unroll
            for (int j = 0; j < 8; ++j) if (j != i1 && el[j] > v2) { v2 = el[j]; i2 = j; }
            const float p2 = 1.f / (1.f + __expf(v1 - v2)), p1 = 1.f - p2;
            e1 = 8 * gs + i1; e2 = 8 * gs + i2; w1 = p1 * gp; w2 = p2 * gp;
            lr1 = __hip_atomic_fetch_add(&cnt[e1], 1, __ATOMIC_RELAXED, __HIP_MEMORY_SCOPE_WORKGROUP); lr2 = __hip_atomic_fetch_add(&cnt[e2], 1, __ATOMIC_RELAXED, __HIP_MEMORY_SCOPE_WORKGROUP); }
        __syncthreads();
        if (F.tid < 32) basev[F.tid] = dry ? 0 : (int)atomicAdd(&gcnt[64 * F.tid], (unsigned)cnt[F.tid]);
        __syncthreads();
        if (lane < 16 && !dry) { const int t = tok0 + lane; TOKE[2 * t] = e1; TOKE[2 * t + 1] = e2; TOKW[2 * t] = w1; TOKW[2 * t + 1] = w2; TOKR[2 * t] = basev[e1] + lr1; TOKR[2 * t + 1] = basev[e2] + lr2; }
        __syncthreads();
    }
}
DI void moe_assign_phase(const Frame& F, unsigned* gcnt) {
    LAS int* pst = (LAS int*)(F.lds + 65536);
    if (F.tid == 0) { int p = 0; int* BLKE = (int*)(F.ws + WS_BLKE);
        for (int e = 0; e < 32; ++e) { pst[e] = p; const int c = (int)__hip_atomic_load(&gcnt[64 * e], __ATOMIC_RELAXED, __HIP_MEMORY_SCOPE_AGENT); const int nb = (c + 255) >> 8;
            if (F.vcu == 0) for (int j = 0; j < nb; ++j) BLKE[(p >> 8) + j] = e;
            p += nb << 8; }
        if (F.vcu == 0) BLKE[NBLK_MAX] = p >> 8; }
    __syncthreads();
    const int gw = F.vcu * NWAVES + F.wave, NGW = F.G * NWAVES, lane = F.lane;
    const int* TOKE = (const int*)(F.ws + WS_TOKE); const float* TOKW = (const float*)(F.ws + WS_TOKW); const int* TOKR = (const int*)(F.ws + WS_TOKR);
    int* DEST = (int*)(F.ws + WS_DEST); f32x2* ROWW = (f32x2*)(F.ws + WS_ROWW);
    const bf16* X1 = (const bf16*)(F.ws + WS_X1); const float* RINV = (const float*)(F.ws + WS_H2); bf16* XP = (bf16*)(F.ws + WS_XP);
    v4u v0, v1, n0, n1;
    { const v4u* xr = (const v4u*)(X1 + (size_t)(gw < T ? gw : 0) * D) + lane; v0 = xr[0]; v1 = xr[64]; }
#pragma unroll 1
    for (int t = gw; t < T; t += NGW) { const int tn = t + NGW < T ? t + NGW : t; const v4u* xr = (const v4u*)(X1 + (size_t)tn * D) + lane; n0 = xr[0]; n1 = xr[64];
        const int d0 = pst[TOKE[2 * t]] + TOKR[2 * t], d1 = pst[TOKE[2 * t + 1]] + TOKR[2 * t + 1]; const float rinv = RINV[t];
        if (lane == 0) { DEST[2 * t] = d0; DEST[2 * t + 1] = d1; ROWW[d0] = (f32x2){TOKW[2 * t], rinv}; ROWW[d1] = (f32x2){TOKW[2 * t + 1], rinv}; }
        v4u* o0 = (v4u*)(XP + (size_t)d0 * D) + lane; v4u* o1 = (v4u*)(XP + (size_t)d1 * D) + lane;
        o0[0] = v0; o0[64] = v1; o1[0] = v0; o1[64] = v1; v0 = n0; v1 = n1; }
}
DI void combine_phase(const Frame& F, float* out) {
    const int gw = F.vcu * NWAVES + F.wave, NGW = F.G * NWAVES, lane = F.lane;
    const bf16* X1 = (const bf16*)(F.ws + WS_X1); const bf16* Y = (const bf16*)(F.ws + WS_Y); const int* DEST = (const int*)(F.ws + WS_DEST);
    for (int t = gw; t < T; t += NGW) { const int d0 = DEST[2 * t], d1 = DEST[2 * t + 1];
#pragma unroll
        for (int j = 0; j < 2; ++j) { const int c = 8 * lane + 512 * j;
            const v4u x = *(const v4u*)(X1 + (size_t)t * D + c), a = *(const v4u*)(Y + (size_t)d0 * D + c), b = *(const v4u*)(Y + (size_t)d1 * D + c);
            f32x4 oa, ob;
            oa.x = bflo(x.x) + bflo(a.x) + bflo(b.x); oa.y = bfhi(x.x) + bfhi(a.x) + bfhi(b.x); oa.z = bflo(x.y) + bflo(a.y) + bflo(b.y); oa.w = bfhi(x.y) + bfhi(a.y) + bfhi(b.y);
            ob.x = bflo(x.z) + bflo(a.z) + bflo(b.z); ob.y = bfhi(x.z) + bfhi(a.z) + bfhi(b.z); ob.z = bflo(x.w) + bflo(a.w) + bflo(b.w); ob.w = bfhi(x.w) + bfhi(a.w) + bfhi(b.w);
            *(f32x4*)(out + (size_t)t * D + c) = oa; *(f32x4*)(out + (size_t)t * D + c + 4) = ob; } }
}

constexpr int PER_PHASE = 13;
struct Args { Ins I; float* out; unsigned char* ws; int ph_lo, ph_hi, li, pad; };
__global__ void __launch_bounds__(NTHR, 2) fwd_kernel(Args args) {
    extern __shared__ __attribute__((aligned(16))) unsigned char lds[];
    Frame F;
    F.lds = (LAS unsigned char*)lds;
    F.tid = threadIdx.x; F.lane = F.tid & 63; F.wave = __builtin_amdgcn_readfirstlane(F.tid >> 6);
    F.G = gridDim.x; { const int bx = blockIdx.x; F.vcu = (F.G % 8 == 0) ? (bx % 8) * (F.G / 8) + bx / 8 : bx; }
    F.ws = args.ws; F.dout = (unsigned char*)args.out;
    unsigned* ctl = (unsigned*)(args.ws + WS_CTL);
    volatile LAS unsigned* MISC = (volatile LAS unsigned*)(F.lds + MISC_OFF);
    for (int u = F.tid; u < (LDS_BYTES - LDSCTL_OFF) / 4; u += NTHR) ((LAS unsigned*)(F.lds + LDSCTL_OFF))[u] = 0u;
    __syncthreads();
    XcdBarrier bar; bar.bar = ctl + CW_BAR; bar.x = 0; bar.st = nullptr;
    if (MK_N_LAUNCHES == 1) bar = xcd_barrier_post(ctl + CW_BAR + args.li * 4096, MISC + 8);
    const int lo = args.ph_lo, hi = args.ph_hi;
#ifdef ONLY_PHASE
#define IN(k) ((k) == ONLY_PHASE && lo <= (k) && (k) < hi)
#else
#define IN(k) (lo <= (k) && (k) < hi)
#endif
#define SEAM(k) do { if (IN(k) && IN((k) + 1)) xcd_barrier(bar); } while (0)
#ifndef DUP_MASK
#define DUP_MASK 0
#endif
#define REPS(k) (((DUP_MASK >> (k)) & 1) ? 2 : 1)
    const Ins& I = args.I;
    unsigned char* ws = args.ws;

    if (IN(0)) { _Pragma("unroll 1") for (int rep = 0; rep < REPS(0); ++rep) { if (rep) xcd_barrier(bar); p0_prologue(F, I); } SEAM(0); }

    if (IN(1)) { _Pragma("unroll 1") for (int rep = 0; rep < REPS(1); ++rep) { if (rep) xcd_barrier(bar);
        pg8::GemmDesc g{1024, 1024, 1024};
        pg8::OrderStd S{T / 256, N1 / 256, F.G, (int)blockIdx.x, (const char*)(ws + WS_XN), (const char*)(ws + WS_W1T), (size_t)256 * 1024 * 2, (size_t)256 * 1024 * 2};
        pg8::EpiP1 E{ws, F.dout, I.in[4], I.in[6], I.in[7], (LAS float*)(F.lds + LDSCTL_OFF + 1024)};
        pg8::gemm_phase<pg8::EpiP1, pg8::OrderStd>(F.lds + RING_OFF, g, S, E);
}         SEAM(1);
    }
    if (IN(3)) {
        _Pragma("unroll 1") for (int rep = 0; rep < REPS(3); ++rep) { if (rep) xcd_barrier(bar);
        for (int it = F.vcu; it < 16 * NSEG; it += F.G) gla_pass1(F, it, rep + 1 < REPS(3)); }
        const int gw = F.vcu * NWAVES + F.wave, NGW = F.G * NWAVES;
        _Pragma("unroll 1") for (int rep = 0; rep < REPS(13); ++rep) { if (rep) xcd_barrier(bar);
        for (int j = gw; j < 3 * 4096; j += NGW) attn_job(F, j, rep + 1 < REPS(13)); }
        SEAM(3);
    }
    if (IN(4)) {
        _Pragma("unroll 1") for (int rep = 0; rep < REPS(4); ++rep) { if (rep) xcd_barrier(bar);
        for (int it = F.vcu; it < 16 * NSEG; it += F.G) gla_pass2(F, it, I.in[5], rep + 1 < REPS(4)); }
        _Pragma("unroll 1") for (int rep = 0; rep < REPS(14); ++rep) { if (rep) xcd_barrier(bar); attn_merge_phase(F, rep + 1 < REPS(14)); }
        SEAM(4);
    }
    if (IN(5)) { _Pragma("unroll 1") for (int rep = 0; rep < REPS(5); ++rep) { if (rep) xcd_barrier(bar);
        pg8::GemmDesc g{512, 512, 512};
        pg8::OrderProj2 S{T / 256, 4, F.G, (int)blockIdx.x, (const char*)(ws + WS_GLAV), (const char*)(ws + WS_DILQ), (const char*)(ws + WS_WPGT), (const char*)(ws + WS_WPAT), (size_t)256 * 512 * 2, (size_t)256 * 512 * 2};
        pg8::EpiY E{(bf16*)(ws + WS_GATES), 2048};
        pg8::gemm_phase<pg8::EpiY, pg8::OrderProj2>(F.lds + RING_OFF, g, S, E);
}         SEAM(5);
    }
    if (IN(6)) { _Pragma("unroll 1") for (int rep = 0; rep < REPS(6); ++rep) { if (rep) xcd_barrier(bar);
        pg8::GemmDesc g{1024, 1024, 1024};
        pg8::OrderStd S{T / 256, 2048 / 256, F.G, (int)blockIdx.x, (const char*)(ws + WS_XN), (const char*)(ws + WS_WBGT), (size_t)256 * 1024 * 2, (size_t)256 * 1024 * 2};
        pg8::EpiGateMerge E{(bf16*)(ws + WS_MERGED), (const bf16*)(ws + WS_GATES), I.in[11]};
        pg8::gemm_phase<pg8::EpiGateMerge, pg8::OrderStd>(F.lds + RING_OFF, g, S, E);
}         SEAM(6);
    }
    if (IN(7)) { _Pragma("unroll 1") for (int rep = 0; rep < REPS(7); ++rep) { if (rep) xcd_barrier(bar);
        pg8::GemmDesc g{1024, 1024, 1024};
        pg8::OrderStd S{T / 256, 4, F.G, (int)blockIdx.x, (const char*)(ws + WS_MERGED), (const char*)(ws + WS_WOUTT), (size_t)256 * 1024 * 2, (size_t)256 * 1024 * 2};
        pg8::EpiX1 E{(bf16*)(ws + WS_X1), I.in[0]};
        pg8::gemm_phase<pg8::EpiX1, pg8::OrderStd>(F.lds + RING_OFF, g, S, E);
}         SEAM(7);
    }
    if (IN(8)) { _Pragma("unroll 1") for (int rep = 0; rep < REPS(8); ++rep) { if (rep) xcd_barrier(bar); router_phase(F, I.in[15], I.in[17], ctl + CW_GCNT, rep + 1 < REPS(8)); } SEAM(8); }
    if (IN(9)) { _Pragma("unroll 1") for (int rep = 0; rep < REPS(9); ++rep) { if (rep) xcd_barrier(bar); moe_assign_phase(F, ctl + CW_GCNT); } SEAM(9); }
    if (IN(10)) { _Pragma("unroll 1") for (int rep = 0; rep < REPS(10); ++rep) { if (rep) xcd_barrier(bar);
        const int* BLKE = (const int*)(ws + WS_BLKE); const int nblk = BLKE[NBLK_MAX];
        pg8::GemmDesc g{1024, 1024, 1024};
        pg8::OrderMoe S{nblk, F.G, (int)blockIdx.x, BLKE, (const char*)(ws + WS_XP), (const char*)(F.dout + DO_EXPGU), (size_t)256 * 1024 * 2, (size_t)1024 * 1024 * 2, (size_t)256 * 1024 * 2};
        pg8::EpiGU E{(bf16*)(ws + WS_HBUF), (const f32x2*)(ws + WS_ROWW)};
        pg8::gemm_phase<pg8::EpiGU, pg8::OrderMoe>(F.lds + RING_OFF, g, S, E);
}         SEAM(10);
    }
    if (IN(11)) { _Pragma("unroll 1") for (int rep = 0; rep < REPS(11); ++rep) { if (rep) xcd_barrier(bar);
        const int* BLKE = (const int*)(ws + WS_BLKE); const int nblk = BLKE[NBLK_MAX];
        pg8::GemmDesc g{512, 512, 512};
        pg8::OrderMoe S{nblk, F.G, (int)blockIdx.x, BLKE, (const char*)(ws + WS_HBUF), (const char*)(F.dout + DO_EXPDN), (size_t)256 * 512 * 2, (size_t)1024 * 512 * 2, (size_t)256 * 512 * 2};
        pg8::EpiY E{(bf16*)(ws + WS_Y), 1024};
        pg8::gemm_phase<pg8::EpiY, pg8::OrderMoe>(F.lds + RING_OFF, g, S, E);
}         SEAM(11);
    }
    if (IN(12)) { _Pragma("unroll 1") for (int rep = 0; rep < REPS(12); ++rep) { if (rep) xcd_barrier(bar); combine_phase(F, args.out); } }
#undef IN
#undef SEAM
}

extern "C" void kernel_launch(void* const* d_in, const int* in_sizes, int n_in, void* d_out, int out_size, void* d_ws, size_t ws_size, hipStream_t stream) {
    static int grid = 0;
    if (grid == 0) {
        if (n_in != 21 || out_size != T * D || ws_size < WS_END) { fprintf(stderr, "kernel_launch: unexpected shapes (n_in %d out %d ws %zu)\n", n_in, out_size, ws_size); grid = -1; return; }
        int dev = 0, cus = 0, per_cu = 0;
        if (hipGetDevice(&dev) != hipSuccess || hipDeviceGetAttribute(&cus, hipDeviceAttributeMultiprocessorCount, dev) != hipSuccess) { grid = -1; return; }
        if (hipFuncSetAttribute((const void*)fwd_kernel, hipFuncAttributeMaxDynamicSharedMemorySize, LDS_BYTES) != hipSuccess) { fprintf(stderr, "kernel_launch: hipFuncSetAttribute failed\n"); grid = -1; return; }
        if (hipOccupancyMaxActiveBlocksPerMultiprocessor(&per_cu, (const void*)fwd_kernel, NTHR, LDS_BYTES) != hipSuccess || per_cu < 1) fprintf(stderr, "kernel_launch: occupancy query reports %d\n", per_cu);
        (void)hipGetLastError();
        grid = cus;
    }
    if (grid < 0) return;
    if (hipMemsetAsync((char*)d_ws + WS_CTL, 0, CTL_ZERO_BYTES, stream) != hipSuccess) return;
    Args a{};
    for (int i = 0; i < 21; ++i) a.I.in[i] = (const float*)d_in[i];
    a.out = (float*)d_out; a.ws = (unsigned char*)d_ws;
#if defined(PROBE_PLAN)
    { const int plan[3][2] = {{0, PROBE_PLAN + 1}, {PROBE_PLAN, PROBE_PLAN + 1}, {PROBE_PLAN + 1, PER_PHASE}};
      for (int li = 0; li < 3; ++li) { a.ph_lo = plan[li][0]; a.ph_hi = plan[li][1]; a.li = li; hipLaunchKernelGGL(fwd_kernel, dim3(grid), dim3(NTHR), LDS_BYTES, stream, a); } return; }
#endif
    if (MK_N_LAUNCHES == 1) { a.ph_lo = 0; a.ph_hi = PER_PHASE; a.li = 0; hipLaunchKernelGGL(fwd_kernel, dim3(grid), dim3(NTHR), LDS_BYTES, stream, a); }
    else for (int li = 0; li < PER_PHASE; ++li) { a.ph_lo = li; a.ph_hi = li + 1; a.li = li; hipLaunchKernelGGL(fwd_kernel, dim3(grid), dim3(NTHR), LDS_BYTES, stream, a); }
}
```

```cpp
#include <hip/hip_runtime.h>
#include <cstdio>
#include <cstdint>

#ifndef MK_N_LAUNCHES
#define MK_N_LAUNCHES 1
#endif

#define GAS __attribute__((address_space(1)))
#define LAS __attribute__((address_space(3)))
typedef unsigned short bf16;
typedef unsigned v4u __attribute__((ext_vector_type(4)));
typedef unsigned v2u __attribute__((ext_vector_type(2)));
typedef float f32x2 __attribute__((ext_vector_type(2)));
typedef float f32x4 __attribute__((ext_vector_type(4)));
typedef float f32x16 __attribute__((ext_vector_type(16)));
typedef short bf16x8 __attribute__((ext_vector_type(8)));
typedef short bf16x4 __attribute__((ext_vector_type(4)));
typedef __bf16 hbf2 __attribute__((ext_vector_type(2)));

#define DI __device__ __forceinline__
DI unsigned pk2(float lo, float hi) { f32x2 v = {lo, hi}; hbf2 r = __builtin_convertvector(v, hbf2); return __builtin_bit_cast(unsigned, r); }
DI bf16 f2bf(float f) { return (bf16)(pk2(f, 0.f) & 0xffffu); }
DI float bf2f(bf16 b) { return __builtin_bit_cast(float, ((unsigned)b) << 16); }
DI float bflo(unsigned u) { return __builtin_bit_cast(float, u << 16); }
DI float bfhi(unsigned u) { return __builtin_bit_cast(float, u & 0xffff0000u); }
DI float xor32_sum(float x) { const unsigned u = __builtin_bit_cast(unsigned, x); const auto r = __builtin_amdgcn_permlane32_swap(u, u, false, false); return __builtin_bit_cast(float, (unsigned)r[0]) + __builtin_bit_cast(float, (unsigned)r[1]); }
DI float xor16_sum(float x) { const unsigned u = __builtin_bit_cast(unsigned, x); const auto r = __builtin_amdgcn_permlane16_swap(u, u, false, false); return __builtin_bit_cast(float, (unsigned)r[0]) + __builtin_bit_cast(float, (unsigned)r[1]); }
DI float xor32_max(float x) { const unsigned u = __builtin_bit_cast(unsigned, x); const auto r = __builtin_amdgcn_permlane32_swap(u, u, false, false); return fmaxf(__builtin_bit_cast(float, (unsigned)r[0]), __builtin_bit_cast(float, (unsigned)r[1])); }
#define DPPF(x, ctrl) __builtin_bit_cast(float, __builtin_amdgcn_mov_dpp(__builtin_bit_cast(int, (x)), (ctrl), 0xf, 0xf, false))
DI float row16_sum(float x) { x += DPPF(x, 0x128); x += DPPF(x, 0x124); x += DPPF(x, 0x122); x += DPPF(x, 0x121); return x; }
DI float grp8_sum(float x) { x += DPPF(x, 0x141); x += DPPF(x, 0x1B); x += DPPF(x, 0xB1); return x; }
DI float rs32(float a, float b) { const auto r = __builtin_amdgcn_permlane32_swap(__builtin_bit_cast(unsigned, a), __builtin_bit_cast(unsigned, b), false, false); return __builtin_bit_cast(float, (unsigned)r[0]) + __builtin_bit_cast(float, (unsigned)r[1]); }
DI float rs16(float a, float b) { const auto r = __builtin_amdgcn_permlane16_swap(__builtin_bit_cast(unsigned, a), __builtin_bit_cast(unsigned, b), false, false); return __builtin_bit_cast(float, (unsigned)r[0]) + __builtin_bit_cast(float, (unsigned)r[1]); }

constexpr int T = 32768, D = 1024, SEQ = 8192;
constexpr int N1 = 6656;
constexpr int IN_COLS = 6672;
constexpr int NSEG = 16, TSEG = SEQ / NSEG;
constexpr float EPS = 1e-6f;
constexpr float LOG2E = 1.4426950408889634f;
constexpr int PMAX = 65536 + 32 * 256;
constexpr int NBLK_MAX = PMAX / 256;

constexpr size_t MiB = 1u << 20;
constexpr size_t WS_CTL = 0, CTL_ZERO_BYTES = 256 * 1024;
constexpr size_t WS_LB = 1 * MiB;
constexpr size_t WS_W1T = 1 * MiB;
constexpr size_t WS_WBGT = 15 * MiB, WS_WPGT = 19 * MiB, WS_WPAT = 20 * MiB, WS_WOUTT = 21 * MiB, WS_WRH = 23 * MiB;
constexpr size_t WS_XN = 24 * MiB;
constexpr size_t WS_GLAQ = 88 * MiB, WS_GLAK = 120 * MiB, WS_GALR = 152 * MiB  , WS_GLAV = 184 * MiB;
constexpr size_t WS_DILQ = 216 * MiB, WS_DILK = 312 * MiB, WS_DILV = 408 * MiB;
constexpr size_t WS_STATS = 504 * MiB;
constexpr size_t WS_LSE = WS_STATS;
constexpr size_t WS_DSEG = WS_STATS + 1536 * 1024;
constexpr size_t WS_TOKE = WS_STATS + 2 * MiB;
constexpr size_t WS_TOKW = WS_TOKE + 256 * 1024;
constexpr size_t WS_TOKR = WS_TOKW + 256 * 1024;
constexpr size_t WS_DEST = WS_TOKR + 256 * 1024;
constexpr size_t WS_ROWW = WS_DEST + 256 * 1024;
constexpr size_t WS_BLKE = WS_ROWW + 640 * 1024;
constexpr size_t WS_END = 512 * MiB;
constexpr size_t WS_GATES = 376 * MiB;
constexpr size_t WS_MERGED = 312 * MiB;
constexpr size_t WS_X1 = 88 * MiB;
constexpr size_t WS_H2 = 24 * MiB;
constexpr size_t WS_XP = 216 * MiB;
constexpr size_t WS_HBUF = 360 * MiB;
constexpr size_t WS_Y = 216 * MiB;
constexpr size_t WS_ROWTOK = 440 * MiB;
constexpr size_t DO_R = 0;
constexpr size_t DO_EXPGU = 32 * MiB;
constexpr size_t DO_EXPDN = 96 * MiB;
constexpr int CW_BAR = 4096;
constexpr int CW_GCNT = 16384;

constexpr int RING_OFF = 0, RING_BYTES = 131072;
constexpr int LDSCTL_OFF = RING_BYTES, MISC_OFF = LDSCTL_OFF + 320;
constexpr int LDS_BYTES = 147456;

#define XB_TMO      128
#define XB_XCNT(j)  (256  + 64 * (j))
#define XB_XSUB(j)  (1280 + 64 * (j))
#define XB_XGEN(j)  (2304 + 64 * (j))
#define XB_TOP      3328
#define XB_TOPGEN   3392
#define XCD_BAR_WORDS 3456
#define XB_SPIN_CAP (1u << 18)
DI unsigned xb_ld(unsigned* p)              { return __hip_atomic_load(p, __ATOMIC_RELAXED, __HIP_MEMORY_SCOPE_AGENT); }
DI unsigned xb_add(unsigned* p, unsigned v) { return __hip_atomic_fetch_add(p, v, __ATOMIC_RELAXED, __HIP_MEMORY_SCOPE_AGENT); }
DI unsigned xb_xcc_id() { return (unsigned)__builtin_amdgcn_s_getreg((3 << 11) | 20) & 0xFu; }
#define XB_SPIN(cond, bar) do { unsigned _sp = 0; while (cond) { __builtin_amdgcn_s_sleep(1); \
    if ((++_sp & 255u) == 0u) { if (xb_ld(&(bar)[XB_TMO])) break; if (_sp > XB_SPIN_CAP) { atomicAdd(&(bar)[XB_TMO], 1u); break; } } } } while (0)
struct XcdBarrier { unsigned* bar; unsigned x; volatile LAS unsigned* st; };
DI XcdBarrier xcd_barrier_post(unsigned* bar, volatile LAS unsigned* st) {
    XcdBarrier b; b.bar = bar; b.x = xb_xcc_id(); b.st = st;
    if (threadIdx.x == 0) (void)xb_add(&bar[XB_XCNT(b.x)], 1u);
    return b;
}
DI void xcd_barrier_complete(unsigned* bar, unsigned x, unsigned& nloc, unsigned& nx) {
    const unsigned G = gridDim.x * gridDim.y * gridDim.z;
    unsigned sum, cnt, mine, sp = 0u;
    for (;;) {
        sum = 0u; cnt = 0u; mine = 0u;
#pragma unroll
        for (unsigned j = 0; j < 16; ++j) { const unsigned c = xb_ld(&bar[XB_XCNT(j)]); sum += c; cnt += (c > 0u) ? 1u : 0u; mine = (j == x) ? c : mine; }
        if (sum == G) break;
        __builtin_amdgcn_s_sleep(1);
        if ((++sp & 255u) == 0u) { if (xb_ld(&bar[XB_TMO])) break; if (sp > XB_SPIN_CAP) { atomicAdd(&bar[XB_TMO], 1u); break; } }
    }
    nloc = mine > 0u ? mine : 1u; nx = cnt > 0u ? cnt : 1u;
}
DI void xcd_barrier(const XcdBarrier& b) {
    asm volatile("s_waitcnt vmcnt(0)" ::: "memory");
    __syncthreads();
    if (threadIdx.x == 0) {
        unsigned* bar = b.bar;
        __builtin_amdgcn_s_waitcnt(0);
        unsigned nloc = b.st[0], nx = b.st[1];
        if (nloc == 0u) { xcd_barrier_complete(bar, b.x, nloc, nx); b.st[0] = nloc; b.st[1] = nx; }
        const unsigned old = xb_add(&bar[XB_XSUB(b.x)], 1u);
        const unsigned gen = old / nloc;
        if (old + 1u == (gen + 1u) * nloc) {
            __builtin_amdgcn_fence(__ATOMIC_RELEASE, "agent");
            asm volatile("s_waitcnt vmcnt(0)" ::: "memory");
            const unsigned og = xb_add(&bar[XB_TOP], 1u);
            const unsigned tg = og / nx;
            if (og + 1u == (tg + 1u) * nx) xb_add(&bar[XB_TOPGEN], 1u);
            else XB_SPIN(xb_ld(&bar[XB_TOPGEN]) == tg, bar);
            __builtin_amdgcn_fence(__ATOMIC_ACQUIRE, "agent");
            xb_add(&bar[XB_XGEN(b.x)], 1u);
            asm volatile("s_waitcnt vmcnt(0)" ::: "memory");
        } else {
            XB_SPIN(xb_ld(&bar[XB_XGEN(b.x)]) == gen, bar);
            __builtin_amdgcn_fence(__ATOMIC_ACQUIRE, "agent");
            asm volatile("s_waitcnt vmcnt(0)" ::: "memory");
        }
    }
    __syncthreads();
}

namespace pg8 {
constexpr int BM = 256, BK = 64, HALF = 128, HTB = HALF * BK * 2, STAGE_BYTES = 8 * HTB, NXCD = 8, WGM = 8;
__host__ __device__ __forceinline__ int lds_byte(int r, int c) { const int st = (r >> 4) * 2 + (c >> 5), rr = r & 15, cc = c & 31, ob = rr * 64 + cc * 2; return st * 1024 + (ob ^ (((ob >> 9) & 1) << 5)); }
__host__ __device__ __forceinline__ void stage_rc(int b, int& R, int& C) { const int st = b / 1024, sb = b % 1024, swz = sb ^ (((sb >> 9) & 1) << 5); R = (st >> 1) * 16 + swz / 64; C = (st & 1) * 32 + (swz % 64) / 2; }
__host__ __device__ __forceinline__ int perm32(int rho) { const int n = rho >> 4, i = rho & 15; return 8 * (i >> 2) + 4 * n + (i & 3); }

struct Unit { const char* A; const char* B; int pm, pn, aux; };
struct GemmDesc { int lda, ldb, K; };

DI bool static_tile(int L, int nM, int nN, int& pm, int& pn) {
    const int nwg = nM * nN; if (L >= nwg) return false;
    int wgid = L; { const int q = nwg / NXCD, r = nwg % NXCD, xcd = wgid % NXCD, off = wgid / NXCD; wgid = (xcd < r ? xcd * (q + 1) : r * (q + 1) + (xcd - r) * q) + off; }
    const int nig = WGM * nN, gid = wgid / nig, fm = gid * WGM, gsz = (nM - fm) < WGM ? (nM - fm) : WGM;
    pm = fm + ((wgid % nig) % gsz); pn = (wgid % nig) / gsz; return true;
}
struct OrderStd {
    int nM, nN, G, c; const char* A0; const char* B0; size_t sA, sB;
    DI bool next(int i, Unit& u) const {
        int pm, pn; if (!static_tile(i * G + c, nM, nN, pm, pn)) return false;
        u.pm = pm; u.pn = pn; u.aux = 0; u.A = A0 + (size_t)pm * sA; u.B = B0 + (size_t)pn * sB; return true;
    }
};
struct OrderPair {
    int nM, nN, G, c; const char* A0; const char* A1; const char* B0; const char* B1; size_t sA, sB;
    DI bool next(int i, Unit& u) const {
        int pm, pn; if (!static_tile((i >> 1) * G + c, nM, nN, pm, pn)) return false;
        const int br = i & 1; u.pm = pm; u.pn = pn; u.aux = br; u.A = (br ? A1 : A0) + (size_t)pm * sA; u.B = (br ? B1 : B0) + (size_t)pn * sB; return true;
    }
};
struct OrderProj2 {
    int nM, nh, G, c; const char* A0; const char* A1; const char* B0; const char* B1; size_t sA, sB;
    DI bool next(int i, Unit& u) const {
        int pm, pn; if (!static_tile(i * G + c, nM, 2 * nh, pm, pn)) return false;
        const int br = pn >= nh; u.pm = pm; u.pn = pn; u.aux = br; u.A = (br ? A1 : A0) + (size_t)pm * sA; u.B = (br ? B1 : B0) + (size_t)(pn - br * nh) * sB; return true;
    }
};
struct OrderMoe {
    int nblk, G, c; const int* blke; const int* rowtok; const char* A0; const char* B0; size_t sA, sE, sB;
    DI bool next(int i, Unit& u) const {
        int rb, pn;
        if ((G & 31) == 0) { const int R = G >> 2, per = R >> 3, loc = c >> 3; rb = i * R + (c & 7) * per + (loc >> 2); pn = loc & 3; }
        else { const int L = i * G + c; rb = L >> 2; pn = L & 3; }
        if (rb >= nblk) return false;
        const int e = blke[rb];
        u.pm = rb; u.pn = pn; u.aux = 0;
        u.A = A0 + (size_t)rb * sA; u.B = B0 + (size_t)e * sE + (size_t)pn * sB; return true;
    }
};

#define PG8_LAS __attribute__((address_space(3)))
template <class Epi, class Sched, bool ALIGN_EPI = true, bool SP2 = true, bool GATHER = false>
DI void gemm_phase(PG8_LAS unsigned char* lds, const GemmDesc g, const Sched& S, const Epi& E) {
    const int tid = threadIdx.x, wid = __builtin_amdgcn_readfirstlane(tid >> 6), lane = tid & 63, wr = wid >> 2, wc = wid & 3, fr = lane & 15, fq = lane >> 4;
    const int K = g.K, nt = K / BK;
    static_assert(SP2 || !GATHER, "GATHER is written for the SP2 loop");
    unsigned vA[2][2], vAn[2][2], voffB[2]; int Rr[2]; unsigned cO[2];
#pragma unroll
    for (int i = 0; i < 2; ++i) { int R, C; stage_rc(tid * 16 + i * 8192, R, C); const int Rb = Epi::PERM ? ((R & ~31) + perm32(R & 31)) : R;
        Rr[i] = R; cO[i] = (unsigned)C * 2u; vA[0][i] = (unsigned)(R * g.lda + C) * 2u; vA[1][i] = (unsigned)((R + HALF) * g.lda + C) * 2u; voffB[i] = (unsigned)(Rb * g.ldb + C) * 2u;
        vAn[0][i] = vA[0][i]; vAn[1][i] = vA[1][i]; }
#define PG8_GOFFS(dst, unit) do { _Pragma("unroll") for (int _h = 0; _h < 2; ++_h) _Pragma("unroll") for (int _i = 0; _i < 2; ++_i) \
        dst[_h][_i] = (unsigned)S.rowtok[(unit).pm * BM + _h * HALF + Rr[_i]] * (unsigned)(g.lda * 2) + cO[_i]; } while (0)
    const size_t kstep = (size_t)(BK * 2);
    const size_t hstepA = (size_t)HALF * g.lda * 2, hstepB = (size_t)HALF * g.ldb * 2;
    const unsigned ldsw = (unsigned)wid * 1024u;
    const int aoff = lds_byte(wr * 64 + fr, fq * 8), boff = Epi::WIDE ? lds_byte((wc & 1) * 64 + fr, fq * 8) + (wc >> 1) * HTB : lds_byte(wc * 32 + fr, fq * 8);
#define PG8_SA(b, h) (((b) * 2 + (h)) * HTB)
#define PG8_SB(b, h) ((4 + (b) * 2 + (h)) * HTB)
#define PG8_STAGE(bufoff, gbase, voff) do { _Pragma("unroll") for (int _i = 0; _i < 2; ++_i) \
        __builtin_amdgcn_global_load_lds((const unsigned*)((const char*)(gbase) + (voff)[_i]), (PG8_LAS unsigned*)(lds + (bufoff) + ldsw + _i * 8192), 16, 0, 0); } while (0)
#define PG8_LDA(dst, b, h) do { _Pragma("unroll") for (int m = 0; m < 4; ++m) _Pragma("unroll") for (int k = 0; k < 2; ++k) dst[m][k] = *(const PG8_LAS bf16x8*)(lds + PG8_SA(b, h) + aoff + m * 2048 + k * 1024); } while (0)
#define PG8_LDB(dst, b, h) do { _Pragma("unroll") for (int n = 0; n < 2; ++n) _Pragma("unroll") for (int k = 0; k < 2; ++k) dst[n][k] = *(const PG8_LAS bf16x8*)(lds + (Epi::WIDE ? PG8_SB(b, 0) + (h) * 4096 : PG8_SB(b, h)) + boff + n * 2048 + k * 1024); } while (0)
#define PG8_MMA(ai, bj, At, Bt) do { __builtin_amdgcn_s_setprio(1); _Pragma("unroll") for (int m = 0; m < 4; ++m) _Pragma("unroll") for (int n = 0; n < 2; ++n) _Pragma("unroll") for (int k = 0; k < 2; ++k) \
        acc[ai][bj][m][n] = __builtin_amdgcn_mfma_f32_16x16x32_bf16(Bt[n][k], At[m][k], acc[ai][bj][m][n], 0, 0, 0); __builtin_amdgcn_s_setprio(0); } while (0)
#define PG8_WAIT_V(n) asm volatile("s_waitcnt vmcnt(" #n ")" ::: "memory")
#define PG8_WAIT_L(n) asm volatile("s_waitcnt lgkmcnt(" #n ")" ::: "memory")
#define PG8_BAR __builtin_amdgcn_s_barrier()
#define PG8_SCHED __builtin_amdgcn_sched_barrier(0)
    Unit cur, nxt; int ui = 0;
    if (!S.next(0, cur)) return;
    f32x4 acc[2][2][4][2];
#pragma unroll
    for (int a = 0; a < 2; ++a)
#pragma unroll
        for (int b = 0; b < 2; ++b)
#pragma unroll
            for (int m = 0; m < 4; ++m)
#pragma unroll
                for (int n = 0; n < 2; ++n) acc[a][b][m][n] = (f32x4){0.f, 0.f, 0.f, 0.f};
    bf16x8 At[4][2], B0[2][2], B1[2][2];
    const char* cA = cur.A; const char* cB = cur.B;
    if constexpr (GATHER) { PG8_GOFFS(vA, cur); }
    if constexpr (SP2) {
        PG8_STAGE(PG8_SB(0, 0), cB, voffB); PG8_STAGE(PG8_SB(0, 1), cB + hstepB, voffB); PG8_STAGE(PG8_SA(0, 0), cA, vA[0]); PG8_STAGE(PG8_SA(0, 1), cA, vA[1]);
        if (wr == 1) PG8_BAR;
        PG8_WAIT_V(2); PG8_BAR;
        PG8_STAGE(PG8_SB(1, 0), cB + kstep, voffB); PG8_STAGE(PG8_SA(1, 0), cA + kstep, vA[0]); PG8_STAGE(PG8_SB(1, 1), cB + hstepB + kstep, voffB);
        PG8_WAIT_V(6); PG8_BAR;
    } else {
        PG8_STAGE(PG8_SB(0, 0), cB, voffB); PG8_STAGE(PG8_SA(0, 0), cA, vA[0]); PG8_STAGE(PG8_SB(0, 1), cB + hstepB, voffB); PG8_STAGE(PG8_SA(0, 1), cA, vA[1]);
        if (wr == 1) PG8_BAR;
        PG8_WAIT_V(4); PG8_BAR;
        PG8_STAGE(PG8_SB(1, 0), cB + kstep, voffB); PG8_STAGE(PG8_SA(1, 0), cA + kstep, vA[0]); PG8_STAGE(PG8_SB(1, 1), cB + hstepB + kstep, voffB);
        PG8_WAIT_V(6); PG8_BAR;
    }
    for (;;) {
        const bool has_next = S.next(ui + 1, nxt);
        const char* nA = has_next ? nxt.A : cA; const char* nB = has_next ? nxt.B : cB;
        if constexpr (GATHER) { if (has_next) { PG8_GOFFS(vAn, nxt); } }
        for (int t = 0; t < nt; t += 2) {
            const bool last = (t == nt - 2);
            const char* a1 = cA + (size_t)(t + 1) * kstep;
            const char* a2 = last ? nA : cA + (size_t)(t + 2) * kstep; const char* b2 = last ? nB : cB + (size_t)(t + 2) * kstep;
            const char* a3 = a2 + kstep; const char* b3 = b2 + kstep;
            if constexpr (SP2) {
            unsigned w0[2], w1[2];
#pragma unroll
            for (int _i = 0; _i < 2; ++_i) { w0[_i] = last ? vAn[0][_i] : vA[0][_i]; w1[_i] = last ? vAn[1][_i] : vA[1][_i]; }
            PG8_LDB(B0, 0, 0); PG8_LDB(B1, 0, 1); PG8_SCHED; PG8_LDA(At, 0, 0); PG8_STAGE(PG8_SA(1, 1), a1, vA[1]);
            PG8_WAIT_V(8); PG8_WAIT_L(0); PG8_BAR; PG8_MMA(0, 0, At, B0); PG8_MMA(0, 1, At, B1); PG8_BAR; PG8_SCHED;
            PG8_LDA(At, 0, 1); PG8_STAGE(PG8_SB(0, 0), b2, voffB); PG8_STAGE(PG8_SB(0, 1), b2 + hstepB, voffB); PG8_STAGE(PG8_SA(0, 0), a2, w0);
            PG8_WAIT_V(8); PG8_WAIT_L(0); PG8_BAR; PG8_MMA(1, 0, At, B0); PG8_MMA(1, 1, At, B1); PG8_BAR; PG8_SCHED;
            PG8_LDB(B0, 1, 0); PG8_LDB(B1, 1, 1); PG8_SCHED; PG8_LDA(At, 1, 0); PG8_STAGE(PG8_SA(0, 1), a2, w1);
            PG8_WAIT_V(8); PG8_WAIT_L(0); PG8_BAR; PG8_MMA(0, 0, At, B0); PG8_MMA(0, 1, At, B1); PG8_BAR; PG8_SCHED;
            PG8_LDA(At, 1, 1); PG8_STAGE(PG8_SB(1, 0), b3, voffB); PG8_STAGE(PG8_SB(1, 1), b3 + hstepB, voffB); PG8_STAGE(PG8_SA(1, 0), a3, w0);
            PG8_WAIT_V(8); PG8_WAIT_L(0); PG8_BAR; PG8_MMA(1, 0, At, B0); PG8_MMA(1, 1, At, B1); PG8_BAR; PG8_SCHED;
            } else {
            PG8_LDB(B0, 0, 0); PG8_SCHED; PG8_LDA(At, 0, 0); PG8_STAGE(PG8_SA(1, 1), a1, vA[1]);
            PG8_WAIT_L(8); PG8_BAR; PG8_WAIT_L(0); PG8_MMA(0, 0, At, B0); PG8_BAR; PG8_SCHED;
            PG8_LDB(B1, 0, 1); PG8_STAGE(PG8_SB(0, 0), b2, voffB);
            PG8_BAR; PG8_WAIT_L(0); PG8_MMA(0, 1, At, B1); PG8_BAR;
            PG8_LDA(At, 0, 1); PG8_STAGE(PG8_SA(0, 0), a2, vA[0]);
            PG8_BAR; PG8_WAIT_L(0); PG8_MMA(1, 0, At, B0); PG8_BAR; PG8_SCHED;
            PG8_STAGE(PG8_SB(0, 1), b2 + hstepB, voffB);
            PG8_WAIT_V(6); PG8_BAR; PG8_MMA(1, 1, At, B1); PG8_BAR;
            PG8_LDB(B0, 1, 0); PG8_SCHED; PG8_LDA(At, 1, 0); PG8_STAGE(PG8_SA(0, 1), a2, vA[1]);
            PG8_WAIT_L(8); PG8_BAR; PG8_WAIT_L(0); PG8_MMA(0, 0, At, B0); PG8_BAR; PG8_SCHED;
            PG8_LDB(B1, 1, 1); PG8_STAGE(PG8_SB(1, 0), b3, voffB);
            PG8_BAR; PG8_WAIT_L(0); PG8_MMA(0, 1, At, B1); PG8_BAR;
            PG8_LDA(At, 1, 1); PG8_STAGE(PG8_SA(1, 0), a3, vA[0]);
            PG8_BAR; PG8_WAIT_L(0); PG8_MMA(1, 0, At, B0); PG8_BAR; PG8_SCHED;
            PG8_STAGE(PG8_SB(1, 1), b3 + hstepB, voffB);
            PG8_WAIT_V(6); PG8_BAR; PG8_MMA(1, 1, At, B1); PG8_BAR;
            }
        }
        if constexpr (ALIGN_EPI) { if (wr == 0) PG8_BAR; }
        E(acc, cur, wr, wc, fr, fq);
        if (!has_next) break;
#pragma unroll
        for (int a = 0; a < 2; ++a)
#pragma unroll
            for (int b = 0; b < 2; ++b)
#pragma unroll
                for (int m = 0; m < 4; ++m)
#pragma unroll
                    for (int n = 0; n < 2; ++n) acc[a][b][m][n] = (f32x4){0.f, 0.f, 0.f, 0.f};
        cur = nxt; cA = nA; cB = nB; ++ui;
#pragma unroll
        for (int _h = 0; _h < 2; ++_h)
#pragma unroll
            for (int _i = 0; _i < 2; ++_i) vA[_h][_i] = vAn[_h][_i];
        if constexpr (ALIGN_EPI) { if (wr == 1) PG8_BAR; }
    }
    PG8_WAIT_V(0);
    if constexpr (!ALIGN_EPI) { if (wr == 0) PG8_BAR; }
    PG8_BAR;
#undef PG8_GOFFS
#undef PG8_SA
#undef PG8_SB
#undef PG8_STAGE
#undef PG8_LDA
#undef PG8_LDB
#undef PG8_MMA
#undef PG8_WAIT_V
#undef PG8_WAIT_L
#undef PG8_BAR
#undef PG8_SCHED
}

typedef f32x4 AccT[2][2][4][2];
DI float fexp(float v) { return __builtin_amdgcn_exp2f(v * 1.4426950408889634f); }
DI float sigmoid_f(float v) { return __builtin_amdgcn_rcpf(1.f + fexp(-v)); }
DI float silu_f(float v) { return v * sigmoid_f(v); }
DI float logsig16(float v) { return (fminf(v, 0.f) - __builtin_amdgcn_logf(1.f + fexp(-fabsf(v))) * 0.6931471805599453f) * 0.0625f; }
DI v4u pack8(f32x4 a, f32x4 b) { v4u w; w.x = pk2(a[0], a[1]); w.y = pk2(a[2], a[3]); w.z = pk2(b[0], b[1]); w.w = pk2(b[2], b[3]); return w; }

DI void wide_pair(const v4u P0, const v4u P1, v4u& SA, v4u& SB) {
#pragma unroll
    for (int c = 0; c < 4; ++c) { SA[c] = (unsigned)__builtin_amdgcn_update_dpp((int)P0[c], (int)P1[c], 0x128, 0xF, 0xC, false);
                                  SB[c] = (unsigned)__builtin_amdgcn_update_dpp((int)P1[c], (int)P0[c], 0x128, 0xF, 0x3, false); }
}
struct EpiP1 {
    static constexpr bool PERM = true, WIDE = true;
    unsigned char* ws; unsigned char* dout; const float* gq; const float* gk; LAS float* xch;
    DI void operator()(const AccT& acc, const Unit& u, int wr, int wc, int fr, int fq) const {
        const int pn = u.pn, rowA = u.pm * BM + wr * 64 + (fr & 7), clw = (wc >> 1) * HALF + (wc & 1) * 64 + (fr >> 3) * 32 + 8 * fq;
        const int rem = pn >= 8 ? (pn - 8) % 6 : 6, gi = pn >= 8 ? (pn - 8) / 6 : 0;
        int mode = 0; const int colbase = (pn & 1) * 256; size_t off;
        if (pn < 8) { const int bi = pn >> 1; off = bi == 0 ? WS_GLAQ : (bi == 1 ? WS_GLAK : (bi == 2 ? WS_GLAV : DO_R)); mode = bi == 3 ? 1 : 0; }
        else { off = (rem < 2 ? WS_DILQ : (rem < 4 ? WS_DILK : WS_DILV)) + (size_t)gi * T * 1024; mode = rem < 4 ? 3 : 0; }
        bf16* dst = (bf16*)(((pn >> 1) == 3 ? dout : ws) + off) + colbase + clw;
        if (mode == 3) {
            const bool isq = rem < 2;
#pragma unroll
            for (int ai = 0; ai < 2; ++ai)
#pragma unroll
                for (int m = 0; m < 4; ++m) { float ss = 0.f;
#pragma unroll
                    for (int bj = 0; bj < 2; ++bj) { const f32x4 v0 = acc[ai][bj][m][0], v1 = acc[ai][bj][m][1];
                        ss += ((v0[0] * v0[0] + v0[1] * v0[1]) + (v0[2] * v0[2] + v0[3] * v0[3])) + ((v1[0] * v1[0] + v1[1] * v1[1]) + (v1[2] * v1[2] + v1[3] * v1[3])); }
                    ss = xor32_sum(xor16_sum(ss));
                    if (fq == 0) xch[(ai * 128 + wr * 64 + m * 16 + fr) * 4 + wc] = ss; }
            asm volatile("s_waitcnt lgkmcnt(0)" ::: "memory"); __builtin_amdgcn_s_barrier(); asm volatile("" ::: "memory");
            const float* gp = (isq ? gq : gk) + gi * 128 + (wc & 1) * 64 + 8 * fq;
            const f32x4 g00 = *(const f32x4*)gp, g01 = *(const f32x4*)(gp + 4), g10 = *(const f32x4*)(gp + 32), g11 = *(const f32x4*)(gp + 36);
            const float qs = isq ? 0.08838834764831845f * LOG2E : 1.f;
#pragma unroll
            for (int ai = 0; ai < 2; ++ai)
#pragma unroll
                for (int m = 0; m < 4; ++m) { const f32x2 t = *(const LAS f32x2*)(xch + (ai * 128 + wr * 64 + m * 16 + fr) * 4 + (wc & 2));
                    const float rinv = __frsqrt_rn((t[0] + t[1]) * (1.f / 128.f) + EPS) * qs;
                    bf16* rp = dst + (size_t)(rowA + ai * HALF + m * 16) * 512; v4u SA, SB;
                    wide_pair(pack8(acc[ai][0][m][0] * rinv * g00, acc[ai][0][m][1] * rinv * g01), pack8(acc[ai][1][m][0] * rinv * g10, acc[ai][1][m][1] * rinv * g11), SA, SB);
                    *(v4u*)rp = SA; *(v4u*)(rp + 8 * 512) = SB; }
            return;
        }
#pragma unroll
        for (int ai = 0; ai < 2; ++ai)
#pragma unroll
            for (int m = 0; m < 4; ++m) { bf16* rp = dst + (size_t)(rowA + ai * HALF + m * 16) * 512; v4u P[2], SA, SB;
#pragma unroll
                for (int bj = 0; bj < 2; ++bj) { f32x4 v0 = acc[ai][bj][m][0], v1 = acc[ai][bj][m][1];
                    if (mode == 1) {
#pragma unroll
                        for (int j = 0; j < 4; ++j) { v0[j] = silu_f(v0[j]); v1[j] = silu_f(v1[j]); } }
                    P[bj] = pack8(v0, v1); }
                wide_pair(P[0], P[1], SA, SB);
                *(v4u*)rp = SA; *(v4u*)(rp + 8 * 512) = SB; }
    }
};
struct EpiGateMerge {
    static constexpr bool PERM = true, WIDE = false;
    bf16* Mg; const bf16* Y; const float* bias; bool dry;
    DI void operator()(const AccT& acc, const Unit& u, int wr, int wc, int fr, int fq) const {
#if defined(PROBE_PLAN)
        if (dry) { asm volatile("" :: "v"(acc[0][0][0][0][0]), "v"(acc[1][1][3][1][3])); return; }
#endif
        const int row0 = u.pm * BM + wr * 64 + fr, col0 = u.pn * HALF + wc * 32 + 8 * fq;
        f32x4 bv[2][2];
#pragma unroll
        for (int bj = 0; bj < 2; ++bj)
#pragma unroll
            for (int n = 0; n < 2; ++n) bv[bj][n] = *(const f32x4*)(bias + bj * 1024 + col0 + 4 * n);
#pragma unroll
        for (int ai = 0; ai < 2; ++ai)
#pragma unroll
            for (int m = 0; m < 4; ++m) { const size_t row = (size_t)(row0 + ai * HALF + m * 16);
                const v4u yg = *(const v4u*)(Y + row * 2048 + col0), ya = *(const v4u*)(Y + row * 2048 + 1024 + col0);
                f32x4 g0 = acc[ai][0][m][0] + bv[0][0], g1 = acc[ai][0][m][1] + bv[0][1], a0 = acc[ai][1][m][0] + bv[1][0], a1 = acc[ai][1][m][1] + bv[1][1];
#pragma unroll
                for (int j = 0; j < 4; ++j) { g0[j] = sigmoid_f(g0[j]); g1[j] = sigmoid_f(g1[j]); a0[j] = sigmoid_f(a0[j]); a1[j] = sigmoid_f(a1[j]); }
                f32x4 o0, o1;
                o0[0] = g0[0] * bflo(yg.x) + a0[0] * bflo(ya.x); o0[1] = g0[1] * bfhi(yg.x) + a0[1] * bfhi(ya.x); o0[2] = g0[2] * bflo(yg.y) + a0[2] * bflo(ya.y); o0[3] = g0[3] * bfhi(yg.y) + a0[3] * bfhi(ya.y);
                o1[0] = g1[0] * bflo(yg.z) + a1[0] * bflo(ya.z); o1[1] = g1[1] * bfhi(yg.z) + a1[1] * bfhi(ya.z); o1[2] = g1[2] * bflo(yg.w) + a1[2] * bflo(ya.w); o1[3] = g1[3] * bfhi(yg.w) + a1[3] * bfhi(ya.w);
                *(v4u*)(Mg + row * 1024 + col0) = pack8(o0, o1); }
    }
};
struct EpiX1 {
    static constexpr bool PERM = true, WIDE = true;
    bf16* X1; const float* X;
    DI void operator()(const AccT& acc, const Unit& u, int wr, int wc, int fr, int fq) const {
        const int row0 = u.pm * BM + wr * 64 + fr, col0 = u.pn * BM + (wc >> 1) * HALF + (wc & 1) * 64 + 8 * fq;
        const int rowA = u.pm * BM + wr * 64 + (fr & 7), colw = u.pn * BM + (wc >> 1) * HALF + (wc & 1) * 64 + (fr >> 3) * 32 + 8 * fq;
#pragma unroll
        for (int ai = 0; ai < 2; ++ai)
#pragma unroll
            for (int m = 0; m < 4; ++m) { const float* xp = X + (size_t)(row0 + ai * HALF + m * 16) * 1024 + col0; v4u SA, SB;
                wide_pair(pack8(acc[ai][0][m][0] + *(const f32x4*)xp, acc[ai][0][m][1] + *(const f32x4*)(xp + 4)), pack8(acc[ai][1][m][0] + *(const f32x4*)(xp + 32), acc[ai][1][m][1] + *(const f32x4*)(xp + 36)), SA, SB);
                bf16* rp = X1 + (size_t)(rowA + ai * HALF + m * 16) * 1024 + colw;
                *(v4u*)rp = SA; *(v4u*)(rp + 8 * 1024) = SB; }
    }
};
struct EpiGU {
    static constexpr bool PERM = true, WIDE = false;
    bf16* H; const f32x2* roww;
    DI void operator()(const AccT& acc, const Unit& u, int wr, int wc, int fr, int fq) const {
        const int row0 = u.pm * BM + wr * 64 + fr, hc0 = u.pn * 128 + wc * 16 + 4 * fq;
#pragma unroll
        for (int ai = 0; ai < 2; ++ai)
#pragma unroll
            for (int m = 0; m < 4; ++m) { const int row = row0 + ai * HALF + m * 16; const f32x2 wv = roww[row]; const float ri = wv.y, w = wv.x * ri;
#pragma unroll
                for (int bj = 0; bj < 2; ++bj) { const f32x4 g = acc[ai][bj][m][0] * ri, up = acc[ai][bj][m][1];
                    v2u o; o.x = pk2(w * silu_f(g[0]) * up[0], w * silu_f(g[1]) * up[1]); o.y = pk2(w * silu_f(g[2]) * up[2], w * silu_f(g[3]) * up[3]);
                    *(v2u*)(H + (size_t)row * 512 + hc0 + bj * 64) = o; } }
    }
};
struct EpiY {
    static constexpr bool PERM = true, WIDE = true;
    bf16* Y; int ld; bool dry;
    DI void operator()(const AccT& acc, const Unit& u, int wr, int wc, int fr, int fq) const {
#if defined(PROBE_PLAN)
        if (dry) { asm volatile("" :: "v"(acc[0][0][0][0][0]), "v"(acc[1][1][3][1][3])); return; }
#endif
        const int rowA = u.pm * BM + wr * 64 + (fr & 7), colw = u.pn * BM + (wc >> 1) * HALF + (wc & 1) * 64 + (fr >> 3) * 32 + 8 * fq;
#pragma unroll
        for (int ai = 0; ai < 2; ++ai)
#pragma unroll
            for (int m = 0; m < 4; ++m) { bf16* rp = Y + (size_t)(rowA + ai * HALF + m * 16) * ld + colw; v4u SA, SB;
                wide_pair(pack8(acc[ai][0][m][0], acc[ai][0][m][1]), pack8(acc[ai][1][m][0], acc[ai][1][m][1]), SA, SB);
                *(v4u*)rp = SA; *(v4u*)(rp + (size_t)8 * ld) = SB; }
    }
};
}

constexpr int NWAVES = 8, NTHR = 512;
struct Frame {
    LAS unsigned char* lds;
    int tid, lane, wave, vcu, G;
    unsigned char* ws; unsigned char* dout;
};
#define LDS_WAIT() asm volatile("s_waitcnt lgkmcnt(0)" ::: "memory")
#define LDS_BARRIER() do { asm volatile("s_waitcnt lgkmcnt(0)" ::: "memory"); __builtin_amdgcn_s_barrier(); asm volatile("" ::: "memory"); } while (0)
DI float wave_sum(float v) {
    return xor32_sum(xor16_sum(row16_sum(v)));
}
#define MFMA16(a, b, c) __builtin_amdgcn_mfma_f32_16x16x32_bf16((a), (b), (c), 0, 0, 0)
#define MFMA32(a, b, c) __builtin_amdgcn_mfma_f32_32x32x16_bf16((a), (b), (c), 0, 0, 0)

struct TItem { const float* src; bf16* dst; const float* gain; int ldw, ldd, kind, aux, hasg; };
struct Ins { const float* in[21]; };
constexpr int I_IN = 16 * 208, I_BG = 16 * 64, I_PG = 8 * 32, I_PA = 8 * 32, I_OUT = 16 * 32, I_GU = 32 * 2 * 16 * 16, I_DN = 32 * 8 * 32;
constexpr int NITEMS = I_IN + I_BG + I_PG + I_PA + I_OUT + I_GU + I_DN;
DI TItem p0_decode(const Frame& F, const Ins& I, int it) {
    TItem t; int r = it; t.gain = I.in[13]; t.hasg = 0;
    if (r < I_IN) { const int kb = r / 208, nb = r % 208; const int n0 = nb * 32, c0 = nb < 64 ? n0 : n0 + 16;
        t.src = I.in[2] + (size_t)kb * 64 * IN_COLS + c0; t.ldw = IN_COLS; t.dst = (bf16*)(F.ws + WS_W1T) + kb * 64; t.ldd = 1024; t.kind = 0; t.aux = n0; return t; } r -= I_IN;
    if (r < I_BG) { const int kb = r / 64, nb = r % 64; t.src = I.in[10] + (size_t)kb * 64 * 2048 + nb * 32; t.ldw = 2048; t.dst = (bf16*)(F.ws + WS_WBGT) + kb * 64; t.ldd = 1024; t.kind = 1; t.aux = nb * 32; return t; } r -= I_BG;
    if (r < I_PG) { const int kb = r / 32, nb = r % 32; t.src = I.in[8] + (size_t)kb * 64 * 1024 + nb * 32; t.ldw = 1024; t.dst = (bf16*)(F.ws + WS_WPGT) + kb * 64; t.ldd = 512; t.kind = 0; t.aux = nb * 32; return t; } r -= I_PG;
    if (r < I_PA) { const int kb = r / 32, nb = r % 32; t.src = I.in[9] + (size_t)kb * 64 * 1024 + nb * 32; t.ldw = 1024; t.dst = (bf16*)(F.ws + WS_WPAT) + kb * 64; t.ldd = 512; t.kind = 0; t.aux = nb * 32; return t; } r -= I_PA;
    if (r < I_OUT) { const int kb = r / 32, nb = r % 32; t.src = I.in[12] + (size_t)kb * 64 * 1024 + nb * 32; t.ldw = 1024; t.dst = (bf16*)(F.ws + WS_WOUTT) + kb * 64; t.ldd = 1024; t.kind = 0; t.aux = nb * 32; return t; } r -= I_OUT;
    if (r < I_GU) { const int e = r / 512, q = r % 512, up = q >> 8, kb = (q >> 4) & 15, nb = q & 15;
        t.src = (up ? I.in[19] : I.in[18]) + (size_t)e * 1024 * 512 + (size_t)kb * 64 * 512 + nb * 32; t.ldw = 512; t.dst = (bf16*)(F.dout + DO_EXPGU) + (size_t)e * 1024 * 1024 + kb * 64; t.ldd = 1024; t.kind = 2; t.aux = nb * 32 * 2 + up; t.gain = I.in[13] + kb * 64; t.hasg = 1; return t; } r -= I_GU;
    { const int e = r / 256, q = r % 256, kb = q / 32, nb = q % 32;
        t.src = I.in[20] + (size_t)e * 512 * 1024 + (size_t)kb * 64 * 1024 + nb * 32; t.ldw = 1024; t.dst = (bf16*)(F.dout + DO_EXPDN) + (size_t)e * 1024 * 512 + kb * 64; t.ldd = 512; t.kind = 0; t.aux = nb * 32; return t; }
}
DI int p0_rowmap(const TItem& t, int n) {
    if (t.kind == 0) return t.aux + n;
    if (t.kind == 1) { const int c = t.aux + n, cc = c & 1023; return (cc >> 7) * 256 + (c >> 10) * 128 + (cc & 127); }
    const int c = (t.aux >> 1) + n; return (c >> 2) * 8 + (c & 3) + 4 * (t.aux & 1);
}
DI void p0_prologue(const Frame& F, const Ins& I, bool pdry) {
    LAS float* scr = (LAS float*)(F.lds + RING_OFF + F.wave * 16384);
    const int gw = F.vcu * NWAVES + F.wave, NGW = F.G * NWAVES, lane = F.lane;
    { float cur[32], nxt[32]; TItem ti = p0_decode(F, I, gw < NITEMS ? gw : 0);
#pragma unroll
      for (int i = 0; i < 32; ++i) cur[i] = ti.src[(size_t)(2 * i + (lane >> 5)) * ti.ldw + (lane & 31)];
#pragma unroll 1
      for (int it = gw; it < NITEMS; it += NGW) {
          const bool more = it + NGW < NITEMS; const TItem tn = p0_decode(F, I, more ? it + NGW : it);
#pragma unroll
          for (int i = 0; i < 32; ++i) nxt[i] = tn.src[(size_t)(2 * i + (lane >> 5)) * tn.ldw + (lane & 31)];
#pragma unroll
          for (int i = 0; i < 32; ++i) scr[(2 * i + (lane >> 5)) * 33 + (lane & 31)] = cur[i];
          LDS_WAIT(); asm volatile("" ::: "memory");
          const int c = lane & 7;
          f32x4 ga = *(const f32x4*)(ti.gain + 8 * c), gb = *(const f32x4*)(ti.gain + 8 * c + 4);
          if (!ti.hasg) { ga = (f32x4){1.f, 1.f, 1.f, 1.f}; gb = ga; }
#pragma unroll
          for (int j = 0; j < 4; ++j) { const int n = (lane >> 3) + 8 * j; const LAS float* sp = scr + (8 * c) * 33 + n;
              v4u o; o.x = pk2(sp[0 * 33] * ga.x, sp[1 * 33] * ga.y); o.y = pk2(sp[2 * 33] * ga.z, sp[3 * 33] * ga.w); o.z = pk2(sp[4 * 33] * gb.x, sp[5 * 33] * gb.y); o.w = pk2(sp[6 * 33] * gb.z, sp[7 * 33] * gb.w);
              *(v4u*)(ti.dst + (size_t)p0_rowmap(ti, n) * ti.ldd + 8 * c) = o; }
          LDS_WAIT(); asm volatile("" ::: "memory");
          ti = tn;
#pragma unroll
          for (int i = 0; i < 32; ++i) cur[i] = nxt[i];
      } }
    { bf16* WRH = (bf16*)(F.ws + WS_WRH); bf16* WRL = WRH + 48 * 1024; const float* wrg = I.in[14]; const float* wre = I.in[16];
      for (int e = (F.vcu * NTHR + F.tid); e < 48 * 1024; e += F.G * NTHR) { const int k = e & 1023, n = e >> 10;
          const float w = (n < 4 ? wrg[k * 4 + n] : (n < 36 ? wre[k * 32 + n - 4] : 0.f)) * I.in[13][k]; const bf16 h = f2bf(w); WRH[e] = h; WRL[e] = f2bf(w - bf2f(h)); } }
    { const float* x = I.in[0]; const float* g1 = I.in[1]; bf16* XN = (bf16*)(F.ws + WS_XN);
      f32x4 gv[4];
#pragma unroll
      for (int j = 0; j < 4; ++j) gv[j] = *(const f32x4*)(g1 + 4 * lane + 256 * j);
      LAS float* wlr = (LAS float*)(F.lds + RING_OFF);
      __syncthreads();
      for (int e = F.tid; e < 16 * 1024; e += NTHR) { const int k = e >> 4, n = e & 15; wlr[n * 1024 + k] = I.in[2][(size_t)k * IN_COLS + 2048 + n] * g1[k]; }
      __syncthreads();
      float* GALR = (float*)(F.ws + WS_GALR);
      f32x4 v[4], vn[4], vb1[4], vb2[4];
#pragma unroll
      for (int rr = 0; rr < 3; ++rr) { const int m0 = gw + rr * NGW; const f32x4* xr = (const f32x4*)(x + (size_t)(m0 < T ? m0 : 0) * D) + lane;
#pragma unroll
        for (int j = 0; j < 4; ++j) { const f32x4 t = xr[64 * j]; if (rr == 0) v[j] = t; else if (rr == 1) vb1[j] = t; else vb2[j] = t; } }
#pragma unroll 1
      for (int m = gw; m < T; m += NGW) { const int mn = m + 3 * NGW < T ? m + 3 * NGW : m; const f32x4* xr = (const f32x4*)(x + (size_t)mn * D) + lane; float s = 0.f;
#pragma unroll
          for (int j = 0; j < 4; ++j) { vn[j] = xr[64 * j]; s += (v[j].x * v[j].x + v[j].y * v[j].y) + (v[j].z * v[j].z + v[j].w * v[j].w); }
          const float rinv = __frsqrt_rn(wave_sum(s) * (1.f / D) + EPS);
          v2u* o8 = (v2u*)(XN + (size_t)m * D) + lane;
#pragma unroll
          for (int j = 0; j < 4; ++j) { v2u o; o.x = pk2(v[j].x * rinv * gv[j].x, v[j].y * rinv * gv[j].y); o.y = pk2(v[j].z * rinv * gv[j].z, v[j].w * rinv * gv[j].w); o8[64 * j] = o; }
#if defined(PROBE_PLAN) && PROBE_SKIP == 2
          if (pdry) { _Pragma("unroll") for (int j = 0; j < 4; ++j) { v[j] = vb1[j]; vb1[j] = vb2[j]; vb2[j] = vn[j]; } continue; }
#endif
          float p[16];
#pragma unroll
          for (int n = 0; n < 16; ++n) { float a = 0.f;
#pragma unroll
              for (int j = 0; j < 4; ++j) { const f32x4 wv = *(const LAS f32x4*)(wlr + n * 1024 + 4 * lane + 256 * j); a += (v[j].x * wv.x + v[j].y * wv.y) + (v[j].z * wv.z + v[j].w * wv.w); }
              p[n] = a; asm volatile("" ::: "memory"); }
#if defined(PROBE_PLAN) && PROBE_SKIP == 1
          if (pdry) { asm volatile("" :: "v"(p[0]), "v"(p[15])); _Pragma("unroll") for (int j = 0; j < 4; ++j) { v[j] = vb1[j]; vb1[j] = vb2[j]; vb2[j] = vn[j]; } continue; }
#endif
          { const bool h3 = lane & 8, h2 = lane & 4; float q8[8], q4[4], q2[2], q1;
#pragma unroll
            for (int i = 0; i < 8; ++i) q8[i] = rs32(p[i], p[i + 8]);
#pragma unroll
            for (int i = 0; i < 4; ++i) q4[i] = rs16(q8[i], q8[i + 4]);
#pragma unroll
            for (int i = 0; i < 2; ++i) { const float snd = h3 ? q4[i] : q4[i + 2], kp = h3 ? q4[i + 2] : q4[i]; q2[i] = kp + __shfl_xor(snd, 8); }
            { const float snd = h2 ? q2[0] : q2[1], kp = h2 ? q2[1] : q2[0]; q1 = kp + __shfl_xor(snd, 4); }
            q1 += __shfl_xor(q1, 2); q1 += __shfl_xor(q1, 1);
            if ((lane & 3) == 0) GALR[(size_t)m * 16 + ((lane >> 5) & 1) * 8 + ((lane >> 4) & 1) * 4 + ((lane >> 3) & 1) * 2 + ((lane >> 2) & 1)] = q1 * rinv; }
#pragma unroll
          for (int j = 0; j < 4; ++j) { v[j] = vb1[j]; vb1[j] = vb2[j]; vb2[j] = vn[j]; } } }
}

DI void qk_norm_phase(const Frame& F, const float* gq, const float* gk, bool dry) {
    const int gw = F.vcu * NWAVES + F.wave, NGW = F.G * NWAVES, lane = F.lane;
    bf16* Q = (bf16*)(F.ws + WS_DILQ);
    for (int rr = gw; rr < 6 * T; rr += NGW) { const int which = rr / T; const int gi = which % 3; const bool isq = which < 3;
        bf16* p = Q + (size_t)rr * 512 + 8 * lane; const v4u v = *(const v4u*)p;
        float x[8] = {bflo(v.x), bfhi(v.x), bflo(v.y), bfhi(v.y), bflo(v.z), bfhi(v.z), bflo(v.w), bfhi(v.w)};
        float s = 0.f;
#pragma unroll
        for (int j = 0; j < 8; ++j) s += x[j] * x[j];
        s += __shfl_xor(s, 1); s += __shfl_xor(s, 2); s += __shfl_xor(s, 4); s += __shfl_xor(s, 8);
        const float rinv = __frsqrt_rn(s * (1.f / 128.f) + EPS) * (isq ? 0.08838834764831845f * LOG2E : 1.f);
        const float* g = (isq ? gq : gk) + gi * 128 + (8 * lane & 127);
        const f32x4 g0 = *(const f32x4*)g, g1 = *(const f32x4*)(g + 4);
        v4u o; o.x = pk2(x[0] * rinv * g0.x, x[1] * rinv * g0.y); o.y = pk2(x[2] * rinv * g0.z, x[3] * rinv * g0.w); o.z = pk2(x[4] * rinv * g1.x, x[5] * rinv * g1.y); o.w = pk2(x[6] * rinv * g1.z, x[7] * rinv * g1.w);
        if (!dry) *(v4u*)p = o; }
}

DI int crow(int i, int h) { return (i & 3) + 8 * (i >> 2) + 4 * h; }
DI int img_off(int row, int ch) { return 256 * row + 16 * (ch ^ (((row & 3) << 2) | ((row >> 2) & 3))); }
typedef short s16x4 __attribute__((ext_vector_type(4)));
DI void attn_round(const Frame& F, int jr, bool dry) {
    const int lane = F.lane, r = lane & 31, h = lane >> 5, w = F.wave, side = w & 1;
    const int job = jr * 8 + w;
    const int gi = job >> 12; int rem = job & 4095;
    const int sh = 2 * gi, d = 1 << sh, L = SEQ >> sh, nqt = L >> 5;
    const int qt = rem % nqt; rem /= nqt; const int res = rem & (d - 1); rem >>= sh; const int head = rem & 3, b = rem >> 2;
    const int p0 = qt * 32, qtA = qt - side;
    const float slope = exp2f(-8.f * (float)(gi * 4 + head + 1) / 12.f) * LOG2E * (float)d;
    bf16* Qg = (bf16*)(F.ws + WS_DILQ) + (size_t)gi * T * 512;
    const bf16* Kg = (const bf16*)(F.ws + WS_DILK) + (size_t)gi * T * 512 + head * 128;
    const bf16* Vg = (const bf16*)(F.ws + WS_DILV) + (size_t)gi * T * 512 + head * 128;
    LAS unsigned char* pbuf = F.lds + (w >> 1) * 32768;
    const size_t qtok = (size_t)b * SEQ + (size_t)(p0 + r) * d + res;
    bf16x8 qf[8];
#pragma unroll
    for (int ks = 0; ks < 8; ++ks) qf[ks] = *(const bf16x8*)(Qg + qtok * 512 + head * 128 + 16 * ks + 8 * h);
    f32x16 O[4];
#pragma unroll
    for (int db = 0; db < 4; ++db)
#pragma unroll
        for (int i = 0; i < 16; ++i) O[db][i] = 0.f;
    float m = -1e30f, l = 0.f;
    const int srow = lane >> 4, sslot = lane & 15;
    v4u ks0[4], vs0[4], ks1[4], vs1[4];
#define ATT_LOAD(KS, VS, sN) do { const int _kb = 32 * (qtA - 4 + (sN)); if (_kb >= 0) { _Pragma("unroll") for (int ii = 0; ii < 4; ++ii) { const int kk = 16 * side + 4 * ii + srow; \
        const size_t _o = ((size_t)b * SEQ + (size_t)(_kb + kk) * d + res) * 512 + 8 * (sslot ^ ((srow << 2) | ii)); KS[ii] = *(const v4u*)(Kg + _o); VS[ii] = *(const v4u*)(Vg + _o); } } } while (0)
#define ATT_STEP(KS, VS, sN) do { const int s_ = (sN); LAS unsigned char* Kimg = pbuf + (s_ & 1) * 16384; LAS unsigned char* Vimg = Kimg + 8192; const int kb = 32 * (qtA - 4 + s_); \
        _Pragma("unroll") for (int ii = 0; ii < 4; ++ii) { *(LAS v4u*)(Kimg + 1024 * (4 * side + ii) + 16 * lane) = KS[ii]; *(LAS v4u*)(Vimg + 1024 * (4 * side + ii) + 16 * lane) = VS[ii]; } \
        if (s_ - 2 >= 0) ATT_LOAD(KS, VS, s_ - 2); \
        LDS_BARRIER(); \
        const int kt = s_ - side; \
        if (kt >= 0 && kt < 5 && kb >= 0) { \
            f32x16 sc; _Pragma("unroll") for (int i = 0; i < 16; ++i) sc[i] = 0.f; \
            _Pragma("unroll") for (int ks = 0; ks < 8; ++ks) { const bf16x8 kf = *(const LAS bf16x8*)(Kimg + img_off(r, 2 * ks + h)); sc = MFMA32(kf, qf[ks], sc); } \
            float mx = -1e30f; const int dq = p0 + r - kb; \
            _Pragma("unroll") for (int i = 0; i < 16; ++i) { const int dist = dq - crow(i, h); const bool ok = dist >= 0 && dist <= 128; const float sv = ok ? sc[i] - slope * (float)dist : -1e30f; sc[i] = sv; mx = fmaxf(mx, sv); } \
            mx = xor32_max(mx); \
            const float mn = fmaxf(m, mx), alpha = __builtin_amdgcn_exp2f(m - mn); const bool grow = !__all(mn <= m); m = mn; \
            float ps = 0.f; \
            _Pragma("unroll") for (int i = 0; i < 16; ++i) { const float pe = __builtin_amdgcn_exp2f(sc[i] - mn);     sc[i] = pe; ps += pe; } \
            l = l * alpha + ps; \
            if (grow) { _Pragma("unroll") for (int db = 0; db < 4; ++db) _Pragma("unroll") for (int i = 0; i < 16; ++i) O[db][i] *= alpha; } \
            bf16x8 pb[2]; \
            _Pragma("unroll") for (int si = 0; si < 2; ++si) { v4u wq; wq.x = pk2(sc[8 * si], sc[8 * si + 1]); wq.y = pk2(sc[8 * si + 2], sc[8 * si + 3]); wq.z = pk2(sc[8 * si + 4], sc[8 * si + 5]); wq.w = pk2(sc[8 * si + 6], sc[8 * si + 7]); pb[si] = __builtin_bit_cast(bf16x8, wq); } \
            const int i16 = lane & 15, q = i16 >> 2, pp = i16 & 3, gl = (lane >> 4) & 1; \
            _Pragma("unroll") for (int db = 0; db < 4; ++db) _Pragma("unroll") for (int si = 0; si < 2; ++si) { \
                const s16x4 lo = __builtin_amdgcn_ds_read_tr16_b64_v4i16((LAS s16x4*)(Vimg + img_off(16 * si + 4 * h + q, 4 * db + 2 * gl + (pp >> 1)) + 8 * (pp & 1))); \
                const s16x4 hi = __builtin_amdgcn_ds_read_tr16_b64_v4i16((LAS s16x4*)(Vimg + img_off(16 * si + 8 + 4 * h + q, 4 * db + 2 * gl + (pp >> 1)) + 8 * (pp & 1))); \
                const bf16x8 vf = __builtin_shufflevector(lo, hi, 0, 1, 2, 3, 4, 5, 6, 7); O[db] = MFMA32(vf, pb[si], O[db]); } } } while (0)
    ATT_LOAD(ks1, vs1, 5); ATT_LOAD(ks0, vs0, 4);
#pragma unroll 1
    for (int s2 = 2; s2 >= 0; --s2) { ATT_STEP(ks1, vs1, 2 * s2 + 1); ATT_STEP(ks0, vs0, 2 * s2); }
    LDS_BARRIER();
#undef ATT_LOAD
#undef ATT_STEP
    const float lt = xor32_sum(l), inv = 1.f / lt;
    bf16* op = Qg + qtok * 512 + head * 128 + 4 * h;
    if (dry) return;
#pragma unroll
    for (int db = 0; db < 4; ++db)
#pragma unroll
        for (int q4 = 0; q4 < 4; ++q4) { v2u o; o.x = pk2(O[db][4 * q4] * inv, O[db][4 * q4 + 1] * inv); o.y = pk2(O[db][4 * q4 + 2] * inv, O[db][4 * q4 + 3] * inv); *(v2u*)(op + 32 * db + 8 * q4) = o; }
    if (h == 0) ((float*)(F.ws + WS_LSE))[(size_t)gi * T * 4 + qtok * 4 + head] = m + log2f(lt);
}

constexpr int G_QS = 0, G_KS = 17408, G_KET = 34816, G_VT = 53248, G_ATT = 71680, G_TOT = 80896, G_DL = 82944, G_OS = 84992, G_LRAW = 83456, G_EC = 87552, G_VRAW = 100864;
constexpr int QS_LD = 136, KT_LD = 72, OS_LD = 132;
DI void gla_pass1(const Frame& F, int item, const float* wa2, const float* ba, bool dry) {
    const int tid = F.tid, lane = F.lane, w = F.wave, fr = lane & 15, g = lane >> 4;
    const int seg = item & (NSEG - 1), bh = item >> 4, hh = bh & 3, b = bh >> 2;
    const int dk = tid & 127, qr = tid >> 7;
    LAS bf16* Qs = (LAS bf16*)(F.lds + G_QS); LAS bf16* Ks = (LAS bf16*)(F.lds + G_KS); LAS bf16* KEt = (LAS bf16*)(F.lds + G_KET); LAS bf16* Vt = (LAS bf16*)(F.lds + G_VT);
    LAS bf16* Att = (LAS bf16*)(F.lds + G_ATT); LAS float* tot = (LAS float*)(F.lds + G_TOT); LAS float* Dl = (LAS float*)(F.lds + G_DL);
    const bf16* GQ = (const bf16*)(F.ws + WS_GLAQ); const bf16* GK = (const bf16*)(F.ws + WS_GLAK); const float* GAL = (const float*)(F.ws + WS_GALR); bf16* GV = (bf16*)(F.ws + WS_GLAV);
    f32x4 S[8];
#pragma unroll
    for (int a = 0; a < 8; ++a) S[a] = (f32x4){0.f, 0.f, 0.f, 0.f};
    float Btot = 0.f;
    const int dv0 = 16 * w;
    v4u sq[2], sk[2], sv[2]; f32x2 sg; unsigned odef[8];
    float wcol[16];
#pragma unroll
    for (int j = 0; j < 16; ++j) wcol[j] = wa2[j * 512 + hh * 128 + dk];
    const float bcol = ba[hh * 128 + dk];
#pragma unroll
    for (int i = 0; i < 8; ++i) odef[i] = 0u;
    const int srow = tid >> 4, sch = tid & 15;
    LAS float* Gl = (LAS float*)(F.lds + G_LRAW); LAS bf16* Vraw = (LAS bf16*)(F.lds + G_VRAW); LAS float* ecum = (LAS float*)(F.lds + G_EC);
    bf16* GQw = (bf16*)(F.ws + WS_GLAQ); v4u qd[2] = {{0u, 0u, 0u, 0u}, {0u, 0u, 0u, 0u}};
    const int troff = ((16 * qr + ((lane & 15) >> 2)) * QS_LD + (w & 1) * 64 + 16 * (lane >> 4) + 4 * (lane & 3)) * 2;
#define GLA_LOAD1(chn) do { const size_t _o = ((size_t)b * SEQ + seg * TSEG + (chn) * 64 + srow) * 512 + hh * 128 + 8 * sch; \
        sg = *(const f32x2*)(GAL + ((size_t)b * SEQ + seg * TSEG + (chn) * 64) * 16 + 2 * tid); \
        _Pragma("unroll") for (int i = 0; i < 2; ++i) { sq[i] = *(const v4u*)(GQ + _o + (size_t)i * 16384); sk[i] = *(const v4u*)(GK + _o + (size_t)i * 16384); sv[i] = *(const v4u*)(GV + _o + (size_t)i * 16384); } } while (0)
    GLA_LOAD1(0);
#pragma unroll 1
    for (int ch = 0; ch < TSEG / 64; ++ch) {
        const size_t tokbase = (size_t)b * SEQ + seg * TSEG + ch * 64;
#pragma unroll
        for (int i = 0; i < 2; ++i) { const int o = (srow + 32 * i) * QS_LD + 8 * sch; *(LAS v4u*)(Qs + o) = sq[i]; *(LAS v4u*)(Ks + o) = sk[i]; *(LAS v4u*)(Vraw + o) = sv[i]; }
        *(LAS f32x2*)(Gl + 2 * tid) = sg;
        if (ch > 0 && !dry) { bf16* op = GV + (tokbase - 64 + 4 * g) * 512 + hh * 128 + dv0 + fr;
#pragma unroll
            for (int it = 0; it < 4; ++it) { op[(size_t)(16 * it) * 512] = (bf16)(odef[2 * it] & 0xffffu); op[(size_t)(16 * it + 1) * 512] = (bf16)(odef[2 * it] >> 16); op[(size_t)(16 * it + 2) * 512] = (bf16)(odef[2 * it + 1] & 0xffffu); op[(size_t)(16 * it + 3) * 512] = (bf16)(odef[2 * it + 1] >> 16); } }
        if (ch > 0 && !dry) { const size_t qo = (tokbase - 64 + srow) * 512 + hh * 128 + 8 * sch; *(v4u*)(GQw + qo) = qd[0]; *(v4u*)(GQw + qo + 16384) = qd[1]; }
        if (ch + 1 < TSEG / 64) GLA_LOAD1(ch + 1);
        LDS_BARRIER();
        float la[16], qv[16], kv[16]; bf16 vv[16];
#pragma unroll
        for (int k4 = 0; k4 < 4; ++k4) { const int o = troff + k4 * 4 * QS_LD * 2;
            const s16x4 q4 = __builtin_amdgcn_ds_read_tr16_b64_v4i16((LAS s16x4*)((LAS unsigned char*)Qs + o));
            const s16x4 k4v = __builtin_amdgcn_ds_read_tr16_b64_v4i16((LAS s16x4*)((LAS unsigned char*)Ks + o)), v4v = __builtin_amdgcn_ds_read_tr16_b64_v4i16((LAS s16x4*)((LAS unsigned char*)Vraw + o));
#pragma unroll
            for (int e = 0; e < 4; ++e) { qv[4 * k4 + e] = bf2f((bf16)q4[e]); kv[4 * k4 + e] = bf2f((bf16)k4v[e]); vv[4 * k4 + e] = (bf16)v4v[e]; } }
#pragma unroll
        for (int i = 0; i < 16; ++i) { const LAS f32x4* gp = (const LAS f32x4*)(Gl + (16 * qr + i) * 16); float a = bcol;
#pragma unroll
            for (int jj = 0; jj < 4; ++jj) { const f32x4 gvv = gp[jj]; a += (gvv.x * wcol[4 * jj] + gvv.y * wcol[4 * jj + 1]) + (gvv.z * wcol[4 * jj + 2] + gvv.w * wcol[4 * jj + 3]); }
            la[i] = pg8::logsig16(a); }
#pragma unroll
        for (int i = 1; i < 16; ++i) la[i] += la[i - 1];
        tot[qr * 128 + dk] = la[15];
        { v4u v0, v1; v0.x = vv[0] | ((unsigned)vv[1] << 16); v0.y = vv[2] | ((unsigned)vv[3] << 16); v0.z = vv[4] | ((unsigned)vv[5] << 16); v0.w = vv[6] | ((unsigned)vv[7] << 16);
          v1.x = vv[8] | ((unsigned)vv[9] << 16); v1.y = vv[10] | ((unsigned)vv[11] << 16); v1.z = vv[12] | ((unsigned)vv[13] << 16); v1.w = vv[14] | ((unsigned)vv[15] << 16);
          *(LAS v4u*)(Vt + dk * KT_LD + 16 * qr) = v0; *(LAS v4u*)(Vt + dk * KT_LD + 16 * qr + 8) = v1; }
        LDS_BARRIER();
        const float t0 = tot[dk], t1 = tot[128 + dk], t2 = tot[256 + dk], t3 = tot[384 + dk];
        const float base = (qr > 0 ? t0 : 0.f) + (qr > 1 ? t1 : 0.f) + (qr > 2 ? t2 : 0.f), blast = (t0 + t1) + (t2 + t3);
        Btot += blast;
        const float eblast = pg8::fexp(blast);
        if (qr == 0) { Dl[dk] = eblast; ecum[dk] = pg8::fexp(Btot - blast); }
        { unsigned ke[8];
#pragma unroll
          for (int i = 0; i < 16; i += 2) { const float b0 = base + la[i], b1 = base + la[i + 1]; const float e0 = pg8::fexp(b0), e1 = pg8::fexp(b1), r0 = __builtin_amdgcn_rcpf(e0), r1 = __builtin_amdgcn_rcpf(e1);
              Qs[(16 * qr + i) * QS_LD + dk] = f2bf(qv[i] * 0.08838834764831845f * e0); Qs[(16 * qr + i + 1) * QS_LD + dk] = f2bf(qv[i + 1] * 0.08838834764831845f * e1);
              Ks[(16 * qr + i) * QS_LD + dk] = f2bf(kv[i] * r0); Ks[(16 * qr + i + 1) * QS_LD + dk] = f2bf(kv[i + 1] * r1);
              ke[i >> 1] = pk2(kv[i] * (eblast * r0), kv[i + 1] * (eblast * r1)); }
          v4u k0 = {ke[0], ke[1], ke[2], ke[3]}, k1 = {ke[4], ke[5], ke[6], ke[7]};
          *(LAS v4u*)(KEt + dk * KT_LD + 16 * qr) = k0; *(LAS v4u*)(KEt + dk * KT_LD + 16 * qr + 8) = k1; }
        LDS_BARRIER();
#pragma unroll
        for (int tt = 0; tt < 2; ++tt) { const int n = 2 * w + tt, jt = n >> 2, it = n & 3; f32x4 a4 = {0.f, 0.f, 0.f, 0.f};
#pragma unroll
            for (int s = 0; s < 4; ++s) { const bf16x8 ka = *(const LAS bf16x8*)(Ks + (16 * jt + fr) * QS_LD + 32 * s + 8 * g); const bf16x8 qb = *(const LAS bf16x8*)(Qs + (16 * it + fr) * QS_LD + 32 * s + 8 * g); a4 = MFMA16(ka, qb, a4); }
            const int tj = 16 * jt + 4 * g, ti = 16 * it + fr;
            v2u o; o.x = pk2(tj <= ti ? a4[0] : 0.f, tj + 1 <= ti ? a4[1] : 0.f); o.y = pk2(tj + 2 <= ti ? a4[2] : 0.f, tj + 3 <= ti ? a4[3] : 0.f);
            *(LAS v2u*)(Att + ti * KT_LD + tj) = o; }
        LDS_BARRIER();
        bf16x8 Sb[4];
#pragma unroll
        for (int s = 0; s < 4; ++s) { v4u p; p.x = pk2(S[2 * s][0], S[2 * s][1]); p.y = pk2(S[2 * s][2], S[2 * s][3]); p.z = pk2(S[2 * s + 1][0], S[2 * s + 1][1]); p.w = pk2(S[2 * s + 1][2], S[2 * s + 1][3]); Sb[s] = __builtin_bit_cast(bf16x8, p); }
        bf16x8 Vf[2];
#pragma unroll
        for (int ks = 0; ks < 2; ++ks) Vf[ks] = *(const LAS bf16x8*)(Vt + (dv0 + fr) * KT_LD + 32 * ks + 8 * g);
#pragma unroll
        for (int it = 0; it < 4; ++it) { f32x4 o = {0.f, 0.f, 0.f, 0.f};
#pragma unroll
            for (int s = 0; s < 4; ++s) { const bf16x4 lo = *(const LAS bf16x4*)(Qs + (16 * it + fr) * QS_LD + 32 * s + 4 * g); const bf16x4 hi = *(const LAS bf16x4*)(Qs + (16 * it + fr) * QS_LD + 32 * s + 16 + 4 * g);
                const bf16x8 qa = __builtin_shufflevector(lo, hi, 0, 1, 2, 3, 4, 5, 6, 7); o = MFMA16(qa, Sb[s], o); }
#pragma unroll
            for (int ks = 0; ks < 2; ++ks) { const bf16x8 aa = *(const LAS bf16x8*)(Att + (16 * it + fr) * KT_LD + 32 * ks + 8 * g); o = MFMA16(aa, Vf[ks], o); }
            odef[2 * it] = pk2(o[0], o[1]); odef[2 * it + 1] = pk2(o[2], o[3]); }
#pragma unroll
        for (int a = 0; a < 8; ++a) { const f32x4 dsc = *(const LAS f32x4*)(Dl + 16 * a + 4 * g); S[a] = S[a] * dsc;
#pragma unroll
            for (int ks = 0; ks < 2; ++ks) { const bf16x8 ka = *(const LAS bf16x8*)(KEt + (16 * a + fr) * KT_LD + 32 * ks + 8 * g); S[a] = MFMA16(ka, Vf[ks], S[a]); } }
#pragma unroll
        for (int i = 0; i < 2; ++i) { const v4u qraw = *(const LAS v4u*)(Qs + (srow + 32 * i) * QS_LD + 8 * sch); const f32x4 e0 = *(const LAS f32x4*)(ecum + 8 * sch), e1 = *(const LAS f32x4*)(ecum + 8 * sch + 4);
            v4u o; o.x = pk2(bflo(qraw.x) * e0.x, bfhi(qraw.x) * e0.y); o.y = pk2(bflo(qraw.y) * e0.z, bfhi(qraw.y) * e0.w); o.z = pk2(bflo(qraw.z) * e1.x, bfhi(qraw.z) * e1.y); o.w = pk2(bflo(qraw.w) * e1.z, bfhi(qraw.w) * e1.w); qd[i] = o; }
        LDS_BARRIER();
    }
    if (!dry) { const size_t qo = ((size_t)b * SEQ + seg * TSEG + TSEG - 64 + srow) * 512 + hh * 128 + 8 * sch; *(v4u*)(GQw + qo) = qd[0]; *(v4u*)(GQw + qo + 16384) = qd[1]; }
    if (!dry) { bf16* op = GV + ((size_t)b * SEQ + seg * TSEG + TSEG - 64 + 4 * g) * 512 + hh * 128 + dv0 + fr;
#pragma unroll
        for (int it = 0; it < 4; ++it) { op[(size_t)(16 * it) * 512] = (bf16)(odef[2 * it] & 0xffffu); op[(size_t)(16 * it + 1) * 512] = (bf16)(odef[2 * it] >> 16); op[(size_t)(16 * it + 2) * 512] = (bf16)(odef[2 * it + 1] & 0xffffu); op[(size_t)(16 * it + 3) * 512] = (bf16)(odef[2 * it + 1] >> 16); } }
    v2u* LB = (v2u*)(F.ws + WS_LB) + (size_t)item * 4096 + w * 512 + lane;
#pragma unroll
    for (int a = 0; a < 8; ++a) { v2u o; o.x = pk2(S[a][0], S[a][1]); o.y = pk2(S[a][2], S[a][3]); LB[a * 64] = o; }
    if (qr == 0) ((float*)(F.ws + WS_DSEG))[item * 128 + dk] = pg8::fexp(Btot);
}

DI void gla_pass2(const Frame& F, int item, const float* gnorm, bool dry) {
    const int tid = F.tid, lane = F.lane, w = F.wave, fr = lane & 15, g = lane >> 4;
    const int seg = item & (NSEG - 1), bh = item >> 4, hh = bh & 3, b = bh >> 2;
    const int dv0 = 16 * w;
    LAS bf16* Qs = (LAS bf16*)(F.lds + G_QS); LAS float* Os = (LAS float*)(F.lds + G_OS);
    const bf16* GQ = (const bf16*)(F.ws + WS_GLAQ); bf16* GV = (bf16*)(F.ws + WS_GLAV); const bf16* R = (const bf16*)(F.dout + DO_R);
    f32x4 Sc[8];
#pragma unroll
    for (int a = 0; a < 8; ++a) Sc[a] = (f32x4){0.f, 0.f, 0.f, 0.f};
    { v2u lv[8], lvn[8]; f32x4 dc[8], dcn[8];
#define GLA_CLOAD(LV, DC, spn) do { const int _it2 = bh * NSEG + (spn); const v2u* _LB = (const v2u*)(F.ws + WS_LB) + (size_t)_it2 * 4096 + w * 512 + lane; const float* _DS = (const float*)(F.ws + WS_DSEG) + _it2 * 128 + 4 * g; \
        _Pragma("unroll") for (int a = 0; a < 8; ++a) { DC[a] = *(const f32x4*)(_DS + 16 * a); LV[a] = _LB[a * 64]; } } while (0)
      if (seg > 0) GLA_CLOAD(lv, dc, 0);
#pragma unroll 1
      for (int sp = 0; sp < seg; ++sp) {
          if (sp + 1 < seg) GLA_CLOAD(lvn, dcn, sp + 1);
#pragma unroll
          for (int a = 0; a < 8; ++a) { Sc[a][0] = Sc[a][0] * dc[a][0] + bflo(lv[a].x); Sc[a][1] = Sc[a][1] * dc[a][1] + bfhi(lv[a].x); Sc[a][2] = Sc[a][2] * dc[a][2] + bflo(lv[a].y); Sc[a][3] = Sc[a][3] * dc[a][3] + bfhi(lv[a].y);
              lv[a] = lvn[a]; dc[a] = dcn[a]; } }
#undef GLA_CLOAD
    }
    bf16x8 Sb[4];
#pragma unroll
    for (int s = 0; s < 4; ++s) { v4u p; p.x = pk2(Sc[2 * s][0], Sc[2 * s][1]); p.y = pk2(Sc[2 * s][2], Sc[2 * s][3]); p.z = pk2(Sc[2 * s + 1][0], Sc[2 * s + 1][1]); p.w = pk2(Sc[2 * s + 1][2], Sc[2 * s + 1][3]); Sb[s] = __builtin_bit_cast(bf16x8, p); }
    const int tk = tid >> 3, pc = tid & 7;
    f32x4 gn[4];
#pragma unroll
    for (int j = 0; j < 4; ++j) gn[j] = *(const f32x4*)(gnorm + 16 * pc + 4 * j);
    v4u sq[2], ow0, ow1, r0, r1, od0 = {0u, 0u, 0u, 0u}, od1 = {0u, 0u, 0u, 0u};
    const int srow = tid >> 4, sch = tid & 15;
#define GLA_LOAD2A(chn) do { const size_t _o = ((size_t)b * SEQ + seg * TSEG + (chn) * 64 + srow) * 512 + hh * 128 + 8 * sch; \
        _Pragma("unroll") for (int i = 0; i < 2; ++i) sq[i] = *(const v4u*)(GQ + _o + (size_t)i * 16384); } while (0)
#define GLA_LOAD2B(chn) do { const size_t _o = ((size_t)b * SEQ + seg * TSEG + (chn) * 64 + tk) * 512 + hh * 128 + 16 * pc; \
        ow0 = *(const v4u*)(GV + _o); ow1 = *(const v4u*)(GV + _o + 8); r0 = *(const v4u*)(R + _o); r1 = *(const v4u*)(R + _o + 8); } while (0)
    GLA_LOAD2A(0); GLA_LOAD2B(0);
#pragma unroll 1
    for (int ch = 0; ch < TSEG / 64; ++ch) {
        const size_t tokbase = (size_t)b * SEQ + seg * TSEG + ch * 64;
#pragma unroll
        for (int i = 0; i < 2; ++i) { const int o = (srow + 32 * i) * QS_LD + 8 * sch; *(LAS v4u*)(Qs + o) = sq[i]; }
        if (ch > 0 && !dry) { const size_t pofs = (tokbase - 64 + tk) * 512 + hh * 128 + 16 * pc; *(v4u*)(GV + pofs) = od0; *(v4u*)(GV + pofs + 8) = od1; }
        const v4u cw0 = ow0, cw1 = ow1, cr0 = r0, cr1 = r1;
        if (ch + 1 < TSEG / 64) { GLA_LOAD2A(ch + 1); GLA_LOAD2B(ch + 1); }
        LDS_BARRIER();
#pragma unroll
        for (int it = 0; it < 4; ++it) { f32x4 o = {0.f, 0.f, 0.f, 0.f};
            if (seg > 0) {
#pragma unroll
                for (int s = 0; s < 4; ++s) { const bf16x4 lo = *(const LAS bf16x4*)(Qs + (16 * it + fr) * QS_LD + 32 * s + 4 * g); const bf16x4 hi = *(const LAS bf16x4*)(Qs + (16 * it + fr) * QS_LD + 32 * s + 16 + 4 * g);
                    const bf16x8 qa = __builtin_shufflevector(lo, hi, 0, 1, 2, 3, 4, 5, 6, 7); o = MFMA16(qa, Sb[s], o); } }
#pragma unroll
            for (int rr = 0; rr < 4; ++rr) Os[(16 * it + 4 * g + rr) * OS_LD + dv0 + fr] = o[rr]; }
        LDS_BARRIER();
        { f32x4 v[4]; float ss = 0.f;
#pragma unroll
          for (int j = 0; j < 4; ++j) v[j] = *(const LAS f32x4*)(Os + tk * OS_LD + 16 * pc + 4 * j);
          v[0].x += bflo(cw0.x); v[0].y += bfhi(cw0.x); v[0].z += bflo(cw0.y); v[0].w += bfhi(cw0.y); v[1].x += bflo(cw0.z); v[1].y += bfhi(cw0.z); v[1].z += bflo(cw0.w); v[1].w += bfhi(cw0.w);
          v[2].x += bflo(cw1.x); v[2].y += bfhi(cw1.x); v[2].z += bflo(cw1.y); v[2].w += bfhi(cw1.y); v[3].x += bflo(cw1.z); v[3].y += bfhi(cw1.z); v[3].z += bflo(cw1.w); v[3].w += bfhi(cw1.w);
#pragma unroll
          for (int j = 0; j < 4; ++j) ss += (v[j].x * v[j].x + v[j].y * v[j].y) + (v[j].z * v[j].z + v[j].w * v[j].w);
          ss = grp8_sum(ss);
          const float rinv = __frsqrt_rn(ss * (1.f / 128.f) + EPS);
          const size_t ofs = (tokbase + tk) * 512 + hh * 128 + 16 * pc;
          v4u o0, o1;
          o0.x = pk2(v[0].x * rinv * gn[0].x * bflo(cr0.x), v[0].y * rinv * gn[0].y * bfhi(cr0.x)); o0.y = pk2(v[0].z * rinv * gn[0].z * bflo(cr0.y), v[0].w * rinv * gn[0].w * bfhi(cr0.y));
          o0.z = pk2(v[1].x * rinv * gn[1].x * bflo(cr0.z), v[1].y * rinv * gn[1].y * bfhi(cr0.z)); o0.w = pk2(v[1].z * rinv * gn[1].z * bflo(cr0.w), v[1].w * rinv * gn[1].w * bfhi(cr0.w));
          o1.x = pk2(v[2].x * rinv * gn[2].x * bflo(cr1.x), v[2].y * rinv * gn[2].y * bfhi(cr1.x)); o1.y = pk2(v[2].z * rinv * gn[2].z * bflo(cr1.y), v[2].w * rinv * gn[2].w * bfhi(cr1.y));
          o1.z = pk2(v[3].x * rinv * gn[3].x * bflo(cr1.z), v[3].y * rinv * gn[3].y * bfhi(cr1.z)); o1.w = pk2(v[3].z * rinv * gn[3].z * bflo(cr1.w), v[3].w * rinv * gn[3].w * bfhi(cr1.w));
          od0 = o0; od1 = o1; }
        LDS_BARRIER();
    }
    if (!dry) { const size_t pofs = ((size_t)b * SEQ + seg * TSEG + TSEG - 64 + tk) * 512 + hh * 128 + 16 * pc; *(v4u*)(GV + pofs) = od0; *(v4u*)(GV + pofs + 8) = od1; }
}
DI void attn_merge_phase(const Frame& F, bool dry) {
    const int gw = F.vcu * NWAVES + F.wave, NGW = F.G * NWAVES, lane = F.lane, head = lane >> 4;
    bf16* O0 = (bf16*)(F.ws + WS_DILQ); const float* LSE = (const float*)(F.ws + WS_LSE);
    for (int t = gw; t < T; t += NGW) {
        const float l0 = LSE[(size_t)t * 4 + head], l1 = LSE[(size_t)T * 4 + (size_t)t * 4 + head], l2 = LSE[(size_t)2 * T * 4 + (size_t)t * 4 + head];
        const float M = fmaxf(l0, fmaxf(l1, l2)); float w0 = exp2f(l0 - M), w1 = exp2f(l1 - M), w2 = exp2f(l2 - M); const float inv = 1.f / (w0 + w1 + w2); w0 *= inv; w1 *= inv; w2 *= inv;
        bf16* p = O0 + (size_t)t * 512 + 8 * lane; const v4u a = *(const v4u*)p, bq = *(const v4u*)(p + (size_t)T * 512), c = *(const v4u*)(p + (size_t)2 * T * 512);
        v4u o;
        o.x = pk2(w0 * bflo(a.x) + w1 * bflo(bq.x) + w2 * bflo(c.x), w0 * bfhi(a.x) + w1 * bfhi(bq.x) + w2 * bfhi(c.x));
        o.y = pk2(w0 * bflo(a.y) + w1 * bflo(bq.y) + w2 * bflo(c.y), w0 * bfhi(a.y) + w1 * bfhi(bq.y) + w2 * bfhi(c.y));
        o.z = pk2(w0 * bflo(a.z) + w1 * bflo(bq.z) + w2 * bflo(c.z), w0 * bfhi(a.z) + w1 * bfhi(bq.z) + w2 * bfhi(c.z));
        o.w = pk2(w0 * bflo(a.w) + w1 * bflo(bq.w) + w2 * bflo(c.w), w0 * bfhi(a.w) + w1 * bfhi(bq.w) + w2 * bfhi(c.w));
        if (!dry) *(v4u*)p = o; }
}

DI void router_phase(const Frame& F, const float* brg, const float* bre, unsigned* gcnt, bool dry) {
    const int lane = F.lane, w = F.wave, fr = lane & 15, g = lane >> 4;
    const bf16* X1 = (const bf16*)(F.ws + WS_X1);
    const bf16* WRH = (const bf16*)(F.ws + WS_WRH); const bf16* WRL = WRH + 48 * 1024;
    int* TOKE = (int*)(F.ws + WS_TOKE); float* TOKW = (float*)(F.ws + WS_TOKW); int* TOKR = (int*)(F.ws + WS_TOKR);
    LAS float* lg = (LAS float*)(F.lds + w * 3072);
    LAS int* cnt = (LAS int*)(F.lds + 24576); LAS int* basev = cnt + 32;
    LAS unsigned char* wh = F.lds + 28672;
    __syncthreads();
    for (int e = F.tid; e < 48 * 128; e += NTHR) *(LAS v4u*)(wh + (e >> 7) * 2064 + (e & 127) * 16) = *(const v4u*)(WRH + (size_t)e * 8);
    __syncthreads();
    if (!dry) { int* ROWTOK = (int*)(F.ws + WS_ROWTOK); for (int e = F.vcu * NTHR + F.tid; e < PMAX; e += F.G * NTHR) ROWTOK[e] = 0; }
    for (int it = 0; it * F.G * 128 < T; ++it) {
        const int tok0 = (it * F.G + F.vcu) * 128 + w * 16;
        if (F.tid < 32) cnt[F.tid] = 0;
        __syncthreads();
        f32x4 acc[3]; acc[0] = acc[1] = acc[2] = (f32x4){0.f, 0.f, 0.f, 0.f};
        float ss = 0.f;
        const bf16* xr = X1 + (size_t)(tok0 + fr) * D + 8 * g;
#pragma unroll 4
        for (int s = 0; s < 32; ++s) {
            const v4u xv = *(const v4u*)(xr + 32 * s);
            ss += (bflo(xv.x) * bflo(xv.x) + bfhi(xv.x) * bfhi(xv.x)) + (bflo(xv.y) * bflo(xv.y) + bfhi(xv.y) * bfhi(xv.y)) + (bflo(xv.z) * bflo(xv.z) + bfhi(xv.z) * bfhi(xv.z)) + (bflo(xv.w) * bflo(xv.w) + bfhi(xv.w) * bfhi(xv.w));
            const bf16x8 ah = __builtin_bit_cast(bf16x8, xv);
#pragma unroll
            for (int nt = 0; nt < 3; ++nt) { const bf16x8 bh = *(const LAS bf16x8*)(wh + (16 * nt + fr) * 2064 + 64 * s + 16 * g), bl = *(const bf16x8*)(WRL + (size_t)(16 * nt + fr) * 1024 + 32 * s + 8 * g);
                acc[nt] = MFMA16(ah, bh, acc[nt]); acc[nt] = MFMA16(ah, bl, acc[nt]); }
        }
        ss = xor32_sum(xor16_sum(ss));
        const float rinv = __frsqrt_rn(ss * (1.f / D) + EPS);
#pragma unroll
        for (int rr = 0; rr < 4; ++rr) { const float ri = __shfl(rinv, 4 * g + rr);
#pragma unroll
            for (int nt = 0; nt < 3; ++nt) lg[(4 * g + rr) * 48 + 16 * nt + fr] = acc[nt][rr] * ri; }
        if (lane < 16 && !dry) ((float*)(F.ws + WS_H2))[tok0 + lane] = rinv;
        LDS_WAIT(); asm volatile("" ::: "memory");
        int e1 = 0, e2 = 0, lr1 = 0, lr2 = 0; float w1 = 0.f, w2 = 0.f;
        if (lane < 16) { const LAS float* q = lg + lane * 48;
            float gl[4]; int gs = 0; float gm = -3.0e38f;
#pragma unroll
            for (int j = 0; j < 4; ++j) { gl[j] = q[j] + brg[j]; if (gl[j] > gm) { gm = gl[j]; gs = j; } }
            float gsum = 0.f;
#pragma unroll
            for (int j = 0; j < 4; ++j) gsum += __expf(gl[j] - gm);
            const float gp = 1.f / gsum;
            float el[8]; int i1 = 0; float v1 = -3.0e38f;
#pragma unroll
            for (int j = 0; j < 8; ++j) { el[j] = q[4 + 8 * gs + j] + bre[8 * gs + j]; if (el[j] > v1) { v1 = el[j]; i1 = j; } }
            int i2 = 0; float v2 = -3.0e38f;
#pragma unroll
            for (int j = 0; j < 8; ++j) if (j != i1 && el[j] > v2) { v2 = el[j]; i2 = j; }
            const float p2 = 1.f / (1.f + __expf(v1 - v2)), p1 = 1.f - p2;
            e1 = 8 * gs + i1; e2 = 8 * gs + i2; w1 = p1 * gp; w2 = p2 * gp;
            lr1 = __hip_atomic_fetch_add(&cnt[e1], 1, __ATOMIC_RELAXED, __HIP_MEMORY_SCOPE_WORKGROUP); lr2 = __hip_atomic_fetch_add(&cnt[e2], 1, __ATOMIC_RELAXED, __HIP_MEMORY_SCOPE_WORKGROUP); }
        __syncthreads();
        if (F.tid < 32) basev[F.tid] = dry ? 0 : (int)atomicAdd(&gcnt[64 * F.tid], (unsigned)cnt[F.tid]);
        __syncthreads();
        if (lane < 16 && !dry) { const int t = tok0 + lane; TOKE[2 * t] = e1; TOKE[2 * t + 1] = e2; TOKW[2 * t] = w1; TOKW[2 * t + 1] = w2; TOKR[2 * t] = basev[e1] + lr1; TOKR[2 * t + 1] = basev[e2] + lr2; }
        __syncthreads();
    }
}
DI void moe_assign_phase(const Frame& F, unsigned* gcnt) {
    LAS int* pst = (LAS int*)(F.lds + 65536);
    if (F.tid == 0) { int p = 0; int* BLKE = (int*)(F.ws + WS_BLKE);
        for (int e = 0; e < 32; ++e) { pst[e] = p; const int c = (int)__hip_atomic_load(&gcnt[64 * e], __ATOMIC_RELAXED, __HIP_MEMORY_SCOPE_AGENT); const int nb = (c + 255) >> 8;
            if (F.vcu == 0) for (int j = 0; j < nb; ++j) BLKE[(p >> 8) + j] = e;
            p += nb << 8; }
        if (F.vcu == 0) BLKE[NBLK_MAX] = p >> 8; }
    __syncthreads();
    const int* TOKE = (const int*)(F.ws + WS_TOKE); const float* TOKW = (const float*)(F.ws + WS_TOKW); const int* TOKR = (const int*)(F.ws + WS_TOKR);
    int* DEST = (int*)(F.ws + WS_DEST); f32x2* ROWW = (f32x2*)(F.ws + WS_ROWW); int* ROWTOK = (int*)(F.ws + WS_ROWTOK); const float* RINV = (const float*)(F.ws + WS_H2);
    for (int t = F.vcu * NTHR + F.tid; t < T; t += F.G * NTHR) {
        const int d0 = pst[TOKE[2 * t]] + TOKR[2 * t], d1 = pst[TOKE[2 * t + 1]] + TOKR[2 * t + 1]; const float rinv = RINV[t];
        DEST[2 * t] = d0; DEST[2 * t + 1] = d1; ROWW[d0] = (f32x2){TOKW[2 * t], rinv}; ROWW[d1] = (f32x2){TOKW[2 * t + 1], rinv}; ROWTOK[d0] = t; ROWTOK[d1] = t; }
}
DI void combine_phase(const Frame& F, float* out) {
    const int gw = F.vcu * NWAVES + F.wave, NGW = F.G * NWAVES, lane = F.lane;
    const bf16* X1 = (const bf16*)(F.ws + WS_X1); const bf16* Y = (const bf16*)(F.ws + WS_Y); const int* DEST = (const int*)(F.ws + WS_DEST);
    for (int t = gw; t < T; t += NGW) { const int d0 = DEST[2 * t], d1 = DEST[2 * t + 1];
#pragma unroll
        for (int j = 0; j < 2; ++j) { const int c = 8 * lane + 512 * j;
            const v4u x = *(const v4u*)(X1 + (size_t)t * D + c), a = *(const v4u*)(Y + (size_t)d0 * D + c), b = *(const v4u*)(Y + (size_t)d1 * D + c);
            f32x4 oa, ob;
            oa.x = bflo(x.x) + bflo(a.x) + bflo(b.x); oa.y = bfhi(x.x) + bfhi(a.x) + bfhi(b.x); oa.z = bflo(x.y) + bflo(a.y) + bflo(b.y); oa.w = bfhi(x.y) + bfhi(a.y) + bfhi(b.y);
            ob.x = bflo(x.z) + bflo(a.z) + bflo(b.z); ob.y = bfhi(x.z) + bfhi(a.z) + bfhi(b.z); ob.z = bflo(x.w) + bflo(a.w) + bflo(b.w); ob.w = bfhi(x.w) + bfhi(a.w) + bfhi(b.w);
            *(f32x4*)(out + (size_t)t * D + c) = oa; *(f32x4*)(out + (size_t)t * D + c + 4) = ob; } }
}

constexpr int PER_PHASE = 13;
#ifndef STAGGER_TICKS
#define STAGGER_TICKS 200
#endif
struct Args { Ins I; float* out; unsigned char* ws; int ph_lo, ph_hi, li, pad; };
__global__ void __launch_bounds__(NTHR, 2) fwd_kernel(Args args) {
    extern __shared__ __attribute__((aligned(16))) unsigned char lds[];
    Frame F;
    F.lds = (LAS unsigned char*)lds;
    F.tid = threadIdx.x; F.lane = F.tid & 63; F.wave = __builtin_amdgcn_readfirstlane(F.tid >> 6);
    F.G = gridDim.x; { const int bx = blockIdx.x; F.vcu = (F.G % 8 == 0) ? (bx % 8) * (F.G / 8) + bx / 8 : bx; }
    F.ws = args.ws; F.dout = (unsigned char*)args.out;
    unsigned* ctl = (unsigned*)(args.ws + WS_CTL);
    volatile LAS unsigned* MISC = (volatile LAS unsigned*)(F.lds + MISC_OFF);
    for (int u = F.tid; u < (LDS_BYTES - LDSCTL_OFF) / 4; u += NTHR) ((LAS unsigned*)(F.lds + LDSCTL_OFF))[u] = 0u;
    __syncthreads();
    XcdBarrier bar; bar.bar = ctl + CW_BAR; bar.x = 0; bar.st = nullptr;
    if (MK_N_LAUNCHES == 1) bar = xcd_barrier_post(ctl + CW_BAR + args.li * 4096, MISC + 8);
    const int lo = args.ph_lo, hi = args.ph_hi;
#ifdef ONLY_PHASE
#define IN(k) ((k) == ONLY_PHASE && lo <= (k) && (k) < hi)
#else
#define IN(k) (lo <= (k) && (k) < hi)
#endif
#define STAGGER() do { const unsigned long long _t0 = __builtin_amdgcn_s_memrealtime(), _dl = (unsigned long long)(blockIdx.x & 3) * STAGGER_TICKS; while (__builtin_amdgcn_s_memrealtime() - _t0 < _dl) __builtin_amdgcn_s_sleep(8); } while (0)
#define SEAM(k) do { if (IN(k) && IN((k) + 1)) xcd_barrier(bar); } while (0)
#ifndef DUP_MASK
#define DUP_MASK 0
#endif
#define REPS(k) (((DUP_MASK >> (k)) & 1) ? 2 : 1)
    const Ins& I = args.I;
    unsigned char* ws = args.ws;
#if defined(PROBE_PLAN)
    const bool pdry = args.li == 1 && args.pad == 77;
#else
    const bool pdry = false;
#endif

    if (IN(0)) { _Pragma("unroll 1") for (int rep = 0; rep < REPS(0); ++rep) { if (rep) xcd_barrier(bar); p0_prologue(F, I, pdry); } SEAM(0); }

    if (IN(1)) { _Pragma("unroll 1") for (int rep = 0; rep < REPS(1); ++rep) { if (rep) xcd_barrier(bar);
        pg8::GemmDesc g{1024, 1024, 1024};
        pg8::OrderStd S{T / 256, N1 / 256, F.G, (int)blockIdx.x, (const char*)(ws + WS_XN), (const char*)(ws + WS_W1T), (size_t)256 * 1024 * 2, (size_t)256 * 1024 * 2};
        pg8::EpiP1 E{ws, F.dout, I.in[6], I.in[7], (LAS float*)(F.lds + LDSCTL_OFF + 1024)};
        pg8::gemm_phase<pg8::EpiP1, pg8::OrderStd>(F.lds + RING_OFF, g, S, E);
}         SEAM(1);
    }
    if (IN(3)) {
        _Pragma("unroll 1") for (int rep = 0; rep < REPS(3); ++rep) { if (rep) xcd_barrier(bar);
        for (int it = F.vcu; it < 16 * NSEG; it += F.G) gla_pass1(F, it, I.in[3], I.in[4], (rep + 1 < REPS(3)) || pdry); }
        const int gw = F.vcu * NWAVES + F.wave, NGW = F.G * NWAVES;
        _Pragma("unroll 1") for (int rep = 0; rep < REPS(13); ++rep) { if (rep) xcd_barrier(bar);
        for (int jr = F.vcu; jr < 3 * 4096 / 8; jr += F.G) attn_round(F, jr, (rep + 1 < REPS(13)) || pdry); }
        SEAM(3);
    }
    if (IN(4)) {
        _Pragma("unroll 1") for (int rep = 0; rep < REPS(4); ++rep) { if (rep) xcd_barrier(bar);
        for (int it = F.vcu; it < 16 * NSEG; it += F.G) gla_pass2(F, it, I.in[5], (rep + 1 < REPS(4)) || pdry); }
        _Pragma("unroll 1") for (int rep = 0; rep < REPS(14); ++rep) { if (rep) xcd_barrier(bar); attn_merge_phase(F, (rep + 1 < REPS(14)) || pdry); }
        SEAM(4);
    }
    if (IN(5)) { _Pragma("unroll 1") for (int rep = 0; rep < REPS(5); ++rep) { if (rep) xcd_barrier(bar);
        pg8::GemmDesc g{512, 512, 512};
        pg8::OrderProj2 S{T / 256, 4, F.G, (int)blockIdx.x, (const char*)(ws + WS_GLAV), (const char*)(ws + WS_DILQ), (const char*)(ws + WS_WPGT), (const char*)(ws + WS_WPAT), (size_t)256 * 512 * 2, (size_t)256 * 512 * 2};
        pg8::EpiY E{(bf16*)(ws + WS_GATES), 2048, pdry};
        pg8::gemm_phase<pg8::EpiY, pg8::OrderProj2>(F.lds + RING_OFF, g, S, E);
}         SEAM(5);
    }
    if (IN(6)) { _Pragma("unroll 1") for (int rep = 0; rep < REPS(6); ++rep) { if (rep) xcd_barrier(bar);
        pg8::GemmDesc g{1024, 1024, 1024};
        pg8::OrderStd S{T / 256, 2048 / 256, F.G, (int)blockIdx.x, (const char*)(ws + WS_XN), (const char*)(ws + WS_WBGT), (size_t)256 * 1024 * 2, (size_t)256 * 1024 * 2};
        pg8::EpiGateMerge E{(bf16*)(ws + WS_MERGED), (const bf16*)(ws + WS_GATES), I.in[11], args.li == 1 && args.pad == 77};
        pg8::gemm_phase<pg8::EpiGateMerge, pg8::OrderStd>(F.lds + RING_OFF, g, S, E);
}         SEAM(6);
    }
    if (IN(7)) { _Pragma("unroll 1") for (int rep = 0; rep < REPS(7); ++rep) { if (rep) xcd_barrier(bar);
        pg8::GemmDesc g{1024, 1024, 1024};
        pg8::OrderStd S{T / 256, 4, F.G, (int)blockIdx.x, (const char*)(ws + WS_MERGED), (const char*)(ws + WS_WOUTT), (size_t)256 * 1024 * 2, (size_t)256 * 1024 * 2};
        pg8::EpiX1 E{(bf16*)(ws + WS_X1), I.in[0]};
        pg8::gemm_phase<pg8::EpiX1, pg8::OrderStd>(F.lds + RING_OFF, g, S, E);
}         SEAM(7);
    }
    if (IN(8)) { _Pragma("unroll 1") for (int rep = 0; rep < REPS(8); ++rep) { if (rep) xcd_barrier(bar); router_phase(F, I.in[15], I.in[17], ctl + CW_GCNT, rep + 1 < REPS(8)); } SEAM(8); }
    if (IN(9)) { _Pragma("unroll 1") for (int rep = 0; rep < REPS(9); ++rep) { if (rep) xcd_barrier(bar); moe_assign_phase(F, ctl + CW_GCNT); } SEAM(9); }
    if (IN(10)) { _Pragma("unroll 1") for (int rep = 0; rep < REPS(10); ++rep) { if (rep) xcd_barrier(bar);
        const int* BLKE = (const int*)(ws + WS_BLKE); const int nblk = BLKE[NBLK_MAX];
        pg8::GemmDesc g{1024, 1024, 1024};
        pg8::OrderMoe S{nblk, F.G, (int)blockIdx.x, BLKE, (const int*)(ws + WS_ROWTOK), (const char*)(ws + WS_X1), (const char*)(F.dout + DO_EXPGU), (size_t)0, (size_t)1024 * 1024 * 2, (size_t)256 * 1024 * 2};
        pg8::EpiGU E{(bf16*)(ws + WS_HBUF), (const f32x2*)(ws + WS_ROWW)};
        pg8::gemm_phase<pg8::EpiGU, pg8::OrderMoe, true, true, true>(F.lds + RING_OFF, g, S, E);
}         SEAM(10);
    }
    if (IN(11)) { _Pragma("unroll 1") for (int rep = 0; rep < REPS(11); ++rep) { if (rep) xcd_barrier(bar);
        const int* BLKE = (const int*)(ws + WS_BLKE); const int nblk = BLKE[NBLK_MAX];
        pg8::GemmDesc g{512, 512, 512};
        pg8::OrderMoe S{nblk, F.G, (int)blockIdx.x, BLKE, nullptr, (const char*)(ws + WS_HBUF), (const char*)(F.dout + DO_EXPDN), (size_t)256 * 512 * 2, (size_t)1024 * 512 * 2, (size_t)256 * 512 * 2};
        pg8::EpiY E{(bf16*)(ws + WS_Y), 1024, false};
        pg8::gemm_phase<pg8::EpiY, pg8::OrderMoe>(F.lds + RING_OFF, g, S, E);
}         SEAM(11);
    }
    if (IN(12)) { _Pragma("unroll 1") for (int rep = 0; rep < REPS(12); ++rep) { if (rep) xcd_barrier(bar); combine_phase(F, args.out); } }
#undef IN
#undef SEAM
}

extern "C" void kernel_launch(void* const* d_in, const int* in_sizes, int n_in, void* d_out, int out_size, void* d_ws, size_t ws_size, hipStream_t stream) {
    static int grid = 0;
    if (grid == 0) {
        if (n_in != 21 || out_size != T * D || ws_size < WS_END) { fprintf(stderr, "kernel_launch: unexpected shapes (n_in %d out %d ws %zu)\n", n_in, out_size, ws_size); grid = -1; return; }
        int dev = 0, cus = 0, per_cu = 0;
        if (hipGetDevice(&dev) != hipSuccess || hipDeviceGetAttribute(&cus, hipDeviceAttributeMultiprocessorCount, dev) != hipSuccess) { grid = -1; return; }
        if (hipFuncSetAttribute((const void*)fwd_kernel, hipFuncAttributeMaxDynamicSharedMemorySize, LDS_BYTES) != hipSuccess) { fprintf(stderr, "kernel_launch: hipFuncSetAttribute failed\n"); grid = -1; return; }
        if (hipOccupancyMaxActiveBlocksPerMultiprocessor(&per_cu, (const void*)fwd_kernel, NTHR, LDS_BYTES) != hipSuccess || per_cu < 1) fprintf(stderr, "kernel_launch: occupancy query reports %d\n", per_cu);
        (void)hipGetLastError();
        grid = cus;
    }
    if (grid < 0) return;
    if (hipMemsetAsync((char*)d_ws + WS_CTL, 0, CTL_ZERO_BYTES, stream) != hipSuccess) return;
    Args a{};
    for (int i = 0; i < 21; ++i) a.I.in[i] = (const float*)d_in[i];
    a.out = (float*)d_out; a.ws = (unsigned char*)d_ws;
#if defined(PROBE_PLAN)
#ifndef PROBE_DRY
#define PROBE_DRY 0
#endif
    { const int plan[3][2] = {{0, PROBE_DRY == 77 ? PROBE_PLAN : PROBE_PLAN + 1}, {PROBE_PLAN, PROBE_PLAN + 1}, {PROBE_DRY == 77 ? PROBE_PLAN : PROBE_PLAN + 1, PER_PHASE}};
      for (int li = 0; li < 3; ++li) { a.ph_lo = plan[li][0]; a.ph_hi = plan[li][1]; a.li = li; a.pad = PROBE_DRY; hipLaunchKernelGGL(fwd_kernel, dim3(grid), dim3(NTHR), LDS_BYTES, stream, a); } return; }
#endif
    if (MK_N_LAUNCHES == 1) { a.ph_lo = 0; a.ph_hi = PER_PHASE; a.li = 0; hipLaunchKernelGGL(fwd_kernel, dim3(grid), dim3(NTHR), LDS_BYTES, stream, a); }
    else for (int li = 0; li < PER_PHASE; ++li) { a.ph_lo = li; a.ph_hi = li + 1; a.li = li; hipLaunchKernelGGL(fwd_kernel, dim3(grid), dim3(NTHR), LDS_BYTES, stream, a); }
}
```

```cpp
#include <hip/hip_runtime.h>
#include <cstdio>
#include <cstdint>

#ifndef MK_N_LAUNCHES
#define MK_N_LAUNCHES 1
#endif

#define GAS __attribute__((address_space(1)))
#define LAS __attribute__((address_space(3)))
typedef unsigned short bf16;
typedef unsigned v4u __attribute__((ext_vector_type(4)));
typedef unsigned v2u __attribute__((ext_vector_type(2)));
typedef float f32x2 __attribute__((ext_vector_type(2)));
typedef float f32x4 __attribute__((ext_vector_type(4)));
typedef float f32x16 __attribute__((ext_vector_type(16)));
typedef short bf16x8 __attribute__((ext_vector_type(8)));
typedef short bf16x4 __attribute__((ext_vector_type(4)));
typedef __bf16 hbf2 __attribute__((ext_vector_type(2)));

#define DI __device__ __forceinline__
DI unsigned pk2(float lo, float hi) { f32x2 v = {lo, hi}; hbf2 r = __builtin_convertvector(v, hbf2); return __builtin_bit_cast(unsigned, r); }
DI bf16 f2bf(float f) { return (bf16)(pk2(f, 0.f) & 0xffffu); }
DI float bf2f(bf16 b) { return __builtin_bit_cast(float, ((unsigned)b) << 16); }
DI float bflo(unsigned u) { return __builtin_bit_cast(float, u << 16); }
DI float bfhi(unsigned u) { return __builtin_bit_cast(float, u & 0xffff0000u); }
DI float xor32_sum(float x) { const unsigned u = __builtin_bit_cast(unsigned, x); const auto r = __builtin_amdgcn_permlane32_swap(u, u, false, false); return __builtin_bit_cast(float, (unsigned)r[0]) + __builtin_bit_cast(float, (unsigned)r[1]); }
DI float xor16_sum(float x) { const unsigned u = __builtin_bit_cast(unsigned, x); const auto r = __builtin_amdgcn_permlane16_swap(u, u, false, false); return __builtin_bit_cast(float, (unsigned)r[0]) + __builtin_bit_cast(float, (unsigned)r[1]); }
DI float xor32_max(float x) { const unsigned u = __builtin_bit_cast(unsigned, x); const auto r = __builtin_amdgcn_permlane32_swap(u, u, false, false); return fmaxf(__builtin_bit_cast(float, (unsigned)r[0]), __builtin_bit_cast(float, (unsigned)r[1])); }
#define DPPF(x, ctrl) __builtin_bit_cast(float, __builtin_amdgcn_mov_dpp(__builtin_bit_cast(int, (x)), (ctrl), 0xf, 0xf, false))
DI float row16_sum(float x) { x += DPPF(x, 0x128); x += DPPF(x, 0x124); x += DPPF(x, 0x122); x += DPPF(x, 0x121); return x; }
DI float grp8_sum(float x) { x += DPPF(x, 0x141); x += DPPF(x, 0x1B); x += DPPF(x, 0xB1); return x; }
DI float rs32(float a, float b) { const auto r = __builtin_amdgcn_permlane32_swap(__builtin_bit_cast(unsigned, a), __builtin_bit_cast(unsigned, b), false, false); return __builtin_bit_cast(float, (unsigned)r[0]) + __builtin_bit_cast(float, (unsigned)r[1]); }
DI float rs16(float a, float b) { const auto r = __builtin_amdgcn_permlane16_swap(__builtin_bit_cast(unsigned, a), __builtin_bit_cast(unsigned, b), false, false); return __builtin_bit_cast(float, (unsigned)r[0]) + __builtin_bit_cast(float, (unsigned)r[1]); }

constexpr int T = 32768, D = 1024, SEQ = 8192;
constexpr int N1 = 6656;
constexpr int IN_COLS = 6672;
constexpr int NSEG = 16, TSEG = SEQ / NSEG;
constexpr float EPS = 1e-6f;
constexpr float LOG2E = 1.4426950408889634f;
constexpr int PMAX = 65536 + 32 * 256;
constexpr int NBLK_MAX = PMAX / 256;

constexpr size_t MiB = 1u << 20;
constexpr size_t WS_CTL = 0, CTL_ZERO_BYTES = 256 * 1024;
constexpr size_t WS_LB = 1 * MiB;
constexpr size_t WS_W1T = 1 * MiB;
constexpr size_t WS_WBGT = 15 * MiB, WS_WPGT = 19 * MiB, WS_WPAT = 20 * MiB, WS_WOUTT = 21 * MiB, WS_WRH = 23 * MiB;
constexpr size_t WS_XN = 24 * MiB;
constexpr size_t WS_GLAQ = 88 * MiB, WS_GLAK = 120 * MiB, WS_GALR = 152 * MiB  , WS_GLAV = 184 * MiB;
constexpr size_t WS_DILQ = 216 * MiB, WS_DILK = 312 * MiB, WS_DILV = 408 * MiB;
constexpr size_t WS_STATS = 504 * MiB;
constexpr size_t WS_LSE = WS_STATS;
constexpr size_t WS_DSEG = WS_STATS + 1536 * 1024;
constexpr size_t WS_TOKE = WS_STATS + 2 * MiB;
constexpr size_t WS_TOKW = WS_TOKE + 256 * 1024;
constexpr size_t WS_TOKR = WS_TOKW + 256 * 1024;
constexpr size_t WS_DEST = WS_TOKR + 256 * 1024;
constexpr size_t WS_ROWW = WS_DEST + 256 * 1024;
constexpr size_t WS_BLKE = WS_ROWW + 640 * 1024;
constexpr size_t WS_END = 512 * MiB;
constexpr size_t WS_GATES = 376 * MiB;
constexpr size_t WS_MERGED = 312 * MiB;
constexpr size_t WS_X1 = 88 * MiB;
constexpr size_t WS_H2 = 24 * MiB;
constexpr size_t WS_XP = 216 * MiB;
constexpr size_t WS_HBUF = 360 * MiB;
constexpr size_t WS_Y = 216 * MiB;
constexpr size_t WS_ROWTOK = 440 * MiB;
constexpr size_t DO_R = 0;
constexpr size_t DO_EXPGU = 32 * MiB;
constexpr size_t DO_EXPDN = 96 * MiB;
constexpr int CW_BAR = 4096;
constexpr int CW_GCNT = 16384;

constexpr int RING_OFF = 0, RING_BYTES = 131072;
constexpr int LDSCTL_OFF = RING_BYTES, MISC_OFF = LDSCTL_OFF + 320;
constexpr int LDS_BYTES = 147456;

#define XB_TMO      128
#define XB_XCNT(j)  (256  + 64 * (j))
#define XB_XSUB(j)  (1280 + 64 * (j))
#define XB_XGEN(j)  (2304 + 64 * (j))
#define XB_TOP      3328
#define XB_TOPGEN   3392
#define XCD_BAR_WORDS 3456
#define XB_SPIN_CAP (1u << 18)
DI unsigned xb_ld(unsigned* p)              { return __hip_atomic_load(p, __ATOMIC_RELAXED, __HIP_MEMORY_SCOPE_AGENT); }
DI unsigned xb_add(unsigned* p, unsigned v) { return __hip_atomic_fetch_add(p, v, __ATOMIC_RELAXED, __HIP_MEMORY_SCOPE_AGENT); }
DI unsigned xb_xcc_id() { return (unsigned)__builtin_amdgcn_s_getreg((3 << 11) | 20) & 0xFu; }
#define XB_SPIN(cond, bar) do { unsigned _sp = 0; while (cond) { __builtin_amdgcn_s_sleep(1); \
    if ((++_sp & 255u) == 0u) { if (xb_ld(&(bar)[XB_TMO])) break; if (_sp > XB_SPIN_CAP) { atomicAdd(&(bar)[XB_TMO], 1u); break; } } } } while (0)
struct XcdBarrier { unsigned* bar; unsigned x; volatile LAS unsigned* st; };
DI XcdBarrier xcd_barrier_post(unsigned* bar, volatile LAS unsigned* st) {
    XcdBarrier b; b.bar = bar; b.x = xb_xcc_id(); b.st = st;
    if (threadIdx.x == 0) (void)xb_add(&bar[XB_XCNT(b.x)], 1u);
    return b;
}
DI void xcd_barrier_complete(unsigned* bar, unsigned x, unsigned& nloc, unsigned& nx) {
    const unsigned G = gridDim.x * gridDim.y * gridDim.z;
    unsigned sum, cnt, mine, sp = 0u;
    for (;;) {
        sum = 0u; cnt = 0u; mine = 0u;
#pragma unroll
        for (unsigned j = 0; j < 16; ++j) { const unsigned c = xb_ld(&bar[XB_XCNT(j)]); sum += c; cnt += (c > 0u) ? 1u : 0u; mine = (j == x) ? c : mine; }
        if (sum == G) break;
        __builtin_amdgcn_s_sleep(1);
        if ((++sp & 255u) == 0u) { if (xb_ld(&bar[XB_TMO])) break; if (sp > XB_SPIN_CAP) { atomicAdd(&bar[XB_TMO], 1u); break; } }
    }
    nloc = mine > 0u ? mine : 1u; nx = cnt > 0u ? cnt : 1u;
}
DI void xcd_barrier(const XcdBarrier& b) {
    asm volatile("s_waitcnt vmcnt(0)" ::: "memory");
    __syncthreads();
    if (threadIdx.x == 0) {
        unsigned* bar = b.bar;
        __builtin_amdgcn_s_waitcnt(0);
        unsigned nloc = b.st[0], nx = b.st[1];
        if (nloc == 0u) { xcd_barrier_complete(bar, b.x, nloc, nx); b.st[0] = nloc; b.st[1] = nx; }
        const unsigned old = xb_add(&bar[XB_XSUB(b.x)], 1u);
        const unsigned gen = old / nloc;
        if (old + 1u == (gen + 1u) * nloc) {
            __builtin_amdgcn_fence(__ATOMIC_RELEASE, "agent");
            asm volatile("s_waitcnt vmcnt(0)" ::: "memory");
            const unsigned og = xb_add(&bar[XB_TOP], 1u);
            const unsigned tg = og / nx;
            if (og + 1u == (tg + 1u) * nx) xb_add(&bar[XB_TOPGEN], 1u);
            else XB_SPIN(xb_ld(&bar[XB_TOPGEN]) == tg, bar);
            __builtin_amdgcn_fence(__ATOMIC_ACQUIRE, "agent");
            xb_add(&bar[XB_XGEN(b.x)], 1u);
            asm volatile("s_waitcnt vmcnt(0)" ::: "memory");
        } else {
            XB_SPIN(xb_ld(&bar[XB_XGEN(b.x)]) == gen, bar);
            __builtin_amdgcn_fence(__ATOMIC_ACQUIRE, "agent");
            asm volatile("s_waitcnt vmcnt(0)" ::: "memory");
        }
    }
    __syncthreads();
}

namespace pg8 {
constexpr int BM = 256, BK = 64, HALF = 128, HTB = HALF * BK * 2, STAGE_BYTES = 8 * HTB, NXCD = 8, WGM = 8;
__host__ __device__ __forceinline__ int lds_byte(int r, int c) { const int st = (r >> 4) * 2 + (c >> 5), rr = r & 15, cc = c & 31, ob = rr * 64 + cc * 2; return st * 1024 + (ob ^ (((ob >> 9) & 1) << 5)); }
__host__ __device__ __forceinline__ void stage_rc(int b, int& R, int& C) { const int st = b / 1024, sb = b % 1024, swz = sb ^ (((sb >> 9) & 1) << 5); R = (st >> 1) * 16 + swz / 64; C = (st & 1) * 32 + (swz % 64) / 2; }
__host__ __device__ __forceinline__ int perm32(int rho) { const int n = rho >> 4, i = rho & 15; return 8 * (i >> 2) + 4 * n + (i & 3); }

struct Unit { const char* A; const char* B; int pm, pn, aux; };
struct GemmDesc { int lda, ldb, K; };

DI bool static_tile(int L, int nM, int nN, int& pm, int& pn) {
    const int nwg = nM * nN; if (L >= nwg) return false;
    int wgid = L; { const int q = nwg / NXCD, r = nwg % NXCD, xcd = wgid % NXCD, off = wgid / NXCD; wgid = (xcd < r ? xcd * (q + 1) : r * (q + 1) + (xcd - r) * q) + off; }
    const int nig = WGM * nN, gid = wgid / nig, fm = gid * WGM, gsz = (nM - fm) < WGM ? (nM - fm) : WGM;
    pm = fm + ((wgid % nig) % gsz); pn = (wgid % nig) / gsz; return true;
}
struct OrderStd {
    int nM, nN, G, c; const char* A0; const char* B0; size_t sA, sB;
    DI bool next(int i, Unit& u) const {
        int pm, pn; if (!static_tile(i * G + c, nM, nN, pm, pn)) return false;
        u.pm = pm; u.pn = pn; u.aux = 0; u.A = A0 + (size_t)pm * sA; u.B = B0 + (size_t)pn * sB; return true;
    }
};
struct OrderSplit {
    int nM, nN, L0, stride, slot, cnt; const char* A0; const char* B0; size_t sA, sB;
    DI bool next(int i, Unit& u) const {
        int pm, pn; if (i >= cnt || !static_tile(L0 + i * stride + slot, nM, nN, pm, pn)) return false;
        u.pm = pm; u.pn = pn; u.aux = 0; u.A = A0 + (size_t)pm * sA; u.B = B0 + (size_t)pn * sB; return true;
    }
};
struct OrderPair {
    int nM, nN, G, c; const char* A0; const char* A1; const char* B0; const char* B1; size_t sA, sB;
    DI bool next(int i, Unit& u) const {
        int pm, pn; if (!static_tile((i >> 1) * G + c, nM, nN, pm, pn)) return false;
        const int br = i & 1; u.pm = pm; u.pn = pn; u.aux = br; u.A = (br ? A1 : A0) + (size_t)pm * sA; u.B = (br ? B1 : B0) + (size_t)pn * sB; return true;
    }
};
struct OrderProj2 {
    int nM, nh, G, c; const char* A0; const char* A1; const char* B0; const char* B1; size_t sA, sB;
    DI bool next(int i, Unit& u) const {
        int pm, pn; if (!static_tile(i * G + c, nM, 2 * nh, pm, pn)) return false;
        const int br = pn >= nh; u.pm = pm; u.pn = pn; u.aux = br; u.A = (br ? A1 : A0) + (size_t)pm * sA; u.B = (br ? B1 : B0) + (size_t)(pn - br * nh) * sB; return true;
    }
};
struct OrderMoe {
    int nblk, G, c; const int* blke; const int* rowtok; const char* A0; const char* B0; size_t sA, sE, sB;
    DI bool next(int i, Unit& u) const {
        int rb, pn;
        if ((G & 31) == 0) { const int R = G >> 2, per = R >> 3, loc = c >> 3; rb = i * R + (c & 7) * per + (loc >> 2); pn = loc & 3; }
        else { const int L = i * G + c; rb = L >> 2; pn = L & 3; }
        if (rb >= nblk) return false;
        const int e = blke[rb];
        u.pm = rb; u.pn = pn; u.aux = 0;
        u.A = A0 + (size_t)rb * sA; u.B = B0 + (size_t)e * sE + (size_t)pn * sB; return true;
    }
};

#define PG8_LAS __attribute__((address_space(3)))
template <class Epi, class Sched, bool ALIGN_EPI = true, bool SP2 = true, bool GATHER = false>
DI void gemm_phase(PG8_LAS unsigned char* lds, const GemmDesc g, const Sched& S, const Epi& E) {
    const int tid = threadIdx.x, wid = __builtin_amdgcn_readfirstlane(tid >> 6), lane = tid & 63, wr = wid >> 2, wc = wid & 3, fr = lane & 15, fq = lane >> 4;
    const int K = g.K, nt = K / BK;
    static_assert(SP2 || !GATHER, "GATHER is written for the SP2 loop");
    unsigned vA[2][2], vAn[2][2], voffB[2]; int Rr[2]; unsigned cO[2];
#pragma unroll
    for (int i = 0; i < 2; ++i) { int R, C; stage_rc(tid * 16 + i * 8192, R, C); const int Rb = Epi::PERM ? ((R & ~31) + perm32(R & 31)) : R;
        Rr[i] = R; cO[i] = (unsigned)C * 2u; vA[0][i] = (unsigned)(R * g.lda + C) * 2u; vA[1][i] = (unsigned)((R + HALF) * g.lda + C) * 2u; voffB[i] = (unsigned)(Rb * g.ldb + C) * 2u;
        vAn[0][i] = vA[0][i]; vAn[1][i] = vA[1][i]; }
#define PG8_GOFFS(dst, unit) do { _Pragma("unroll") for (int _h = 0; _h < 2; ++_h) _Pragma("unroll") for (int _i = 0; _i < 2; ++_i) \
        dst[_h][_i] = (unsigned)S.rowtok[(unit).pm * BM + _h * HALF + Rr[_i]] * (unsigned)(g.lda * 2) + cO[_i]; } while (0)
    const size_t kstep = (size_t)(BK * 2);
    const size_t hstepA = (size_t)HALF * g.lda * 2, hstepB = (size_t)HALF * g.ldb * 2;
    const unsigned ldsw = (unsigned)wid * 1024u;
    const int aoff = lds_byte(wr * 64 + fr, fq * 8), boff = Epi::WIDE ? lds_byte((wc & 1) * 64 + fr, fq * 8) + (wc >> 1) * HTB : lds_byte(wc * 32 + fr, fq * 8);
#define PG8_SA(b, h) (((b) * 2 + (h)) * HTB)
#define PG8_SB(b, h) ((4 + (b) * 2 + (h)) * HTB)
#define PG8_STAGE(bufoff, gbase, voff) do { _Pragma("unroll") for (int _i = 0; _i < 2; ++_i) \
        __builtin_amdgcn_global_load_lds((const unsigned*)((const char*)(gbase) + (voff)[_i]), (PG8_LAS unsigned*)(lds + (bufoff) + ldsw + _i * 8192), 16, 0, 0); } while (0)
#define PG8_LDA(dst, b, h) do { _Pragma("unroll") for (int m = 0; m < 4; ++m) _Pragma("unroll") for (int k = 0; k < 2; ++k) dst[m][k] = *(const PG8_LAS bf16x8*)(lds + PG8_SA(b, h) + aoff + m * 2048 + k * 1024); } while (0)
#define PG8_LDB(dst, b, h) do { _Pragma("unroll") for (int n = 0; n < 2; ++n) _Pragma("unroll") for (int k = 0; k < 2; ++k) dst[n][k] = *(const PG8_LAS bf16x8*)(lds + (Epi::WIDE ? PG8_SB(b, 0) + (h) * 4096 : PG8_SB(b, h)) + boff + n * 2048 + k * 1024); } while (0)
#define PG8_MMA(ai, bj, At, Bt) do { __builtin_amdgcn_s_setprio(1); _Pragma("unroll") for (int m = 0; m < 4; ++m) _Pragma("unroll") for (int n = 0; n < 2; ++n) _Pragma("unroll") for (int k = 0; k < 2; ++k) \
        acc[ai][bj][m][n] = __builtin_amdgcn_mfma_f32_16x16x32_bf16(Bt[n][k], At[m][k], acc[ai][bj][m][n], 0, 0, 0); __builtin_amdgcn_s_setprio(0); } while (0)
#define PG8_WAIT_V(n) asm volatile("s_waitcnt vmcnt(" #n ")" ::: "memory")
#define PG8_WAIT_L(n) asm volatile("s_waitcnt lgkmcnt(" #n ")" ::: "memory")
#define PG8_BAR __builtin_amdgcn_s_barrier()
#define PG8_SCHED __builtin_amdgcn_sched_barrier(0)
    Unit cur, nxt; int ui = 0;
    if (!S.next(0, cur)) return;
    f32x4 acc[2][2][4][2];
#pragma unroll
    for (int a = 0; a < 2; ++a)
#pragma unroll
        for (int b = 0; b < 2; ++b)
#pragma unroll
            for (int m = 0; m < 4; ++m)
#pragma unroll
                for (int n = 0; n < 2; ++n) acc[a][b][m][n] = (f32x4){0.f, 0.f, 0.f, 0.f};
    bf16x8 At[4][2], B0[2][2], B1[2][2];
    const char* cA = cur.A; const char* cB = cur.B;
    if constexpr (GATHER) { PG8_GOFFS(vA, cur); }
    if constexpr (SP2) {
        PG8_STAGE(PG8_SB(0, 0), cB, voffB); PG8_STAGE(PG8_SB(0, 1), cB + hstepB, voffB); PG8_STAGE(PG8_SA(0, 0), cA, vA[0]); PG8_STAGE(PG8_SA(0, 1), cA, vA[1]);
        if (wr == 1) PG8_BAR;
        PG8_WAIT_V(2); PG8_BAR;
        PG8_STAGE(PG8_SB(1, 0), cB + kstep, voffB); PG8_STAGE(PG8_SA(1, 0), cA + kstep, vA[0]); PG8_STAGE(PG8_SB(1, 1), cB + hstepB + kstep, voffB);
        PG8_WAIT_V(6); PG8_BAR;
    } else {
        PG8_STAGE(PG8_SB(0, 0), cB, voffB); PG8_STAGE(PG8_SA(0, 0), cA, vA[0]); PG8_STAGE(PG8_SB(0, 1), cB + hstepB, voffB); PG8_STAGE(PG8_SA(0, 1), cA, vA[1]);
        if (wr == 1) PG8_BAR;
        PG8_WAIT_V(4); PG8_BAR;
        PG8_STAGE(PG8_SB(1, 0), cB + kstep, voffB); PG8_STAGE(PG8_SA(1, 0), cA + kstep, vA[0]); PG8_STAGE(PG8_SB(1, 1), cB + hstepB + kstep, voffB);
        PG8_WAIT_V(6); PG8_BAR;
    }
    for (;;) {
        const bool has_next = S.next(ui + 1, nxt);
        const char* nA = has_next ? nxt.A : cA; const char* nB = has_next ? nxt.B : cB;
        if constexpr (GATHER) { if (has_next) { PG8_GOFFS(vAn, nxt); } }
        for (int t = 0; t < nt; t += 2) {
            const bool last = (t == nt - 2);
            const char* a1 = cA + (size_t)(t + 1) * kstep;
            const char* a2 = last ? nA : cA + (size_t)(t + 2) * kstep; const char* b2 = last ? nB : cB + (size_t)(t + 2) * kstep;
            const char* a3 = a2 + kstep; const char* b3 = b2 + kstep;
            if constexpr (SP2) {
            unsigned w0[2], w1[2];
#pragma unroll
            for (int _i = 0; _i < 2; ++_i) { w0[_i] = last ? vAn[0][_i] : vA[0][_i]; w1[_i] = last ? vAn[1][_i] : vA[1][_i]; }
            PG8_LDB(B0, 0, 0); PG8_LDB(B1, 0, 1); PG8_SCHED; PG8_LDA(At, 0, 0); PG8_STAGE(PG8_SA(1, 1), a1, vA[1]);
            PG8_WAIT_V(8); PG8_WAIT_L(0); PG8_BAR; PG8_MMA(0, 0, At, B0); PG8_MMA(0, 1, At, B1); PG8_BAR; PG8_SCHED;
            PG8_LDA(At, 0, 1); PG8_STAGE(PG8_SB(0, 0), b2, voffB); PG8_STAGE(PG8_SB(0, 1), b2 + hstepB, voffB); PG8_STAGE(PG8_SA(0, 0), a2, w0);
            PG8_WAIT_V(8); PG8_WAIT_L(0); PG8_BAR; PG8_MMA(1, 0, At, B0); PG8_MMA(1, 1, At, B1); PG8_BAR; PG8_SCHED;
            PG8_LDB(B0, 1, 0); PG8_LDB(B1, 1, 1); PG8_SCHED; PG8_LDA(At, 1, 0); PG8_STAGE(PG8_SA(0, 1), a2, w1);
            PG8_WAIT_V(8); PG8_WAIT_L(0); PG8_BAR; PG8_MMA(0, 0, At, B0); PG8_MMA(0, 1, At, B1); PG8_BAR; PG8_SCHED;
            PG8_LDA(At, 1, 1); PG8_STAGE(PG8_SB(1, 0), b3, voffB); PG8_STAGE(PG8_SB(1, 1), b3 + hstepB, voffB); PG8_STAGE(PG8_SA(1, 0), a3, w0);
            PG8_WAIT_V(8); PG8_WAIT_L(0); PG8_BAR; PG8_MMA(1, 0, At, B0); PG8_MMA(1, 1, At, B1); PG8_BAR; PG8_SCHED;
            } else {
            PG8_LDB(B0, 0, 0); PG8_SCHED; PG8_LDA(At, 0, 0); PG8_STAGE(PG8_SA(1, 1), a1, vA[1]);
            PG8_WAIT_L(8); PG8_BAR; PG8_WAIT_L(0); PG8_MMA(0, 0, At, B0); PG8_BAR; PG8_SCHED;
            PG8_LDB(B1, 0, 1); PG8_STAGE(PG8_SB(0, 0), b2, voffB);
            PG8_BAR; PG8_WAIT_L(0); PG8_MMA(0, 1, At, B1); PG8_BAR;
            PG8_LDA(At, 0, 1); PG8_STAGE(PG8_SA(0, 0), a2, vA[0]);
            PG8_BAR; PG8_WAIT_L(0); PG8_MMA(1, 0, At, B0); PG8_BAR; PG8_SCHED;
            PG8_STAGE(PG8_SB(0, 1), b2 + hstepB, voffB);
            PG8_WAIT_V(6); PG8_BAR; PG8_MMA(1, 1, At, B1); PG8_BAR;
            PG8_LDB(B0, 1, 0); PG8_SCHED; PG8_LDA(At, 1, 0); PG8_STAGE(PG8_SA(0, 1), a2, vA[1]);
            PG8_WAIT_L(8); PG8_BAR; PG8_WAIT_L(0); PG8_MMA(0, 0, At, B0); PG8_BAR; PG8_SCHED;
            PG8_LDB(B1, 1, 1); PG8_STAGE(PG8_SB(1, 0), b3, voffB);
            PG8_BAR; PG8_WAIT_L(0); PG8_MMA(0, 1, At, B1); PG8_BAR;
            PG8_LDA(At, 1, 1); PG8_STAGE(PG8_SA(1, 0), a3, vA[0]);
            PG8_BAR; PG8_WAIT_L(0); PG8_MMA(1, 0, At, B0); PG8_BAR; PG8_SCHED;
            PG8_STAGE(PG8_SB(1, 1), b3 + hstepB, voffB);
            PG8_WAIT_V(6); PG8_BAR; PG8_MMA(1, 1, At, B1); PG8_BAR;
            }
        }
        if constexpr (ALIGN_EPI) { if (wr == 0) PG8_BAR; }
        E(acc, cur, wr, wc, fr, fq);
        if (!has_next) break;
#pragma unroll
        for (int a = 0; a < 2; ++a)
#pragma unroll
            for (int b = 0; b < 2; ++b)
#pragma unroll
                for (int m = 0; m < 4; ++m)
#pragma unroll
                    for (int n = 0; n < 2; ++n) acc[a][b][m][n] = (f32x4){0.f, 0.f, 0.f, 0.f};
        cur = nxt; cA = nA; cB = nB; ++ui;
#pragma unroll
        for (int _h = 0; _h < 2; ++_h)
#pragma unroll
            for (int _i = 0; _i < 2; ++_i) vA[_h][_i] = vAn[_h][_i];
        if constexpr (ALIGN_EPI) { if (wr == 1) PG8_BAR; }
    }
    PG8_WAIT_V(0);
    if constexpr (!ALIGN_EPI) { if (wr == 0) PG8_BAR; }
    PG8_BAR;
#undef PG8_GOFFS
#undef PG8_SA
#undef PG8_SB
#undef PG8_STAGE
#undef PG8_LDA
#undef PG8_LDB
#undef PG8_MMA
#undef PG8_WAIT_V
#undef PG8_WAIT_L
#undef PG8_BAR
#undef PG8_SCHED
}

typedef f32x4 AccT[2][2][4][2];
DI float fexp(float v) { return __builtin_amdgcn_exp2f(v * 1.4426950408889634f); }
DI float sigmoid_f(float v) { return __builtin_amdgcn_rcpf(1.f + fexp(-v)); }
DI float silu_f(float v) { return v * sigmoid_f(v); }
DI float logsig16(float v) { return (fminf(v, 0.f) - __builtin_amdgcn_logf(1.f + fexp(-fabsf(v))) * 0.6931471805599453f) * 0.0625f; }
DI v4u pack8(f32x4 a, f32x4 b) { v4u w; w.x = pk2(a[0], a[1]); w.y = pk2(a[2], a[3]); w.z = pk2(b[0], b[1]); w.w = pk2(b[2], b[3]); return w; }

DI void wide_pair(const v4u P0, const v4u P1, v4u& SA, v4u& SB) {
#pragma unroll
    for (int c = 0; c < 4; ++c) { SA[c] = (unsigned)__builtin_amdgcn_update_dpp((int)P0[c], (int)P1[c], 0x128, 0xF, 0xC, false);
                                  SB[c] = (unsigned)__builtin_amdgcn_update_dpp((int)P1[c], (int)P0[c], 0x128, 0xF, 0x3, false); }
}
struct EpiP1 {
    static constexpr bool PERM = true, WIDE = true;
    unsigned char* ws; unsigned char* dout; const float* gq; const float* gk; LAS float* xch;
    DI void operator()(const AccT& acc, const Unit& u, int wr, int wc, int fr, int fq) const {
        const int pn = u.pn, rowA = u.pm * BM + wr * 64 + (fr & 7), clw = (wc >> 1) * HALF + (wc & 1) * 64 + (fr >> 3) * 32 + 8 * fq;
        const int rem = pn >= 8 ? (pn - 8) % 6 : 6, gi = pn >= 8 ? (pn - 8) / 6 : 0;
        int mode = 0; const int colbase = (pn & 1) * 256; size_t off;
        if (pn < 8) { const int bi = pn >> 1; off = bi == 0 ? WS_GLAQ : (bi == 1 ? WS_GLAK : (bi == 2 ? WS_GLAV : DO_R)); mode = bi == 3 ? 1 : 0; }
        else { off = (rem < 2 ? WS_DILQ : (rem < 4 ? WS_DILK : WS_DILV)) + (size_t)gi * T * 1024; mode = rem < 4 ? 3 : 0; }
        bf16* dst = (bf16*)(((pn >> 1) == 3 ? dout : ws) + off) + colbase + clw;
        if (mode == 3) {
            const bool isq = rem < 2;
#pragma unroll
            for (int ai = 0; ai < 2; ++ai)
#pragma unroll
                for (int m = 0; m < 4; ++m) { float ss = 0.f;
#pragma unroll
                    for (int bj = 0; bj < 2; ++bj) { const f32x4 v0 = acc[ai][bj][m][0], v1 = acc[ai][bj][m][1];
                        ss += ((v0[0] * v0[0] + v0[1] * v0[1]) + (v0[2] * v0[2] + v0[3] * v0[3])) + ((v1[0] * v1[0] + v1[1] * v1[1]) + (v1[2] * v1[2] + v1[3] * v1[3])); }
                    ss = xor32_sum(xor16_sum(ss));
                    if (fq == 0) xch[(ai * 128 + wr * 64 + m * 16 + fr) * 4 + wc] = ss; }
            asm volatile("s_waitcnt lgkmcnt(0)" ::: "memory"); __builtin_amdgcn_s_barrier(); asm volatile("" ::: "memory");
            const float* gp = (isq ? gq : gk) + gi * 128 + (wc & 1) * 64 + 8 * fq;
            const f32x4 g00 = *(const f32x4*)gp, g01 = *(const f32x4*)(gp + 4), g10 = *(const f32x4*)(gp + 32), g11 = *(const f32x4*)(gp + 36);
            const float qs = isq ? 0.08838834764831845f * LOG2E : 1.f;
#pragma unroll
            for (int ai = 0; ai < 2; ++ai)
#pragma unroll
                for (int m = 0; m < 4; ++m) { const f32x2 t = *(const LAS f32x2*)(xch + (ai * 128 + wr * 64 + m * 16 + fr) * 4 + (wc & 2));
                    const float rinv = __frsqrt_rn((t[0] + t[1]) * (1.f / 128.f) + EPS) * qs;
                    bf16* rp = dst + (size_t)(rowA + ai * HALF + m * 16) * 512; v4u SA, SB;
                    wide_pair(pack8(acc[ai][0][m][0] * rinv * g00, acc[ai][0][m][1] * rinv * g01), pack8(acc[ai][1][m][0] * rinv * g10, acc[ai][1][m][1] * rinv * g11), SA, SB);
                    *(v4u*)rp = SA; *(v4u*)(rp + 8 * 512) = SB; }
            return;
        }
#pragma unroll
        for (int ai = 0; ai < 2; ++ai)
#pragma unroll
            for (int m = 0; m < 4; ++m) { bf16* rp = dst + (size_t)(rowA + ai * HALF + m * 16) * 512; v4u P[2], SA, SB;
#pragma unroll
                for (int bj = 0; bj < 2; ++bj) { f32x4 v0 = acc[ai][bj][m][0], v1 = acc[ai][bj][m][1];
                    if (mode == 1) {
#pragma unroll
                        for (int j = 0; j < 4; ++j) { v0[j] = silu_f(v0[j]); v1[j] = silu_f(v1[j]); } }
                    P[bj] = pack8(v0, v1); }
                wide_pair(P[0], P[1], SA, SB);
                *(v4u*)rp = SA; *(v4u*)(rp + 8 * 512) = SB; }
    }
};
struct EpiGateMerge {
    static constexpr bool PERM = true, WIDE = false;
    bf16* Mg; const bf16* Y; const float* bias; bool dry;
    DI void operator()(const AccT& acc, const Unit& u, int wr, int wc, int fr, int fq) const {
#if defined(PROBE_PLAN)
        if (dry) { asm volatile("" :: "v"(acc[0][0][0][0][0]), "v"(acc[1][1][3][1][3])); return; }
#endif
        const int row0 = u.pm * BM + wr * 64 + fr, col0 = u.pn * HALF + wc * 32 + 8 * fq;
        f32x4 bv[2][2];
#pragma unroll
        for (int bj = 0; bj < 2; ++bj)
#pragma unroll
            for (int n = 0; n < 2; ++n) bv[bj][n] = *(const f32x4*)(bias + bj * 1024 + col0 + 4 * n);
#pragma unroll
        for (int ai = 0; ai < 2; ++ai)
#pragma unroll
            for (int m = 0; m < 4; ++m) { const size_t row = (size_t)(row0 + ai * HALF + m * 16);
                const v4u yg = *(const v4u*)(Y + row * 2048 + col0), ya = *(const v4u*)(Y + row * 2048 + 1024 + col0);
                f32x4 g0 = acc[ai][0][m][0] + bv[0][0], g1 = acc[ai][0][m][1] + bv[0][1], a0 = acc[ai][1][m][0] + bv[1][0], a1 = acc[ai][1][m][1] + bv[1][1];
#pragma unroll
                for (int j = 0; j < 4; ++j) { g0[j] = sigmoid_f(g0[j]); g1[j] = sigmoid_f(g1[j]); a0[j] = sigmoid_f(a0[j]); a1[j] = sigmoid_f(a1[j]); }
                f32x4 o0, o1;
                o0[0] = g0[0] * bflo(yg.x) + a0[0] * bflo(ya.x); o0[1] = g0[1] * bfhi(yg.x) + a0[1] * bfhi(ya.x); o0[2] = g0[2] * bflo(yg.y) + a0[2] * bflo(ya.y); o0[3] = g0[3] * bfhi(yg.y) + a0[3] * bfhi(ya.y);
                o1[0] = g1[0] * bflo(yg.z) + a1[0] * bflo(ya.z); o1[1] = g1[1] * bfhi(yg.z) + a1[1] * bfhi(ya.z); o1[2] = g1[2] * bflo(yg.w) + a1[2] * bflo(ya.w); o1[3] = g1[3] * bfhi(yg.w) + a1[3] * bfhi(ya.w);
                *(v4u*)(Mg + row * 1024 + col0) = pack8(o0, o1); }
    }
};
struct EpiX1 {
    static constexpr bool PERM = true, WIDE = true;
    bf16* X1; const float* X;
    DI void operator()(const AccT& acc, const Unit& u, int wr, int wc, int fr, int fq) const {
        const int row0 = u.pm * BM + wr * 64 + fr, col0 = u.pn * BM + (wc >> 1) * HALF + (wc & 1) * 64 + 8 * fq;
        const int rowA = u.pm * BM + wr * 64 + (fr & 7), colw = u.pn * BM + (wc >> 1) * HALF + (wc & 1) * 64 + (fr >> 3) * 32 + 8 * fq;
#pragma unroll
        for (int ai = 0; ai < 2; ++ai)
#pragma unroll
            for (int m = 0; m < 4; ++m) { const float* xp = X + (size_t)(row0 + ai * HALF + m * 16) * 1024 + col0; v4u SA, SB;
                wide_pair(pack8(acc[ai][0][m][0] + *(const f32x4*)xp, acc[ai][0][m][1] + *(const f32x4*)(xp + 4)), pack8(acc[ai][1][m][0] + *(const f32x4*)(xp + 32), acc[ai][1][m][1] + *(const f32x4*)(xp + 36)), SA, SB);
                bf16* rp = X1 + (size_t)(rowA + ai * HALF + m * 16) * 1024 + colw;
                *(v4u*)rp = SA; *(v4u*)(rp + 8 * 1024) = SB; }
    }
};
struct EpiGU {
    static constexpr bool PERM = true, WIDE = false;
    bf16* H; const f32x2* roww;
    DI void operator()(const AccT& acc, const Unit& u, int wr, int wc, int fr, int fq) const {
        const int row0 = u.pm * BM + wr * 64 + fr, hc0 = u.pn * 128 + wc * 16 + 4 * fq;
#pragma unroll
        for (int ai = 0; ai < 2; ++ai)
#pragma unroll
            for (int m = 0; m < 4; ++m) { const int row = row0 + ai * HALF + m * 16; const f32x2 wv = roww[row]; const float ri = wv.y, w = wv.x * ri;
#pragma unroll
                for (int bj = 0; bj < 2; ++bj) { const f32x4 g = acc[ai][bj][m][0] * ri, up = acc[ai][bj][m][1];
                    v2u o; o.x = pk2(w * silu_f(g[0]) * up[0], w * silu_f(g[1]) * up[1]); o.y = pk2(w * silu_f(g[2]) * up[2], w * silu_f(g[3]) * up[3]);
                    *(v2u*)(H + (size_t)row * 512 + hc0 + bj * 64) = o; } }
    }
};
struct EpiY {
    static constexpr bool PERM = true, WIDE = true;
    bf16* Y; int ld; bool dry;
    DI void operator()(const AccT& acc, const Unit& u, int wr, int wc, int fr, int fq) const {
#if defined(PROBE_PLAN)
        if (dry) { asm volatile("" :: "v"(acc[0][0][0][0][0]), "v"(acc[1][1][3][1][3])); return; }
#endif
        const int rowA = u.pm * BM + wr * 64 + (fr & 7), colw = u.pn * BM + (wc >> 1) * HALF + (wc & 1) * 64 + (fr >> 3) * 32 + 8 * fq;
#pragma unroll
        for (int ai = 0; ai < 2; ++ai)
#pragma unroll
            for (int m = 0; m < 4; ++m) { bf16* rp = Y + (size_t)(rowA + ai * HALF + m * 16) * ld + colw; v4u SA, SB;
                wide_pair(pack8(acc[ai][0][m][0], acc[ai][0][m][1]), pack8(acc[ai][1][m][0], acc[ai][1][m][1]), SA, SB);
                *(v4u*)rp = SA; *(v4u*)(rp + (size_t)8 * ld) = SB; }
    }
};
}

constexpr int NWAVES = 8, NTHR = 512;
struct Frame {
    LAS unsigned char* lds;
    int tid, lane, wave, vcu, G;
    unsigned char* ws; unsigned char* dout;
};
#define LDS_WAIT() asm volatile("s_waitcnt lgkmcnt(0)" ::: "memory")
#define LDS_BARRIER() do { asm volatile("s_waitcnt lgkmcnt(0)" ::: "memory"); __builtin_amdgcn_s_barrier(); asm volatile("" ::: "memory"); } while (0)
DI float wave_sum(float v) {
    return xor32_sum(xor16_sum(row16_sum(v)));
}
#define MFMA16(a, b, c) __builtin_amdgcn_mfma_f32_16x16x32_bf16((a), (b), (c), 0, 0, 0)
#define MFMA32(a, b, c) __builtin_amdgcn_mfma_f32_32x32x16_bf16((a), (b), (c), 0, 0, 0)

struct TItem { const float* src; bf16* dst; const float* gain; int ldw, ldd, kind, aux, hasg; };
struct Ins { const float* in[21]; };
constexpr int I_IN = 16 * 208, I_BG = 16 * 64, I_PG = 8 * 32, I_PA = 8 * 32, I_OUT = 16 * 32, I_GU = 32 * 2 * 16 * 16, I_DN = 32 * 8 * 32;
constexpr int NITEMS = I_IN + I_BG + I_PG + I_PA + I_OUT + I_GU + I_DN;
DI TItem p0_decode(const Frame& F, const Ins& I, int it) {
    TItem t; int r = it; t.gain = I.in[13]; t.hasg = 0;
    if (r < I_IN) { const int kb = r / 208, nb = r % 208; const int n0 = nb * 32, c0 = nb < 64 ? n0 : n0 + 16;
        t.src = I.in[2] + (size_t)kb * 64 * IN_COLS + c0; t.ldw = IN_COLS; t.dst = (bf16*)(F.ws + WS_W1T) + kb * 64; t.ldd = 1024; t.kind = 0; t.aux = n0; return t; } r -= I_IN;
    if (r < I_BG) { const int kb = r / 64, nb = r % 64; t.src = I.in[10] + (size_t)kb * 64 * 2048 + nb * 32; t.ldw = 2048; t.dst = (bf16*)(F.ws + WS_WBGT) + kb * 64; t.ldd = 1024; t.kind = 1; t.aux = nb * 32; return t; } r -= I_BG;
    if (r < I_PG) { const int kb = r / 32, nb = r % 32; t.src = I.in[8] + (size_t)kb * 64 * 1024 + nb * 32; t.ldw = 1024; t.dst = (bf16*)(F.ws + WS_WPGT) + kb * 64; t.ldd = 512; t.kind = 0; t.aux = nb * 32; return t; } r -= I_PG;
    if (r < I_PA) { const int kb = r / 32, nb = r % 32; t.src = I.in[9] + (size_t)kb * 64 * 1024 + nb * 32; t.ldw = 1024; t.dst = (bf16*)(F.ws + WS_WPAT) + kb * 64; t.ldd = 512; t.kind = 0; t.aux = nb * 32; return t; } r -= I_PA;
    if (r < I_OUT) { const int kb = r / 32, nb = r % 32; t.src = I.in[12] + (size_t)kb * 64 * 1024 + nb * 32; t.ldw = 1024; t.dst = (bf16*)(F.ws + WS_WOUTT) + kb * 64; t.ldd = 1024; t.kind = 0; t.aux = nb * 32; return t; } r -= I_OUT;
    if (r < I_GU) { const int e = r / 512, q = r % 512, up = q >> 8, kb = (q >> 4) & 15, nb = q & 15;
        t.src = (up ? I.in[19] : I.in[18]) + (size_t)e * 1024 * 512 + (size_t)kb * 64 * 512 + nb * 32; t.ldw = 512; t.dst = (bf16*)(F.dout + DO_EXPGU) + (size_t)e * 1024 * 1024 + kb * 64; t.ldd = 1024; t.kind = 2; t.aux = nb * 32 * 2 + up; t.gain = I.in[13] + kb * 64; t.hasg = 1; return t; } r -= I_GU;
    { const int e = r / 256, q = r % 256, kb = q / 32, nb = q % 32;
        t.src = I.in[20] + (size_t)e * 512 * 1024 + (size_t)kb * 64 * 1024 + nb * 32; t.ldw = 1024; t.dst = (bf16*)(F.dout + DO_EXPDN) + (size_t)e * 1024 * 512 + kb * 64; t.ldd = 512; t.kind = 0; t.aux = nb * 32; return t; }
}
DI int p0_rowmap(const TItem& t, int n) {
    if (t.kind == 0) return t.aux + n;
    if (t.kind == 1) { const int c = t.aux + n, cc = c & 1023; return (cc >> 7) * 256 + (c >> 10) * 128 + (cc & 127); }
    const int c = (t.aux >> 1) + n; return (c >> 2) * 8 + (c & 3) + 4 * (t.aux & 1);
}
DI void p0_transpose(const Frame& F, const Ins& I, int it0, int it1, int gw, int NGW) {
    LAS float* scr = (LAS float*)(F.lds + RING_OFF + F.wave * 16384);
    const int lane = F.lane;
    { float cur[32], nxt[32]; TItem ti = p0_decode(F, I, it0 + gw < it1 ? it0 + gw : it0);
#pragma unroll
      for (int i = 0; i < 32; ++i) cur[i] = ti.src[(size_t)(2 * i + (lane >> 5)) * ti.ldw + (lane & 31)];
#pragma unroll 1
      for (int it = it0 + gw; it < it1; it += NGW) {
          const bool more = it + NGW < it1; const TItem tn = p0_decode(F, I, more ? it + NGW : it);
#pragma unroll
          for (int i = 0; i < 32; ++i) nxt[i] = tn.src[(size_t)(2 * i + (lane >> 5)) * tn.ldw + (lane & 31)];
#pragma unroll
          for (int i = 0; i < 32; ++i) scr[(2 * i + (lane >> 5)) * 33 + (lane & 31)] = cur[i];
          LDS_WAIT(); asm volatile("" ::: "memory");
          const int c = lane & 7;
          f32x4 ga = *(const f32x4*)(ti.gain + 8 * c), gb = *(const f32x4*)(ti.gain + 8 * c + 4);
          if (!ti.hasg) { ga = (f32x4){1.f, 1.f, 1.f, 1.f}; gb = ga; }
#pragma unroll
          for (int j = 0; j < 4; ++j) { const int n = (lane >> 3) + 8 * j; const LAS float* sp = scr + (8 * c) * 33 + n;
              v4u o; o.x = pk2(sp[0 * 33] * ga.x, sp[1 * 33] * ga.y); o.y = pk2(sp[2 * 33] * ga.z, sp[3 * 33] * ga.w); o.z = pk2(sp[4 * 33] * gb.x, sp[5 * 33] * gb.y); o.w = pk2(sp[6 * 33] * gb.z, sp[7 * 33] * gb.w);
              *(v4u*)(ti.dst + (size_t)p0_rowmap(ti, n) * ti.ldd + 8 * c) = o; }
          LDS_WAIT(); asm volatile("" ::: "memory");
          ti = tn;
#pragma unroll
          for (int i = 0; i < 32; ++i) cur[i] = nxt[i];
      } }
}
DI bool p0_split(const Frame& F) { return F.G == 256; }
DI void p0_prologue(const Frame& F, const Ins& I, bool pdry) {
    const int gw = F.vcu * NWAVES + F.wave, NGW = F.G * NWAVES, lane = F.lane;
    p0_transpose(F, I, 0, p0_split(F) ? I_IN : NITEMS, gw, NGW);
    { bf16* WRH = (bf16*)(F.ws + WS_WRH); bf16* WRL = WRH + 48 * 1024; const float* wrg = I.in[14]; const float* wre = I.in[16];
      for (int e = (F.vcu * NTHR + F.tid); e < 48 * 1024; e += F.G * NTHR) { const int k = e & 1023, n = e >> 10;
          const float w = (n < 4 ? wrg[k * 4 + n] : (n < 36 ? wre[k * 32 + n - 4] : 0.f)) * I.in[13][k]; const bf16 h = f2bf(w); WRH[e] = h; WRL[e] = f2bf(w - bf2f(h)); } }
    { const float* x = I.in[0]; const float* g1 = I.in[1]; bf16* XN = (bf16*)(F.ws + WS_XN);
      f32x4 gv[4];
#pragma unroll
      for (int j = 0; j < 4; ++j) gv[j] = *(const f32x4*)(g1 + 4 * lane + 256 * j);
      LAS float* wlr = (LAS float*)(F.lds + RING_OFF);
      __syncthreads();
      for (int e = F.tid; e < 16 * 1024; e += NTHR) { const int k = e >> 4, n = e & 15; wlr[n * 1024 + k] = I.in[2][(size_t)k * IN_COLS + 2048 + n] * g1[k]; }
      __syncthreads();
      float* GALR = (float*)(F.ws + WS_GALR);
      f32x4 v[4], vn[4], vb1[4], vb2[4];
#pragma unroll
      for (int rr = 0; rr < 3; ++rr) { const int m0 = gw + rr * NGW; const f32x4* xr = (const f32x4*)(x + (size_t)(m0 < T ? m0 : 0) * D) + lane;
#pragma unroll
        for (int j = 0; j < 4; ++j) { const f32x4 t = xr[64 * j]; if (rr == 0) v[j] = t; else if (rr == 1) vb1[j] = t; else vb2[j] = t; } }
#pragma unroll 1
      for (int m = gw; m < T; m += NGW) { const int mn = m + 3 * NGW < T ? m + 3 * NGW : m; const f32x4* xr = (const f32x4*)(x + (size_t)mn * D) + lane; float s = 0.f;
#pragma unroll
          for (int j = 0; j < 4; ++j) { vn[j] = xr[64 * j]; s += (v[j].x * v[j].x + v[j].y * v[j].y) + (v[j].z * v[j].z + v[j].w * v[j].w); }
          const float rinv = __frsqrt_rn(wave_sum(s) * (1.f / D) + EPS);
          v2u* o8 = (v2u*)(XN + (size_t)m * D) + lane;
#pragma unroll
          for (int j = 0; j < 4; ++j) { v2u o; o.x = pk2(v[j].x * rinv * gv[j].x, v[j].y * rinv * gv[j].y); o.y = pk2(v[j].z * rinv * gv[j].z, v[j].w * rinv * gv[j].w); o8[64 * j] = o; }
#if defined(PROBE_PLAN) && PROBE_SKIP == 2
          if (pdry) { _Pragma("unroll") for (int j = 0; j < 4; ++j) { v[j] = vb1[j]; vb1[j] = vb2[j]; vb2[j] = vn[j]; } continue; }
#endif
          float p[16];
#pragma unroll
          for (int n = 0; n < 16; ++n) { float a = 0.f;
#pragma unroll
              for (int j = 0; j < 4; ++j) { const f32x4 wv = *(const LAS f32x4*)(wlr + n * 1024 + 4 * lane + 256 * j); a += (v[j].x * wv.x + v[j].y * wv.y) + (v[j].z * wv.z + v[j].w * wv.w); }
              p[n] = a; asm volatile("" ::: "memory"); }
#if defined(PROBE_PLAN) && PROBE_SKIP == 1
          if (pdry) { asm volatile("" :: "v"(p[0]), "v"(p[15])); _Pragma("unroll") for (int j = 0; j < 4; ++j) { v[j] = vb1[j]; vb1[j] = vb2[j]; vb2[j] = vn[j]; } continue; }
#endif
          { const bool h3 = lane & 8, h2 = lane & 4; float q8[8], q4[4], q2[2], q1;
#pragma unroll
            for (int i = 0; i < 8; ++i) q8[i] = rs32(p[i], p[i + 8]);
#pragma unroll
            for (int i = 0; i < 4; ++i) q4[i] = rs16(q8[i], q8[i + 4]);
#pragma unroll
            for (int i = 0; i < 2; ++i) { const float snd = h3 ? q4[i] : q4[i + 2], kp = h3 ? q4[i + 2] : q4[i]; q2[i] = kp + __shfl_xor(snd, 8); }
            { const float snd = h2 ? q2[0] : q2[1], kp = h2 ? q2[1] : q2[0]; q1 = kp + __shfl_xor(snd, 4); }
            q1 += __shfl_xor(q1, 2); q1 += __shfl_xor(q1, 1);
            if ((lane & 3) == 0) GALR[(size_t)m * 16 + ((lane >> 5) & 1) * 8 + ((lane >> 4) & 1) * 4 + ((lane >> 3) & 1) * 2 + ((lane >> 2) & 1)] = q1 * rinv; }
#pragma unroll
          for (int j = 0; j < 4; ++j) { v[j] = vb1[j]; vb1[j] = vb2[j]; vb2[j] = vn[j]; } } }
}

DI void qk_norm_phase(const Frame& F, const float* gq, const float* gk, bool dry) {
    const int gw = F.vcu * NWAVES + F.wave, NGW = F.G * NWAVES, lane = F.lane;
    bf16* Q = (bf16*)(F.ws + WS_DILQ);
    for (int rr = gw; rr < 6 * T; rr += NGW) { const int which = rr / T; const int gi = which % 3; const bool isq = which < 3;
        bf16* p = Q + (size_t)rr * 512 + 8 * lane; const v4u v = *(const v4u*)p;
        float x[8] = {bflo(v.x), bfhi(v.x), bflo(v.y), bfhi(v.y), bflo(v.z), bfhi(v.z), bflo(v.w), bfhi(v.w)};
        float s = 0.f;
#pragma unroll
        for (int j = 0; j < 8; ++j) s += x[j] * x[j];
        s += __shfl_xor(s, 1); s += __shfl_xor(s, 2); s += __shfl_xor(s, 4); s += __shfl_xor(s, 8);
        const float rinv = __frsqrt_rn(s * (1.f / 128.f) + EPS) * (isq ? 0.08838834764831845f * LOG2E : 1.f);
        const float* g = (isq ? gq : gk) + gi * 128 + (8 * lane & 127);
        const f32x4 g0 = *(const f32x4*)g, g1 = *(const f32x4*)(g + 4);
        v4u o; o.x = pk2(x[0] * rinv * g0.x, x[1] * rinv * g0.y); o.y = pk2(x[2] * rinv * g0.z, x[3] * rinv * g0.w); o.z = pk2(x[4] * rinv * g1.x, x[5] * rinv * g1.y); o.w = pk2(x[6] * rinv * g1.z, x[7] * rinv * g1.w);
        if (!dry) *(v4u*)p = o; }
}

DI int crow(int i, int h) { return (i & 3) + 8 * (i >> 2) + 4 * h; }
DI int img_off(int row, int ch) { return 256 * row + 16 * (ch ^ (((row & 3) << 2) | ((row >> 2) & 3))); }
typedef short s16x4 __attribute__((ext_vector_type(4)));
DI void attn_round(const Frame& F, int jr, bool dry) {
    const int lane = F.lane, r = lane & 31, h = lane >> 5, w = F.wave, side = w & 1;
    const int job = jr * 8 + w;
    const int gi = job >> 12; int rem = job & 4095;
    const int sh = 2 * gi, d = 1 << sh, L = SEQ >> sh, nqt = L >> 5;
    const int qt = rem % nqt; rem /= nqt; const int res = rem & (d - 1); rem >>= sh; const int head = rem & 3, b = rem >> 2;
    const int p0 = qt * 32, qtA = qt - side;
    const float slope = exp2f(-8.f * (float)(gi * 4 + head + 1) / 12.f) * LOG2E * (float)d;
    bf16* Qg = (bf16*)(F.ws + WS_DILQ) + (size_t)gi * T * 512;
    const bf16* Kg = (const bf16*)(F.ws + WS_DILK) + (size_t)gi * T * 512 + head * 128;
    const bf16* Vg = (const bf16*)(F.ws + WS_DILV) + (size_t)gi * T * 512 + head * 128;
    LAS unsigned char* pbuf = F.lds + (w >> 1) * 32768;
    const size_t qtok = (size_t)b * SEQ + (size_t)(p0 + r) * d + res;
    bf16x8 qf[8];
#pragma unroll
    for (int ks = 0; ks < 8; ++ks) qf[ks] = *(const bf16x8*)(Qg + qtok * 512 + head * 128 + 16 * ks + 8 * h);
    f32x16 O[4];
#pragma unroll
    for (int db = 0; db < 4; ++db)
#pragma unroll
        for (int i = 0; i < 16; ++i) O[db][i] = 0.f;
    float m = -1e30f, l = 0.f;
    const int srow = lane >> 4, sslot = lane & 15;
    v4u ks0[4], vs0[4], ks1[4], vs1[4];
#define ATT_LOAD(KS, VS, sN) do { const int _kb = 32 * (qtA - 4 + (sN)); if (_kb >= 0) { _Pragma("unroll") for (int ii = 0; ii < 4; ++ii) { const int kk = 16 * side + 4 * ii + srow; \
        const size_t _o = ((size_t)b * SEQ + (size_t)(_kb + kk) * d + res) * 512 + 8 * (sslot ^ ((srow << 2) | ii)); KS[ii] = *(const v4u*)(Kg + _o); VS[ii] = *(const v4u*)(Vg + _o); } } } while (0)
#define ATT_STEP(KS, VS, sN) do { const int s_ = (sN); LAS unsigned char* Kimg = pbuf + (s_ & 1) * 16384; LAS unsigned char* Vimg = Kimg + 8192; const int kb = 32 * (qtA - 4 + s_); \
        _Pragma("unroll") for (int ii = 0; ii < 4; ++ii) { *(LAS v4u*)(Kimg + 1024 * (4 * side + ii) + 16 * lane) = KS[ii]; *(LAS v4u*)(Vimg + 1024 * (4 * side + ii) + 16 * lane) = VS[ii]; } \
        if (s_ - 2 >= 0) ATT_LOAD(KS, VS, s_ - 2); \
        LDS_BARRIER(); \
        const int kt = s_ - side; \
        if (kt >= 0 && kt < 5 && kb >= 0) { \
            f32x16 sc; _Pragma("unroll") for (int i = 0; i < 16; ++i) sc[i] = 0.f; \
            _Pragma("unroll") for (int ks = 0; ks < 8; ++ks) { const bf16x8 kf = *(const LAS bf16x8*)(Kimg + img_off(r, 2 * ks + h)); sc = MFMA32(kf, qf[ks], sc); } \
            float mx = -1e30f; const int dq = p0 + r - kb; \
            _Pragma("unroll") for (int i = 0; i < 16; ++i) { const int dist = dq - crow(i, h); const bool ok = dist >= 0 && dist <= 128; const float sv = ok ? sc[i] - slope * (float)dist : -1e30f; sc[i] = sv; mx = fmaxf(mx, sv); } \
            mx = xor32_max(mx); \
            const float mn = fmaxf(m, mx), alpha = __builtin_amdgcn_exp2f(m - mn); const bool grow = !__all(mn <= m); m = mn; \
            float ps = 0.f; \
            _Pragma("unroll") for (int i = 0; i < 16; ++i) { const float pe = __builtin_amdgcn_exp2f(sc[i] - mn);     sc[i] = pe; ps += pe; } \
            l = l * alpha + ps; \
            if (grow) { _Pragma("unroll") for (int db = 0; db < 4; ++db) _Pragma("unroll") for (int i = 0; i < 16; ++i) O[db][i] *= alpha; } \
            bf16x8 pb[2]; \
            _Pragma("unroll") for (int si = 0; si < 2; ++si) { v4u wq; wq.x = pk2(sc[8 * si], sc[8 * si + 1]); wq.y = pk2(sc[8 * si + 2], sc[8 * si + 3]); wq.z = pk2(sc[8 * si + 4], sc[8 * si + 5]); wq.w = pk2(sc[8 * si + 6], sc[8 * si + 7]); pb[si] = __builtin_bit_cast(bf16x8, wq); } \
            const int i16 = lane & 15, q = i16 >> 2, pp = i16 & 3, gl = (lane >> 4) & 1; \
            _Pragma("unroll") for (int db = 0; db < 4; ++db) _Pragma("unroll") for (int si = 0; si < 2; ++si) { \
                const s16x4 lo = __builtin_amdgcn_ds_read_tr16_b64_v4i16((LAS s16x4*)(Vimg + img_off(16 * si + 4 * h + q, 4 * db + 2 * gl + (pp >> 1)) + 8 * (pp & 1))); \
                const s16x4 hi = __builtin_amdgcn_ds_read_tr16_b64_v4i16((LAS s16x4*)(Vimg + img_off(16 * si + 8 + 4 * h + q, 4 * db + 2 * gl + (pp >> 1)) + 8 * (pp & 1))); \
                const bf16x8 vf = __builtin_shufflevector(lo, hi, 0, 1, 2, 3, 4, 5, 6, 7); O[db] = MFMA32(vf, pb[si], O[db]); } } } while (0)
    ATT_LOAD(ks1, vs1, 5); ATT_LOAD(ks0, vs0, 4);
#pragma unroll 1
    for (int s2 = 2; s2 >= 0; --s2) { ATT_STEP(ks1, vs1, 2 * s2 + 1); ATT_STEP(ks0, vs0, 2 * s2); }
    LDS_BARRIER();
#undef ATT_LOAD
#undef ATT_STEP
    const float lt = xor32_sum(l), inv = 1.f / lt;
    bf16* op = Qg + qtok * 512 + head * 128 + 4 * h;
    if (dry) return;
#pragma unroll
    for (int db = 0; db < 4; ++db)
#pragma unroll
        for (int q4 = 0; q4 < 4; ++q4) { v2u o; o.x = pk2(O[db][4 * q4] * inv, O[db][4 * q4 + 1] * inv); o.y = pk2(O[db][4 * q4 + 2] * inv, O[db][4 * q4 + 3] * inv); *(v2u*)(op + 32 * db + 8 * q4) = o; }
    if (h == 0) ((float*)(F.ws + WS_LSE))[(size_t)gi * T * 4 + qtok * 4 + head] = m + log2f(lt);
}

constexpr int G_QS = 0, G_KS = 17408, G_KET = 34816, G_VT = 53248, G_ATT = 71680, G_TOT = 80896, G_DL = 82944, G_OS = 84992, G_LRAW = 83456, G_EC = 87552, G_VRAW = 100864;
constexpr int QS_LD = 136, KT_LD = 72, OS_LD = 132;
DI void gla_pass1(const Frame& F, int item, const float* wa2, const float* ba, bool dry) {
    const int tid = F.tid, lane = F.lane, w = F.wave, fr = lane & 15, g = lane >> 4;
    const int seg = item & (NSEG - 1), bh = item >> 4, hh = bh & 3, b = bh >> 2;
    const int dk = tid & 127, qr = tid >> 7;
    LAS bf16* Qs = (LAS bf16*)(F.lds + G_QS); LAS bf16* Ks = (LAS bf16*)(F.lds + G_KS); LAS bf16* KEt = (LAS bf16*)(F.lds + G_KET); LAS bf16* Vt = (LAS bf16*)(F.lds + G_VT);
    LAS bf16* Att = (LAS bf16*)(F.lds + G_ATT); LAS float* tot = (LAS float*)(F.lds + G_TOT); LAS float* Dl = (LAS float*)(F.lds + G_DL);
    const bf16* GQ = (const bf16*)(F.ws + WS_GLAQ); const bf16* GK = (const bf16*)(F.ws + WS_GLAK); const float* GAL = (const float*)(F.ws + WS_GALR); bf16* GV = (bf16*)(F.ws + WS_GLAV);
    f32x4 S[8];
#pragma unroll
    for (int a = 0; a < 8; ++a) S[a] = (f32x4){0.f, 0.f, 0.f, 0.f};
    float Btot = 0.f;
    const int dv0 = 16 * w;
    v4u sq[2], sk[2], sv[2]; f32x2 sg; unsigned odef[8];
    float wcol[16];
#pragma unroll
    for (int j = 0; j < 16; ++j) wcol[j] = wa2[j * 512 + hh * 128 + dk];
    const float bcol = ba[hh * 128 + dk];
#pragma unroll
    for (int i = 0; i < 8; ++i) odef[i] = 0u;
    const int srow = tid >> 4, sch = tid & 15;
    LAS float* Gl = (LAS float*)(F.lds + G_LRAW); LAS bf16* Vraw = (LAS bf16*)(F.lds + G_VRAW); LAS float* ecum = (LAS float*)(F.lds + G_EC);
    bf16* GQw = (bf16*)(F.ws + WS_GLAQ); v4u qd[2] = {{0u, 0u, 0u, 0u}, {0u, 0u, 0u, 0u}};
    const int troff = ((16 * qr + ((lane & 15) >> 2)) * QS_LD + (w & 1) * 64 + 16 * (lane >> 4) + 4 * (lane & 3)) * 2;
#define GLA_LOAD1(chn) do { const size_t _o = ((size_t)b * SEQ + seg * TSEG + (chn) * 64 + srow) * 512 + hh * 128 + 8 * sch; \
        sg = *(const f32x2*)(GAL + ((size_t)b * SEQ + seg * TSEG + (chn) * 64) * 16 + 2 * tid); \
        _Pragma("unroll") for (int i = 0; i < 2; ++i) { sq[i] = *(const v4u*)(GQ + _o + (size_t)i * 16384); sk[i] = *(const v4u*)(GK + _o + (size_t)i * 16384); sv[i] = *(const v4u*)(GV + _o + (size_t)i * 16384); } } while (0)
    GLA_LOAD1(0);
#pragma unroll 1
    for (int ch = 0; ch < TSEG / 64; ++ch) {
        const size_t tokbase = (size_t)b * SEQ + seg * TSEG + ch * 64;
#pragma unroll
        for (int i = 0; i < 2; ++i) { const int o = (srow + 32 * i) * QS_LD + 8 * sch; *(LAS v4u*)(Qs + o) = sq[i]; *(LAS v4u*)(Ks + o) = sk[i]; *(LAS v4u*)(Vraw + o) = sv[i]; }
        *(LAS f32x2*)(Gl + 2 * tid) = sg;
        if (ch > 0 && !dry) { bf16* op = GV + (tokbase - 64 + 4 * g) * 512 + hh * 128 + dv0 + fr;
#pragma unroll
            for (int it = 0; it < 4; ++it) { op[(size_t)(16 * it) * 512] = (bf16)(odef[2 * it] & 0xffffu); op[(size_t)(16 * it + 1) * 512] = (bf16)(odef[2 * it] >> 16); op[(size_t)(16 * it + 2) * 512] = (bf16)(odef[2 * it + 1] & 0xffffu); op[(size_t)(16 * it + 3) * 512] = (bf16)(odef[2 * it + 1] >> 16); } }
        if (ch > 0 && !dry) { const size_t qo = (tokbase - 64 + srow) * 512 + hh * 128 + 8 * sch; *(v4u*)(GQw + qo) = qd[0]; *(v4u*)(GQw + qo + 16384) = qd[1]; }
        if (ch + 1 < TSEG / 64) GLA_LOAD1(ch + 1);
        LDS_BARRIER();
        float la[16], qv[16], kv[16]; bf16 vv[16];
#pragma unroll
        for (int k4 = 0; k4 < 4; ++k4) { const int o = troff + k4 * 4 * QS_LD * 2;
            const s16x4 q4 = __builtin_amdgcn_ds_read_tr16_b64_v4i16((LAS s16x4*)((LAS unsigned char*)Qs + o));
            const s16x4 k4v = __builtin_amdgcn_ds_read_tr16_b64_v4i16((LAS s16x4*)((LAS unsigned char*)Ks + o)), v4v = __builtin_amdgcn_ds_read_tr16_b64_v4i16((LAS s16x4*)((LAS unsigned char*)Vraw + o));
#pragma unroll
            for (int e = 0; e < 4; ++e) { qv[4 * k4 + e] = bf2f((bf16)q4[e]); kv[4 * k4 + e] = bf2f((bf16)k4v[e]); vv[4 * k4 + e] = (bf16)v4v[e]; } }
#pragma unroll
        for (int i = 0; i < 16; ++i) { const LAS f32x4* gp = (const LAS f32x4*)(Gl + (16 * qr + i) * 16); float a = bcol;
#pragma unroll
            for (int jj = 0; jj < 4; ++jj) { const f32x4 gvv = gp[jj]; a += (gvv.x * wcol[4 * jj] + gvv.y * wcol[4 * jj + 1]) + (gvv.z * wcol[4 * jj + 2] + gvv.w * wcol[4 * jj + 3]); }
            la[i] = pg8::logsig16(a); }
#pragma unroll
        for (int i = 1; i < 16; ++i) la[i] += la[i - 1];
        tot[qr * 128 + dk] = la[15];
        { v4u v0, v1; v0.x = vv[0] | ((unsigned)vv[1] << 16); v0.y = vv[2] | ((unsigned)vv[3] << 16); v0.z = vv[4] | ((unsigned)vv[5] << 16); v0.w = vv[6] | ((unsigned)vv[7] << 16);
          v1.x = vv[8] | ((unsigned)vv[9] << 16); v1.y = vv[10] | ((unsigned)vv[11] << 16); v1.z = vv[12] | ((unsigned)vv[13] << 16); v1.w = vv[14] | ((unsigned)vv[15] << 16);
          *(LAS v4u*)(Vt + dk * KT_LD + 16 * qr) = v0; *(LAS v4u*)(Vt + dk * KT_LD + 16 * qr + 8) = v1; }
        LDS_BARRIER();
        const float t0 = tot[dk], t1 = tot[128 + dk], t2 = tot[256 + dk], t3 = tot[384 + dk];
        const float base = (qr > 0 ? t0 : 0.f) + (qr > 1 ? t1 : 0.f) + (qr > 2 ? t2 : 0.f), blast = (t0 + t1) + (t2 + t3);
        Btot += blast;
        const float eblast = pg8::fexp(blast);
        if (qr == 0) { Dl[dk] = eblast; ecum[dk] = pg8::fexp(Btot - blast); }
        { unsigned ke[8];
#pragma unroll
          for (int i = 0; i < 16; i += 2) { const float b0 = base + la[i], b1 = base + la[i + 1]; const float e0 = pg8::fexp(b0), e1 = pg8::fexp(b1), r0 = __builtin_amdgcn_rcpf(e0), r1 = __builtin_amdgcn_rcpf(e1);
              Qs[(16 * qr + i) * QS_LD + dk] = f2bf(qv[i] * 0.08838834764831845f * e0); Qs[(16 * qr + i + 1) * QS_LD + dk] = f2bf(qv[i + 1] * 0.08838834764831845f * e1);
              Ks[(16 * qr + i) * QS_LD + dk] = f2bf(kv[i] * r0); Ks[(16 * qr + i + 1) * QS_LD + dk] = f2bf(kv[i + 1] * r1);
              ke[i >> 1] = pk2(kv[i] * (eblast * r0), kv[i + 1] * (eblast * r1)); }
          v4u k0 = {ke[0], ke[1], ke[2], ke[3]}, k1 = {ke[4], ke[5], ke[6], ke[7]};
          *(LAS v4u*)(KEt + dk * KT_LD + 16 * qr) = k0; *(LAS v4u*)(KEt + dk * KT_LD + 16 * qr + 8) = k1; }
        LDS_BARRIER();
#pragma unroll
        for (int tt = 0; tt < 2; ++tt) { const int n = 2 * w + tt, jt = n >> 2, it = n & 3; f32x4 a4 = {0.f, 0.f, 0.f, 0.f};
#pragma unroll
            for (int s = 0; s < 4; ++s) { const bf16x8 ka = *(const LAS bf16x8*)(Ks + (16 * jt + fr) * QS_LD + 32 * s + 8 * g); const bf16x8 qb = *(const LAS bf16x8*)(Qs + (16 * it + fr) * QS_LD + 32 * s + 8 * g); a4 = MFMA16(ka, qb, a4); }
            const int tj = 16 * jt + 4 * g, ti = 16 * it + fr;
            v2u o; o.x = pk2(tj <= ti ? a4[0] : 0.f, tj + 1 <= ti ? a4[1] : 0.f); o.y = pk2(tj + 2 <= ti ? a4[2] : 0.f, tj + 3 <= ti ? a4[3] : 0.f);
            *(LAS v2u*)(Att + ti * KT_LD + tj) = o; }
        LDS_BARRIER();
        bf16x8 Sb[4];
#pragma unroll
        for (int s = 0; s < 4; ++s) { v4u p; p.x = pk2(S[2 * s][0], S[2 * s][1]); p.y = pk2(S[2 * s][2], S[2 * s][3]); p.z = pk2(S[2 * s + 1][0], S[2 * s + 1][1]); p.w = pk2(S[2 * s + 1][2], S[2 * s + 1][3]); Sb[s] = __builtin_bit_cast(bf16x8, p); }
        bf16x8 Vf[2];
#pragma unroll
        for (int ks = 0; ks < 2; ++ks) Vf[ks] = *(const LAS bf16x8*)(Vt + (dv0 + fr) * KT_LD + 32 * ks + 8 * g);
#pragma unroll
        for (int it = 0; it < 4; ++it) { f32x4 o = {0.f, 0.f, 0.f, 0.f};
#pragma unroll
            for (int s = 0; s < 4; ++s) { const bf16x4 lo = *(const LAS bf16x4*)(Qs + (16 * it + fr) * QS_LD + 32 * s + 4 * g); const bf16x4 hi = *(const LAS bf16x4*)(Qs + (16 * it + fr) * QS_LD + 32 * s + 16 + 4 * g);
                const bf16x8 qa = __builtin_shufflevector(lo, hi, 0, 1, 2, 3, 4, 5, 6, 7); o = MFMA16(qa, Sb[s], o); }
#pragma unroll
            for (int ks = 0; ks < 2; ++ks) { const bf16x8 aa = *(const LAS bf16x8*)(Att + (16 * it + fr) * KT_LD + 32 * ks + 8 * g); o = MFMA16(aa, Vf[ks], o); }
            odef[2 * it] = pk2(o[0], o[1]); odef[2 * it + 1] = pk2(o[2], o[3]); }
#pragma unroll
        for (int a = 0; a < 8; ++a) { const f32x4 dsc = *(const LAS f32x4*)(Dl + 16 * a + 4 * g); S[a] = S[a] * dsc;
#pragma unroll
            for (int ks = 0; ks < 2; ++ks) { const bf16x8 ka = *(const LAS bf16x8*)(KEt + (16 * a + fr) * KT_LD + 32 * ks + 8 * g); S[a] = MFMA16(ka, Vf[ks], S[a]); } }
#pragma unroll
        for (int i = 0; i < 2; ++i) { const v4u qraw = *(const LAS v4u*)(Qs + (srow + 32 * i) * QS_LD + 8 * sch); const f32x4 e0 = *(const LAS f32x4*)(ecum + 8 * sch), e1 = *(const LAS f32x4*)(ecum + 8 * sch + 4);
            v4u o; o.x = pk2(bflo(qraw.x) * e0.x, bfhi(qraw.x) * e0.y); o.y = pk2(bflo(qraw.y) * e0.z, bfhi(qraw.y) * e0.w); o.z = pk2(bflo(qraw.z) * e1.x, bfhi(qraw.z) * e1.y); o.w = pk2(bflo(qraw.w) * e1.z, bfhi(qraw.w) * e1.w); qd[i] = o; }
        LDS_BARRIER();
    }
    if (!dry) { const size_t qo = ((size_t)b * SEQ + seg * TSEG + TSEG - 64 + srow) * 512 + hh * 128 + 8 * sch; *(v4u*)(GQw + qo) = qd[0]; *(v4u*)(GQw + qo + 16384) = qd[1]; }
    if (!dry) { bf16* op = GV + ((size_t)b * SEQ + seg * TSEG + TSEG - 64 + 4 * g) * 512 + hh * 128 + dv0 + fr;
#pragma unroll
        for (int it = 0; it < 4; ++it) { op[(size_t)(16 * it) * 512] = (bf16)(odef[2 * it] & 0xffffu); op[(size_t)(16 * it + 1) * 512] = (bf16)(odef[2 * it] >> 16); op[(size_t)(16 * it + 2) * 512] = (bf16)(odef[2 * it + 1] & 0xffffu); op[(size_t)(16 * it + 3) * 512] = (bf16)(odef[2 * it + 1] >> 16); } }
    v2u* LB = (v2u*)(F.ws + WS_LB) + (size_t)item * 4096 + w * 512 + lane;
#pragma unroll
    for (int a = 0; a < 8; ++a) { v2u o; o.x = pk2(S[a][0], S[a][1]); o.y = pk2(S[a][2], S[a][3]); LB[a * 64] = o; }
    if (qr == 0) ((float*)(F.ws + WS_DSEG))[item * 128 + dk] = pg8::fexp(Btot);
}

DI void gla_pass2(const Frame& F, int item, const float* gnorm, bool dry) {
    const int tid = F.tid, lane = F.lane, w = F.wave, fr = lane & 15, g = lane >> 4;
    const int seg = item & (NSEG - 1), bh = item >> 4, hh = bh & 3, b = bh >> 2;
    const int dv0 = 16 * w;
    LAS bf16* Qs = (LAS bf16*)(F.lds + G_QS); LAS float* Os = (LAS float*)(F.lds + G_OS);
    const bf16* GQ = (const bf16*)(F.ws + WS_GLAQ); bf16* GV = (bf16*)(F.ws + WS_GLAV); const bf16* R = (const bf16*)(F.dout + DO_R);
    f32x4 Sc[8];
#pragma unroll
    for (int a = 0; a < 8; ++a) Sc[a] = (f32x4){0.f, 0.f, 0.f, 0.f};
    { v2u lv[8], lvn[8]; f32x4 dc[8], dcn[8];
#define GLA_CLOAD(LV, DC, spn) do { const int _it2 = bh * NSEG + (spn); const v2u* _LB = (const v2u*)(F.ws + WS_LB) + (size_t)_it2 * 4096 + w * 512 + lane; const float* _DS = (const float*)(F.ws + WS_DSEG) + _it2 * 128 + 4 * g; \
        _Pragma("unroll") for (int a = 0; a < 8; ++a) { DC[a] = *(const f32x4*)(_DS + 16 * a); LV[a] = _LB[a * 64]; } } while (0)
      if (seg > 0) GLA_CLOAD(lv, dc, 0);
#pragma unroll 1
      for (int sp = 0; sp < seg; ++sp) {
          if (sp + 1 < seg) GLA_CLOAD(lvn, dcn, sp + 1);
#pragma unroll
          for (int a = 0; a < 8; ++a) { Sc[a][0] = Sc[a][0] * dc[a][0] + bflo(lv[a].x); Sc[a][1] = Sc[a][1] * dc[a][1] + bfhi(lv[a].x); Sc[a][2] = Sc[a][2] * dc[a][2] + bflo(lv[a].y); Sc[a][3] = Sc[a][3] * dc[a][3] + bfhi(lv[a].y);
              lv[a] = lvn[a]; dc[a] = dcn[a]; } }
#undef GLA_CLOAD
    }
    bf16x8 Sb[4];
#pragma unroll
    for (int s = 0; s < 4; ++s) { v4u p; p.x = pk2(Sc[2 * s][0], Sc[2 * s][1]); p.y = pk2(Sc[2 * s][2], Sc[2 * s][3]); p.z = pk2(Sc[2 * s + 1][0], Sc[2 * s + 1][1]); p.w = pk2(Sc[2 * s + 1][2], Sc[2 * s + 1][3]); Sb[s] = __builtin_bit_cast(bf16x8, p); }
    const int tk = tid >> 3, pc = tid & 7;
    f32x4 gn[4];
#pragma unroll
    for (int j = 0; j < 4; ++j) gn[j] = *(const f32x4*)(gnorm + 16 * pc + 4 * j);
    v4u sq[2], ow0, ow1, r0, r1, od0 = {0u, 0u, 0u, 0u}, od1 = {0u, 0u, 0u, 0u};
    const int srow = tid >> 4, sch = tid & 15;
#define GLA_LOAD2A(chn) do { const size_t _o = ((size_t)b * SEQ + seg * TSEG + (chn) * 64 + srow) * 512 + hh * 128 + 8 * sch; \
        _Pragma("unroll") for (int i = 0; i < 2; ++i) sq[i] = *(const v4u*)(GQ + _o + (size_t)i * 16384); } while (0)
#define GLA_LOAD2B(chn) do { const size_t _o = ((size_t)b * SEQ + seg * TSEG + (chn) * 64 + tk) * 512 + hh * 128 + 16 * pc; \
        ow0 = *(const v4u*)(GV + _o); ow1 = *(const v4u*)(GV + _o + 8); r0 = *(const v4u*)(R + _o); r1 = *(const v4u*)(R + _o + 8); } while (0)
    GLA_LOAD2A(0); GLA_LOAD2B(0);
#pragma unroll 1
    for (int ch = 0; ch < TSEG / 64; ++ch) {
        const size_t tokbase = (size_t)b * SEQ + seg * TSEG + ch * 64;
#pragma unroll
        for (int i = 0; i < 2; ++i) { const int o = (srow + 32 * i) * QS_LD + 8 * sch; *(LAS v4u*)(Qs + o) = sq[i]; }
        if (ch > 0 && !dry) { const size_t pofs = (tokbase - 64 + tk) * 512 + hh * 128 + 16 * pc; *(v4u*)(GV + pofs) = od0; *(v4u*)(GV + pofs + 8) = od1; }
        const v4u cw0 = ow0, cw1 = ow1, cr0 = r0, cr1 = r1;
        if (ch + 1 < TSEG / 64) { GLA_LOAD2A(ch + 1); GLA_LOAD2B(ch + 1); }
        LDS_BARRIER();
#pragma unroll
        for (int it = 0; it < 4; ++it) { f32x4 o = {0.f, 0.f, 0.f, 0.f};
            if (seg > 0) {
#pragma unroll
                for (int s = 0; s < 4; ++s) { const bf16x4 lo = *(const LAS bf16x4*)(Qs + (16 * it + fr) * QS_LD + 32 * s + 4 * g); const bf16x4 hi = *(const LAS bf16x4*)(Qs + (16 * it + fr) * QS_LD + 32 * s + 16 + 4 * g);
                    const bf16x8 qa = __builtin_shufflevector(lo, hi, 0, 1, 2, 3, 4, 5, 6, 7); o = MFMA16(qa, Sb[s], o); } }
#pragma unroll
            for (int rr = 0; rr < 4; ++rr) Os[(16 * it + 4 * g + rr) * OS_LD + dv0 + fr] = o[rr]; }
        LDS_BARRIER();
        { f32x4 v[4]; float ss = 0.f;
#pragma unroll
          for (int j = 0; j < 4; ++j) v[j] = *(const LAS f32x4*)(Os + tk * OS_LD + 16 * pc + 4 * j);
          v[0].x += bflo(cw0.x); v[0].y += bfhi(cw0.x); v[0].z += bflo(cw0.y); v[0].w += bfhi(cw0.y); v[1].x += bflo(cw0.z); v[1].y += bfhi(cw0.z); v[1].z += bflo(cw0.w); v[1].w += bfhi(cw0.w);
          v[2].x += bflo(cw1.x); v[2].y += bfhi(cw1.x); v[2].z += bflo(cw1.y); v[2].w += bfhi(cw1.y); v[3].x += bflo(cw1.z); v[3].y += bfhi(cw1.z); v[3].z += bflo(cw1.w); v[3].w += bfhi(cw1.w);
#pragma unroll
          for (int j = 0; j < 4; ++j) ss += (v[j].x * v[j].x + v[j].y * v[j].y) + (v[j].z * v[j].z + v[j].w * v[j].w);
          ss = grp8_sum(ss);
          const float rinv = __frsqrt_rn(ss * (1.f / 128.f) + EPS);
          const size_t ofs = (tokbase + tk) * 512 + hh * 128 + 16 * pc;
          v4u o0, o1;
          o0.x = pk2(v[0].x * rinv * gn[0].x * bflo(cr0.x), v[0].y * rinv * gn[0].y * bfhi(cr0.x)); o0.y = pk2(v[0].z * rinv * gn[0].z * bflo(cr0.y), v[0].w * rinv * gn[0].w * bfhi(cr0.y));
          o0.z = pk2(v[1].x * rinv * gn[1].x * bflo(cr0.z), v[1].y * rinv * gn[1].y * bfhi(cr0.z)); o0.w = pk2(v[1].z * rinv * gn[1].z * bflo(cr0.w), v[1].w * rinv * gn[1].w * bfhi(cr0.w));
          o1.x = pk2(v[2].x * rinv * gn[2].x * bflo(cr1.x), v[2].y * rinv * gn[2].y * bfhi(cr1.x)); o1.y = pk2(v[2].z * rinv * gn[2].z * bflo(cr1.y), v[2].w * rinv * gn[2].w * bfhi(cr1.y));
          o1.z = pk2(v[3].x * rinv * gn[3].x * bflo(cr1.z), v[3].y * rinv * gn[3].y * bfhi(cr1.z)); o1.w = pk2(v[3].z * rinv * gn[3].z * bflo(cr1.w), v[3].w * rinv * gn[3].w * bfhi(cr1.w));
          od0 = o0; od1 = o1; }
        LDS_BARRIER();
    }
    if (!dry) { const size_t pofs = ((size_t)b * SEQ + seg * TSEG + TSEG - 64 + tk) * 512 + hh * 128 + 16 * pc; *(v4u*)(GV + pofs) = od0; *(v4u*)(GV + pofs + 8) = od1; }
}
DI void attn_merge_phase(const Frame& F, bool dry) {
    const int gw = F.vcu * NWAVES + F.wave, NGW = F.G * NWAVES, lane = F.lane, head = lane >> 4;
    bf16* O0 = (bf16*)(F.ws + WS_DILQ); const float* LSE = (const float*)(F.ws + WS_LSE);
    for (int t = gw; t < T; t += NGW) {
        const float l0 = LSE[(size_t)t * 4 + head], l1 = LSE[(size_t)T * 4 + (size_t)t * 4 + head], l2 = LSE[(size_t)2 * T * 4 + (size_t)t * 4 + head];
        const float M = fmaxf(l0, fmaxf(l1, l2)); float w0 = exp2f(l0 - M), w1 = exp2f(l1 - M), w2 = exp2f(l2 - M); const float inv = 1.f / (w0 + w1 + w2); w0 *= inv; w1 *= inv; w2 *= inv;
        bf16* p = O0 + (size_t)t * 512 + 8 * lane; const v4u a = *(const v4u*)p, bq = *(const v4u*)(p + (size_t)T * 512), c = *(const v4u*)(p + (size_t)2 * T * 512);
        v4u o;
        o.x = pk2(w0 * bflo(a.x) + w1 * bflo(bq.x) + w2 * bflo(c.x), w0 * bfhi(a.x) + w1 * bfhi(bq.x) + w2 * bfhi(c.x));
        o.y = pk2(w0 * bflo(a.y) + w1 * bflo(bq.y) + w2 * bflo(c.y), w0 * bfhi(a.y) + w1 * bfhi(bq.y) + w2 * bfhi(c.y));
        o.z = pk2(w0 * bflo(a.z) + w1 * bflo(bq.z) + w2 * bflo(c.z), w0 * bfhi(a.z) + w1 * bfhi(bq.z) + w2 * bfhi(c.z));
        o.w = pk2(w0 * bflo(a.w) + w1 * bflo(bq.w) + w2 * bflo(c.w), w0 * bfhi(a.w) + w1 * bfhi(bq.w) + w2 * bfhi(c.w));
        if (!dry) *(v4u*)p = o; }
}

DI void router_phase(const Frame& F, const float* brg, const float* bre, unsigned* gcnt, bool dry) {
    const int lane = F.lane, w = F.wave, fr = lane & 15, g = lane >> 4;
    const bf16* X1 = (const bf16*)(F.ws + WS_X1);
    const bf16* WRH = (const bf16*)(F.ws + WS_WRH); const bf16* WRL = WRH + 48 * 1024;
    int* TOKE = (int*)(F.ws + WS_TOKE); float* TOKW = (float*)(F.ws + WS_TOKW); int* TOKR = (int*)(F.ws + WS_TOKR);
    LAS float* lg = (LAS float*)(F.lds + w * 3072);
    LAS int* cnt = (LAS int*)(F.lds + 24576); LAS int* basev = cnt + 32;
    LAS unsigned char* wh = F.lds + 28672;
    __syncthreads();
    for (int e = F.tid; e < 48 * 128; e += NTHR) *(LAS v4u*)(wh + (e >> 7) * 2064 + (e & 127) * 16) = *(const v4u*)(WRH + (size_t)e * 8);
    __syncthreads();
    if (!dry) { int* ROWTOK = (int*)(F.ws + WS_ROWTOK); for (int e = F.vcu * NTHR + F.tid; e < PMAX; e += F.G * NTHR) ROWTOK[e] = 0; }
    for (int it = 0; it * F.G * 128 < T; ++it) {
        const int tok0 = (it * F.G + F.vcu) * 128 + w * 16;
        if (F.tid < 32) cnt[F.tid] = 0;
        __syncthreads();
        f32x4 acc[3]; acc[0] = acc[1] = acc[2] = (f32x4){0.f, 0.f, 0.f, 0.f};
        float ss = 0.f;
        const bf16* xr = X1 + (size_t)(tok0 + fr) * D + 8 * g;
#pragma unroll 4
        for (int s = 0; s < 32; ++s) {
            const v4u xv = *(const v4u*)(xr + 32 * s);
            ss += (bflo(xv.x) * bflo(xv.x) + bfhi(xv.x) * bfhi(xv.x)) + (bflo(xv.y) * bflo(xv.y) + bfhi(xv.y) * bfhi(xv.y)) + (bflo(xv.z) * bflo(xv.z) + bfhi(xv.z) * bfhi(xv.z)) + (bflo(xv.w) * bflo(xv.w) + bfhi(xv.w) * bfhi(xv.w));
            const bf16x8 ah = __builtin_bit_cast(bf16x8, xv);
#pragma unroll
            for (int nt = 0; nt < 3; ++nt) { const bf16x8 bh = *(const LAS bf16x8*)(wh + (16 * nt + fr) * 2064 + 64 * s + 16 * g), bl = *(const bf16x8*)(WRL + (size_t)(16 * nt + fr) * 1024 + 32 * s + 8 * g);
                acc[nt] = MFMA16(ah, bh, acc[nt]); acc[nt] = MFMA16(ah, bl, acc[nt]); }
        }
        ss = xor32_sum(xor16_sum(ss));
        const float rinv = __frsqrt_rn(ss * (1.f / D) + EPS);
#pragma unroll
        for (int rr = 0; rr < 4; ++rr) { const float ri = __shfl(rinv, 4 * g + rr);
#pragma unroll
            for (int nt = 0; nt < 3; ++nt) lg[(4 * g + rr) * 48 + 16 * nt + fr] = acc[nt][rr] * ri; }
        if (lane < 16 && !dry) ((float*)(F.ws + WS_H2))[tok0 + lane] = rinv;
        LDS_WAIT(); asm volatile("" ::: "memory");
        int e1 = 0, e2 = 0, lr1 = 0, lr2 = 0; float w1 = 0.f, w2 = 0.f;
        if (lane < 16) { const LAS float* q = lg + lane * 48;
            float gl[4]; int gs = 0; float gm = -3.0e38f;
#pragma unroll
            for (int j = 0; j < 4; ++j) { gl[j] = q[j] + brg[j]; if (gl[j] > gm) { gm = gl[j]; gs = j; } }
            float gsum = 0.f;
#pragma unroll
            for (int j = 0; j < 4; ++j) gsum += __expf(gl[j] - gm);
            const float gp = 1.f / gsum;
            float el[8]; int i1 = 0; float v1 = -3.0e38f;
#pragma unroll
            for (int j = 0; j < 8; ++j) { el[j] = q[4 + 8 * gs + j] + bre[8 * gs + j]; if (el[j] > v1) { v1 = el[j]; i1 = j; } }
            int i2 = 0; float v2 = -3.0e38f;
#pragma unroll
            for (int j = 0; j < 8; ++j) if (j != i1 && el[j] > v2) { v2 = el[j]; i2 = j; }
            const float p2 = 1.f / (1.f + __expf(v1 - v2)), p1 = 1.f - p2;
            e1 = 8 * gs + i1; e2 = 8 * gs + i2; w1 = p1 * gp; w2 = p2 * gp;
            lr1 = __hip_atomic_fetch_add(&cnt[e1], 1, __ATOMIC_RELAXED, __HIP_MEMORY_SCOPE_WORKGROUP); lr2 = __hip_atomic_fetch_add(&cnt[e2], 1, __ATOMIC_RELAXED, __HIP_MEMORY_SCOPE_WORKGROUP); }
        __syncthreads();
        if (F.tid < 32) basev[F.tid] = dry ? 0 : (int)atomicAdd(&gcnt[64 * F.tid], (unsigned)cnt[F.tid]);
        __syncthreads();
        if (lane < 16 && !dry) { const int t = tok0 + lane; TOKE[2 * t] = e1; TOKE[2 * t + 1] = e2; TOKW[2 * t] = w1; TOKW[2 * t + 1] = w2; TOKR[2 * t] = basev[e1] + lr1; TOKR[2 * t + 1] = basev[e2] + lr2; }
        __syncthreads();
    }
}
DI void moe_assign_phase(const Frame& F, unsigned* gcnt) {
    LAS int* pst = (LAS int*)(F.lds + 65536);
    if (F.tid == 0) { int p = 0; int* BLKE = (int*)(F.ws + WS_BLKE);
        for (int e = 0; e < 32; ++e) { pst[e] = p; const int c = (int)__hip_atomic_load(&gcnt[64 * e], __ATOMIC_RELAXED, __HIP_MEMORY_SCOPE_AGENT); const int nb = (c + 255) >> 8;
            if (F.vcu == 0) for (int j = 0; j < nb; ++j) BLKE[(p >> 8) + j] = e;
            p += nb << 8; }
        if (F.vcu == 0) BLKE[NBLK_MAX] = p >> 8; }
    __syncthreads();
    const int* TOKE = (const int*)(F.ws + WS_TOKE); const float* TOKW = (const float*)(F.ws + WS_TOKW); const int* TOKR = (const int*)(F.ws + WS_TOKR);
    int* DEST = (int*)(F.ws + WS_DEST); f32x2* ROWW = (f32x2*)(F.ws + WS_ROWW); int* ROWTOK = (int*)(F.ws + WS_ROWTOK); const float* RINV = (const float*)(F.ws + WS_H2);
    for (int t = F.vcu * NTHR + F.tid; t < T; t += F.G * NTHR) {
        const int d0 = pst[TOKE[2 * t]] + TOKR[2 * t], d1 = pst[TOKE[2 * t + 1]] + TOKR[2 * t + 1]; const float rinv = RINV[t];
        DEST[2 * t] = d0; DEST[2 * t + 1] = d1; ROWW[d0] = (f32x2){TOKW[2 * t], rinv}; ROWW[d1] = (f32x2){TOKW[2 * t + 1], rinv}; ROWTOK[d0] = t; ROWTOK[d1] = t; }
}
DI void combine_phase(const Frame& F, float* out) {
    const int gw = F.vcu * NWAVES + F.wave, NGW = F.G * NWAVES, lane = F.lane;
    const bf16* X1 = (const bf16*)(F.ws + WS_X1); const bf16* Y = (const bf16*)(F.ws + WS_Y); const int* DEST = (const int*)(F.ws + WS_DEST);
    for (int t = gw; t < T; t += NGW) { const int d0 = DEST[2 * t], d1 = DEST[2 * t + 1];
#pragma unroll
        for (int j = 0; j < 2; ++j) { const int c = 8 * lane + 512 * j;
            const v4u x = *(const v4u*)(X1 + (size_t)t * D + c), a = *(const v4u*)(Y + (size_t)d0 * D + c), b = *(const v4u*)(Y + (size_t)d1 * D + c);
            f32x4 oa, ob;
            oa.x = bflo(x.x) + bflo(a.x) + bflo(b.x); oa.y = bfhi(x.x) + bfhi(a.x) + bfhi(b.x); oa.z = bflo(x.y) + bflo(a.y) + bflo(b.y); oa.w = bfhi(x.y) + bfhi(a.y) + bfhi(b.y);
            ob.x = bflo(x.z) + bflo(a.z) + bflo(b.z); ob.y = bfhi(x.z) + bfhi(a.z) + bfhi(b.z); ob.z = bflo(x.w) + bflo(a.w) + bflo(b.w); ob.w = bfhi(x.w) + bfhi(a.w) + bfhi(b.w);
            *(f32x4*)(out + (size_t)t * D + c) = oa; *(f32x4*)(out + (size_t)t * D + c + 4) = ob; } }
}

constexpr int PER_PHASE = 13;
#ifndef STAGGER_TICKS
#define STAGGER_TICKS 200
#endif
struct Args { Ins I; float* out; unsigned char* ws; int ph_lo, ph_hi, li, pad; };
__global__ void __launch_bounds__(NTHR, 2) fwd_kernel(Args args) {
    extern __shared__ __attribute__((aligned(16))) unsigned char lds[];
    Frame F;
    F.lds = (LAS unsigned char*)lds;
    F.tid = threadIdx.x; F.lane = F.tid & 63; F.wave = __builtin_amdgcn_readfirstlane(F.tid >> 6);
    F.G = gridDim.x; { const int bx = blockIdx.x; F.vcu = (F.G % 8 == 0) ? (bx % 8) * (F.G / 8) + bx / 8 : bx; }
    F.ws = args.ws; F.dout = (unsigned char*)args.out;
    unsigned* ctl = (unsigned*)(args.ws + WS_CTL);
    volatile LAS unsigned* MISC = (volatile LAS unsigned*)(F.lds + MISC_OFF);
    for (int u = F.tid; u < (LDS_BYTES - LDSCTL_OFF) / 4; u += NTHR) ((LAS unsigned*)(F.lds + LDSCTL_OFF))[u] = 0u;
    __syncthreads();
    XcdBarrier bar; bar.bar = ctl + CW_BAR; bar.x = 0; bar.st = nullptr;
    if (MK_N_LAUNCHES == 1) bar = xcd_barrier_post(ctl + CW_BAR + args.li * 4096, MISC + 8);
    const int lo = args.ph_lo, hi = args.ph_hi;
#ifdef ONLY_PHASE
#define IN(k) ((k) == ONLY_PHASE && lo <= (k) && (k) < hi)
#else
#define IN(k) (lo <= (k) && (k) < hi)
#endif
#define STAGGER() do { const unsigned long long _t0 = __builtin_amdgcn_s_memrealtime(), _dl = (unsigned long long)(blockIdx.x & 3) * STAGGER_TICKS; while (__builtin_amdgcn_s_memrealtime() - _t0 < _dl) __builtin_amdgcn_s_sleep(8); } while (0)
#define SEAM(k) do { if (IN(k) && IN((k) + 1)) xcd_barrier(bar); } while (0)
#ifndef DUP_MASK
#define DUP_MASK 0
#endif
#define REPS(k) (((DUP_MASK >> (k)) & 1) ? 2 : 1)
    const Ins& I = args.I;
    unsigned char* ws = args.ws;
#if defined(PROBE_PLAN)
    const bool pdry = args.li == 1 && args.pad == 77;
#else
    const bool pdry = false;
#endif

    if (IN(0)) { _Pragma("unroll 1") for (int rep = 0; rep < REPS(0); ++rep) { if (rep) xcd_barrier(bar); p0_prologue(F, I, pdry); } SEAM(0); }

    if (IN(1)) { _Pragma("unroll 1") for (int rep = 0; rep < REPS(1); ++rep) { if (rep) xcd_barrier(bar);
        pg8::GemmDesc g{1024, 1024, 1024};
        const int bx = (int)blockIdx.x, iw = bx >> 3; const bool split = p0_split(F), grpB = split && iw >= 16;
        if (grpB) { p0_transpose(F, I, I_IN, NITEMS, ((iw - 16) * 8 + (bx & 7)) * NWAVES + F.wave, 128 * NWAVES); __syncthreads(); }
        pg8::OrderSplit S{T / 256, N1 / 256, grpB ? 128 * 14 : 0, split ? 128 : F.G, split ? (iw & 15) * 8 + (bx & 7) : bx, split ? (grpB ? 12 : 14) : 0x7fffffff, (const char*)(ws + WS_XN), (const char*)(ws + WS_W1T), (size_t)256 * 1024 * 2, (size_t)256 * 1024 * 2};
        pg8::EpiP1 E{ws, F.dout, I.in[6], I.in[7], (LAS float*)(F.lds + LDSCTL_OFF + 1024)};
        pg8::gemm_phase<pg8::EpiP1, pg8::OrderSplit>(F.lds + RING_OFF, g, S, E);
}         SEAM(1);
    }
    if (IN(3)) {
        _Pragma("unroll 1") for (int rep = 0; rep < REPS(3); ++rep) { if (rep) xcd_barrier(bar);
        for (int it = F.vcu; it < 16 * NSEG; it += F.G) gla_pass1(F, it, I.in[3], I.in[4], (rep + 1 < REPS(3)) || pdry); }
        const int gw = F.vcu * NWAVES + F.wave, NGW = F.G * NWAVES;
        _Pragma("unroll 1") for (int rep = 0; rep < REPS(13); ++rep) { if (rep) xcd_barrier(bar);
        for (int jr = F.vcu; jr < 3 * 4096 / 8; jr += F.G) attn_round(F, jr, (rep + 1 < REPS(13)) || pdry); }
        SEAM(3);
    }
    if (IN(4)) {
        _Pragma("unroll 1") for (int rep = 0; rep < REPS(4); ++rep) { if (rep) xcd_barrier(bar);
        for (int it = F.vcu; it < 16 * NSEG; it += F.G) gla_pass2(F, it, I.in[5], (rep + 1 < REPS(4)) || pdry); }
        _Pragma("unroll 1") for (int rep = 0; rep < REPS(14); ++rep) { if (rep) xcd_barrier(bar); attn_merge_phase(F, (rep + 1 < REPS(14)) || pdry); }
        SEAM(4);
    }
    if (IN(5)) { _Pragma("unroll 1") for (int rep = 0; rep < REPS(5); ++rep) { if (rep) xcd_barrier(bar);
        pg8::GemmDesc g{512, 512, 512};
        pg8::OrderProj2 S{T / 256, 4, F.G, (int)blockIdx.x, (const char*)(ws + WS_GLAV), (const char*)(ws + WS_DILQ), (const char*)(ws + WS_WPGT), (const char*)(ws + WS_WPAT), (size_t)256 * 512 * 2, (size_t)256 * 512 * 2};
        pg8::EpiY E{(bf16*)(ws + WS_GATES), 2048, pdry};
        pg8::gemm_phase<pg8::EpiY, pg8::OrderProj2>(F.lds + RING_OFF, g, S, E);
}         SEAM(5);
    }
    if (IN(6)) { _Pragma("unroll 1") for (int rep = 0; rep < REPS(6); ++rep) { if (rep) xcd_barrier(bar);
        pg8::GemmDesc g{1024, 1024, 1024};
        pg8::OrderStd S{T / 256, 2048 / 256, F.G, (int)blockIdx.x, (const char*)(ws + WS_XN), (const char*)(ws + WS_WBGT), (size_t)256 * 1024 * 2, (size_t)256 * 1024 * 2};
        pg8::EpiGateMerge E{(bf16*)(ws + WS_MERGED), (const bf16*)(ws + WS_GATES), I.in[11], args.li == 1 && args.pad == 77};
        pg8::gemm_phase<pg8::EpiGateMerge, pg8::OrderStd>(F.lds + RING_OFF, g, S, E);
}         SEAM(6);
    }
    if (IN(7)) { _Pragma("unroll 1") for (int rep = 0; rep < REPS(7); ++rep) { if (rep) xcd_barrier(bar);
        pg8::GemmDesc g{1024, 1024, 1024};
        pg8::OrderStd S{T / 256, 4, F.G, (int)blockIdx.x, (const char*)(ws + WS_MERGED), (const char*)(ws + WS_WOUTT), (size_t)256 * 1024 * 2, (size_t)256 * 1024 * 2};
        pg8::EpiX1 E{(bf16*)(ws + WS_X1), I.in[0]};
        pg8::gemm_phase<pg8::EpiX1, pg8::OrderStd>(F.lds + RING_OFF, g, S, E);
}         SEAM(7);
    }
    if (IN(8)) { _Pragma("unroll 1") for (int rep = 0; rep < REPS(8); ++rep) { if (rep) xcd_barrier(bar); router_phase(F, I.in[15], I.in[17], ctl + CW_GCNT, rep + 1 < REPS(8)); } SEAM(8); }
    if (IN(9)) { _Pragma("unroll 1") for (int rep = 0; rep < REPS(9); ++rep) { if (rep) xcd_barrier(bar); moe_assign_phase(F, ctl + CW_GCNT); } SEAM(9); }
    if (IN(10)) { _Pragma("unroll 1") for (int rep = 0; rep < REPS(10); ++rep) { if (rep) xcd_barrier(bar);
        const int* BLKE = (const int*)(ws + WS_BLKE); const int nblk = BLKE[NBLK_MAX];
        pg8::GemmDesc g{1024, 1024, 1024};
        pg8::OrderMoe S{nblk, F.G, (int)blockIdx.x, BLKE, (const int*)(ws + WS_ROWTOK), (const char*)(ws + WS_X1), (const char*)(F.dout + DO_EXPGU), (size_t)0, (size_t)1024 * 1024 * 2, (size_t)256 * 1024 * 2};
        pg8::EpiGU E{(bf16*)(ws + WS_HBUF), (const f32x2*)(ws + WS_ROWW)};
        pg8::gemm_phase<pg8::EpiGU, pg8::OrderMoe, true, true, true>(F.lds + RING_OFF, g, S, E);
}         SEAM(10);
    }
    if (IN(11)) { _Pragma("unroll 1") for (int rep = 0; rep < REPS(11); ++rep) { if (rep) xcd_barrier(bar);
        const int* BLKE = (const int*)(ws + WS_BLKE); const int nblk = BLKE[NBLK_MAX];
        pg8::GemmDesc g{512, 512, 512};
        pg8::OrderMoe S{nblk, F.G, (int)blockIdx.x, BLKE, nullptr, (const char*)(ws + WS_HBUF), (const char*)(F.dout + DO_EXPDN), (size_t)256 * 512 * 2, (size_t)1024 * 512 * 2, (size_t)256 * 512 * 2};
        pg8::EpiY E{(bf16*)(ws + WS_Y), 1024, false};
        pg8::gemm_phase<pg8::EpiY, pg8::OrderMoe>(F.lds + RING_OFF, g, S, E);
}         SEAM(11);
    }
    if (IN(12)) { _Pragma("unroll 1") for (int rep = 0; rep < REPS(12); ++rep) { if (rep) xcd_barrier(bar); combine_phase(F, args.out); } }
#undef IN
#undef SEAM
}

extern "C" void kernel_launch(void* const* d_in, const int* in_sizes, int n_in, void* d_out, int out_size, void* d_ws, size_t ws_size, hipStream_t stream) {
    static int grid = 0;
    if (grid == 0) {
        if (n_in != 21 || out_size != T * D || ws_size < WS_END) { fprintf(stderr, "kernel_launch: unexpected shapes (n_in %d out %d ws %zu)\n", n_in, out_size, ws_size); grid = -1; return; }
        int dev = 0, cus = 0, per_cu = 0;
        if (hipGetDevice(&dev) != hipSuccess || hipDeviceGetAttribute(&cus, hipDeviceAttributeMultiprocessorCount, dev) != hipSuccess) { grid = -1; return; }
        if (hipFuncSetAttribute((const void*)fwd_kernel, hipFuncAttributeMaxDynamicSharedMemorySize, LDS_BYTES) != hipSuccess) { fprintf(stderr, "kernel_launch: hipFuncSetAttribute failed\n"); grid = -1; return; }
        if (hipOccupancyMaxActiveBlocksPerMultiprocessor(&per_cu, (const void*)fwd_kernel, NTHR, LDS_BYTES) != hipSuccess || per_cu < 1) fprintf(stderr, "kernel_launch: occupancy query reports %d\n", per_cu);
        (void)hipGetLastError();
        grid = cus;
    }
    if (grid < 0) return;
    if (hipMemsetAsync((char*)d_ws + WS_CTL, 0, CTL_ZERO_BYTES, stream) != hipSuccess) return;
    Args a{};
    for (int i = 0; i < 21; ++i) a.I.in[i] = (const float*)d_in[i];
    a.out = (float*)d_out; a.ws = (unsigned char*)d_ws;
#if defined(PROBE_PLAN)
#ifndef PROBE_DRY
#define PROBE_DRY 0
#endif
    { const int plan[3][2] = {{0, PROBE_DRY == 77 ? PROBE_PLAN : PROBE_PLAN + 1}, {PROBE_PLAN, PROBE_PLAN + 1}, {PROBE_DRY == 77 ? PROBE_PLAN : PROBE_PLAN + 1, PER_PHASE}};
      for (int li = 0; li < 3; ++li) { a.ph_lo = plan[li][0]; a.ph_hi = plan[li][1]; a.li = li; a.pad = PROBE_DRY; hipLaunchKernelGGL(fwd_kernel, dim3(grid), dim3(NTHR), LDS_BYTES, stream, a); } return; }
#endif
    if (MK_N_LAUNCHES == 1) { a.ph_lo = 0; a.ph_hi = PER_PHASE; a.li = 0; hipLaunchKernelGGL(fwd_kernel, dim3(grid), dim3(NTHR), LDS_BYTES, stream, a); }
    else for (int li = 0; li < PER_PHASE; ++li) { a.ph_lo = li; a.ph_hi = li + 1; a.li = li; hipLaunchKernelGGL(fwd_kernel, dim3(grid), dim3(NTHR), LDS_BYTES, stream, a); }
}
```

```cpp
#include <hip/hip_runtime.h>
#include <cstdio>
#include <cstdint>

#ifndef MK_N_LAUNCHES
#define MK_N_LAUNCHES 1
#endif

#define GAS __attribute__((address_space(1)))
#define LAS __attribute__((address_space(3)))
typedef unsigned short bf16;
typedef unsigned v4u __attribute__((ext_vector_type(4)));
typedef unsigned v2u __attribute__((ext_vector_type(2)));
typedef float f32x2 __attribute__((ext_vector_type(2)));
typedef float f32x4 __attribute__((ext_vector_type(4)));
typedef float f32x16 __attribute__((ext_vector_type(16)));
typedef short bf16x8 __attribute__((ext_vector_type(8)));
typedef short bf16x4 __attribute__((ext_vector_type(4)));
typedef __bf16 hbf2 __attribute__((ext_vector_type(2)));

#define DI __device__ __forceinline__
DI unsigned pk2(float lo, float hi) { f32x2 v = {lo, hi}; hbf2 r = __builtin_convertvector(v, hbf2); return __builtin_bit_cast(unsigned, r); }
DI bf16 f2bf(float f) { return (bf16)(pk2(f, 0.f) & 0xffffu); }
DI float bf2f(bf16 b) { return __builtin_bit_cast(float, ((unsigned)b) << 16); }
DI float bflo(unsigned u) { return __builtin_bit_cast(float, u << 16); }
DI float bfhi(unsigned u) { return __builtin_bit_cast(float, u & 0xffff0000u); }
DI float xor32_sum(float x) { const unsigned u = __builtin_bit_cast(unsigned, x); const auto r = __builtin_amdgcn_permlane32_swap(u, u, false, false); return __builtin_bit_cast(float, (unsigned)r[0]) + __builtin_bit_cast(float, (unsigned)r[1]); }
DI float xor16_sum(float x) { const unsigned u = __builtin_bit_cast(unsigned, x); const auto r = __builtin_amdgcn_permlane16_swap(u, u, false, false); return __builtin_bit_cast(float, (unsigned)r[0]) + __builtin_bit_cast(float, (unsigned)r[1]); }
DI float xor32_max(float x) { const unsigned u = __builtin_bit_cast(unsigned, x); const auto r = __builtin_amdgcn_permlane32_swap(u, u, false, false); return fmaxf(__builtin_bit_cast(float, (unsigned)r[0]), __builtin_bit_cast(float, (unsigned)r[1])); }
#define DPPF(x, ctrl) __builtin_bit_cast(float, __builtin_amdgcn_mov_dpp(__builtin_bit_cast(int, (x)), (ctrl), 0xf, 0xf, false))
DI float row16_sum(float x) { x += DPPF(x, 0x128); x += DPPF(x, 0x124); x += DPPF(x, 0x122); x += DPPF(x, 0x121); return x; }
DI float grp8_sum(float x) { x += DPPF(x, 0x141); x += DPPF(x, 0x1B); x += DPPF(x, 0xB1); return x; }
DI float rs32(float a, float b) { const auto r = __builtin_amdgcn_permlane32_swap(__builtin_bit_cast(unsigned, a), __builtin_bit_cast(unsigned, b), false, false); return __builtin_bit_cast(float, (unsigned)r[0]) + __builtin_bit_cast(float, (unsigned)r[1]); }
DI float rs16(float a, float b) { const auto r = __builtin_amdgcn_permlane16_swap(__builtin_bit_cast(unsigned, a), __builtin_bit_cast(unsigned, b), false, false); return __builtin_bit_cast(float, (unsigned)r[0]) + __builtin_bit_cast(float, (unsigned)r[1]); }

constexpr int T = 32768, D = 1024, SEQ = 8192;
constexpr int N1 = 6656;
constexpr int IN_COLS = 6672;
constexpr int NSEG = 16, TSEG = SEQ / NSEG;
constexpr float EPS = 1e-6f;
constexpr float LOG2E = 1.4426950408889634f;
constexpr int PMAX = 65536 + 32 * 256;
constexpr int NBLK_MAX = PMAX / 256;

constexpr size_t MiB = 1u << 20;
constexpr size_t WS_CTL = 0, CTL_ZERO_BYTES = 256 * 1024;
constexpr size_t WS_LB = 1 * MiB;
constexpr size_t WS_W1T = 1 * MiB;
constexpr size_t WS_WBGT = 15 * MiB, WS_WPGT = 19 * MiB, WS_WPAT = 20 * MiB, WS_WOUTT = 21 * MiB, WS_WRH = 23 * MiB;
constexpr size_t WS_XN = 24 * MiB;
constexpr size_t WS_GLAQ = 88 * MiB, WS_GLAK = 120 * MiB, WS_GALR = 152 * MiB  , WS_GLAV = 184 * MiB;
constexpr size_t WS_DILQ = 216 * MiB, WS_DILK = 312 * MiB, WS_DILV = 408 * MiB;
constexpr size_t WS_STATS = 504 * MiB;
constexpr size_t WS_LSE = WS_STATS;
constexpr size_t WS_DSEG = WS_STATS + 1536 * 1024;
constexpr size_t WS_TOKE = WS_STATS + 2 * MiB;
constexpr size_t WS_TOKW = WS_TOKE + 256 * 1024;
constexpr size_t WS_TOKR = WS_TOKW + 256 * 1024;
constexpr size_t WS_DEST = WS_TOKR + 256 * 1024;
constexpr size_t WS_ROWW = WS_DEST + 256 * 1024;
constexpr size_t WS_BLKE = WS_ROWW + 640 * 1024;
constexpr size_t WS_END = 512 * MiB;
constexpr size_t WS_GATES = 376 * MiB;
constexpr size_t WS_MERGED = 312 * MiB;
constexpr size_t WS_X1 = 88 * MiB;
constexpr size_t WS_H2 = 24 * MiB;
constexpr size_t WS_XP = 216 * MiB;
constexpr size_t WS_HBUF = 360 * MiB;
constexpr size_t WS_Y = 216 * MiB;
constexpr size_t WS_ROWTOK = 440 * MiB;
constexpr size_t DO_R = 0;
constexpr size_t DO_EXPGU = 32 * MiB;
constexpr size_t DO_EXPDN = 96 * MiB;
constexpr int CW_BAR = 4096;
constexpr int CW_GCNT = 16384;

constexpr int RING_OFF = 0, RING_BYTES = 131072;
constexpr int LDSCTL_OFF = RING_BYTES, MISC_OFF = LDSCTL_OFF + 320;
constexpr int LDS_BYTES = 147456;

#define XB_TMO      128
#define XB_XCNT(j)  (256  + 64 * (j))
#define XB_XSUB(j)  (1280 + 64 * (j))
#define XB_XGEN(j)  (2304 + 64 * (j))
#define XB_TOP      3328
#define XB_TOPGEN   3392
#define XCD_BAR_WORDS 3456
#define XB_SPIN_CAP (1u << 18)
DI unsigned xb_ld(unsigned* p)              { return __hip_atomic_load(p, __ATOMIC_RELAXED, __HIP_MEMORY_SCOPE_AGENT); }
DI unsigned xb_add(unsigned* p, unsigned v) { return __hip_atomic_fetch_add(p, v, __ATOMIC_RELAXED, __HIP_MEMORY_SCOPE_AGENT); }
DI unsigned xb_xcc_id() { return (unsigned)__builtin_amdgcn_s_getreg((3 << 11) | 20) & 0xFu; }
#define XB_SPIN(cond, bar) do { unsigned _sp = 0; while (cond) { __builtin_amdgcn_s_sleep(1); \
    if ((++_sp & 255u) == 0u) { if (xb_ld(&(bar)[XB_TMO])) break; if (_sp > XB_SPIN_CAP) { atomicAdd(&(bar)[XB_TMO], 1u); break; } } } } while (0)
struct XcdBarrier { unsigned* bar; unsigned x; volatile LAS unsigned* st; };
DI XcdBarrier xcd_barrier_post(unsigned* bar, volatile LAS unsigned* st) {
    XcdBarrier b; b.bar = bar; b.x = xb_xcc_id(); b.st = st;
    if (threadIdx.x == 0) (void)xb_add(&bar[XB_XCNT(b.x)], 1u);
    return b;
}
DI void xcd_barrier_complete(unsigned* bar, unsigned x, unsigned& nloc, unsigned& nx) {
    const unsigned G = gridDim.x * gridDim.y * gridDim.z;
    unsigned sum, cnt, mine, sp = 0u;
    for (;;) {
        sum = 0u; cnt = 0u; mine = 0u;
#pragma unroll
        for (unsigned j = 0; j < 16; ++j) { const unsigned c = xb_ld(&bar[XB_XCNT(j)]); sum += c; cnt += (c > 0u) ? 1u : 0u; mine = (j == x) ? c : mine; }
        if (sum == G) break;
        __builtin_amdgcn_s_sleep(1);
        if ((++sp & 255u) == 0u) { if (xb_ld(&bar[XB_TMO])) break; if (sp > XB_SPIN_CAP) { atomicAdd(&bar[XB_TMO], 1u); break; } }
    }
    nloc = mine > 0u ? mine : 1u; nx = cnt > 0u ? cnt : 1u;
}
DI void xcd_barrier(const XcdBarrier& b) {
    asm volatile("s_waitcnt vmcnt(0)" ::: "memory");
    __syncthreads();
    if (threadIdx.x == 0) {
        unsigned* bar = b.bar;
        __builtin_amdgcn_s_waitcnt(0);
        unsigned nloc = b.st[0], nx = b.st[1];
        if (nloc == 0u) { xcd_barrier_complete(bar, b.x, nloc, nx); b.st[0] = nloc; b.st[1] = nx; }
        const unsigned old = xb_add(&bar[XB_XSUB(b.x)], 1u);
        const unsigned gen = old / nloc;
        if (old + 1u == (gen + 1u) * nloc) {
            __builtin_amdgcn_fence(__ATOMIC_RELEASE, "agent");
            asm volatile("s_waitcnt vmcnt(0)" ::: "memory");
            const unsigned og = xb_add(&bar[XB_TOP], 1u);
            const unsigned tg = og / nx;
            if (og + 1u == (tg + 1u) * nx) xb_add(&bar[XB_TOPGEN], 1u);
            else XB_SPIN(xb_ld(&bar[XB_TOPGEN]) == tg, bar);
            __builtin_amdgcn_fence(__ATOMIC_ACQUIRE, "agent");
            xb_add(&bar[XB_XGEN(b.x)], 1u);
            asm volatile("s_waitcnt vmcnt(0)" ::: "memory");
        } else {
            XB_SPIN(xb_ld(&bar[XB_XGEN(b.x)]) == gen, bar);
            __builtin_amdgcn_fence(__ATOMIC_ACQUIRE, "agent");
            asm volatile("s_waitcnt vmcnt(0)" ::: "memory");
        }
    }
    __syncthreads();
}

namespace pg8 {
constexpr int BM = 256, BK = 64, HALF = 128, HTB = HALF * BK * 2, STAGE_BYTES = 8 * HTB, NXCD = 8, WGM = 8;
__host__ __device__ __forceinline__ int lds_byte(int r, int c) { const int st = (r >> 4) * 2 + (c >> 5), rr = r & 15, cc = c & 31, ob = rr * 64 + cc * 2; return st * 1024 + (ob ^ (((ob >> 9) & 1) << 5)); }
__host__ __device__ __forceinline__ void stage_rc(int b, int& R, int& C) { const int st = b / 1024, sb = b % 1024, swz = sb ^ (((sb >> 9) & 1) << 5); R = (st >> 1) * 16 + swz / 64; C = (st & 1) * 32 + (swz % 64) / 2; }
__host__ __device__ __forceinline__ int perm32(int rho) { const int n = rho >> 4, i = rho & 15; return 8 * (i >> 2) + 4 * n + (i & 3); }

struct Unit { const char* A; const char* B; int pm, pn, aux; };
struct GemmDesc { int lda, ldb, K; };

DI bool static_tile(int L, int nM, int nN, int& pm, int& pn) {
    const int nwg = nM * nN; if (L >= nwg) return false;
    int wgid = L; { const int q = nwg / NXCD, r = nwg % NXCD, xcd = wgid % NXCD, off = wgid / NXCD; wgid = (xcd < r ? xcd * (q + 1) : r * (q + 1) + (xcd - r) * q) + off; }
    const int nig = WGM * nN, gid = wgid / nig, fm = gid * WGM, gsz = (nM - fm) < WGM ? (nM - fm) : WGM;
    pm = fm + ((wgid % nig) % gsz); pn = (wgid % nig) / gsz; return true;
}
struct OrderStd {
    int nM, nN, G, c; const char* A0; const char* B0; size_t sA, sB;
    DI bool next(int i, Unit& u) const {
        int pm, pn; if (!static_tile(i * G + c, nM, nN, pm, pn)) return false;
        u.pm = pm; u.pn = pn; u.aux = 0; u.A = A0 + (size_t)pm * sA; u.B = B0 + (size_t)pn * sB; return true;
    }
};
struct OrderSplit {
    int nM, nN, L0, stride, slot, cnt; const char* A0; const char* B0; size_t sA, sB;
    DI bool next(int i, Unit& u) const {
        int pm, pn; if (i >= cnt || !static_tile(L0 + i * stride + slot, nM, nN, pm, pn)) return false;
        u.pm = pm; u.pn = pn; u.aux = 0; u.A = A0 + (size_t)pm * sA; u.B = B0 + (size_t)pn * sB; return true;
    }
};
struct OrderPair {
    int nM, nN, G, c; const char* A0; const char* A1; const char* B0; const char* B1; size_t sA, sB;
    DI bool next(int i, Unit& u) const {
        int pm, pn; if (!static_tile((i >> 1) * G + c, nM, nN, pm, pn)) return false;
        const int br = i & 1; u.pm = pm; u.pn = pn; u.aux = br; u.A = (br ? A1 : A0) + (size_t)pm * sA; u.B = (br ? B1 : B0) + (size_t)pn * sB; return true;
    }
};
struct OrderProj2 {
    int nM, nh, G, c; const char* A0; const char* A1; const char* B0; const char* B1; size_t sA, sB;
    DI bool next(int i, Unit& u) const {
        int pm, pn; if (!static_tile(i * G + c, nM, 2 * nh, pm, pn)) return false;
        const int br = pn >= nh; u.pm = pm; u.pn = pn; u.aux = br; u.A = (br ? A1 : A0) + (size_t)pm * sA; u.B = (br ? B1 : B0) + (size_t)(pn - br * nh) * sB; return true;
    }
};
struct OrderMoe {
    int nblk, G, c; const int* blke; const int* rowtok; const char* A0; const char* B0; size_t sA, sE, sB; int i0, cnt;
    DI bool next(int i_, Unit& u) const {
        if (i_ >= cnt) return false;
        const int i = i_ + i0; int rb, pn;
        if ((G & 31) == 0) { const int R = G >> 2, per = R >> 3, loc = c >> 3; rb = i * R + (c & 7) * per + (loc >> 2); pn = loc & 3; }
        else { const int L = i * G + c; rb = L >> 2; pn = L & 3; }
        if (rb >= nblk) return false;
        const int e = blke[rb];
        u.pm = rb; u.pn = pn; u.aux = 0;
        u.A = A0 + (size_t)rb * sA; u.B = B0 + (size_t)e * sE + (size_t)pn * sB; return true;
    }
};

struct OrderMoeU {
    int nblk, G, u0, stride, cnt; const int* blke; const char* A0; const char* B0; size_t sA, sE, sB;
    DI bool next(int j, Unit& u) const {
        if (j >= cnt) return false;
        const int t = u0 + j * stride, i = t / G, v = t - i * G, w8 = G >> 3, x = v / w8, loc = v - x * w8, R = G >> 2;
        int rb = i * R + x * (R >> 3) + (loc >> 2), pn = loc & 3;
        if ((G & 31) != 0) { rb = t >> 2; pn = t & 3; }
        if (rb >= nblk) return false;
        const int e = blke[rb];
        u.pm = rb; u.pn = pn; u.aux = 0;
        u.A = A0 + (size_t)rb * sA; u.B = B0 + (size_t)e * sE + (size_t)pn * sB; return true;
    }
};
#define PG8_LAS __attribute__((address_space(3)))
template <class Epi, class Sched, bool ALIGN_EPI = true, bool SP2 = true, bool GATHER = false>
DI void gemm_phase(PG8_LAS unsigned char* lds, const GemmDesc g, const Sched& S, const Epi& E) {
    const int tid = threadIdx.x, wid = __builtin_amdgcn_readfirstlane(tid >> 6), lane = tid & 63, wr = wid >> 2, wc = wid & 3, fr = lane & 15, fq = lane >> 4;
    const int K = g.K, nt = K / BK;
    static_assert(SP2 || !GATHER, "GATHER is written for the SP2 loop");
    unsigned vA[2][2], vAn[2][2], voffB[2]; int Rr[2]; unsigned cO[2];
#pragma unroll
    for (int i = 0; i < 2; ++i) { int R, C; stage_rc(tid * 16 + i * 8192, R, C); const int Rb = Epi::PERM ? ((R & ~31) + perm32(R & 31)) : R;
        Rr[i] = R; cO[i] = (unsigned)C * 2u; vA[0][i] = (unsigned)(R * g.lda + C) * 2u; vA[1][i] = (unsigned)((R + HALF) * g.lda + C) * 2u; voffB[i] = (unsigned)(Rb * g.ldb + C) * 2u;
        vAn[0][i] = vA[0][i]; vAn[1][i] = vA[1][i]; }
#define PG8_GOFFS(dst, unit) do { _Pragma("unroll") for (int _h = 0; _h < 2; ++_h) _Pragma("unroll") for (int _i = 0; _i < 2; ++_i) \
        dst[_h][_i] = (unsigned)S.rowtok[(unit).pm * BM + _h * HALF + Rr[_i]] * (unsigned)(g.lda * 2) + cO[_i]; } while (0)
    const size_t kstep = (size_t)(BK * 2);
    const size_t hstepA = (size_t)HALF * g.lda * 2, hstepB = (size_t)HALF * g.ldb * 2;
    const unsigned ldsw = (unsigned)wid * 1024u;
    const int aoff = lds_byte(wr * 64 + fr, fq * 8), boff = Epi::WIDE ? lds_byte((wc & 1) * 64 + fr, fq * 8) + (wc >> 1) * HTB : lds_byte(wc * 32 + fr, fq * 8);
#define PG8_SA(b, h) (((b) * 2 + (h)) * HTB)
#define PG8_SB(b, h) ((4 + (b) * 2 + (h)) * HTB)
#define PG8_STAGE(bufoff, gbase, voff) do { _Pragma("unroll") for (int _i = 0; _i < 2; ++_i) \
        __builtin_amdgcn_global_load_lds((const unsigned*)((const char*)(gbase) + (voff)[_i]), (PG8_LAS unsigned*)(lds + (bufoff) + ldsw + _i * 8192), 16, 0, 0); } while (0)
#define PG8_LDA(dst, b, h) do { _Pragma("unroll") for (int m = 0; m < 4; ++m) _Pragma("unroll") for (int k = 0; k < 2; ++k) dst[m][k] = *(const PG8_LAS bf16x8*)(lds + PG8_SA(b, h) + aoff + m * 2048 + k * 1024); } while (0)
#define PG8_LDB(dst, b, h) do { _Pragma("unroll") for (int n = 0; n < 2; ++n) _Pragma("unroll") for (int k = 0; k < 2; ++k) dst[n][k] = *(const PG8_LAS bf16x8*)(lds + (Epi::WIDE ? PG8_SB(b, 0) + (h) * 4096 : PG8_SB(b, h)) + boff + n * 2048 + k * 1024); } while (0)
#define PG8_MMA(ai, bj, At, Bt) do { __builtin_amdgcn_s_setprio(1); _Pragma("unroll") for (int m = 0; m < 4; ++m) _Pragma("unroll") for (int n = 0; n < 2; ++n) _Pragma("unroll") for (int k = 0; k < 2; ++k) \
        acc[ai][bj][m][n] = __builtin_amdgcn_mfma_f32_16x16x32_bf16(Bt[n][k], At[m][k], acc[ai][bj][m][n], 0, 0, 0); __builtin_amdgcn_s_setprio(0); } while (0)
#define PG8_WAIT_V(n) asm volatile("s_waitcnt vmcnt(" #n ")" ::: "memory")
#define PG8_WAIT_L(n) asm volatile("s_waitcnt lgkmcnt(" #n ")" ::: "memory")
#define PG8_BAR __builtin_amdgcn_s_barrier()
#define PG8_SCHED __builtin_amdgcn_sched_barrier(0)
    Unit cur, nxt; int ui = 0;
    if (!S.next(0, cur)) return;
    f32x4 acc[2][2][4][2];
#pragma unroll
    for (int a = 0; a < 2; ++a)
#pragma unroll
        for (int b = 0; b < 2; ++b)
#pragma unroll
            for (int m = 0; m < 4; ++m)
#pragma unroll
                for (int n = 0; n < 2; ++n) acc[a][b][m][n] = (f32x4){0.f, 0.f, 0.f, 0.f};
    bf16x8 At[4][2], B0[2][2], B1[2][2];
    const char* cA = cur.A; const char* cB = cur.B;
    if constexpr (GATHER) { PG8_GOFFS(vA, cur); }
    if constexpr (SP2) {
        PG8_STAGE(PG8_SB(0, 0), cB, voffB); PG8_STAGE(PG8_SB(0, 1), cB + hstepB, voffB); PG8_STAGE(PG8_SA(0, 0), cA, vA[0]); PG8_STAGE(PG8_SA(0, 1), cA, vA[1]);
        if (wr == 1) PG8_BAR;
        PG8_WAIT_V(2); PG8_BAR;
        PG8_STAGE(PG8_SB(1, 0), cB + kstep, voffB); PG8_STAGE(PG8_SA(1, 0), cA + kstep, vA[0]); PG8_STAGE(PG8_SB(1, 1), cB + hstepB + kstep, voffB);
        PG8_WAIT_V(6); PG8_BAR;
    } else {
        PG8_STAGE(PG8_SB(0, 0), cB, voffB); PG8_STAGE(PG8_SA(0, 0), cA, vA[0]); PG8_STAGE(PG8_SB(0, 1), cB + hstepB, voffB); PG8_STAGE(PG8_SA(0, 1), cA, vA[1]);
        if (wr == 1) PG8_BAR;
        PG8_WAIT_V(4); PG8_BAR;
        PG8_STAGE(PG8_SB(1, 0), cB + kstep, voffB); PG8_STAGE(PG8_SA(1, 0), cA + kstep, vA[0]); PG8_STAGE(PG8_SB(1, 1), cB + hstepB + kstep, voffB);
        PG8_WAIT_V(6); PG8_BAR;
    }
    for (;;) {
        const bool has_next = S.next(ui + 1, nxt);
        const char* nA = has_next ? nxt.A : cA; const char* nB = has_next ? nxt.B : cB;
        if constexpr (GATHER) { if (has_next) { PG8_GOFFS(vAn, nxt); } }
        for (int t = 0; t < nt; t += 2) {
            const bool last = (t == nt - 2);
            const char* a1 = cA + (size_t)(t + 1) * kstep;
            const char* a2 = last ? nA : cA + (size_t)(t + 2) * kstep; const char* b2 = last ? nB : cB + (size_t)(t + 2) * kstep;
            const char* a3 = a2 + kstep; const char* b3 = b2 + kstep;
            if constexpr (SP2) {
            unsigned w0[2], w1[2];
#pragma unroll
            for (int _i = 0; _i < 2; ++_i) { w0[_i] = last ? vAn[0][_i] : vA[0][_i]; w1[_i] = last ? vAn[1][_i] : vA[1][_i]; }
            PG8_LDB(B0, 0, 0); PG8_LDB(B1, 0, 1); PG8_SCHED; PG8_LDA(At, 0, 0); PG8_STAGE(PG8_SA(1, 1), a1, vA[1]);
            PG8_WAIT_V(8); PG8_WAIT_L(0); PG8_BAR; PG8_MMA(0, 0, At, B0); PG8_MMA(0, 1, At, B1); PG8_BAR; PG8_SCHED;
            PG8_LDA(At, 0, 1); PG8_STAGE(PG8_SB(0, 0), b2, voffB); PG8_STAGE(PG8_SB(0, 1), b2 + hstepB, voffB); PG8_STAGE(PG8_SA(0, 0), a2, w0);
            PG8_WAIT_V(8); PG8_WAIT_L(0); PG8_BAR; PG8_MMA(1, 0, At, B0); PG8_MMA(1, 1, At, B1); PG8_BAR; PG8_SCHED;
            PG8_LDB(B0, 1, 0); PG8_LDB(B1, 1, 1); PG8_SCHED; PG8_LDA(At, 1, 0); PG8_STAGE(PG8_SA(0, 1), a2, w1);
            PG8_WAIT_V(8); PG8_WAIT_L(0); PG8_BAR; PG8_MMA(0, 0, At, B0); PG8_MMA(0, 1, At, B1); PG8_BAR; PG8_SCHED;
            PG8_LDA(At, 1, 1); PG8_STAGE(PG8_SB(1, 0), b3, voffB); PG8_STAGE(PG8_SB(1, 1), b3 + hstepB, voffB); PG8_STAGE(PG8_SA(1, 0), a3, w0);
            PG8_WAIT_V(8); PG8_WAIT_L(0); PG8_BAR; PG8_MMA(1, 0, At, B0); PG8_MMA(1, 1, At, B1); PG8_BAR; PG8_SCHED;
            } else {
            PG8_LDB(B0, 0, 0); PG8_SCHED; PG8_LDA(At, 0, 0); PG8_STAGE(PG8_SA(1, 1), a1, vA[1]);
            PG8_WAIT_L(8); PG8_BAR; PG8_WAIT_L(0); PG8_MMA(0, 0, At, B0); PG8_BAR; PG8_SCHED;
            PG8_LDB(B1, 0, 1); PG8_STAGE(PG8_SB(0, 0), b2, voffB);
            PG8_BAR; PG8_WAIT_L(0); PG8_MMA(0, 1, At, B1); PG8_BAR;
            PG8_LDA(At, 0, 1); PG8_STAGE(PG8_SA(0, 0), a2, vA[0]);
            PG8_BAR; PG8_WAIT_L(0); PG8_MMA(1, 0, At, B0); PG8_BAR; PG8_SCHED;
            PG8_STAGE(PG8_SB(0, 1), b2 + hstepB, voffB);
            PG8_WAIT_V(6); PG8_BAR; PG8_MMA(1, 1, At, B1); PG8_BAR;
            PG8_LDB(B0, 1, 0); PG8_SCHED; PG8_LDA(At, 1, 0); PG8_STAGE(PG8_SA(0, 1), a2, vA[1]);
            PG8_WAIT_L(8); PG8_BAR; PG8_WAIT_L(0); PG8_MMA(0, 0, At, B0); PG8_BAR; PG8_SCHED;
            PG8_LDB(B1, 1, 1); PG8_STAGE(PG8_SB(1, 0), b3, voffB);
            PG8_BAR; PG8_WAIT_L(0); PG8_MMA(0, 1, At, B1); PG8_BAR;
            PG8_LDA(At, 1, 1); PG8_STAGE(PG8_SA(1, 0), a3, vA[0]);
            PG8_BAR; PG8_WAIT_L(0); PG8_MMA(1, 0, At, B0); PG8_BAR; PG8_SCHED;
            PG8_STAGE(PG8_SB(1, 1), b3 + hstepB, voffB);
            PG8_WAIT_V(6); PG8_BAR; PG8_MMA(1, 1, At, B1); PG8_BAR;
            }
        }
        if constexpr (ALIGN_EPI) { if (wr == 0) PG8_BAR; }
        E(acc, cur, wr, wc, fr, fq);
        if (!has_next) break;
#pragma unroll
        for (int a = 0; a < 2; ++a)
#pragma unroll
            for (int b = 0; b < 2; ++b)
#pragma unroll
                for (int m = 0; m < 4; ++m)
#pragma unroll
                    for (int n = 0; n < 2; ++n) acc[a][b][m][n] = (f32x4){0.f, 0.f, 0.f, 0.f};
        cur = nxt; cA = nA; cB = nB; ++ui;
#pragma unroll
        for (int _h = 0; _h < 2; ++_h)
#pragma unroll
            for (int _i = 0; _i < 2; ++_i) vA[_h][_i] = vAn[_h][_i];
        if constexpr (ALIGN_EPI) { if (wr == 1) PG8_BAR; }
    }
    PG8_WAIT_V(0);
    if constexpr (!ALIGN_EPI) { if (wr == 0) PG8_BAR; }
    PG8_BAR;
#undef PG8_GOFFS
#undef PG8_SA
#undef PG8_SB
#undef PG8_STAGE
#undef PG8_LDA
#undef PG8_LDB
#undef PG8_MMA
#undef PG8_WAIT_V
#undef PG8_WAIT_L
#undef PG8_BAR
#undef PG8_SCHED
}

typedef f32x4 AccT[2][2][4][2];
DI float fexp(float v) { return __builtin_amdgcn_exp2f(v * 1.4426950408889634f); }
DI float sigmoid_f(float v) { return __builtin_amdgcn_rcpf(1.f + fexp(-v)); }
DI float silu_f(float v) { return v * sigmoid_f(v); }
DI float logsig16(float v) { return (fminf(v, 0.f) - __builtin_amdgcn_logf(1.f + fexp(-fabsf(v))) * 0.6931471805599453f) * 0.0625f; }
DI v4u pack8(f32x4 a, f32x4 b) { v4u w; w.x = pk2(a[0], a[1]); w.y = pk2(a[2], a[3]); w.z = pk2(b[0], b[1]); w.w = pk2(b[2], b[3]); return w; }

DI void wide_pair(const v4u P0, const v4u P1, v4u& SA, v4u& SB) {
#pragma unroll
    for (int c = 0; c < 4; ++c) { SA[c] = (unsigned)__builtin_amdgcn_update_dpp((int)P0[c], (int)P1[c], 0x128, 0xF, 0xC, false);
                                  SB[c] = (unsigned)__builtin_amdgcn_update_dpp((int)P1[c], (int)P0[c], 0x128, 0xF, 0x3, false); }
}
struct EpiP1 {
    static constexpr bool PERM = true, WIDE = true;
    unsigned char* ws; unsigned char* dout; const float* gq; const float* gk; LAS float* xch;
    DI void operator()(const AccT& acc, const Unit& u, int wr, int wc, int fr, int fq) const {
        const int pn = u.pn, rowA = u.pm * BM + wr * 64 + (fr & 7), clw = (wc >> 1) * HALF + (wc & 1) * 64 + (fr >> 3) * 32 + 8 * fq;
        const int rem = pn >= 8 ? (pn - 8) % 6 : 6, gi = pn >= 8 ? (pn - 8) / 6 : 0;
        int mode = 0; const int colbase = (pn & 1) * 256; size_t off;
        if (pn < 8) { const int bi = pn >> 1; off = bi == 0 ? WS_GLAQ : (bi == 1 ? WS_GLAK : (bi == 2 ? WS_GLAV : DO_R)); mode = bi == 3 ? 1 : 0; }
        else { off = (rem < 2 ? WS_DILQ : (rem < 4 ? WS_DILK : WS_DILV)) + (size_t)gi * T * 1024; mode = rem < 4 ? 3 : 0; }
        bf16* dst = (bf16*)(((pn >> 1) == 3 ? dout : ws) + off) + colbase + clw;
        if (mode == 3) {
            const bool isq = rem < 2;
#pragma unroll
            for (int ai = 0; ai < 2; ++ai)
#pragma unroll
                for (int m = 0; m < 4; ++m) { float ss = 0.f;
#pragma unroll
                    for (int bj = 0; bj < 2; ++bj) { const f32x4 v0 = acc[ai][bj][m][0], v1 = acc[ai][bj][m][1];
                        ss += ((v0[0] * v0[0] + v0[1] * v0[1]) + (v0[2] * v0[2] + v0[3] * v0[3])) + ((v1[0] * v1[0] + v1[1] * v1[1]) + (v1[2] * v1[2] + v1[3] * v1[3])); }
                    ss = xor32_sum(xor16_sum(ss));
                    if (fq == 0) xch[(ai * 128 + wr * 64 + m * 16 + fr) * 4 + wc] = ss; }
            asm volatile("s_waitcnt lgkmcnt(0)" ::: "memory"); __builtin_amdgcn_s_barrier(); asm volatile("" ::: "memory");
            const float* gp = (isq ? gq : gk) + gi * 128 + (wc & 1) * 64 + 8 * fq;
            const f32x4 g00 = *(const f32x4*)gp, g01 = *(const f32x4*)(gp + 4), g10 = *(const f32x4*)(gp + 32), g11 = *(const f32x4*)(gp + 36);
            const float qs = isq ? 0.08838834764831845f * LOG2E : 1.f;
#pragma unroll
            for (int ai = 0; ai < 2; ++ai)
#pragma unroll
                for (int m = 0; m < 4; ++m) { const f32x2 t = *(const LAS f32x2*)(xch + (ai * 128 + wr * 64 + m * 16 + fr) * 4 + (wc & 2));
                    const float rinv = __frsqrt_rn((t[0] + t[1]) * (1.f / 128.f) + EPS) * qs;
                    bf16* rp = dst + (size_t)(rowA + ai * HALF + m * 16) * 512; v4u SA, SB;
                    wide_pair(pack8(acc[ai][0][m][0] * rinv * g00, acc[ai][0][m][1] * rinv * g01), pack8(acc[ai][1][m][0] * rinv * g10, acc[ai][1][m][1] * rinv * g11), SA, SB);
                    *(v4u*)rp = SA; *(v4u*)(rp + 8 * 512) = SB; }
            return;
        }
#pragma unroll
        for (int ai = 0; ai < 2; ++ai)
#pragma unroll
            for (int m = 0; m < 4; ++m) { bf16* rp = dst + (size_t)(rowA + ai * HALF + m * 16) * 512; v4u P[2], SA, SB;
#pragma unroll
                for (int bj = 0; bj < 2; ++bj) { f32x4 v0 = acc[ai][bj][m][0], v1 = acc[ai][bj][m][1];
                    if (mode == 1) {
#pragma unroll
                        for (int j = 0; j < 4; ++j) { v0[j] = silu_f(v0[j]); v1[j] = silu_f(v1[j]); } }
                    P[bj] = pack8(v0, v1); }
                wide_pair(P[0], P[1], SA, SB);
                *(v4u*)rp = SA; *(v4u*)(rp + 8 * 512) = SB; }
    }
};
struct EpiGateMerge {
    static constexpr bool PERM = true, WIDE = false;
    bf16* Mg; const bf16* Y; const float* bias; bool dry;
    DI void operator()(const AccT& acc, const Unit& u, int wr, int wc, int fr, int fq) const {
#if defined(PROBE_PLAN)
        if (dry) { asm volatile("" :: "v"(acc[0][0][0][0][0]), "v"(acc[1][1][3][1][3])); return; }
#endif
        const int row0 = u.pm * BM + wr * 64 + fr, col0 = u.pn * HALF + wc * 32 + 8 * fq;
        f32x4 bv[2][2];
#pragma unroll
        for (int bj = 0; bj < 2; ++bj)
#pragma unroll
            for (int n = 0; n < 2; ++n) bv[bj][n] = *(const f32x4*)(bias + bj * 1024 + col0 + 4 * n);
#pragma unroll
        for (int ai = 0; ai < 2; ++ai)
#pragma unroll
            for (int m = 0; m < 4; ++m) { const size_t row = (size_t)(row0 + ai * HALF + m * 16);
                const v4u yg = *(const v4u*)(Y + row * 2048 + col0), ya = *(const v4u*)(Y + row * 2048 + 1024 + col0);
                f32x4 g0 = acc[ai][0][m][0] + bv[0][0], g1 = acc[ai][0][m][1] + bv[0][1], a0 = acc[ai][1][m][0] + bv[1][0], a1 = acc[ai][1][m][1] + bv[1][1];
#pragma unroll
                for (int j = 0; j < 4; ++j) { g0[j] = sigmoid_f(g0[j]); g1[j] = sigmoid_f(g1[j]); a0[j] = sigmoid_f(a0[j]); a1[j] = sigmoid_f(a1[j]); }
                f32x4 o0, o1;
                o0[0] = g0[0] * bflo(yg.x) + a0[0] * bflo(ya.x); o0[1] = g0[1] * bfhi(yg.x) + a0[1] * bfhi(ya.x); o0[2] = g0[2] * bflo(yg.y) + a0[2] * bflo(ya.y); o0[3] = g0[3] * bfhi(yg.y) + a0[3] * bfhi(ya.y);
                o1[0] = g1[0] * bflo(yg.z) + a1[0] * bflo(ya.z); o1[1] = g1[1] * bfhi(yg.z) + a1[1] * bfhi(ya.z); o1[2] = g1[2] * bflo(yg.w) + a1[2] * bflo(ya.w); o1[3] = g1[3] * bfhi(yg.w) + a1[3] * bfhi(ya.w);
                *(v4u*)(Mg + row * 1024 + col0) = pack8(o0, o1); }
    }
};
struct EpiX1 {
    static constexpr bool PERM = true, WIDE = true;
    bf16* X1; const float* X;
    DI void operator()(const AccT& acc, const Unit& u, int wr, int wc, int fr, int fq) const {
        const int row0 = u.pm * BM + wr * 64 + fr, col0 = u.pn * BM + (wc >> 1) * HALF + (wc & 1) * 64 + 8 * fq;
        const int rowA = u.pm * BM + wr * 64 + (fr & 7), colw = u.pn * BM + (wc >> 1) * HALF + (wc & 1) * 64 + (fr >> 3) * 32 + 8 * fq;
#pragma unroll
        for (int ai = 0; ai < 2; ++ai)
#pragma unroll
            for (int m = 0; m < 4; ++m) { const float* xp = X + (size_t)(row0 + ai * HALF + m * 16) * 1024 + col0; v4u SA, SB;
                wide_pair(pack8(acc[ai][0][m][0] + *(const f32x4*)xp, acc[ai][0][m][1] + *(const f32x4*)(xp + 4)), pack8(acc[ai][1][m][0] + *(const f32x4*)(xp + 32), acc[ai][1][m][1] + *(const f32x4*)(xp + 36)), SA, SB);
                bf16* rp = X1 + (size_t)(rowA + ai * HALF + m * 16) * 1024 + colw;
                *(v4u*)rp = SA; *(v4u*)(rp + 8 * 1024) = SB; }
    }
};
struct EpiGU {
    static constexpr bool PERM = true, WIDE = false;
    bf16* H; const f32x2* roww;
    DI void operator()(const AccT& acc, const Unit& u, int wr, int wc, int fr, int fq) const {
        const int row0 = u.pm * BM + wr * 64 + fr, hc0 = u.pn * 128 + wc * 16 + 4 * fq;
#pragma unroll
        for (int ai = 0; ai < 2; ++ai)
#pragma unroll
            for (int m = 0; m < 4; ++m) { const int row = row0 + ai * HALF + m * 16; const f32x2 wv = roww[row]; const float ri = wv.y, w = wv.x * ri;
#pragma unroll
                for (int bj = 0; bj < 2; ++bj) { const f32x4 g = acc[ai][bj][m][0] * ri, up = acc[ai][bj][m][1];
                    v2u o; o.x = pk2(w * silu_f(g[0]) * up[0], w * silu_f(g[1]) * up[1]); o.y = pk2(w * silu_f(g[2]) * up[2], w * silu_f(g[3]) * up[3]);
                    *(v2u*)(H + (size_t)row * 512 + hc0 + bj * 64) = o; } }
    }
};
struct EpiY {
    static constexpr bool PERM = true, WIDE = true;
    bf16* Y; int ld; bool dry;
    DI void operator()(const AccT& acc, const Unit& u, int wr, int wc, int fr, int fq) const {
#if defined(PROBE_PLAN)
        if (dry) { asm volatile("" :: "v"(acc[0][0][0][0][0]), "v"(acc[1][1][3][1][3])); return; }
#endif
        const int rowA = u.pm * BM + wr * 64 + (fr & 7), colw = u.pn * BM + (wc >> 1) * HALF + (wc & 1) * 64 + (fr >> 3) * 32 + 8 * fq;
#pragma unroll
        for (int ai = 0; ai < 2; ++ai)
#pragma unroll
            for (int m = 0; m < 4; ++m) { bf16* rp = Y + (size_t)(rowA + ai * HALF + m * 16) * ld + colw; v4u SA, SB;
                wide_pair(pack8(acc[ai][0][m][0], acc[ai][0][m][1]), pack8(acc[ai][1][m][0], acc[ai][1][m][1]), SA, SB);
                *(v4u*)rp = SA; *(v4u*)(rp + (size_t)8 * ld) = SB; }
    }
};
}

constexpr int NWAVES = 8, NTHR = 512;
struct Frame {
    LAS unsigned char* lds;
    int tid, lane, wave, vcu, G;
    unsigned char* ws; unsigned char* dout;
};
#define LDS_WAIT() asm volatile("s_waitcnt lgkmcnt(0)" ::: "memory")
#define LDS_BARRIER() do { asm volatile("s_waitcnt lgkmcnt(0)" ::: "memory"); __builtin_amdgcn_s_barrier(); asm volatile("" ::: "memory"); } while (0)
DI float wave_sum(float v) {
    return xor32_sum(xor16_sum(row16_sum(v)));
}
#define MFMA16(a, b, c) __builtin_amdgcn_mfma_f32_16x16x32_bf16((a), (b), (c), 0, 0, 0)
#define MFMA32(a, b, c) __builtin_amdgcn_mfma_f32_32x32x16_bf16((a), (b), (c), 0, 0, 0)

struct TItem { const float* src; bf16* dst; const float* gain; int ldw, ldd, kind, aux, hasg; };
struct Ins { const float* in[21]; };
constexpr int I_IN = 16 * 208, I_BG = 16 * 64, I_PG = 8 * 32, I_PA = 8 * 32, I_OUT = 16 * 32, I_GU = 32 * 2 * 16 * 16, I_DN = 32 * 8 * 32;
constexpr int NITEMS = I_IN + I_BG + I_PG + I_PA + I_OUT + I_GU + I_DN;
DI TItem p0_decode(const Frame& F, const Ins& I, int it) {
    TItem t; int r = it; t.gain = I.in[13]; t.hasg = 0;
    if (r < I_IN) { const int kb = r / 208, nb = r % 208; const int n0 = nb * 32, c0 = nb < 64 ? n0 : n0 + 16;
        t.src = I.in[2] + (size_t)kb * 64 * IN_COLS + c0; t.ldw = IN_COLS; t.dst = (bf16*)(F.ws + WS_W1T) + kb * 64; t.ldd = 1024; t.kind = 0; t.aux = n0; return t; } r -= I_IN;
    if (r < I_BG) { const int kb = r / 64, nb = r % 64; t.src = I.in[10] + (size_t)kb * 64 * 2048 + nb * 32; t.ldw = 2048; t.dst = (bf16*)(F.ws + WS_WBGT) + kb * 64; t.ldd = 1024; t.kind = 1; t.aux = nb * 32; return t; } r -= I_BG;
    if (r < I_PG) { const int kb = r / 32, nb = r % 32; t.src = I.in[8] + (size_t)kb * 64 * 1024 + nb * 32; t.ldw = 1024; t.dst = (bf16*)(F.ws + WS_WPGT) + kb * 64; t.ldd = 512; t.kind = 0; t.aux = nb * 32; return t; } r -= I_PG;
    if (r < I_PA) { const int kb = r / 32, nb = r % 32; t.src = I.in[9] + (size_t)kb * 64 * 1024 + nb * 32; t.ldw = 1024; t.dst = (bf16*)(F.ws + WS_WPAT) + kb * 64; t.ldd = 512; t.kind = 0; t.aux = nb * 32; return t; } r -= I_PA;
    if (r < I_OUT) { const int kb = r / 32, nb = r % 32; t.src = I.in[12] + (size_t)kb * 64 * 1024 + nb * 32; t.ldw = 1024; t.dst = (bf16*)(F.ws + WS_WOUTT) + kb * 64; t.ldd = 1024; t.kind = 0; t.aux = nb * 32; return t; } r -= I_OUT;
    if (r < I_GU) { const int e = r / 512, q = r % 512, up = q >> 8, kb = (q >> 4) & 15, nb = q & 15;
        t.src = (up ? I.in[19] : I.in[18]) + (size_t)e * 1024 * 512 + (size_t)kb * 64 * 512 + nb * 32; t.ldw = 512; t.dst = (bf16*)(F.dout + DO_EXPGU) + (size_t)e * 1024 * 1024 + kb * 64; t.ldd = 1024; t.kind = 2; t.aux = nb * 32 * 2 + up; t.gain = I.in[13] + kb * 64; t.hasg = 1; return t; } r -= I_GU;
    { const int e = r / 256, q = r % 256, kb = q / 32, nb = q % 32;
        t.src = I.in[20] + (size_t)e * 512 * 1024 + (size_t)kb * 64 * 1024 + nb * 32; t.ldw = 1024; t.dst = (bf16*)(F.dout + DO_EXPDN) + (size_t)e * 1024 * 512 + kb * 64; t.ldd = 512; t.kind = 0; t.aux = nb * 32; return t; }
}
DI int p0_rowmap(const TItem& t, int n) {
    if (t.kind == 0) return t.aux + n;
    if (t.kind == 1) { const int c = t.aux + n, cc = c & 1023; return (cc >> 7) * 256 + (c >> 10) * 128 + (cc & 127); }
    const int c = (t.aux >> 1) + n; return (c >> 2) * 8 + (c & 3) + 4 * (t.aux & 1);
}
DI void p0_transpose(const Frame& F, const Ins& I, int it0, int it1, int gw, int NGW) {
    LAS float* scr = (LAS float*)(F.lds + RING_OFF + F.wave * 16384);
    const int lane = F.lane;
    { float cur[32], nxt[32]; TItem ti = p0_decode(F, I, it0 + gw < it1 ? it0 + gw : it0);
#pragma unroll
      for (int i = 0; i < 32; ++i) cur[i] = ti.src[(size_t)(2 * i + (lane >> 5)) * ti.ldw + (lane & 31)];
#pragma unroll 1
      for (int it = it0 + gw; it < it1; it += NGW) {
          const bool more = it + NGW < it1; const TItem tn = p0_decode(F, I, more ? it + NGW : it);
#pragma unroll
          for (int i = 0; i < 32; ++i) nxt[i] = tn.src[(size_t)(2 * i + (lane >> 5)) * tn.ldw + (lane & 31)];
#pragma unroll
          for (int i = 0; i < 32; ++i) scr[(2 * i + (lane >> 5)) * 33 + (lane & 31)] = cur[i];
          LDS_WAIT(); asm volatile("" ::: "memory");
          const int c = lane & 7;
          f32x4 ga = *(const f32x4*)(ti.gain + 8 * c), gb = *(const f32x4*)(ti.gain + 8 * c + 4);
          if (!ti.hasg) { ga = (f32x4){1.f, 1.f, 1.f, 1.f}; gb = ga; }
#pragma unroll
          for (int j = 0; j < 4; ++j) { const int n = (lane >> 3) + 8 * j; const LAS float* sp = scr + (8 * c) * 33 + n;
              v4u o; o.x = pk2(sp[0 * 33] * ga.x, sp[1 * 33] * ga.y); o.y = pk2(sp[2 * 33] * ga.z, sp[3 * 33] * ga.w); o.z = pk2(sp[4 * 33] * gb.x, sp[5 * 33] * gb.y); o.w = pk2(sp[6 * 33] * gb.z, sp[7 * 33] * gb.w);
              *(v4u*)(ti.dst + (size_t)p0_rowmap(ti, n) * ti.ldd + 8 * c) = o; }
          LDS_WAIT(); asm volatile("" ::: "memory");
          ti = tn;
#pragma unroll
          for (int i = 0; i < 32; ++i) cur[i] = nxt[i];
      } }
}
DI bool p0_split(const Frame& F) { return F.G == 256; }
DI void p0_prologue(const Frame& F, const Ins& I, bool pdry) {
    const int gw = F.vcu * NWAVES + F.wave, NGW = F.G * NWAVES, lane = F.lane;
    p0_transpose(F, I, 0, p0_split(F) ? I_IN : NITEMS, gw, NGW);
    { bf16* WRH = (bf16*)(F.ws + WS_WRH); bf16* WRL = WRH + 48 * 1024; const float* wrg = I.in[14]; const float* wre = I.in[16];
      for (int e = (F.vcu * NTHR + F.tid); e < 48 * 1024; e += F.G * NTHR) { const int k = e & 1023, n = e >> 10;
          const float w = (n < 4 ? wrg[k * 4 + n] : (n < 36 ? wre[k * 32 + n - 4] : 0.f)) * I.in[13][k]; const bf16 h = f2bf(w); WRH[e] = h; WRL[e] = f2bf(w - bf2f(h)); } }
    { const float* x = I.in[0]; const float* g1 = I.in[1]; bf16* XN = (bf16*)(F.ws + WS_XN);
      f32x4 gv[4];
#pragma unroll
      for (int j = 0; j < 4; ++j) gv[j] = *(const f32x4*)(g1 + 4 * lane + 256 * j);
      LAS float* wlr = (LAS float*)(F.lds + RING_OFF);
      __syncthreads();
      for (int e = F.tid; e < 16 * 1024; e += NTHR) { const int k = e >> 4, n = e & 15; wlr[n * 1024 + k] = I.in[2][(size_t)k * IN_COLS + 2048 + n] * g1[k]; }
      __syncthreads();
      float* GALR = (float*)(F.ws + WS_GALR);
      f32x4 v[4], vn[4], vb1[4], vb2[4];
#pragma unroll
      for (int rr = 0; rr < 3; ++rr) { const int m0 = gw + rr * NGW; const f32x4* xr = (const f32x4*)(x + (size_t)(m0 < T ? m0 : 0) * D) + lane;
#pragma unroll
        for (int j = 0; j < 4; ++j) { const f32x4 t = xr[64 * j]; if (rr == 0) v[j] = t; else if (rr == 1) vb1[j] = t; else vb2[j] = t; } }
#pragma unroll 1
      for (int m = gw; m < T; m += NGW) { const int mn = m + 3 * NGW < T ? m + 3 * NGW : m; const f32x4* xr = (const f32x4*)(x + (size_t)mn * D) + lane; float s = 0.f;
#pragma unroll
          for (int j = 0; j < 4; ++j) { vn[j] = xr[64 * j]; s += (v[j].x * v[j].x + v[j].y * v[j].y) + (v[j].z * v[j].z + v[j].w * v[j].w); }
          const float rinv = __frsqrt_rn(wave_sum(s) * (1.f / D) + EPS);
          v2u* o8 = (v2u*)(XN + (size_t)m * D) + lane;
#pragma unroll
          for (int j = 0; j < 4; ++j) { v2u o; o.x = pk2(v[j].x * rinv * gv[j].x, v[j].y * rinv * gv[j].y); o.y = pk2(v[j].z * rinv * gv[j].z, v[j].w * rinv * gv[j].w); o8[64 * j] = o; }
#if defined(PROBE_PLAN) && PROBE_SKIP == 2
          if (pdry) { _Pragma("unroll") for (int j = 0; j < 4; ++j) { v[j] = vb1[j]; vb1[j] = vb2[j]; vb2[j] = vn[j]; } continue; }
#endif
          float p[16];
#pragma unroll
          for (int n = 0; n < 16; ++n) { float a = 0.f;
#pragma unroll
              for (int j = 0; j < 4; ++j) { const f32x4 wv = *(const LAS f32x4*)(wlr + n * 1024 + 4 * lane + 256 * j); a += (v[j].x * wv.x + v[j].y * wv.y) + (v[j].z * wv.z + v[j].w * wv.w); }
              p[n] = a; asm volatile("" ::: "memory"); }
#if defined(PROBE_PLAN) && PROBE_SKIP == 1
          if (pdry) { asm volatile("" :: "v"(p[0]), "v"(p[15])); _Pragma("unroll") for (int j = 0; j < 4; ++j) { v[j] = vb1[j]; vb1[j] = vb2[j]; vb2[j] = vn[j]; } continue; }
#endif
          { const bool h3 = lane & 8, h2 = lane & 4; float q8[8], q4[4], q2[2], q1;
#pragma unroll
            for (int i = 0; i < 8; ++i) q8[i] = rs32(p[i], p[i + 8]);
#pragma unroll
            for (int i = 0; i < 4; ++i) q4[i] = rs16(q8[i], q8[i + 4]);
#pragma unroll
            for (int i = 0; i < 2; ++i) { const float snd = h3 ? q4[i] : q4[i + 2], kp = h3 ? q4[i + 2] : q4[i]; q2[i] = kp + __shfl_xor(snd, 8); }
            { const float snd = h2 ? q2[0] : q2[1], kp = h2 ? q2[1] : q2[0]; q1 = kp + __shfl_xor(snd, 4); }
            q1 += __shfl_xor(q1, 2); q1 += __shfl_xor(q1, 1);
            if ((lane & 3) == 0) GALR[(size_t)m * 16 + ((lane >> 5) & 1) * 8 + ((lane >> 4) & 1) * 4 + ((lane >> 3) & 1) * 2 + ((lane >> 2) & 1)] = q1 * rinv; }
#pragma unroll
          for (int j = 0; j < 4; ++j) { v[j] = vb1[j]; vb1[j] = vb2[j]; vb2[j] = vn[j]; } } }
}

DI void qk_norm_phase(const Frame& F, const float* gq, const float* gk, bool dry) {
    const int gw = F.vcu * NWAVES + F.wave, NGW = F.G * NWAVES, lane = F.lane;
    bf16* Q = (bf16*)(F.ws + WS_DILQ);
    for (int rr = gw; rr < 6 * T; rr += NGW) { const int which = rr / T; const int gi = which % 3; const bool isq = which < 3;
        bf16* p = Q + (size_t)rr * 512 + 8 * lane; const v4u v = *(const v4u*)p;
        float x[8] = {bflo(v.x), bfhi(v.x), bflo(v.y), bfhi(v.y), bflo(v.z), bfhi(v.z), bflo(v.w), bfhi(v.w)};
        float s = 0.f;
#pragma unroll
        for (int j = 0; j < 8; ++j) s += x[j] * x[j];
        s += __shfl_xor(s, 1); s += __shfl_xor(s, 2); s += __shfl_xor(s, 4); s += __shfl_xor(s, 8);
        const float rinv = __frsqrt_rn(s * (1.f / 128.f) + EPS) * (isq ? 0.08838834764831845f * LOG2E : 1.f);
        const float* g = (isq ? gq : gk) + gi * 128 + (8 * lane & 127);
        const f32x4 g0 = *(const f32x4*)g, g1 = *(const f32x4*)(g + 4);
        v4u o; o.x = pk2(x[0] * rinv * g0.x, x[1] * rinv * g0.y); o.y = pk2(x[2] * rinv * g0.z, x[3] * rinv * g0.w); o.z = pk2(x[4] * rinv * g1.x, x[5] * rinv * g1.y); o.w = pk2(x[6] * rinv * g1.z, x[7] * rinv * g1.w);
        if (!dry) *(v4u*)p = o; }
}

DI int crow(int i, int h) { return (i & 3) + 8 * (i >> 2) + 4 * h; }
DI int img_off(int row, int ch) { return 256 * row + 16 * (ch ^ (((row & 3) << 2) | ((row >> 2) & 3))); }
typedef short s16x4 __attribute__((ext_vector_type(4)));
DI void attn_round(const Frame& F, int jr, bool dry) {
    const int lane = F.lane, r = lane & 31, h = lane >> 5, w = F.wave, side = w & 1;
    const int job = jr * 8 + w;
    const int gi = job >> 12; int rem = job & 4095;
    const int sh = 2 * gi, d = 1 << sh, L = SEQ >> sh, nqt = L >> 5;
    const int qt = rem % nqt; rem /= nqt; const int res = rem & (d - 1); rem >>= sh; const int head = rem & 3, b = rem >> 2;
    const int p0 = qt * 32, qtA = qt - side;
    const float slope = exp2f(-8.f * (float)(gi * 4 + head + 1) / 12.f) * LOG2E * (float)d;
    bf16* Qg = (bf16*)(F.ws + WS_DILQ) + (size_t)gi * T * 512;
    const bf16* Kg = (const bf16*)(F.ws + WS_DILK) + (size_t)gi * T * 512 + head * 128;
    const bf16* Vg = (const bf16*)(F.ws + WS_DILV) + (size_t)gi * T * 512 + head * 128;
    LAS unsigned char* pbuf = F.lds + (w >> 1) * 32768;
    const size_t qtok = (size_t)b * SEQ + (size_t)(p0 + r) * d + res;
    bf16x8 qf[8];
#pragma unroll
    for (int ks = 0; ks < 8; ++ks) qf[ks] = *(const bf16x8*)(Qg + qtok * 512 + head * 128 + 16 * ks + 8 * h);
    f32x16 O[4];
#pragma unroll
    for (int db = 0; db < 4; ++db)
#pragma unroll
        for (int i = 0; i < 16; ++i) O[db][i] = 0.f;
    float m = -1e30f, l = 0.f;
    const int srow = lane >> 4, sslot = lane & 15;
    v4u ks0[4], vs0[4], ks1[4], vs1[4];
#define ATT_LOAD(KS, VS, sN) do { const int _kb = 32 * (qtA - 4 + (sN)); if (_kb >= 0) { _Pragma("unroll") for (int ii = 0; ii < 4; ++ii) { const int kk = 16 * side + 4 * ii + srow; \
        const size_t _o = ((size_t)b * SEQ + (size_t)(_kb + kk) * d + res) * 512 + 8 * (sslot ^ ((srow << 2) | ii)); KS[ii] = *(const v4u*)(Kg + _o); VS[ii] = *(const v4u*)(Vg + _o); } } } while (0)
#define ATT_STEP(KS, VS, sN) do { const int s_ = (sN); LAS unsigned char* Kimg = pbuf + (s_ & 1) * 16384; LAS unsigned char* Vimg = Kimg + 8192; const int kb = 32 * (qtA - 4 + s_); \
        _Pragma("unroll") for (int ii = 0; ii < 4; ++ii) { *(LAS v4u*)(Kimg + 1024 * (4 * side + ii) + 16 * lane) = KS[ii]; *(LAS v4u*)(Vimg + 1024 * (4 * side + ii) + 16 * lane) = VS[ii]; } \
        if (s_ - 2 >= 0) ATT_LOAD(KS, VS, s_ - 2); \
        LDS_BARRIER(); \
        const int kt = s_ - side; \
        if (kt >= 0 && kt < 5 && kb >= 0) { \
            f32x16 sc; _Pragma("unroll") for (int i = 0; i < 16; ++i) sc[i] = 0.f; \
            _Pragma("unroll") for (int ks = 0; ks < 8; ++ks) { const bf16x8 kf = *(const LAS bf16x8*)(Kimg + img_off(r, 2 * ks + h)); sc = MFMA32(kf, qf[ks], sc); } \
            float mx = -1e30f; const int dq = p0 + r - kb; \
            _Pragma("unroll") for (int i = 0; i < 16; ++i) { const int dist = dq - crow(i, h); const bool ok = dist >= 0 && dist <= 128; const float sv = ok ? sc[i] - slope * (float)dist : -1e30f; sc[i] = sv; mx = fmaxf(mx, sv); } \
            mx = xor32_max(mx); \
            const float mn = fmaxf(m, mx), alpha = __builtin_amdgcn_exp2f(m - mn); const bool grow = !__all(mn <= m); m = mn; \
            float ps = 0.f; \
            _Pragma("unroll") for (int i = 0; i < 16; ++i) { const float pe = __builtin_amdgcn_exp2f(sc[i] - mn);     sc[i] = pe; ps += pe; } \
            l = l * alpha + ps; \
            if (grow) { _Pragma("unroll") for (int db = 0; db < 4; ++db) _Pragma("unroll") for (int i = 0; i < 16; ++i) O[db][i] *= alpha; } \
            bf16x8 pb[2]; \
            _Pragma("unroll") for (int si = 0; si < 2; ++si) { v4u wq; wq.x = pk2(sc[8 * si], sc[8 * si + 1]); wq.y = pk2(sc[8 * si + 2], sc[8 * si + 3]); wq.z = pk2(sc[8 * si + 4], sc[8 * si + 5]); wq.w = pk2(sc[8 * si + 6], sc[8 * si + 7]); pb[si] = __builtin_bit_cast(bf16x8, wq); } \
            const int i16 = lane & 15, q = i16 >> 2, pp = i16 & 3, gl = (lane >> 4) & 1; \
            _Pragma("unroll") for (int db = 0; db < 4; ++db) _Pragma("unroll") for (int si = 0; si < 2; ++si) { \
                const s16x4 lo = __builtin_amdgcn_ds_read_tr16_b64_v4i16((LAS s16x4*)(Vimg + img_off(16 * si + 4 * h + q, 4 * db + 2 * gl + (pp >> 1)) + 8 * (pp & 1))); \
                const s16x4 hi = __builtin_amdgcn_ds_read_tr16_b64_v4i16((LAS s16x4*)(Vimg + img_off(16 * si + 8 + 4 * h + q, 4 * db + 2 * gl + (pp >> 1)) + 8 * (pp & 1))); \
                const bf16x8 vf = __builtin_shufflevector(lo, hi, 0, 1, 2, 3, 4, 5, 6, 7); O[db] = MFMA32(vf, pb[si], O[db]); } } } while (0)
    ATT_LOAD(ks1, vs1, 5); ATT_LOAD(ks0, vs0, 4);
#pragma unroll 1
    for (int s2 = 2; s2 >= 0; --s2) { ATT_STEP(ks1, vs1, 2 * s2 + 1); ATT_STEP(ks0, vs0, 2 * s2); }
    LDS_BARRIER();
#undef ATT_LOAD
#undef ATT_STEP
    const float lt = xor32_sum(l), inv = 1.f / lt;
    bf16* op = Qg + qtok * 512 + head * 128 + 4 * h;
    if (dry) return;
#pragma unroll
    for (int db = 0; db < 4; ++db)
#pragma unroll
        for (int q4 = 0; q4 < 4; ++q4) { v2u o; o.x = pk2(O[db][4 * q4] * inv, O[db][4 * q4 + 1] * inv); o.y = pk2(O[db][4 * q4 + 2] * inv, O[db][4 * q4 + 3] * inv); *(v2u*)(op + 32 * db + 8 * q4) = o; }
    if (h == 0) ((float*)(F.ws + WS_LSE))[(size_t)gi * T * 4 + qtok * 4 + head] = m + log2f(lt);
}

constexpr int G_QS = 0, G_KS = 17408, G_KET = 34816, G_VT = 53248, G_ATT = 71680, G_TOT = 80896, G_DL = 82944, G_OS = 84992, G_LRAW = 83456, G_EC = 87552, G_VRAW = 100864;
constexpr int QS_LD = 136, KT_LD = 72, OS_LD = 132;
DI void gla_pass1(const Frame& F, int item, const float* wa2, const float* ba, bool dry) {
    const int tid = F.tid, lane = F.lane, w = F.wave, fr = lane & 15, g = lane >> 4;
    const int seg = item & (NSEG - 1), bh = item >> 4, hh = bh & 3, b = bh >> 2;
    const int dk = tid & 127, qr = tid >> 7;
    LAS bf16* Qs = (LAS bf16*)(F.lds + G_QS); LAS bf16* Ks = (LAS bf16*)(F.lds + G_KS); LAS bf16* KEt = (LAS bf16*)(F.lds + G_KET); LAS bf16* Vt = (LAS bf16*)(F.lds + G_VT);
    LAS bf16* Att = (LAS bf16*)(F.lds + G_ATT); LAS float* tot = (LAS float*)(F.lds + G_TOT); LAS float* Dl = (LAS float*)(F.lds + G_DL);
    const bf16* GQ = (const bf16*)(F.ws + WS_GLAQ); const bf16* GK = (const bf16*)(F.ws + WS_GLAK); const float* GAL = (const float*)(F.ws + WS_GALR); bf16* GV = (bf16*)(F.ws + WS_GLAV);
    f32x4 S[8];
#pragma unroll
    for (int a = 0; a < 8; ++a) S[a] = (f32x4){0.f, 0.f, 0.f, 0.f};
    float Btot = 0.f;
    const int dv0 = 16 * w;
    v4u sq[2], sk[2], sv[2]; f32x2 sg; unsigned odef[8];
    float wcol[16];
#pragma unroll
    for (int j = 0; j < 16; ++j) wcol[j] = wa2[j * 512 + hh * 128 + dk];
    const float bcol = ba[hh * 128 + dk];
#pragma unroll
    for (int i = 0; i < 8; ++i) odef[i] = 0u;
    const int srow = tid >> 4, sch = tid & 15;
    LAS float* Gl = (LAS float*)(F.lds + G_LRAW); LAS bf16* Vraw = (LAS bf16*)(F.lds + G_VRAW); LAS float* ecum = (LAS float*)(F.lds + G_EC);
    bf16* GQw = (bf16*)(F.ws + WS_GLAQ); v4u qd[2] = {{0u, 0u, 0u, 0u}, {0u, 0u, 0u, 0u}};
    const int troff = ((16 * qr + ((lane & 15) >> 2)) * QS_LD + (w & 1) * 64 + 16 * (lane >> 4) + 4 * (lane & 3)) * 2;
#define GLA_LOAD1(chn) do { const size_t _o = ((size_t)b * SEQ + seg * TSEG + (chn) * 64 + srow) * 512 + hh * 128 + 8 * sch; \
        sg = *(const f32x2*)(GAL + ((size_t)b * SEQ + seg * TSEG + (chn) * 64) * 16 + 2 * tid); \
        _Pragma("unroll") for (int i = 0; i < 2; ++i) { sq[i] = *(const v4u*)(GQ + _o + (size_t)i * 16384); sk[i] = *(const v4u*)(GK + _o + (size_t)i * 16384); sv[i] = *(const v4u*)(GV + _o + (size_t)i * 16384); } } while (0)
    GLA_LOAD1(0);
#pragma unroll 1
    for (int ch = 0; ch < TSEG / 64; ++ch) {
        const size_t tokbase = (size_t)b * SEQ + seg * TSEG + ch * 64;
#pragma unroll
        for (int i = 0; i < 2; ++i) { const int o = (srow + 32 * i) * QS_LD + 8 * sch; *(LAS v4u*)(Qs + o) = sq[i]; *(LAS v4u*)(Ks + o) = sk[i]; *(LAS v4u*)(Vraw + o) = sv[i]; }
        *(LAS f32x2*)(Gl + 2 * tid) = sg;
        if (ch > 0 && !dry) { bf16* op = GV + (tokbase - 64 + 4 * g) * 512 + hh * 128 + dv0 + fr;
#pragma unroll
            for (int it = 0; it < 4; ++it) { op[(size_t)(16 * it) * 512] = (bf16)(odef[2 * it] & 0xffffu); op[(size_t)(16 * it + 1) * 512] = (bf16)(odef[2 * it] >> 16); op[(size_t)(16 * it + 2) * 512] = (bf16)(odef[2 * it + 1] & 0xffffu); op[(size_t)(16 * it + 3) * 512] = (bf16)(odef[2 * it + 1] >> 16); } }
        if (ch > 0 && !dry) { const size_t qo = (tokbase - 64 + srow) * 512 + hh * 128 + 8 * sch; *(v4u*)(GQw + qo) = qd[0]; *(v4u*)(GQw + qo + 16384) = qd[1]; }
        if (ch + 1 < TSEG / 64) GLA_LOAD1(ch + 1);
        LDS_BARRIER();
        float la[16], qv[16], kv[16]; bf16 vv[16];
#pragma unroll
        for (int k4 = 0; k4 < 4; ++k4) { const int o = troff + k4 * 4 * QS_LD * 2;
            const s16x4 q4 = __builtin_amdgcn_ds_read_tr16_b64_v4i16((LAS s16x4*)((LAS unsigned char*)Qs + o));
            const s16x4 k4v = __builtin_amdgcn_ds_read_tr16_b64_v4i16((LAS s16x4*)((LAS unsigned char*)Ks + o)), v4v = __builtin_amdgcn_ds_read_tr16_b64_v4i16((LAS s16x4*)((LAS unsigned char*)Vraw + o));
#pragma unroll
            for (int e = 0; e < 4; ++e) { qv[4 * k4 + e] = bf2f((bf16)q4[e]); kv[4 * k4 + e] = bf2f((bf16)k4v[e]); vv[4 * k4 + e] = (bf16)v4v[e]; } }
#pragma unroll
        for (int i = 0; i < 16; ++i) { const LAS f32x4* gp = (const LAS f32x4*)(Gl + (16 * qr + i) * 16); float a = bcol;
#pragma unroll
            for (int jj = 0; jj < 4; ++jj) { const f32x4 gvv = gp[jj]; a += (gvv.x * wcol[4 * jj] + gvv.y * wcol[4 * jj + 1]) + (gvv.z * wcol[4 * jj + 2] + gvv.w * wcol[4 * jj + 3]); }
            la[i] = pg8::logsig16(a); }
#pragma unroll
        for (int i = 1; i < 16; ++i) la[i] += la[i - 1];
        tot[qr * 128 + dk] = la[15];
        { v4u v0, v1; v0.x = vv[0] | ((unsigned)vv[1] << 16); v0.y = vv[2] | ((unsigned)vv[3] << 16); v0.z = vv[4] | ((unsigned)vv[5] << 16); v0.w = vv[6] | ((unsigned)vv[7] << 16);
          v1.x = vv[8] | ((unsigned)vv[9] << 16); v1.y = vv[10] | ((unsigned)vv[11] << 16); v1.z = vv[12] | ((unsigned)vv[13] << 16); v1.w = vv[14] | ((unsigned)vv[15] << 16);
          *(LAS v4u*)(Vt + dk * KT_LD + 16 * qr) = v0; *(LAS v4u*)(Vt + dk * KT_LD + 16 * qr + 8) = v1; }
        LDS_BARRIER();
        const float t0 = tot[dk], t1 = tot[128 + dk], t2 = tot[256 + dk], t3 = tot[384 + dk];
        const float base = (qr > 0 ? t0 : 0.f) + (qr > 1 ? t1 : 0.f) + (qr > 2 ? t2 : 0.f), blast = (t0 + t1) + (t2 + t3);
        Btot += blast;
        const float eblast = pg8::fexp(blast);
        if (qr == 0) { Dl[dk] = eblast; ecum[dk] = pg8::fexp(Btot - blast); }
        { unsigned ke[8];
#pragma unroll
          for (int i = 0; i < 16; i += 2) { const float b0 = base + la[i], b1 = base + la[i + 1]; const float e0 = pg8::fexp(b0), e1 = pg8::fexp(b1), r0 = __builtin_amdgcn_rcpf(e0), r1 = __builtin_amdgcn_rcpf(e1);
              Qs[(16 * qr + i) * QS_LD + dk] = f2bf(qv[i] * 0.08838834764831845f * e0); Qs[(16 * qr + i + 1) * QS_LD + dk] = f2bf(qv[i + 1] * 0.08838834764831845f * e1);
              Ks[(16 * qr + i) * QS_LD + dk] = f2bf(kv[i] * r0); Ks[(16 * qr + i + 1) * QS_LD + dk] = f2bf(kv[i + 1] * r1);
              ke[i >> 1] = pk2(kv[i] * (eblast * r0), kv[i + 1] * (eblast * r1)); }
          v4u k0 = {ke[0], ke[1], ke[2], ke[3]}, k1 = {ke[4], ke[5], ke[6], ke[7]};
          *(LAS v4u*)(KEt + dk * KT_LD + 16 * qr) = k0; *(LAS v4u*)(KEt + dk * KT_LD + 16 * qr + 8) = k1; }
        LDS_BARRIER();
#pragma unroll
        for (int tt = 0; tt < 2; ++tt) { const int n = 2 * w + tt, jt = n >> 2, it = n & 3; f32x4 a4 = {0.f, 0.f, 0.f, 0.f};
#pragma unroll
            for (int s = 0; s < 4; ++s) { const bf16x8 ka = *(const LAS bf16x8*)(Ks + (16 * jt + fr) * QS_LD + 32 * s + 8 * g); const bf16x8 qb = *(const LAS bf16x8*)(Qs + (16 * it + fr) * QS_LD + 32 * s + 8 * g); a4 = MFMA16(ka, qb, a4); }
            const int tj = 16 * jt + 4 * g, ti = 16 * it + fr;
            v2u o; o.x = pk2(tj <= ti ? a4[0] : 0.f, tj + 1 <= ti ? a4[1] : 0.f); o.y = pk2(tj + 2 <= ti ? a4[2] : 0.f, tj + 3 <= ti ? a4[3] : 0.f);
            *(LAS v2u*)(Att + ti * KT_LD + tj) = o; }
        LDS_BARRIER();
        bf16x8 Sb[4];
#pragma unroll
        for (int s = 0; s < 4; ++s) { v4u p; p.x = pk2(S[2 * s][0], S[2 * s][1]); p.y = pk2(S[2 * s][2], S[2 * s][3]); p.z = pk2(S[2 * s + 1][0], S[2 * s + 1][1]); p.w = pk2(S[2 * s + 1][2], S[2 * s + 1][3]); Sb[s] = __builtin_bit_cast(bf16x8, p); }
        bf16x8 Vf[2];
#pragma unroll
        for (int ks = 0; ks < 2; ++ks) Vf[ks] = *(const LAS bf16x8*)(Vt + (dv0 + fr) * KT_LD + 32 * ks + 8 * g);
#pragma unroll
        for (int it = 0; it < 4; ++it) { f32x4 o = {0.f, 0.f, 0.f, 0.f};
#pragma unroll
            for (int s = 0; s < 4; ++s) { const bf16x4 lo = *(const LAS bf16x4*)(Qs + (16 * it + fr) * QS_LD + 32 * s + 4 * g); const bf16x4 hi = *(const LAS bf16x4*)(Qs + (16 * it + fr) * QS_LD + 32 * s + 16 + 4 * g);
                const bf16x8 qa = __builtin_shufflevector(lo, hi, 0, 1, 2, 3, 4, 5, 6, 7); o = MFMA16(qa, Sb[s], o); }
#pragma unroll
            for (int ks = 0; ks < 2; ++ks) { const bf16x8 aa = *(const LAS bf16x8*)(Att + (16 * it + fr) * KT_LD + 32 * ks + 8 * g); o = MFMA16(aa, Vf[ks], o); }
            odef[2 * it] = pk2(o[0], o[1]); odef[2 * it + 1] = pk2(o[2], o[3]); }
#pragma unroll
        for (int a = 0; a < 8; ++a) { const f32x4 dsc = *(const LAS f32x4*)(Dl + 16 * a + 4 * g); S[a] = S[a] * dsc;
#pragma unroll
            for (int ks = 0; ks < 2; ++ks) { const bf16x8 ka = *(const LAS bf16x8*)(KEt + (16 * a + fr) * KT_LD + 32 * ks + 8 * g); S[a] = MFMA16(ka, Vf[ks], S[a]); } }
#pragma unroll
        for (int i = 0; i < 2; ++i) { const v4u qraw = *(const LAS v4u*)(Qs + (srow + 32 * i) * QS_LD + 8 * sch); const f32x4 e0 = *(const LAS f32x4*)(ecum + 8 * sch), e1 = *(const LAS f32x4*)(ecum + 8 * sch + 4);
            v4u o; o.x = pk2(bflo(qraw.x) * e0.x, bfhi(qraw.x) * e0.y); o.y = pk2(bflo(qraw.y) * e0.z, bfhi(qraw.y) * e0.w); o.z = pk2(bflo(qraw.z) * e1.x, bfhi(qraw.z) * e1.y); o.w = pk2(bflo(qraw.w) * e1.z, bfhi(qraw.w) * e1.w); qd[i] = o; }
        LDS_BARRIER();
    }
    if (!dry) { const size_t qo = ((size_t)b * SEQ + seg * TSEG + TSEG - 64 + srow) * 512 + hh * 128 + 8 * sch; *(v4u*)(GQw + qo) = qd[0]; *(v4u*)(GQw + qo + 16384) = qd[1]; }
    if (!dry) { bf16* op = GV + ((size_t)b * SEQ + seg * TSEG + TSEG - 64 + 4 * g) * 512 + hh * 128 + dv0 + fr;
#pragma unroll
        for (int it = 0; it < 4; ++it) { op[(size_t)(16 * it) * 512] = (bf16)(odef[2 * it] & 0xffffu); op[(size_t)(16 * it + 1) * 512] = (bf16)(odef[2 * it] >> 16); op[(size_t)(16 * it + 2) * 512] = (bf16)(odef[2 * it + 1] & 0xffffu); op[(size_t)(16 * it + 3) * 512] = (bf16)(odef[2 * it + 1] >> 16); } }
    v2u* LB = (v2u*)(F.ws + WS_LB) + (size_t)item * 4096 + w * 512 + lane;
#pragma unroll
    for (int a = 0; a < 8; ++a) { v2u o; o.x = pk2(S[a][0], S[a][1]); o.y = pk2(S[a][2], S[a][3]); LB[a * 64] = o; }
    if (qr == 0) ((float*)(F.ws + WS_DSEG))[item * 128 + dk] = pg8::fexp(Btot);
}

DI void gla_pass2(const Frame& F, int item, const float* gnorm, bool dry) {
    const int tid = F.tid, lane = F.lane, w = F.wave, fr = lane & 15, g = lane >> 4;
    const int seg = item & (NSEG - 1), bh = item >> 4, hh = bh & 3, b = bh >> 2;
    const int dv0 = 16 * w;
    LAS bf16* Qs = (LAS bf16*)(F.lds + G_QS); LAS float* Os = (LAS float*)(F.lds + G_OS);
    const bf16* GQ = (const bf16*)(F.ws + WS_GLAQ); bf16* GV = (bf16*)(F.ws + WS_GLAV); const bf16* R = (const bf16*)(F.dout + DO_R);
    f32x4 Sc[8];
#pragma unroll
    for (int a = 0; a < 8; ++a) Sc[a] = (f32x4){0.f, 0.f, 0.f, 0.f};
    { v2u lv[8], lvn[8]; f32x4 dc[8], dcn[8];
#define GLA_CLOAD(LV, DC, spn) do { const int _it2 = bh * NSEG + (spn); const v2u* _LB = (const v2u*)(F.ws + WS_LB) + (size_t)_it2 * 4096 + w * 512 + lane; const float* _DS = (const float*)(F.ws + WS_DSEG) + _it2 * 128 + 4 * g; \
        _Pragma("unroll") for (int a = 0; a < 8; ++a) { DC[a] = *(const f32x4*)(_DS + 16 * a); LV[a] = _LB[a * 64]; } } while (0)
      if (seg > 0) GLA_CLOAD(lv, dc, 0);
#pragma unroll 1
      for (int sp = 0; sp < seg; ++sp) {
          if (sp + 1 < seg) GLA_CLOAD(lvn, dcn, sp + 1);
#pragma unroll
          for (int a = 0; a < 8; ++a) { Sc[a][0] = Sc[a][0] * dc[a][0] + bflo(lv[a].x); Sc[a][1] = Sc[a][1] * dc[a][1] + bfhi(lv[a].x); Sc[a][2] = Sc[a][2] * dc[a][2] + bflo(lv[a].y); Sc[a][3] = Sc[a][3] * dc[a][3] + bfhi(lv[a].y);
              lv[a] = lvn[a]; dc[a] = dcn[a]; } }
#undef GLA_CLOAD
    }
    bf16x8 Sb[4];
#pragma unroll
    for (int s = 0; s < 4; ++s) { v4u p; p.x = pk2(Sc[2 * s][0], Sc[2 * s][1]); p.y = pk2(Sc[2 * s][2], Sc[2 * s][3]); p.z = pk2(Sc[2 * s + 1][0], Sc[2 * s + 1][1]); p.w = pk2(Sc[2 * s + 1][2], Sc[2 * s + 1][3]); Sb[s] = __builtin_bit_cast(bf16x8, p); }
    const int tk = tid >> 3, pc = tid & 7;
    f32x4 gn[4];
#pragma unroll
    for (int j = 0; j < 4; ++j) gn[j] = *(const f32x4*)(gnorm + 16 * pc + 4 * j);
    v4u sq[2], ow0, ow1, r0, r1, od0 = {0u, 0u, 0u, 0u}, od1 = {0u, 0u, 0u, 0u};
    const int srow = tid >> 4, sch = tid & 15;
#define GLA_LOAD2A(chn) do { const size_t _o = ((size_t)b * SEQ + seg * TSEG + (chn) * 64 + srow) * 512 + hh * 128 + 8 * sch; \
        _Pragma("unroll") for (int i = 0; i < 2; ++i) sq[i] = *(const v4u*)(GQ + _o + (size_t)i * 16384); } while (0)
#define GLA_LOAD2B(chn) do { const size_t _o = ((size_t)b * SEQ + seg * TSEG + (chn) * 64 + tk) * 512 + hh * 128 + 16 * pc; \
        ow0 = *(const v4u*)(GV + _o); ow1 = *(const v4u*)(GV + _o + 8); r0 = *(const v4u*)(R + _o); r1 = *(const v4u*)(R + _o + 8); } while (0)
    GLA_LOAD2A(0); GLA_LOAD2B(0);
#pragma unroll 1
    for (int ch = 0; ch < TSEG / 64; ++ch) {
        const size_t tokbase = (size_t)b * SEQ + seg * TSEG + ch * 64;
#pragma unroll
        for (int i = 0; i < 2; ++i) { const int o = (srow + 32 * i) * QS_LD + 8 * sch; *(LAS v4u*)(Qs + o) = sq[i]; }
        if (ch > 0 && !dry) { const size_t pofs = (tokbase - 64 + tk) * 512 + hh * 128 + 16 * pc; *(v4u*)(GV + pofs) = od0; *(v4u*)(GV + pofs + 8) = od1; }
        const v4u cw0 = ow0, cw1 = ow1, cr0 = r0, cr1 = r1;
        if (ch + 1 < TSEG / 64) { GLA_LOAD2A(ch + 1); GLA_LOAD2B(ch + 1); }
        LDS_BARRIER();
#pragma unroll
        for (int it = 0; it < 4; ++it) { f32x4 o = {0.f, 0.f, 0.f, 0.f};
            if (seg > 0) {
#pragma unroll
                for (int s = 0; s < 4; ++s) { const bf16x4 lo = *(const LAS bf16x4*)(Qs + (16 * it + fr) * QS_LD + 32 * s + 4 * g); const bf16x4 hi = *(const LAS bf16x4*)(Qs + (16 * it + fr) * QS_LD + 32 * s + 16 + 4 * g);
                    const bf16x8 qa = __builtin_shufflevector(lo, hi, 0, 1, 2, 3, 4, 5, 6, 7); o = MFMA16(qa, Sb[s], o); } }
#pragma unroll
            for (int rr = 0; rr < 4; ++rr) Os[(16 * it + 4 * g + rr) * OS_LD + dv0 + fr] = o[rr]; }
        LDS_BARRIER();
        { f32x4 v[4]; float ss = 0.f;
#pragma unroll
          for (int j = 0; j < 4; ++j) v[j] = *(const LAS f32x4*)(Os + tk * OS_LD + 16 * pc + 4 * j);
          v[0].x += bflo(cw0.x); v[0].y += bfhi(cw0.x); v[0].z += bflo(cw0.y); v[0].w += bfhi(cw0.y); v[1].x += bflo(cw0.z); v[1].y += bfhi(cw0.z); v[1].z += bflo(cw0.w); v[1].w += bfhi(cw0.w);
          v[2].x += bflo(cw1.x); v[2].y += bfhi(cw1.x); v[2].z += bflo(cw1.y); v[2].w += bfhi(cw1.y); v[3].x += bflo(cw1.z); v[3].y += bfhi(cw1.z); v[3].z += bflo(cw1.w); v[3].w += bfhi(cw1.w);
#pragma unroll
          for (int j = 0; j < 4; ++j) ss += (v[j].x * v[j].x + v[j].y * v[j].y) + (v[j].z * v[j].z + v[j].w * v[j].w);
          ss = grp8_sum(ss);
          const float rinv = __frsqrt_rn(ss * (1.f / 128.f) + EPS);
          const size_t ofs = (tokbase + tk) * 512 + hh * 128 + 16 * pc;
          v4u o0, o1;
          o0.x = pk2(v[0].x * rinv * gn[0].x * bflo(cr0.x), v[0].y * rinv * gn[0].y * bfhi(cr0.x)); o0.y = pk2(v[0].z * rinv * gn[0].z * bflo(cr0.y), v[0].w * rinv * gn[0].w * bfhi(cr0.y));
          o0.z = pk2(v[1].x * rinv * gn[1].x * bflo(cr0.z), v[1].y * rinv * gn[1].y * bfhi(cr0.z)); o0.w = pk2(v[1].z * rinv * gn[1].z * bflo(cr0.w), v[1].w * rinv * gn[1].w * bfhi(cr0.w));
          o1.x = pk2(v[2].x * rinv * gn[2].x * bflo(cr1.x), v[2].y * rinv * gn[2].y * bfhi(cr1.x)); o1.y = pk2(v[2].z * rinv * gn[2].z * bflo(cr1.y), v[2].w * rinv * gn[2].w * bfhi(cr1.y));
          o1.z = pk2(v[3].x * rinv * gn[3].x * bflo(cr1.z), v[3].y * rinv * gn[3].y * bfhi(cr1.z)); o1.w = pk2(v[3].z * rinv * gn[3].z * bflo(cr1.w), v[3].w * rinv * gn[3].w * bfhi(cr1.w));
          od0 = o0; od1 = o1; }
        LDS_BARRIER();
    }
    if (!dry) { const size_t pofs = ((size_t)b * SEQ + seg * TSEG + TSEG - 64 + tk) * 512 + hh * 128 + 16 * pc; *(v4u*)(GV + pofs) = od0; *(v4u*)(GV + pofs + 8) = od1; }
}
DI void attn_merge_phase(const Frame& F, bool dry) {
    const int gw = F.vcu * NWAVES + F.wave, NGW = F.G * NWAVES, lane = F.lane, head = lane >> 4;
    bf16* O0 = (bf16*)(F.ws + WS_DILQ); const float* LSE = (const float*)(F.ws + WS_LSE);
    for (int t = gw; t < T; t += NGW) {
        const float l0 = LSE[(size_t)t * 4 + head], l1 = LSE[(size_t)T * 4 + (size_t)t * 4 + head], l2 = LSE[(size_t)2 * T * 4 + (size_t)t * 4 + head];
        const float M = fmaxf(l0, fmaxf(l1, l2)); float w0 = exp2f(l0 - M), w1 = exp2f(l1 - M), w2 = exp2f(l2 - M); const float inv = 1.f / (w0 + w1 + w2); w0 *= inv; w1 *= inv; w2 *= inv;
        bf16* p = O0 + (size_t)t * 512 + 8 * lane; const v4u a = *(const v4u*)p, bq = *(const v4u*)(p + (size_t)T * 512), c = *(const v4u*)(p + (size_t)2 * T * 512);
        v4u o;
        o.x = pk2(w0 * bflo(a.x) + w1 * bflo(bq.x) + w2 * bflo(c.x), w0 * bfhi(a.x) + w1 * bfhi(bq.x) + w2 * bfhi(c.x));
        o.y = pk2(w0 * bflo(a.y) + w1 * bflo(bq.y) + w2 * bflo(c.y), w0 * bfhi(a.y) + w1 * bfhi(bq.y) + w2 * bfhi(c.y));
        o.z = pk2(w0 * bflo(a.z) + w1 * bflo(bq.z) + w2 * bflo(c.z), w0 * bfhi(a.z) + w1 * bfhi(bq.z) + w2 * bfhi(c.z));
        o.w = pk2(w0 * bflo(a.w) + w1 * bflo(bq.w) + w2 * bflo(c.w), w0 * bfhi(a.w) + w1 * bfhi(bq.w) + w2 * bfhi(c.w));
        if (!dry) *(v4u*)p = o; }
}

DI void router_phase(const Frame& F, const float* brg, const float* bre, unsigned* gcnt, bool dry) {
    const int lane = F.lane, w = F.wave, fr = lane & 15, g = lane >> 4;
    const bf16* X1 = (const bf16*)(F.ws + WS_X1);
    const bf16* WRH = (const bf16*)(F.ws + WS_WRH); const bf16* WRL = WRH + 48 * 1024;
    int* TOKE = (int*)(F.ws + WS_TOKE); float* TOKW = (float*)(F.ws + WS_TOKW); int* TOKR = (int*)(F.ws + WS_TOKR);
    LAS float* lg = (LAS float*)(F.lds + w * 3072);
    LAS int* cnt = (LAS int*)(F.lds + 24576); LAS int* basev = cnt + 32;
    LAS unsigned char* wh = F.lds + 28672;
    __syncthreads();
    for (int e = F.tid; e < 48 * 128; e += NTHR) *(LAS v4u*)(wh + (e >> 7) * 2064 + (e & 127) * 16) = *(const v4u*)(WRH + (size_t)e * 8);
    __syncthreads();
    if (!dry) { int* ROWTOK = (int*)(F.ws + WS_ROWTOK); for (int e = F.vcu * NTHR + F.tid; e < PMAX; e += F.G * NTHR) ROWTOK[e] = 0; }
    for (int it = 0; it * F.G * 128 < T; ++it) {
        const int tok0 = (it * F.G + F.vcu) * 128 + w * 16;
        if (F.tid < 32) cnt[F.tid] = 0;
        __syncthreads();
        f32x4 acc[3]; acc[0] = acc[1] = acc[2] = (f32x4){0.f, 0.f, 0.f, 0.f};
        float ss = 0.f;
        const bf16* xr = X1 + (size_t)(tok0 + fr) * D + 8 * g;
#pragma unroll 4
        for (int s = 0; s < 32; ++s) {
            const v4u xv = *(const v4u*)(xr + 32 * s);
            ss += (bflo(xv.x) * bflo(xv.x) + bfhi(xv.x) * bfhi(xv.x)) + (bflo(xv.y) * bflo(xv.y) + bfhi(xv.y) * bfhi(xv.y)) + (bflo(xv.z) * bflo(xv.z) + bfhi(xv.z) * bfhi(xv.z)) + (bflo(xv.w) * bflo(xv.w) + bfhi(xv.w) * bfhi(xv.w));
            const bf16x8 ah = __builtin_bit_cast(bf16x8, xv);
#pragma unroll
            for (int nt = 0; nt < 3; ++nt) { const bf16x8 bh = *(const LAS bf16x8*)(wh + (16 * nt + fr) * 2064 + 64 * s + 16 * g), bl = *(const bf16x8*)(WRL + (size_t)(16 * nt + fr) * 1024 + 32 * s + 8 * g);
                acc[nt] = MFMA16(ah, bh, acc[nt]); acc[nt] = MFMA16(ah, bl, acc[nt]); }
        }
        ss = xor32_sum(xor16_sum(ss));
        const float rinv = __frsqrt_rn(ss * (1.f / D) + EPS);
#pragma unroll
        for (int rr = 0; rr < 4; ++rr) { const float ri = __shfl(rinv, 4 * g + rr);
#pragma unroll
            for (int nt = 0; nt < 3; ++nt) lg[(4 * g + rr) * 48 + 16 * nt + fr] = acc[nt][rr] * ri; }
        if (lane < 16 && !dry) ((float*)(F.ws + WS_H2))[tok0 + lane] = rinv;
        LDS_WAIT(); asm volatile("" ::: "memory");
        int e1 = 0, e2 = 0, lr1 = 0, lr2 = 0; float w1 = 0.f, w2 = 0.f;
        if (lane < 16) { const LAS float* q = lg + lane * 48;
            float gl[4]; int gs = 0; float gm = -3.0e38f;
#pragma unroll
            for (int j = 0; j < 4; ++j) { gl[j] = q[j] + brg[j]; if (gl[j] > gm) { gm = gl[j]; gs = j; } }
            float gsum = 0.f;
#pragma unroll
            for (int j = 0; j < 4; ++j) gsum += __expf(gl[j] - gm);
            const float gp = 1.f / gsum;
            float el[8]; int i1 = 0; float v1 = -3.0e38f;
#pragma unroll
            for (int j = 0; j < 8; ++j) { el[j] = q[4 + 8 * gs + j] + bre[8 * gs + j]; if (el[j] > v1) { v1 = el[j]; i1 = j; } }
            int i2 = 0; float v2 = -3.0e38f;
#pragma unroll
            for (int j = 0; j < 8; ++j) if (j != i1 && el[j] > v2) { v2 = el[j]; i2 = j; }
            const float p2 = 1.f / (1.f + __expf(v1 - v2)), p1 = 1.f - p2;
            e1 = 8 * gs + i1; e2 = 8 * gs + i2; w1 = p1 * gp; w2 = p2 * gp;
            lr1 = __hip_atomic_fetch_add(&cnt[e1], 1, __ATOMIC_RELAXED, __HIP_MEMORY_SCOPE_WORKGROUP); lr2 = __hip_atomic_fetch_add(&cnt[e2], 1, __ATOMIC_RELAXED, __HIP_MEMORY_SCOPE_WORKGROUP); }
        __syncthreads();
        if (F.tid < 32) basev[F.tid] = dry ? 0 : (int)atomicAdd(&gcnt[64 * F.tid], (unsigned)cnt[F.tid]);
        __syncthreads();
        if (lane < 16 && !dry) { const int t = tok0 + lane; TOKE[2 * t] = e1; TOKE[2 * t + 1] = e2; TOKW[2 * t] = w1; TOKW[2 * t + 1] = w2; TOKR[2 * t] = basev[e1] + lr1; TOKR[2 * t + 1] = basev[e2] + lr2; }
        __syncthreads();
    }
}
DI void moe_assign_phase(const Frame& F, unsigned* gcnt) {
    LAS int* pst = (LAS int*)(F.lds + 65536);
    if (F.tid == 0) { int p = 0; int* BLKE = (int*)(F.ws + WS_BLKE);
        for (int e = 0; e < 32; ++e) { pst[e] = p; const int c = (int)__hip_atomic_load(&gcnt[64 * e], __ATOMIC_RELAXED, __HIP_MEMORY_SCOPE_AGENT); const int nb = (c + 255) >> 8;
            if (F.vcu == 0) for (int j = 0; j < nb; ++j) BLKE[(p >> 8) + j] = e;
            p += nb << 8; }
        if (F.vcu == 0) BLKE[NBLK_MAX] = p >> 8; }
    __syncthreads();
    const int* TOKE = (const int*)(F.ws + WS_TOKE); const float* TOKW = (const float*)(F.ws + WS_TOKW); const int* TOKR = (const int*)(F.ws + WS_TOKR);
    int* DEST = (int*)(F.ws + WS_DEST); f32x2* ROWW = (f32x2*)(F.ws + WS_ROWW); int* ROWTOK = (int*)(F.ws + WS_ROWTOK); const float* RINV = (const float*)(F.ws + WS_H2);
    for (int t = F.vcu * NTHR + F.tid; t < T; t += F.G * NTHR) {
        const int d0 = pst[TOKE[2 * t]] + TOKR[2 * t], d1 = pst[TOKE[2 * t + 1]] + TOKR[2 * t + 1]; const float rinv = RINV[t];
        DEST[2 * t] = d0; DEST[2 * t + 1] = d1; ROWW[d0] = (f32x2){TOKW[2 * t], rinv}; ROWW[d1] = (f32x2){TOKW[2 * t + 1], rinv}; ROWTOK[d0] = t; ROWTOK[d1] = t; }
}
DI void combine_phase(const Frame& F, float* out) {
    const int gw = F.vcu * NWAVES + F.wave, NGW = F.G * NWAVES, lane = F.lane;
    const bf16* X1 = (const bf16*)(F.ws + WS_X1); const bf16* Y = (const bf16*)(F.ws + WS_Y); const int* DEST = (const int*)(F.ws + WS_DEST);
    for (int t = gw; t < T; t += NGW) { const int d0 = DEST[2 * t], d1 = DEST[2 * t + 1];
#pragma unroll
        for (int j = 0; j < 2; ++j) { const int c = 8 * lane + 512 * j;
            const v4u x = *(const v4u*)(X1 + (size_t)t * D + c), a = *(const v4u*)(Y + (size_t)d0 * D + c), b = *(const v4u*)(Y + (size_t)d1 * D + c);
            f32x4 oa, ob;
            oa.x = bflo(x.x) + bflo(a.x) + bflo(b.x); oa.y = bfhi(x.x) + bfhi(a.x) + bfhi(b.x); oa.z = bflo(x.y) + bflo(a.y) + bflo(b.y); oa.w = bfhi(x.y) + bfhi(a.y) + bfhi(b.y);
            ob.x = bflo(x.z) + bflo(a.z) + bflo(b.z); ob.y = bfhi(x.z) + bfhi(a.z) + bfhi(b.z); ob.z = bflo(x.w) + bflo(a.w) + bflo(b.w); ob.w = bfhi(x.w) + bfhi(a.w) + bfhi(b.w);
            *(f32x4*)(out + (size_t)t * D + c) = oa; *(f32x4*)(out + (size_t)t * D + c + 4) = ob; } }
}

constexpr int PER_PHASE = 13;
#ifndef STAGGER_TICKS
#define STAGGER_TICKS 200
#endif
struct Args { Ins I; float* out; unsigned char* ws; int ph_lo, ph_hi, li, pad; };
__global__ void __launch_bounds__(NTHR, 2) fwd_kernel(Args args) {
    extern __shared__ __attribute__((aligned(16))) unsigned char lds[];
    Frame F;
    F.lds = (LAS unsigned char*)lds;
    F.tid = threadIdx.x; F.lane = F.tid & 63; F.wave = __builtin_amdgcn_readfirstlane(F.tid >> 6);
    F.G = gridDim.x; { const int bx = blockIdx.x; F.vcu = (F.G % 8 == 0) ? (bx % 8) * (F.G / 8) + bx / 8 : bx; }
    F.ws = args.ws; F.dout = (unsigned char*)args.out;
    unsigned* ctl = (unsigned*)(args.ws + WS_CTL);
    volatile LAS unsigned* MISC = (volatile LAS unsigned*)(F.lds + MISC_OFF);
    for (int u = F.tid; u < (LDS_BYTES - LDSCTL_OFF) / 4; u += NTHR) ((LAS unsigned*)(F.lds + LDSCTL_OFF))[u] = 0u;
    __syncthreads();
    XcdBarrier bar; bar.bar = ctl + CW_BAR; bar.x = 0; bar.st = nullptr;
    if (MK_N_LAUNCHES == 1) bar = xcd_barrier_post(ctl + CW_BAR + args.li * 4096, MISC + 8);
    const int lo = args.ph_lo, hi = args.ph_hi;
#ifdef ONLY_PHASE
#define IN(k) ((k) == ONLY_PHASE && lo <= (k) && (k) < hi)
#else
#define IN(k) (lo <= (k) && (k) < hi)
#endif
#define STAGGER() do { const unsigned long long _t0 = __builtin_amdgcn_s_memrealtime(), _dl = (unsigned long long)(blockIdx.x & 3) * STAGGER_TICKS; while (__builtin_amdgcn_s_memrealtime() - _t0 < _dl) __builtin_amdgcn_s_sleep(8); } while (0)
#define SEAM(k) do { if (IN(k) && IN((k) + 1)) xcd_barrier(bar); } while (0)
#ifndef DUP_MASK
#define DUP_MASK 0
#endif
#define REPS(k) (((DUP_MASK >> (k)) & 1) ? 2 : 1)
    const Ins& I = args.I;
    unsigned char* ws = args.ws;
#if defined(PROBE_PLAN)
    const bool pdry = args.li == 1 && args.pad == 77;
#else
    const bool pdry = false;
#endif

    if (IN(0)) { _Pragma("unroll 1") for (int rep = 0; rep < REPS(0); ++rep) { if (rep) xcd_barrier(bar); p0_prologue(F, I, pdry); } SEAM(0); }

    if (IN(1)) { _Pragma("unroll 1") for (int rep = 0; rep < REPS(1); ++rep) { if (rep) xcd_barrier(bar);
        pg8::GemmDesc g{1024, 1024, 1024};
        const int bx = (int)blockIdx.x, iw = bx >> 3; const bool split = p0_split(F), grpB = split && iw >= 16;
        if (grpB) { p0_transpose(F, I, I_IN, NITEMS, ((iw - 16) * 8 + (bx & 7)) * NWAVES + F.wave, 128 * NWAVES); __syncthreads(); }
        pg8::OrderSplit S{T / 256, N1 / 256, grpB ? 128 * 14 : 0, split ? 128 : F.G, split ? (iw & 15) * 8 + (bx & 7) : bx, split ? (grpB ? 12 : 14) : 0x7fffffff, (const char*)(ws + WS_XN), (const char*)(ws + WS_W1T), (size_t)256 * 1024 * 2, (size_t)256 * 1024 * 2};
        pg8::EpiP1 E{ws, F.dout, I.in[6], I.in[7], (LAS float*)(F.lds + LDSCTL_OFF + 1024)};
        pg8::gemm_phase<pg8::EpiP1, pg8::OrderSplit>(F.lds + RING_OFF, g, S, E);
}         SEAM(1);
    }
    if (IN(3)) {
        _Pragma("unroll 1") for (int rep = 0; rep < REPS(3); ++rep) { if (rep) xcd_barrier(bar);
        for (int it = F.vcu; it < 16 * NSEG; it += F.G) gla_pass1(F, it, I.in[3], I.in[4], (rep + 1 < REPS(3)) || pdry); }
        const int gw = F.vcu * NWAVES + F.wave, NGW = F.G * NWAVES;
        _Pragma("unroll 1") for (int rep = 0; rep < REPS(13); ++rep) { if (rep) xcd_barrier(bar);
        for (int jr = F.vcu; jr < 3 * 4096 / 8; jr += F.G) attn_round(F, jr, (rep + 1 < REPS(13)) || pdry); }
        SEAM(3);
    }
    if (IN(4)) {
        _Pragma("unroll 1") for (int rep = 0; rep < REPS(4); ++rep) { if (rep) xcd_barrier(bar);
        for (int it = F.vcu; it < 16 * NSEG; it += F.G) gla_pass2(F, it, I.in[5], (rep + 1 < REPS(4)) || pdry); }
        _Pragma("unroll 1") for (int rep = 0; rep < REPS(14); ++rep) { if (rep) xcd_barrier(bar); attn_merge_phase(F, (rep + 1 < REPS(14)) || pdry); }
        SEAM(4);
    }
    if (IN(5)) { _Pragma("unroll 1") for (int rep = 0; rep < REPS(5); ++rep) { if (rep) xcd_barrier(bar);
        pg8::GemmDesc g{512, 512, 512};
        pg8::OrderProj2 S{T / 256, 4, F.G, (int)blockIdx.x, (const char*)(ws + WS_GLAV), (const char*)(ws + WS_DILQ), (const char*)(ws + WS_WPGT), (const char*)(ws + WS_WPAT), (size_t)256 * 512 * 2, (size_t)256 * 512 * 2};
        pg8::EpiY E{(bf16*)(ws + WS_GATES), 2048, pdry};
        pg8::gemm_phase<pg8::EpiY, pg8::OrderProj2>(F.lds + RING_OFF, g, S, E);
}         SEAM(5);
    }
    if (IN(6)) { _Pragma("unroll 1") for (int rep = 0; rep < REPS(6); ++rep) { if (rep) xcd_barrier(bar);
        pg8::GemmDesc g{1024, 1024, 1024};
        pg8::OrderStd S{T / 256, 2048 / 256, F.G, (int)blockIdx.x, (const char*)(ws + WS_XN), (const char*)(ws + WS_WBGT), (size_t)256 * 1024 * 2, (size_t)256 * 1024 * 2};
        pg8::EpiGateMerge E{(bf16*)(ws + WS_MERGED), (const bf16*)(ws + WS_GATES), I.in[11], args.li == 1 && args.pad == 77};
        pg8::gemm_phase<pg8::EpiGateMerge, pg8::OrderStd>(F.lds + RING_OFF, g, S, E);
}         SEAM(6);
    }
    if (IN(7)) { _Pragma("unroll 1") for (int rep = 0; rep < REPS(7); ++rep) { if (rep) xcd_barrier(bar);
        pg8::GemmDesc g{1024, 1024, 1024};
        pg8::OrderStd S{T / 256, 4, F.G, (int)blockIdx.x, (const char*)(ws + WS_MERGED), (const char*)(ws + WS_WOUTT), (size_t)256 * 1024 * 2, (size_t)256 * 1024 * 2};
        pg8::EpiX1 E{(bf16*)(ws + WS_X1), I.in[0]};
        pg8::gemm_phase<pg8::EpiX1, pg8::OrderStd>(F.lds + RING_OFF, g, S, E);
}         SEAM(7);
    }
    if (IN(8)) { _Pragma("unroll 1") for (int rep = 0; rep < REPS(8); ++rep) { if (rep) xcd_barrier(bar); router_phase(F, I.in[15], I.in[17], ctl + CW_GCNT, rep + 1 < REPS(8)); } SEAM(8); }
    if (IN(9)) { _Pragma("unroll 1") for (int rep = 0; rep < REPS(9); ++rep) { if (rep) xcd_barrier(bar); moe_assign_phase(F, ctl + CW_GCNT); } SEAM(9); }
    const bool tsplit = (F.G & 31) == 0;
    if (IN(10)) { _Pragma("unroll 1") for (int rep = 0; rep < REPS(10); ++rep) { if (rep) xcd_barrier(bar);
        const int* BLKE = (const int*)(ws + WS_BLKE); const int nblk = BLKE[NBLK_MAX], Rf = tsplit ? nblk / (F.G >> 2) : 0x3fffffff, nt = tsplit ? nblk - Rf * (F.G >> 2) : 0;
        const bool isT = F.vcu < 4 * nt; const int n1 = Rf >= 2 ? 2 : 0;
        _Pragma("unroll 1") for (int part = 0; part < 2; ++part) {
            if (part) { if (!tsplit) break; xcd_barrier(bar); if (!isT) break; }
            pg8::GemmDesc g{1024, 1024, 1024};
            pg8::OrderMoe S{nblk, F.G, (int)blockIdx.x, BLKE, (const int*)(ws + WS_ROWTOK), (const char*)(ws + WS_X1), (const char*)(F.dout + DO_EXPGU), (size_t)0, (size_t)1024 * 1024 * 2, (size_t)256 * 1024 * 2, part ? Rf : 0, part ? 1 : Rf};
            pg8::EpiGU E{(bf16*)(ws + WS_HBUF), (const f32x2*)(ws + WS_ROWW)};
            pg8::gemm_phase<pg8::EpiGU, pg8::OrderMoe, true, true, true>(F.lds + RING_OFF, g, S, E);
        }
        if (tsplit && !isT) { const int nR = F.G - 4 * nt;
            pg8::GemmDesc g{512, 512, 512};
            pg8::OrderMoeU S{nblk, F.G, F.vcu - 4 * nt, nR, n1, BLKE, (const char*)(ws + WS_HBUF), (const char*)(F.dout + DO_EXPDN), (size_t)256 * 512 * 2, (size_t)1024 * 512 * 2, (size_t)256 * 512 * 2};
            pg8::EpiY E{(bf16*)(ws + WS_Y), 1024, false};
            pg8::gemm_phase<pg8::EpiY, pg8::OrderMoeU>(F.lds + RING_OFF, g, S, E);
        }
}         SEAM(10);
    }
    if (IN(11)) { _Pragma("unroll 1") for (int rep = 0; rep < REPS(11); ++rep) { if (rep) xcd_barrier(bar);
        const int* BLKE = (const int*)(ws + WS_BLKE); const int nblk = BLKE[NBLK_MAX], Rf = tsplit ? nblk / (F.G >> 2) : 0, nt = tsplit ? nblk - Rf * (F.G >> 2) : 0, nR = F.G - 4 * nt, n1 = Rf >= 2 ? 2 : 0;
        pg8::GemmDesc g{512, 512, 512};
        pg8::OrderMoeU S{nblk, F.G, tsplit ? n1 * nR + F.vcu : (int)blockIdx.x, F.G, 0x3fffffff, BLKE, (const char*)(ws + WS_HBUF), (const char*)(F.dout + DO_EXPDN), (size_t)256 * 512 * 2, (size_t)1024 * 512 * 2, (size_t)256 * 512 * 2};
        pg8::EpiY E{(bf16*)(ws + WS_Y), 1024, false};
        pg8::gemm_phase<pg8::EpiY, pg8::OrderMoeU>(F.lds + RING_OFF, g, S, E);
}         SEAM(11);
    }
    if (IN(12)) { _Pragma("unroll 1") for (int rep = 0; rep < REPS(12); ++rep) { if (rep) xcd_barrier(bar); combine_phase(F, args.out); } }
#undef IN
#undef SEAM
}

extern "C" void kernel_launch(void* const* d_in, const int* in_sizes, int n_in, void* d_out, int out_size, void* d_ws, size_t ws_size, hipStream_t stream) {
    static int grid = 0;
    if (grid == 0) {
        if (n_in != 21 || out_size != T * D || ws_size < WS_END) { fprintf(stderr, "kernel_launch: unexpected shapes (n_in %d out %d ws %zu)\n", n_in, out_size, ws_size); grid = -1; return; }
        int dev = 0, cus = 0, per_cu = 0;
        if (hipGetDevice(&dev) != hipSuccess || hipDeviceGetAttribute(&cus, hipDeviceAttributeMultiprocessorCount, dev) != hipSuccess) { grid = -1; return; }
        if (hipFuncSetAttribute((const void*)fwd_kernel, hipFuncAttributeMaxDynamicSharedMemorySize, LDS_BYTES) != hipSuccess) { fprintf(stderr, "kernel_launch: hipFuncSetAttribute failed\n"); grid = -1; return; }
        if (hipOccupancyMaxActiveBlocksPerMultiprocessor(&per_cu, (const void*)fwd_kernel, NTHR, LDS_BYTES) != hipSuccess || per_cu < 1) fprintf(stderr, "kernel_launch: occupancy query reports %d\n", per_cu);
        (void)hipGetLastError();
        grid = cus;
    }
    if (grid < 0) return;
    if (hipMemsetAsync((char*)d_ws + WS_CTL, 0, CTL_ZERO_BYTES, stream) != hipSuccess) return;
    Args a{};
    for (int i = 0; i < 21; ++i) a.I.in[i] = (const float*)d_in[i];
    a.out = (float*)d_out; a.ws = (unsigned char*)d_ws;
#if defined(PROBE_PLAN)
#ifndef PROBE_DRY
#define PROBE_DRY 0
#endif
    { const int plan[3][2] = {{0, PROBE_DRY == 77 ? PROBE_PLAN : PROBE_PLAN + 1}, {PROBE_PLAN, PROBE_PLAN + 1}, {PROBE_DRY == 77 ? PROBE_PLAN : PROBE_PLAN + 1, PER_PHASE}};
      for (int li = 0; li < 3; ++li) { a.ph_lo = plan[li][0]; a.ph_hi = plan[li][1]; a.li = li; a.pad = PROBE_DRY; hipLaunchKernelGGL(fwd_kernel, dim3(grid), dim3(NTHR), LDS_BYTES, stream, a); } return; }
#endif
    if (MK_N_LAUNCHES == 1) { a.ph_lo = 0; a.ph_hi = PER_PHASE; a.li = 0; hipLaunchKernelGGL(fwd_kernel, dim3(grid), dim3(NTHR), LDS_BYTES, stream, a); }
    else for (int li = 0; li < PER_PHASE; ++li) { a.ph_lo = li; a.ph_hi = li + 1; a.li = li; hipLaunchKernelGGL(fwd_kernel, dim3(grid), dim3(NTHR), LDS_BYTES, stream, a); }
}
```

```cpp
#include <hip/hip_runtime.h>
#include <cstdio>
#include <cstdint>

#ifndef MK_N_LAUNCHES
#define MK_N_LAUNCHES 1
#endif

#define GAS __attribute__((address_space(1)))
#define LAS __attribute__((address_space(3)))
typedef unsigned short bf16;
typedef unsigned v4u __attribute__((ext_vector_type(4)));
typedef unsigned v2u __attribute__((ext_vector_type(2)));
typedef float f32x2 __attribute__((ext_vector_type(2)));
typedef float f32x4 __attribute__((ext_vector_type(4)));
typedef float f32x16 __attribute__((ext_vector_type(16)));
typedef short bf16x8 __attribute__((ext_vector_type(8)));
typedef short bf16x4 __attribute__((ext_vector_type(4)));
typedef __bf16 hbf2 __attribute__((ext_vector_type(2)));

#define DI __device__ __forceinline__
DI unsigned pk2(float lo, float hi) { f32x2 v = {lo, hi}; hbf2 r = __builtin_convertvector(v, hbf2); return __builtin_bit_cast(unsigned, r); }
DI bf16 f2bf(float f) { return (bf16)(pk2(f, 0.f) & 0xffffu); }
DI float bf2f(bf16 b) { return __builtin_bit_cast(float, ((unsigned)b) << 16); }
DI float bflo(unsigned u) { return __builtin_bit_cast(float, u << 16); }
DI float bfhi(unsigned u) { return __builtin_bit_cast(float, u & 0xffff0000u); }
DI float xor32_sum(float x) { const unsigned u = __builtin_bit_cast(unsigned, x); const auto r = __builtin_amdgcn_permlane32_swap(u, u, false, false); return __builtin_bit_cast(float, (unsigned)r[0]) + __builtin_bit_cast(float, (unsigned)r[1]); }
DI float xor16_sum(float x) { const unsigned u = __builtin_bit_cast(unsigned, x); const auto r = __builtin_amdgcn_permlane16_swap(u, u, false, false); return __builtin_bit_cast(float, (unsigned)r[0]) + __builtin_bit_cast(float, (unsigned)r[1]); }
DI float xor32_max(float x) { const unsigned u = __builtin_bit_cast(unsigned, x); const auto r = __builtin_amdgcn_permlane32_swap(u, u, false, false); return fmaxf(__builtin_bit_cast(float, (unsigned)r[0]), __builtin_bit_cast(float, (unsigned)r[1])); }
#define DPPF(x, ctrl) __builtin_bit_cast(float, __builtin_amdgcn_mov_dpp(__builtin_bit_cast(int, (x)), (ctrl), 0xf, 0xf, false))
DI float row16_sum(float x) { x += DPPF(x, 0x128); x += DPPF(x, 0x124); x += DPPF(x, 0x122); x += DPPF(x, 0x121); return x; }
DI float grp8_sum(float x) { x += DPPF(x, 0x141); x += DPPF(x, 0x1B); x += DPPF(x, 0xB1); return x; }
DI float rs32(float a, float b) { const auto r = __builtin_amdgcn_permlane32_swap(__builtin_bit_cast(unsigned, a), __builtin_bit_cast(unsigned, b), false, false); return __builtin_bit_cast(float, (unsigned)r[0]) + __builtin_bit_cast(float, (unsigned)r[1]); }
DI float rs16(float a, float b) { const auto r = __builtin_amdgcn_permlane16_swap(__builtin_bit_cast(unsigned, a), __builtin_bit_cast(unsigned, b), false, false); return __builtin_bit_cast(float, (unsigned)r[0]) + __builtin_bit_cast(float, (unsigned)r[1]); }

constexpr int T = 32768, D = 1024, SEQ = 8192;
constexpr int N1 = 6656;
constexpr int IN_COLS = 6672;
constexpr int NSEG = 16, TSEG = SEQ / NSEG;
constexpr float EPS = 1e-6f;
constexpr float LOG2E = 1.4426950408889634f;
constexpr int PMAX = 65536 + 32 * 256;
constexpr int NBLK_MAX = PMAX / 256;

constexpr size_t MiB = 1u << 20;
constexpr size_t WS_CTL = 0, CTL_ZERO_BYTES = 256 * 1024;
constexpr size_t WS_LB = 1 * MiB;
constexpr size_t WS_W1T = 1 * MiB;
constexpr size_t WS_WBGT = 15 * MiB, WS_WPGT = 19 * MiB, WS_WPAT = 20 * MiB, WS_WOUTT = 21 * MiB, WS_WRH = 23 * MiB;
constexpr size_t WS_XN = 24 * MiB;
constexpr size_t WS_GLAQ = 88 * MiB, WS_GLAK = 120 * MiB, WS_GALR = 152 * MiB  , WS_GLAV = 184 * MiB;
constexpr size_t WS_DILQ = 216 * MiB, WS_DILK = 312 * MiB, WS_DILV = 408 * MiB;
constexpr size_t WS_STATS = 504 * MiB;
constexpr size_t WS_LSE = WS_STATS;
constexpr size_t WS_DSEG = WS_STATS + 1536 * 1024;
constexpr size_t WS_TOKE = WS_STATS + 2 * MiB;
constexpr size_t WS_TOKW = WS_TOKE + 256 * 1024;
constexpr size_t WS_TOKR = WS_TOKW + 256 * 1024;
constexpr size_t WS_DEST = WS_TOKR + 256 * 1024;
constexpr size_t WS_ROWW = WS_DEST + 256 * 1024;
constexpr size_t WS_BLKE = WS_ROWW + 640 * 1024;
constexpr size_t WS_END = 512 * MiB;
constexpr size_t WS_GATES = 376 * MiB;
constexpr size_t WS_MERGED = 312 * MiB;
constexpr size_t WS_X1 = 88 * MiB;
constexpr size_t WS_H2 = 24 * MiB;
constexpr size_t WS_XP = 216 * MiB;
constexpr size_t WS_HBUF = 360 * MiB;
constexpr size_t WS_Y = 216 * MiB;
constexpr size_t WS_ROWTOK = 440 * MiB;
constexpr size_t DO_R = 0;
constexpr size_t DO_EXPGU = 32 * MiB;
constexpr size_t DO_EXPDN = 96 * MiB;
constexpr int CW_BAR = 4096;
constexpr int CW_GCNT = 16384;

constexpr int RING_OFF = 0, RING_BYTES = 131072;
constexpr int LDSCTL_OFF = RING_BYTES, MISC_OFF = LDSCTL_OFF + 320;
constexpr int LDS_BYTES = 147456;

#define XB_TMO      128
#define XB_XCNT(j)  (256  + 64 * (j))
#define XB_XSUB(j)  (1280 + 64 * (j))
#define XB_XGEN(j)  (2304 + 64 * (j))
#define XB_TOP      3328
#define XB_TOPGEN   3392
#define XCD_BAR_WORDS 3456
#define XB_SPIN_CAP (1u << 18)
DI unsigned xb_ld(unsigned* p)              { return __hip_atomic_load(p, __ATOMIC_RELAXED, __HIP_MEMORY_SCOPE_AGENT); }
DI unsigned xb_add(unsigned* p, unsigned v) { return __hip_atomic_fetch_add(p, v, __ATOMIC_RELAXED, __HIP_MEMORY_SCOPE_AGENT); }
DI unsigned xb_xcc_id() { return (unsigned)__builtin_amdgcn_s_getreg((3 << 11) | 20) & 0xFu; }
#define XB_SPIN(cond, bar) do { unsigned _sp = 0; while (cond) { __builtin_amdgcn_s_sleep(1); \
    if ((++_sp & 255u) == 0u) { if (xb_ld(&(bar)[XB_TMO])) break; if (_sp > XB_SPIN_CAP) { atomicAdd(&(bar)[XB_TMO], 1u); break; } } } } while (0)
struct XcdBarrier { unsigned* bar; unsigned x; volatile LAS unsigned* st; };
DI XcdBarrier xcd_barrier_post(unsigned* bar, volatile LAS unsigned* st) {
    XcdBarrier b; b.bar = bar; b.x = xb_xcc_id(); b.st = st;
    if (threadIdx.x == 0) (void)xb_add(&bar[XB_XCNT(b.x)], 1u);
    return b;
}
DI void xcd_barrier_complete(unsigned* bar, unsigned x, unsigned& nloc, unsigned& nx) {
    const unsigned G = gridDim.x * gridDim.y * gridDim.z;
    unsigned sum, cnt, mine, sp = 0u;
    for (;;) {
        sum = 0u; cnt = 0u; mine = 0u;
#pragma unroll
        for (unsigned j = 0; j < 16; ++j) { const unsigned c = xb_ld(&bar[XB_XCNT(j)]); sum += c; cnt += (c > 0u) ? 1u : 0u; mine = (j == x) ? c : mine; }
        if (sum == G) break;
        __builtin_amdgcn_s_sleep(1);
        if ((++sp & 255u) == 0u) { if (xb_ld(&bar[XB_TMO])) break; if (sp > XB_SPIN_CAP) { atomicAdd(&bar[XB_TMO], 1u); break; } }
    }
    nloc = mine > 0u ? mine : 1u; nx = cnt > 0u ? cnt : 1u;
}
DI void xcd_barrier(const XcdBarrier& b) {
    asm volatile("s_waitcnt vmcnt(0)" ::: "memory");
    __syncthreads();
    if (threadIdx.x == 0) {
        unsigned* bar = b.bar;
        __builtin_amdgcn_s_waitcnt(0);
        unsigned nloc = b.st[0], nx = b.st[1];
        if (nloc == 0u) { xcd_barrier_complete(bar, b.x, nloc, nx); b.st[0] = nloc; b.st[1] = nx; }
        const unsigned old = xb_add(&bar[XB_XSUB(b.x)], 1u);
        const unsigned gen = old / nloc;
        if (old + 1u == (gen + 1u) * nloc) {
            __builtin_amdgcn_fence(__ATOMIC_RELEASE, "agent");
            asm volatile("s_waitcnt vmcnt(0)" ::: "memory");
            const unsigned og = xb_add(&bar[XB_TOP], 1u);
            const unsigned tg = og / nx;
            if (og + 1u == (tg + 1u) * nx) xb_add(&bar[XB_TOPGEN], 1u);
            else XB_SPIN(xb_ld(&bar[XB_TOPGEN]) == tg, bar);
            __builtin_amdgcn_fence(__ATOMIC_ACQUIRE, "agent");
            xb_add(&bar[XB_XGEN(b.x)], 1u);
            asm volatile("s_waitcnt vmcnt(0)" ::: "memory");
        } else {
            XB_SPIN(xb_ld(&bar[XB_XGEN(b.x)]) == gen, bar);
            __builtin_amdgcn_fence(__ATOMIC_ACQUIRE, "agent");
            asm volatile("s_waitcnt vmcnt(0)" ::: "memory");
        }
    }
    __syncthreads();
}

namespace pg8 {
constexpr int BM = 256, BK = 64, HALF = 128, HTB = HALF * BK * 2, STAGE_BYTES = 8 * HTB, NXCD = 8, WGM = 8;
__host__ __device__ __forceinline__ int lds_byte(int r, int c) { const int st = (r >> 4) * 2 + (c >> 5), rr = r & 15, cc = c & 31, ob = rr * 64 + cc * 2; return st * 1024 + (ob ^ (((ob >> 9) & 1) << 5)); }
__host__ __device__ __forceinline__ void stage_rc(int b, int& R, int& C) { const int st = b / 1024, sb = b % 1024, swz = sb ^ (((sb >> 9) & 1) << 5); R = (st >> 1) * 16 + swz / 64; C = (st & 1) * 32 + (swz % 64) / 2; }
__host__ __device__ __forceinline__ int perm32(int rho) { const int n = rho >> 4, i = rho & 15; return 8 * (i >> 2) + 4 * n + (i & 3); }

struct Unit { const char* A; const char* B; int pm, pn, aux; };
struct GemmDesc { int lda, ldb, K; };

DI bool static_tile(int L, int nM, int nN, int& pm, int& pn) {
    const int nwg = nM * nN; if (L >= nwg) return false;
    int wgid = L; { const int q = nwg / NXCD, r = nwg % NXCD, xcd = wgid % NXCD, off = wgid / NXCD; wgid = (xcd < r ? xcd * (q + 1) : r * (q + 1) + (xcd - r) * q) + off; }
    const int nig = WGM * nN, gid = wgid / nig, fm = gid * WGM, gsz = (nM - fm) < WGM ? (nM - fm) : WGM;
    pm = fm + ((wgid % nig) % gsz); pn = (wgid % nig) / gsz; return true;
}
struct OrderStd {
    int nM, nN, G, c; const char* A0; const char* B0; size_t sA, sB;
    DI bool next(int i, Unit& u) const {
        int pm, pn; if (!static_tile(i * G + c, nM, nN, pm, pn)) return false;
        u.pm = pm; u.pn = pn; u.aux = 0; u.A = A0 + (size_t)pm * sA; u.B = B0 + (size_t)pn * sB; return true;
    }
};
struct OrderSplit {
    int nM, nN, L0, stride, slot, cnt; const char* A0; const char* B0; size_t sA, sB;
    DI bool next(int i, Unit& u) const {
        int pm, pn; if (i >= cnt || !static_tile(L0 + i * stride + slot, nM, nN, pm, pn)) return false;
        u.pm = pm; u.pn = pn; u.aux = 0; u.A = A0 + (size_t)pm * sA; u.B = B0 + (size_t)pn * sB; return true;
    }
};
struct OrderPair {
    int nM, nN, G, c; const char* A0; const char* A1; const char* B0; const char* B1; size_t sA, sB;
    DI bool next(int i, Unit& u) const {
        int pm, pn; if (!static_tile((i >> 1) * G + c, nM, nN, pm, pn)) return false;
        const int br = i & 1; u.pm = pm; u.pn = pn; u.aux = br; u.A = (br ? A1 : A0) + (size_t)pm * sA; u.B = (br ? B1 : B0) + (size_t)pn * sB; return true;
    }
};
struct OrderProj2 {
    int nM, nh, G, c; const char* A0; const char* A1; const char* B0; const char* B1; size_t sA, sB;
    DI bool next(int i, Unit& u) const {
        int pm, pn; if (!static_tile(i * G + c, nM, 2 * nh, pm, pn)) return false;
        const int br = pn >= nh; u.pm = pm; u.pn = pn; u.aux = br; u.A = (br ? A1 : A0) + (size_t)pm * sA; u.B = (br ? B1 : B0) + (size_t)(pn - br * nh) * sB; return true;
    }
};
struct OrderMoe {
    int nblk, G, c; const int* blke; const int* rowtok; const char* A0; const char* B0; size_t sA, sE, sB; int i0, cnt;
    DI bool next(int i_, Unit& u) const {
        if (i_ >= cnt) return false;
        const int i = i_ + i0; int rb, pn;
        if ((G & 31) == 0) { const int R = G >> 2, per = R >> 3, loc = c >> 3; rb = i * R + (c & 7) * per + (loc >> 2); pn = loc & 3; }
        else { const int L = i * G + c; rb = L >> 2; pn = L & 3; }
        if (rb >= nblk) return false;
        const int e = blke[rb];
        u.pm = rb; u.pn = pn; u.aux = 0;
        u.A = A0 + (size_t)rb * sA; u.B = B0 + (size_t)e * sE + (size_t)pn * sB; return true;
    }
};

struct OrderMoeU {
    int nblk, G, u0, stride, cnt; const int* blke; const char* A0; const char* B0; size_t sA, sE, sB;
    DI bool next(int j, Unit& u) const {
        if (j >= cnt) return false;
        const int t = u0 + j * stride, i = t / G, v = t - i * G, w8 = G >> 3, x = v / w8, loc = v - x * w8, R = G >> 2;
        int rb = i * R + x * (R >> 3) + (loc >> 2), pn = loc & 3;
        if ((G & 31) != 0) { rb = t >> 2; pn = t & 3; }
        if (rb >= nblk) return false;
        const int e = blke[rb];
        u.pm = rb; u.pn = pn; u.aux = 0;
        u.A = A0 + (size_t)rb * sA; u.B = B0 + (size_t)e * sE + (size_t)pn * sB; return true;
    }
};
#define PG8_LAS __attribute__((address_space(3)))
template <class Epi, class Sched, bool ALIGN_EPI = true, bool SP2 = true, bool GATHER = false>
DI void gemm_phase(PG8_LAS unsigned char* lds, const GemmDesc g, const Sched& S, const Epi& E) {
    const int tid = threadIdx.x, wid = __builtin_amdgcn_readfirstlane(tid >> 6), lane = tid & 63, wr = wid >> 2, wc = wid & 3, fr = lane & 15, fq = lane >> 4;
    const int K = g.K, nt = K / BK;
    static_assert(SP2 || !GATHER, "GATHER is written for the SP2 loop");
    unsigned vA[2][2], vAn[2][2], voffB[2]; int Rr[2]; unsigned cO[2];
#pragma unroll
    for (int i = 0; i < 2; ++i) { int R, C; stage_rc(tid * 16 + i * 8192, R, C); const int Rb = Epi::PERM ? ((R & ~31) + perm32(R & 31)) : R;
        Rr[i] = R; cO[i] = (unsigned)C * 2u; vA[0][i] = (unsigned)(R * g.lda + C) * 2u; vA[1][i] = (unsigned)((R + HALF) * g.lda + C) * 2u; voffB[i] = (unsigned)(Rb * g.ldb + C) * 2u;
        vAn[0][i] = vA[0][i]; vAn[1][i] = vA[1][i]; }
#define PG8_GOFFS(dst, unit) do { _Pragma("unroll") for (int _h = 0; _h < 2; ++_h) _Pragma("unroll") for (int _i = 0; _i < 2; ++_i) \
        dst[_h][_i] = (unsigned)S.rowtok[(unit).pm * BM + _h * HALF + Rr[_i]] * (unsigned)(g.lda * 2) + cO[_i]; } while (0)
    const size_t kstep = (size_t)(BK * 2);
    const size_t hstepA = (size_t)HALF * g.lda * 2, hstepB = (size_t)HALF * g.ldb * 2;
    const unsigned ldsw = (unsigned)wid * 1024u;
    const int aoff = lds_byte(wr * 64 + fr, fq * 8), boff = Epi::WIDE ? lds_byte((wc & 1) * 64 + fr, fq * 8) + (wc >> 1) * HTB : lds_byte(wc * 32 + fr, fq * 8);
#define PG8_SA(b, h) (((b) * 2 + (h)) * HTB)
#define PG8_SB(b, h) ((4 + (b) * 2 + (h)) * HTB)
#define PG8_STAGE(bufoff, gbase, voff) do { _Pragma("unroll") for (int _i = 0; _i < 2; ++_i) \
        __builtin_amdgcn_global_load_lds((const unsigned*)((const char*)(gbase) + (voff)[_i]), (PG8_LAS unsigned*)(lds + (bufoff) + ldsw + _i * 8192), 16, 0, 0); } while (0)
#define PG8_LDA(dst, b, h) do { _Pragma("unroll") for (int m = 0; m < 4; ++m) _Pragma("unroll") for (int k = 0; k < 2; ++k) dst[m][k] = *(const PG8_LAS bf16x8*)(lds + PG8_SA(b, h) + aoff + m * 2048 + k * 1024); } while (0)
#define PG8_LDB(dst, b, h) do { _Pragma("unroll") for (int n = 0; n < 2; ++n) _Pragma("unroll") for (int k = 0; k < 2; ++k) dst[n][k] = *(const PG8_LAS bf16x8*)(lds + (Epi::WIDE ? PG8_SB(b, 0) + (h) * 4096 : PG8_SB(b, h)) + boff + n * 2048 + k * 1024); } while (0)
#define PG8_MMA(ai, bj, At, Bt) do { __builtin_amdgcn_s_setprio(1); _Pragma("unroll") for (int m = 0; m < 4; ++m) _Pragma("unroll") for (int n = 0; n < 2; ++n) _Pragma("unroll") for (int k = 0; k < 2; ++k) \
        acc[ai][bj][m][n] = __builtin_amdgcn_mfma_f32_16x16x32_bf16(Bt[n][k], At[m][k], acc[ai][bj][m][n], 0, 0, 0); __builtin_amdgcn_s_setprio(0); } while (0)
#define PG8_WAIT_V(n) asm volatile("s_waitcnt vmcnt(" #n ")" ::: "memory")
#define PG8_WAIT_L(n) asm volatile("s_waitcnt lgkmcnt(" #n ")" ::: "memory")
#define PG8_BAR __builtin_amdgcn_s_barrier()
#define PG8_SCHED __builtin_amdgcn_sched_barrier(0)
    Unit cur, nxt; int ui = 0;
    if (!S.next(0, cur)) return;
    f32x4 acc[2][2][4][2];
#pragma unroll
    for (int a = 0; a < 2; ++a)
#pragma unroll
        for (int b = 0; b < 2; ++b)
#pragma unroll
            for (int m = 0; m < 4; ++m)
#pragma unroll
                for (int n = 0; n < 2; ++n) acc[a][b][m][n] = (f32x4){0.f, 0.f, 0.f, 0.f};
    bf16x8 At[4][2], B0[2][2], B1[2][2];
    const char* cA = cur.A; const char* cB = cur.B;
    if constexpr (GATHER) { PG8_GOFFS(vA, cur); }
    if constexpr (SP2) {
        PG8_STAGE(PG8_SB(0, 0), cB, voffB); PG8_STAGE(PG8_SB(0, 1), cB + hstepB, voffB); PG8_STAGE(PG8_SA(0, 0), cA, vA[0]); PG8_STAGE(PG8_SA(0, 1), cA, vA[1]);
        if (wr == 1) PG8_BAR;
        PG8_WAIT_V(2); PG8_BAR;
        PG8_STAGE(PG8_SB(1, 0), cB + kstep, voffB); PG8_STAGE(PG8_SA(1, 0), cA + kstep, vA[0]); PG8_STAGE(PG8_SB(1, 1), cB + hstepB + kstep, voffB);
        PG8_WAIT_V(6); PG8_BAR;
    } else {
        PG8_STAGE(PG8_SB(0, 0), cB, voffB); PG8_STAGE(PG8_SA(0, 0), cA, vA[0]); PG8_STAGE(PG8_SB(0, 1), cB + hstepB, voffB); PG8_STAGE(PG8_SA(0, 1), cA, vA[1]);
        if (wr == 1) PG8_BAR;
        PG8_WAIT_V(4); PG8_BAR;
        PG8_STAGE(PG8_SB(1, 0), cB + kstep, voffB); PG8_STAGE(PG8_SA(1, 0), cA + kstep, vA[0]); PG8_STAGE(PG8_SB(1, 1), cB + hstepB + kstep, voffB);
        PG8_WAIT_V(6); PG8_BAR;
    }
    for (;;) {
        const bool has_next = S.next(ui + 1, nxt);
        const char* nA = has_next ? nxt.A : cA; const char* nB = has_next ? nxt.B : cB;
        if constexpr (GATHER) { if (has_next) { PG8_GOFFS(vAn, nxt); } }
        for (int t = 0; t < nt; t += 2) {
            const bool last = (t == nt - 2);
            const char* a1 = cA + (size_t)(t + 1) * kstep;
            const char* a2 = last ? nA : cA + (size_t)(t + 2) * kstep; const char* b2 = last ? nB : cB + (size_t)(t + 2) * kstep;
            const char* a3 = a2 + kstep; const char* b3 = b2 + kstep;
            if constexpr (SP2) {
            unsigned w0[2], w1[2];
#pragma unroll
            for (int _i = 0; _i < 2; ++_i) { w0[_i] = last ? vAn[0][_i] : vA[0][_i]; w1[_i] = last ? vAn[1][_i] : vA[1][_i]; }
            PG8_LDB(B0, 0, 0); PG8_LDB(B1, 0, 1); PG8_SCHED; PG8_LDA(At, 0, 0); PG8_STAGE(PG8_SA(1, 1), a1, vA[1]);
            PG8_WAIT_V(8); PG8_WAIT_L(0); PG8_BAR; PG8_MMA(0, 0, At, B0); PG8_MMA(0, 1, At, B1); PG8_BAR; PG8_SCHED;
            PG8_LDA(At, 0, 1); PG8_STAGE(PG8_SB(0, 0), b2, voffB); PG8_STAGE(PG8_SB(0, 1), b2 + hstepB, voffB); PG8_STAGE(PG8_SA(0, 0), a2, w0);
            PG8_WAIT_V(8); PG8_WAIT_L(0); PG8_BAR; PG8_MMA(1, 0, At, B0); PG8_MMA(1, 1, At, B1); PG8_BAR; PG8_SCHED;
            PG8_LDB(B0, 1, 0); PG8_LDB(B1, 1, 1); PG8_SCHED; PG8_LDA(At, 1, 0); PG8_STAGE(PG8_SA(0, 1), a2, w1);
            PG8_WAIT_V(8); PG8_WAIT_L(0); PG8_BAR; PG8_MMA(0, 0, At, B0); PG8_MMA(0, 1, At, B1); PG8_BAR; PG8_SCHED;
            PG8_LDA(At, 1, 1); PG8_STAGE(PG8_SB(1, 0), b3, voffB); PG8_STAGE(PG8_SB(1, 1), b3 + hstepB, voffB); PG8_STAGE(PG8_SA(1, 0), a3, w0);
            PG8_WAIT_V(8); PG8_WAIT_L(0); PG8_BAR; PG8_MMA(1, 0, At, B0); PG8_MMA(1, 1, At, B1); PG8_BAR; PG8_SCHED;
            } else {
            PG8_LDB(B0, 0, 0); PG8_SCHED; PG8_LDA(At, 0, 0); PG8_STAGE(PG8_SA(1, 1), a1, vA[1]);
            PG8_WAIT_L(8); PG8_BAR; PG8_WAIT_L(0); PG8_MMA(0, 0, At, B0); PG8_BAR; PG8_SCHED;
            PG8_LDB(B1, 0, 1); PG8_STAGE(PG8_SB(0, 0), b2, voffB);
            PG8_BAR; PG8_WAIT_L(0); PG8_MMA(0, 1, At, B1); PG8_BAR;
            PG8_LDA(At, 0, 1); PG8_STAGE(PG8_SA(0, 0), a2, vA[0]);
            PG8_BAR; PG8_WAIT_L(0); PG8_MMA(1, 0, At, B0); PG8_BAR; PG8_SCHED;
            PG8_STAGE(PG8_SB(0, 1), b2 + hstepB, voffB);
            PG8_WAIT_V(6); PG8_BAR; PG8_MMA(1, 1, At, B1); PG8_BAR;
            PG8_LDB(B0, 1, 0); PG8_SCHED; PG8_LDA(At, 1, 0); PG8_STAGE(PG8_SA(0, 1), a2, vA[1]);
            PG8_WAIT_L(8); PG8_BAR; PG8_WAIT_L(0); PG8_MMA(0, 0, At, B0); PG8_BAR; PG8_SCHED;
            PG8_LDB(B1, 1, 1); PG8_STAGE(PG8_SB(1, 0), b3, voffB);
            PG8_BAR; PG8_WAIT_L(0); PG8_MMA(0, 1, At, B1); PG8_BAR;
            PG8_LDA(At, 1, 1); PG8_STAGE(PG8_SA(1, 0), a3, vA[0]);
            PG8_BAR; PG8_WAIT_L(0); PG8_MMA(1, 0, At, B0); PG8_BAR; PG8_SCHED;
            PG8_STAGE(PG8_SB(1, 1), b3 + hstepB, voffB);
            PG8_WAIT_V(6); PG8_BAR; PG8_MMA(1, 1, At, B1); PG8_BAR;
            }
        }
        if constexpr (ALIGN_EPI) { if (wr == 0) PG8_BAR; }
        E(acc, cur, wr, wc, fr, fq);
        if (!has_next) break;
#pragma unroll
        for (int a = 0; a < 2; ++a)
#pragma unroll
            for (int b = 0; b < 2; ++b)
#pragma unroll
                for (int m = 0; m < 4; ++m)
#pragma unroll
                    for (int n = 0; n < 2; ++n) acc[a][b][m][n] = (f32x4){0.f, 0.f, 0.f, 0.f};
        cur = nxt; cA = nA; cB = nB; ++ui;
#pragma unroll
        for (int _h = 0; _h < 2; ++_h)
#pragma unroll
            for (int _i = 0; _i < 2; ++_i) vA[_h][_i] = vAn[_h][_i];
        if constexpr (ALIGN_EPI) { if (wr == 1) PG8_BAR; }
    }
    PG8_WAIT_V(0);
    if constexpr (!ALIGN_EPI) { if (wr == 0) PG8_BAR; }
    PG8_BAR;
#undef PG8_GOFFS
#undef PG8_SA
#undef PG8_SB
#undef PG8_STAGE
#undef PG8_LDA
#undef PG8_LDB
#undef PG8_MMA
#undef PG8_WAIT_V
#undef PG8_WAIT_L
#undef PG8_BAR
#undef PG8_SCHED
}

typedef f32x4 AccT[2][2][4][2];
DI float fexp(float v) { return __builtin_amdgcn_exp2f(v * 1.4426950408889634f); }
DI float sigmoid_f(float v) { return __builtin_amdgcn_rcpf(1.f + fexp(-v)); }
DI float silu_f(float v) { return v * sigmoid_f(v); }
DI float logsig16(float v) { return (fminf(v, 0.f) - __builtin_amdgcn_logf(1.f + fexp(-fabsf(v))) * 0.6931471805599453f) * 0.0625f; }
DI v4u pack8(f32x4 a, f32x4 b) { v4u w; w.x = pk2(a[0], a[1]); w.y = pk2(a[2], a[3]); w.z = pk2(b[0], b[1]); w.w = pk2(b[2], b[3]); return w; }

DI void wide_pair(const v4u P0, const v4u P1, v4u& SA, v4u& SB) {
#pragma unroll
    for (int c = 0; c < 4; ++c) { SA[c] = (unsigned)__builtin_amdgcn_update_dpp((int)P0[c], (int)P1[c], 0x128, 0xF, 0xC, false);
                                  SB[c] = (unsigned)__builtin_amdgcn_update_dpp((int)P1[c], (int)P0[c], 0x128, 0xF, 0x3, false); }
}
struct EpiP1 {
    static constexpr bool PERM = true, WIDE = true;
    unsigned char* ws; unsigned char* dout; const float* gq; const float* gk; LAS float* xch;
    DI void operator()(const AccT& acc, const Unit& u, int wr, int wc, int fr, int fq) const {
        const int pn = u.pn, rowA = u.pm * BM + wr * 64 + (fr & 7), clw = (wc >> 1) * HALF + (wc & 1) * 64 + (fr >> 3) * 32 + 8 * fq;
        const int rem = pn >= 8 ? (pn - 8) % 6 : 6, gi = pn >= 8 ? (pn - 8) / 6 : 0;
        int mode = 0; const int colbase = (pn & 1) * 256; size_t off;
        if (pn < 8) { const int bi = pn >> 1; off = bi == 0 ? WS_GLAQ : (bi == 1 ? WS_GLAK : (bi == 2 ? WS_GLAV : DO_R)); mode = bi == 3 ? 1 : 0; }
        else { off = (rem < 2 ? WS_DILQ : (rem < 4 ? WS_DILK : WS_DILV)) + (size_t)gi * T * 1024; mode = rem < 4 ? 3 : 0; }
        bf16* dst = (bf16*)(((pn >> 1) == 3 ? dout : ws) + off) + colbase + clw;
        if (mode == 3) {
            const bool isq = rem < 2;
#pragma unroll
            for (int ai = 0; ai < 2; ++ai)
#pragma unroll
                for (int m = 0; m < 4; ++m) { float ss = 0.f;
#pragma unroll
                    for (int bj = 0; bj < 2; ++bj) { const f32x4 v0 = acc[ai][bj][m][0], v1 = acc[ai][bj][m][1];
                        ss += ((v0[0] * v0[0] + v0[1] * v0[1]) + (v0[2] * v0[2] + v0[3] * v0[3])) + ((v1[0] * v1[0] + v1[1] * v1[1]) + (v1[2] * v1[2] + v1[3] * v1[3])); }
                    ss = xor32_sum(xor16_sum(ss));
                    if (fq == 0) xch[(ai * 128 + wr * 64 + m * 16 + fr) * 4 + wc] = ss; }
            asm volatile("s_waitcnt lgkmcnt(0)" ::: "memory"); __builtin_amdgcn_s_barrier(); asm volatile("" ::: "memory");
            const float* gp = (isq ? gq : gk) + gi * 128 + (wc & 1) * 64 + 8 * fq;
            const f32x4 g00 = *(const f32x4*)gp, g01 = *(const f32x4*)(gp + 4), g10 = *(const f32x4*)(gp + 32), g11 = *(const f32x4*)(gp + 36);
            const float qs = isq ? 0.08838834764831845f * LOG2E : 1.f;
#pragma unroll
            for (int ai = 0; ai < 2; ++ai)
#pragma unroll
                for (int m = 0; m < 4; ++m) { const f32x2 t = *(const LAS f32x2*)(xch + (ai * 128 + wr * 64 + m * 16 + fr) * 4 + (wc & 2));
                    const float rinv = __frsqrt_rn((t[0] + t[1]) * (1.f / 128.f) + EPS) * qs;
                    bf16* rp = dst + (size_t)(rowA + ai * HALF + m * 16) * 512; v4u SA, SB;
                    wide_pair(pack8(acc[ai][0][m][0] * rinv * g00, acc[ai][0][m][1] * rinv * g01), pack8(acc[ai][1][m][0] * rinv * g10, acc[ai][1][m][1] * rinv * g11), SA, SB);
                    *(v4u*)rp = SA; *(v4u*)(rp + 8 * 512) = SB; }
            return;
        }
#pragma unroll
        for (int ai = 0; ai < 2; ++ai)
#pragma unroll
            for (int m = 0; m < 4; ++m) { bf16* rp = dst + (size_t)(rowA + ai * HALF + m * 16) * 512; v4u P[2], SA, SB;
#pragma unroll
                for (int bj = 0; bj < 2; ++bj) { f32x4 v0 = acc[ai][bj][m][0], v1 = acc[ai][bj][m][1];
                    if (mode == 1) {
#pragma unroll
                        for (int j = 0; j < 4; ++j) { v0[j] = silu_f(v0[j]); v1[j] = silu_f(v1[j]); } }
                    P[bj] = pack8(v0, v1); }
                wide_pair(P[0], P[1], SA, SB);
                *(v4u*)rp = SA; *(v4u*)(rp + 8 * 512) = SB; }
    }
};
struct EpiGateMerge {
    static constexpr bool PERM = true, WIDE = false;
    bf16* Mg; const bf16* Y; const float* bias; bool dry;
    DI void operator()(const AccT& acc, const Unit& u, int wr, int wc, int fr, int fq) const {
#if defined(PROBE_PLAN)
        if (dry) { asm volatile("" :: "v"(acc[0][0][0][0][0]), "v"(acc[1][1][3][1][3])); return; }
#endif
        const int row0 = u.pm * BM + wr * 64 + fr, col0 = u.pn * HALF + wc * 32 + 8 * fq;
        f32x4 bv[2][2];
#pragma unroll
        for (int bj = 0; bj < 2; ++bj)
#pragma unroll
            for (int n = 0; n < 2; ++n) bv[bj][n] = *(const f32x4*)(bias + bj * 1024 + col0 + 4 * n);
#pragma unroll
        for (int ai = 0; ai < 2; ++ai)
#pragma unroll
            for (int m = 0; m < 4; ++m) { const size_t row = (size_t)(row0 + ai * HALF + m * 16);
                const v4u yg = *(const v4u*)(Y + row * 2048 + col0), ya = *(const v4u*)(Y + row * 2048 + 1024 + col0);
                f32x4 g0 = acc[ai][0][m][0] + bv[0][0], g1 = acc[ai][0][m][1] + bv[0][1], a0 = acc[ai][1][m][0] + bv[1][0], a1 = acc[ai][1][m][1] + bv[1][1];
#pragma unroll
                for (int j = 0; j < 4; ++j) { g0[j] = sigmoid_f(g0[j]); g1[j] = sigmoid_f(g1[j]); a0[j] = sigmoid_f(a0[j]); a1[j] = sigmoid_f(a1[j]); }
                f32x4 o0, o1;
                o0[0] = g0[0] * bflo(yg.x) + a0[0] * bflo(ya.x); o0[1] = g0[1] * bfhi(yg.x) + a0[1] * bfhi(ya.x); o0[2] = g0[2] * bflo(yg.y) + a0[2] * bflo(ya.y); o0[3] = g0[3] * bfhi(yg.y) + a0[3] * bfhi(ya.y);
                o1[0] = g1[0] * bflo(yg.z) + a1[0] * bflo(ya.z); o1[1] = g1[1] * bfhi(yg.z) + a1[1] * bfhi(ya.z); o1[2] = g1[2] * bflo(yg.w) + a1[2] * bflo(ya.w); o1[3] = g1[3] * bfhi(yg.w) + a1[3] * bfhi(ya.w);
                *(v4u*)(Mg + row * 1024 + col0) = pack8(o0, o1); }
    }
};
struct EpiX1 {
    static constexpr bool PERM = true, WIDE = true;
    bf16* X1; const float* X;
    DI void operator()(const AccT& acc, const Unit& u, int wr, int wc, int fr, int fq) const {
        const int row0 = u.pm * BM + wr * 64 + fr, col0 = u.pn * BM + (wc >> 1) * HALF + (wc & 1) * 64 + 8 * fq;
        const int rowA = u.pm * BM + wr * 64 + (fr & 7), colw = u.pn * BM + (wc >> 1) * HALF + (wc & 1) * 64 + (fr >> 3) * 32 + 8 * fq;
#pragma unroll
        for (int ai = 0; ai < 2; ++ai)
#pragma unroll
            for (int m = 0; m < 4; ++m) { const float* xp = X + (size_t)(row0 + ai * HALF + m * 16) * 1024 + col0; v4u SA, SB;
                wide_pair(pack8(acc[ai][0][m][0] + *(const f32x4*)xp, acc[ai][0][m][1] + *(const f32x4*)(xp + 4)), pack8(acc[ai][1][m][0] + *(const f32x4*)(xp + 32), acc[ai][1][m][1] + *(const f32x4*)(xp + 36)), SA, SB);
                bf16* rp = X1 + (size_t)(rowA + ai * HALF + m * 16) * 1024 + colw;
                *(v4u*)rp = SA; *(v4u*)(rp + 8 * 1024) = SB; }
    }
};
struct EpiGU {
    static constexpr bool PERM = true, WIDE = false;
    bf16* H; const f32x2* roww;
    DI void operator()(const AccT& acc, const Unit& u, int wr, int wc, int fr, int fq) const {
        const int row0 = u.pm * BM + wr * 64 + fr, hc0 = u.pn * 128 + wc * 16 + 4 * fq;
#pragma unroll
        for (int ai = 0; ai < 2; ++ai)
#pragma unroll
            for (int m = 0; m < 4; ++m) { const int row = row0 + ai * HALF + m * 16; const f32x2 wv = roww[row]; const float ri = wv.y, w = wv.x * ri;
#pragma unroll
                for (int bj = 0; bj < 2; ++bj) { const f32x4 g = acc[ai][bj][m][0] * ri, up = acc[ai][bj][m][1];
                    v2u o; o.x = pk2(w * silu_f(g[0]) * up[0], w * silu_f(g[1]) * up[1]); o.y = pk2(w * silu_f(g[2]) * up[2], w * silu_f(g[3]) * up[3]);
                    *(v2u*)(H + (size_t)row * 512 + hc0 + bj * 64) = o; } }
    }
};
struct EpiY {
    static constexpr bool PERM = true, WIDE = true;
    bf16* Y; int ld; bool dry;
    DI void operator()(const AccT& acc, const Unit& u, int wr, int wc, int fr, int fq) const {
#if defined(PROBE_PLAN)
        if (dry) { asm volatile("" :: "v"(acc[0][0][0][0][0]), "v"(acc[1][1][3][1][3])); return; }
#endif
        const int rowA = u.pm * BM + wr * 64 + (fr & 7), colw = u.pn * BM + (wc >> 1) * HALF + (wc & 1) * 64 + (fr >> 3) * 32 + 8 * fq;
#pragma unroll
        for (int ai = 0; ai < 2; ++ai)
#pragma unroll
            for (int m = 0; m < 4; ++m) { bf16* rp = Y + (size_t)(rowA + ai * HALF + m * 16) * ld + colw; v4u SA, SB;
                wide_pair(pack8(acc[ai][0][m][0], acc[ai][0][m][1]), pack8(acc[ai][1][m][0], acc[ai][1][m][1]), SA, SB);
                *(v4u*)rp = SA; *(v4u*)(rp + (size_t)8 * ld) = SB; }
    }
};
}

constexpr int NWAVES = 8, NTHR = 512;
struct Frame {
    LAS unsigned char* lds;
    int tid, lane, wave, vcu, G;
    unsigned char* ws; unsigned char* dout;
};
#define LDS_WAIT() asm volatile("s_waitcnt lgkmcnt(0)" ::: "memory")
#define LDS_BARRIER() do { asm volatile("s_waitcnt lgkmcnt(0)" ::: "memory"); __builtin_amdgcn_s_barrier(); asm volatile("" ::: "memory"); } while (0)
DI float wave_sum(float v) {
    return xor32_sum(xor16_sum(row16_sum(v)));
}
#define MFMA16(a, b, c) __builtin_amdgcn_mfma_f32_16x16x32_bf16((a), (b), (c), 0, 0, 0)
#define MFMA32(a, b, c) __builtin_amdgcn_mfma_f32_32x32x16_bf16((a), (b), (c), 0, 0, 0)

struct TItem { const float* src; bf16* dst; const float* gain; int ldw, ldd, kind, aux, hasg; };
struct Ins { const float* in[21]; };
constexpr int I_IN = 16 * 208, I_BG = 16 * 64, I_PG = 8 * 32, I_PA = 8 * 32, I_OUT = 16 * 32, I_GU = 32 * 2 * 16 * 16, I_DN = 32 * 8 * 32;
constexpr int NITEMS = I_IN + I_BG + I_PG + I_PA + I_OUT + I_GU + I_DN;
DI TItem p0_decode(const Frame& F, const Ins& I, int it) {
    TItem t; int r = it; t.gain = I.in[13]; t.hasg = 0;
    if (r < I_IN) { const int kb = r / 208, nb = r % 208; const int n0 = nb * 32, c0 = nb < 64 ? n0 : n0 + 16;
        t.src = I.in[2] + (size_t)kb * 64 * IN_COLS + c0; t.ldw = IN_COLS; t.dst = (bf16*)(F.ws + WS_W1T) + kb * 64; t.ldd = 1024; t.kind = 0; t.aux = n0; return t; } r -= I_IN;
    if (r < I_BG) { const int kb = r / 64, nb = r % 64; t.src = I.in[10] + (size_t)kb * 64 * 2048 + nb * 32; t.ldw = 2048; t.dst = (bf16*)(F.ws + WS_WBGT) + kb * 64; t.ldd = 1024; t.kind = 1; t.aux = nb * 32; return t; } r -= I_BG;
    if (r < I_PG) { const int kb = r / 32, nb = r % 32; t.src = I.in[8] + (size_t)kb * 64 * 1024 + nb * 32; t.ldw = 1024; t.dst = (bf16*)(F.ws + WS_WPGT) + kb * 64; t.ldd = 512; t.kind = 0; t.aux = nb * 32; return t; } r -= I_PG;
    if (r < I_PA) { const int kb = r / 32, nb = r % 32; t.src = I.in[9] + (size_t)kb * 64 * 1024 + nb * 32; t.ldw = 1024; t.dst = (bf16*)(F.ws + WS_WPAT) + kb * 64; t.ldd = 512; t.kind = 0; t.aux = nb * 32; return t; } r -= I_PA;
    if (r < I_OUT) { const int kb = r / 32, nb = r % 32; t.src = I.in[12] + (size_t)kb * 64 * 1024 + nb * 32; t.ldw = 1024; t.dst = (bf16*)(F.ws + WS_WOUTT) + kb * 64; t.ldd = 1024; t.kind = 0; t.aux = nb * 32; return t; } r -= I_OUT;
    if (r < I_GU) { const int e = r / 512, q = r % 512, up = q >> 8, kb = (q >> 4) & 15, nb = q & 15;
        t.src = (up ? I.in[19] : I.in[18]) + (size_t)e * 1024 * 512 + (size_t)kb * 64 * 512 + nb * 32; t.ldw = 512; t.dst = (bf16*)(F.dout + DO_EXPGU) + (size_t)e * 1024 * 1024 + kb * 64; t.ldd = 1024; t.kind = 2; t.aux = nb * 32 * 2 + up; t.gain = I.in[13] + kb * 64; t.hasg = 1; return t; } r -= I_GU;
    { const int e = r / 256, q = r % 256, kb = q / 32, nb = q % 32;
        t.src = I.in[20] + (size_t)e * 512 * 1024 + (size_t)kb * 64 * 1024 + nb * 32; t.ldw = 1024; t.dst = (bf16*)(F.dout + DO_EXPDN) + (size_t)e * 1024 * 512 + kb * 64; t.ldd = 512; t.kind = 0; t.aux = nb * 32; return t; }
}
DI int p0_rowmap(const TItem& t, int n) {
    if (t.kind == 0) return t.aux + n;
    if (t.kind == 1) { const int c = t.aux + n, cc = c & 1023; return (cc >> 7) * 256 + (c >> 10) * 128 + (cc & 127); }
    const int c = (t.aux >> 1) + n; return (c >> 2) * 8 + (c & 3) + 4 * (t.aux & 1);
}
DI void p0_transpose(const Frame& F, const Ins& I, int it0, int it1, int gw, int NGW) {
    LAS float* scr = (LAS float*)(F.lds + RING_OFF + F.wave * 16384);
    const int lane = F.lane;
    { float cur[32], nxt[32], nx2[32]; TItem ti = p0_decode(F, I, it0 + gw < it1 ? it0 + gw : it0);
#pragma unroll
      for (int i = 0; i < 32; ++i) cur[i] = ti.src[(size_t)(2 * i + (lane >> 5)) * ti.ldw + (lane & 31)];
      TItem tn = p0_decode(F, I, it0 + gw + NGW < it1 ? it0 + gw + NGW : it0);
#pragma unroll
      for (int i = 0; i < 32; ++i) nxt[i] = tn.src[(size_t)(2 * i + (lane >> 5)) * tn.ldw + (lane & 31)];
#pragma unroll 1
      for (int it = it0 + gw; it < it1; it += NGW) {
          const bool more = it + 2 * NGW < it1; const TItem t2 = p0_decode(F, I, more ? it + 2 * NGW : it);
#pragma unroll
          for (int i = 0; i < 32; ++i) nx2[i] = t2.src[(size_t)(2 * i + (lane >> 5)) * t2.ldw + (lane & 31)];
#pragma unroll
          for (int i = 0; i < 32; ++i) scr[(2 * i + (lane >> 5)) * 33 + (lane & 31)] = cur[i];
          LDS_WAIT(); asm volatile("" ::: "memory");
          const int c = lane & 7;
          f32x4 ga = *(const f32x4*)(ti.gain + 8 * c), gb = *(const f32x4*)(ti.gain + 8 * c + 4);
          if (!ti.hasg) { ga = (f32x4){1.f, 1.f, 1.f, 1.f}; gb = ga; }
#pragma unroll
          for (int j = 0; j < 4; ++j) { const int n = (lane >> 3) + 8 * j; const LAS float* sp = scr + (8 * c) * 33 + n;
              v4u o; o.x = pk2(sp[0 * 33] * ga.x, sp[1 * 33] * ga.y); o.y = pk2(sp[2 * 33] * ga.z, sp[3 * 33] * ga.w); o.z = pk2(sp[4 * 33] * gb.x, sp[5 * 33] * gb.y); o.w = pk2(sp[6 * 33] * gb.z, sp[7 * 33] * gb.w);
              *(v4u*)(ti.dst + (size_t)p0_rowmap(ti, n) * ti.ldd + 8 * c) = o; }
          LDS_WAIT(); asm volatile("" ::: "memory");
          ti = tn; tn = t2;
#pragma unroll
          for (int i = 0; i < 32; ++i) { cur[i] = nxt[i]; nxt[i] = nx2[i]; }
      } }
}
DI bool p0_split(const Frame& F) { return F.G == 256; }
DI void p0_prologue(const Frame& F, const Ins& I, bool pdry) {
    const int gw = F.vcu * NWAVES + F.wave, NGW = F.G * NWAVES, lane = F.lane;
    p0_transpose(F, I, 0, p0_split(F) ? I_IN : NITEMS, gw, NGW);
    { bf16* WRH = (bf16*)(F.ws + WS_WRH); bf16* WRL = WRH + 48 * 1024; const float* wrg = I.in[14]; const float* wre = I.in[16];
      for (int e = (F.vcu * NTHR + F.tid); e < 48 * 1024; e += F.G * NTHR) { const int k = e & 1023, n = e >> 10;
          const float w = (n < 4 ? wrg[k * 4 + n] : (n < 36 ? wre[k * 32 + n - 4] : 0.f)) * I.in[13][k]; const bf16 h = f2bf(w); WRH[e] = h; WRL[e] = f2bf(w - bf2f(h)); } }
    { const float* x = I.in[0]; const float* g1 = I.in[1]; bf16* XN = (bf16*)(F.ws + WS_XN);
      f32x4 gv[4];
#pragma unroll
      for (int j = 0; j < 4; ++j) gv[j] = *(const f32x4*)(g1 + 4 * lane + 256 * j);
      LAS float* wlr = (LAS float*)(F.lds + RING_OFF);
      __syncthreads();
      for (int e = F.tid; e < 16 * 1024; e += NTHR) { const int k = e >> 4, n = e & 15; wlr[n * 1024 + k] = I.in[2][(size_t)k * IN_COLS + 2048 + n] * g1[k]; }
      __syncthreads();
      float* GALR = (float*)(F.ws + WS_GALR);
      f32x4 v[4], vn[4], vb1[4], vb2[4];
#pragma unroll
      for (int rr = 0; rr < 3; ++rr) { const int m0 = gw + rr * NGW; const f32x4* xr = (const f32x4*)(x + (size_t)(m0 < T ? m0 : 0) * D) + lane;
#pragma unroll
        for (int j = 0; j < 4; ++j) { const f32x4 t = xr[64 * j]; if (rr == 0) v[j] = t; else if (rr == 1) vb1[j] = t; else vb2[j] = t; } }
#pragma unroll 1
      for (int m = gw; m < T; m += NGW) { const int mn = m + 3 * NGW < T ? m + 3 * NGW : m; const f32x4* xr = (const f32x4*)(x + (size_t)mn * D) + lane; float s = 0.f;
#pragma unroll
          for (int j = 0; j < 4; ++j) { vn[j] = xr[64 * j]; s += (v[j].x * v[j].x + v[j].y * v[j].y) + (v[j].z * v[j].z + v[j].w * v[j].w); }
          const float rinv = __frsqrt_rn(wave_sum(s) * (1.f / D) + EPS);
          v2u* o8 = (v2u*)(XN + (size_t)m * D) + lane;
#pragma unroll
          for (int j = 0; j < 4; ++j) { v2u o; o.x = pk2(v[j].x * rinv * gv[j].x, v[j].y * rinv * gv[j].y); o.y = pk2(v[j].z * rinv * gv[j].z, v[j].w * rinv * gv[j].w); o8[64 * j] = o; }
#if defined(PROBE_PLAN) && PROBE_SKIP == 2
          if (pdry) { _Pragma("unroll") for (int j = 0; j < 4; ++j) { v[j] = vb1[j]; vb1[j] = vb2[j]; vb2[j] = vn[j]; } continue; }
#endif
          float p[16];
#pragma unroll
          for (int n = 0; n < 16; ++n) { float a = 0.f;
#pragma unroll
              for (int j = 0; j < 4; ++j) { const f32x4 wv = *(const LAS f32x4*)(wlr + n * 1024 + 4 * lane + 256 * j); a += (v[j].x * wv.x + v[j].y * wv.y) + (v[j].z * wv.z + v[j].w * wv.w); }
              p[n] = a; asm volatile("" ::: "memory"); }
#if defined(PROBE_PLAN) && PROBE_SKIP == 1
          if (pdry) { asm volatile("" :: "v"(p[0]), "v"(p[15])); _Pragma("unroll") for (int j = 0; j < 4; ++j) { v[j] = vb1[j]; vb1[j] = vb2[j]; vb2[j] = vn[j]; } continue; }
#endif
          { const bool h3 = lane & 8, h2 = lane & 4; float q8[8], q4[4], q2[2], q1;
#pragma unroll
            for (int i = 0; i < 8; ++i) q8[i] = rs32(p[i], p[i + 8]);
#pragma unroll
            for (int i = 0; i < 4; ++i) q4[i] = rs16(q8[i], q8[i + 4]);
#pragma unroll
            for (int i = 0; i < 2; ++i) { const float snd = h3 ? q4[i] : q4[i + 2], kp = h3 ? q4[i + 2] : q4[i]; q2[i] = kp + __shfl_xor(snd, 8); }
            { const float snd = h2 ? q2[0] : q2[1], kp = h2 ? q2[1] : q2[0]; q1 = kp + __shfl_xor(snd, 4); }
            q1 += __shfl_xor(q1, 2); q1 += __shfl_xor(q1, 1);
            if ((lane & 3) == 0) GALR[(size_t)m * 16 + ((lane >> 5) & 1) * 8 + ((lane >> 4) & 1) * 4 + ((lane >> 3) & 1) * 2 + ((lane >> 2) & 1)] = q1 * rinv; }
#pragma unroll
          for (int j = 0; j < 4; ++j) { v[j] = vb1[j]; vb1[j] = vb2[j]; vb2[j] = vn[j]; } } }
}

DI void qk_norm_phase(const Frame& F, const float* gq, const float* gk, bool dry) {
    const int gw = F.vcu * NWAVES + F.wave, NGW = F.G * NWAVES, lane = F.lane;
    bf16* Q = (bf16*)(F.ws + WS_DILQ);
    for (int rr = gw; rr < 6 * T; rr += NGW) { const int which = rr / T; const int gi = which % 3; const bool isq = which < 3;
        bf16* p = Q + (size_t)rr * 512 + 8 * lane; const v4u v = *(const v4u*)p;
        float x[8] = {bflo(v.x), bfhi(v.x), bflo(v.y), bfhi(v.y), bflo(v.z), bfhi(v.z), bflo(v.w), bfhi(v.w)};
        float s = 0.f;
#pragma unroll
        for (int j = 0; j < 8; ++j) s += x[j] * x[j];
        s += __shfl_xor(s, 1); s += __shfl_xor(s, 2); s += __shfl_xor(s, 4); s += __shfl_xor(s, 8);
        const float rinv = __frsqrt_rn(s * (1.f / 128.f) + EPS) * (isq ? 0.08838834764831845f * LOG2E : 1.f);
        const float* g = (isq ? gq : gk) + gi * 128 + (8 * lane & 127);
        const f32x4 g0 = *(const f32x4*)g, g1 = *(const f32x4*)(g + 4);
        v4u o; o.x = pk2(x[0] * rinv * g0.x, x[1] * rinv * g0.y); o.y = pk2(x[2] * rinv * g0.z, x[3] * rinv * g0.w); o.z = pk2(x[4] * rinv * g1.x, x[5] * rinv * g1.y); o.w = pk2(x[6] * rinv * g1.z, x[7] * rinv * g1.w);
        if (!dry) *(v4u*)p = o; }
}

DI int crow(int i, int h) { return (i & 3) + 8 * (i >> 2) + 4 * h; }
DI int img_off(int row, int ch) { return 256 * row + 16 * (ch ^ (((row & 3) << 2) | ((row >> 2) & 3))); }
typedef short s16x4 __attribute__((ext_vector_type(4)));
DI void attn_round(const Frame& F, int jr, bool dry) {
    const int lane = F.lane, r = lane & 31, h = lane >> 5, w = F.wave, side = w & 1;
    const int job = jr * 8 + w;
    const int gi = job >> 12; int rem = job & 4095;
    const int sh = 2 * gi, d = 1 << sh, L = SEQ >> sh, nqt = L >> 5;
    const int qt = rem % nqt; rem /= nqt; const int res = rem & (d - 1); rem >>= sh; const int head = rem & 3, b = rem >> 2;
    const int p0 = qt * 32, qtA = qt - side;
    const float slope = exp2f(-8.f * (float)(gi * 4 + head + 1) / 12.f) * LOG2E * (float)d;
    bf16* Qg = (bf16*)(F.ws + WS_DILQ) + (size_t)gi * T * 512;
    const bf16* Kg = (const bf16*)(F.ws + WS_DILK) + (size_t)gi * T * 512 + head * 128;
    const bf16* Vg = (const bf16*)(F.ws + WS_DILV) + (size_t)gi * T * 512 + head * 128;
    LAS unsigned char* pbuf = F.lds + (w >> 1) * 32768;
    const size_t qtok = (size_t)b * SEQ + (size_t)(p0 + r) * d + res;
    bf16x8 qf[8];
#pragma unroll
    for (int ks = 0; ks < 8; ++ks) qf[ks] = *(const bf16x8*)(Qg + qtok * 512 + head * 128 + 16 * ks + 8 * h);
    f32x16 O[4];
#pragma unroll
    for (int db = 0; db < 4; ++db)
#pragma unroll
        for (int i = 0; i < 16; ++i) O[db][i] = 0.f;
    float m = -1e30f, l = 0.f;
    const int srow = lane >> 4, sslot = lane & 15;
    v4u ks0[4], vs0[4], ks1[4], vs1[4];
#define ATT_LOAD(KS, VS, sN) do { const int _kb = 32 * (qtA - 4 + (sN)); if (_kb >= 0) { _Pragma("unroll") for (int ii = 0; ii < 4; ++ii) { const int kk = 16 * side + 4 * ii + srow; \
        const size_t _o = ((size_t)b * SEQ + (size_t)(_kb + kk) * d + res) * 512 + 8 * (sslot ^ ((srow << 2) | ii)); KS[ii] = *(const v4u*)(Kg + _o); VS[ii] = *(const v4u*)(Vg + _o); } } } while (0)
#define ATT_STEP(KS, VS, sN) do { const int s_ = (sN); LAS unsigned char* Kimg = pbuf + (s_ & 1) * 16384; LAS unsigned char* Vimg = Kimg + 8192; const int kb = 32 * (qtA - 4 + s_); \
        _Pragma("unroll") for (int ii = 0; ii < 4; ++ii) { *(LAS v4u*)(Kimg + 1024 * (4 * side + ii) + 16 * lane) = KS[ii]; *(LAS v4u*)(Vimg + 1024 * (4 * side + ii) + 16 * lane) = VS[ii]; } \
        if (s_ - 2 >= 0) ATT_LOAD(KS, VS, s_ - 2); \
        LDS_BARRIER(); \
        const int kt = s_ - side; \
        if (kt >= 0 && kt < 5 && kb >= 0) { \
            f32x16 sc; _Pragma("unroll") for (int i = 0; i < 16; ++i) sc[i] = 0.f; \
            _Pragma("unroll") for (int ks = 0; ks < 8; ++ks) { const bf16x8 kf = *(const LAS bf16x8*)(Kimg + img_off(r, 2 * ks + h)); sc = MFMA32(kf, qf[ks], sc); } \
            float mx = -1e30f; const int dq = p0 + r - kb; \
            _Pragma("unroll") for (int i = 0; i < 16; ++i) { const int dist = dq - crow(i, h); const bool ok = dist >= 0 && dist <= 128; const float sv = ok ? sc[i] - slope * (float)dist : -1e30f; sc[i] = sv; mx = fmaxf(mx, sv); } \
            mx = xor32_max(mx); \
            const float mn = fmaxf(m, mx), alpha = __builtin_amdgcn_exp2f(m - mn); const bool grow = !__all(mn <= m); m = mn; \
            float ps = 0.f; \
            _Pragma("unroll") for (int i = 0; i < 16; ++i) { const float pe = __builtin_amdgcn_exp2f(sc[i] - mn);     sc[i] = pe; ps += pe; } \
            l = l * alpha + ps; \
            if (grow) { _Pragma("unroll") for (int db = 0; db < 4; ++db) _Pragma("unroll") for (int i = 0; i < 16; ++i) O[db][i] *= alpha; } \
            bf16x8 pb[2]; \
            _Pragma("unroll") for (int si = 0; si < 2; ++si) { v4u wq; wq.x = pk2(sc[8 * si], sc[8 * si + 1]); wq.y = pk2(sc[8 * si + 2], sc[8 * si + 3]); wq.z = pk2(sc[8 * si + 4], sc[8 * si + 5]); wq.w = pk2(sc[8 * si + 6], sc[8 * si + 7]); pb[si] = __builtin_bit_cast(bf16x8, wq); } \
            const int i16 = lane & 15, q = i16 >> 2, pp = i16 & 3, gl = (lane >> 4) & 1; \
            _Pragma("unroll") for (int db = 0; db < 4; ++db) _Pragma("unroll") for (int si = 0; si < 2; ++si) { \
                const s16x4 lo = __builtin_amdgcn_ds_read_tr16_b64_v4i16((LAS s16x4*)(Vimg + img_off(16 * si + 4 * h + q, 4 * db + 2 * gl + (pp >> 1)) + 8 * (pp & 1))); \
                const s16x4 hi = __builtin_amdgcn_ds_read_tr16_b64_v4i16((LAS s16x4*)(Vimg + img_off(16 * si + 8 + 4 * h + q, 4 * db + 2 * gl + (pp >> 1)) + 8 * (pp & 1))); \
                const bf16x8 vf = __builtin_shufflevector(lo, hi, 0, 1, 2, 3, 4, 5, 6, 7); O[db] = MFMA32(vf, pb[si], O[db]); } } } while (0)
    ATT_LOAD(ks1, vs1, 5); ATT_LOAD(ks0, vs0, 4);
#pragma unroll 1
    for (int s2 = 2; s2 >= 0; --s2) { ATT_STEP(ks1, vs1, 2 * s2 + 1); ATT_STEP(ks0, vs0, 2 * s2); }
    LDS_BARRIER();
#undef ATT_LOAD
#undef ATT_STEP
    const float lt = xor32_sum(l), inv = 1.f / lt;
    bf16* op = Qg + qtok * 512 + head * 128 + 4 * h;
    if (dry) return;
#pragma unroll
    for (int db = 0; db < 4; ++db)
#pragma unroll
        for (int q4 = 0; q4 < 4; ++q4) { v2u o; o.x = pk2(O[db][4 * q4] * inv, O[db][4 * q4 + 1] * inv); o.y = pk2(O[db][4 * q4 + 2] * inv, O[db][4 * q4 + 3] * inv); *(v2u*)(op + 32 * db + 8 * q4) = o; }
    if (h == 0) ((float*)(F.ws + WS_LSE))[(size_t)gi * T * 4 + qtok * 4 + head] = m + log2f(lt);
}

constexpr int G_QS = 0, G_KS = 17408, G_KET = 34816, G_VT = 53248, G_ATT = 71680, G_TOT = 80896, G_DL = 82944, G_OS = 84992, G_LRAW = 83456, G_EC = 87552, G_VRAW = 100864;
constexpr int QS_LD = 136, KT_LD = 72, OS_LD = 132;
DI void gla_pass1(const Frame& F, int item, const float* wa2, const float* ba, bool dry) {
    const int tid = F.tid, lane = F.lane, w = F.wave, fr = lane & 15, g = lane >> 4;
    const int seg = item & (NSEG - 1), bh = item >> 4, hh = bh & 3, b = bh >> 2;
    const int dk = tid & 127, qr = tid >> 7;
    LAS bf16* Qs = (LAS bf16*)(F.lds + G_QS); LAS bf16* Ks = (LAS bf16*)(F.lds + G_KS); LAS bf16* KEt = (LAS bf16*)(F.lds + G_KET); LAS bf16* Vt = (LAS bf16*)(F.lds + G_VT);
    LAS bf16* Att = (LAS bf16*)(F.lds + G_ATT); LAS float* tot = (LAS float*)(F.lds + G_TOT); LAS float* Dl = (LAS float*)(F.lds + G_DL);
    const bf16* GQ = (const bf16*)(F.ws + WS_GLAQ); const bf16* GK = (const bf16*)(F.ws + WS_GLAK); const float* GAL = (const float*)(F.ws + WS_GALR); bf16* GV = (bf16*)(F.ws + WS_GLAV);
    f32x4 S[8];
#pragma unroll
    for (int a = 0; a < 8; ++a) S[a] = (f32x4){0.f, 0.f, 0.f, 0.f};
    float Btot = 0.f;
    const int dv0 = 16 * w;
    v4u sq[2], sk[2], sv[2]; f32x2 sg; unsigned odef[8];
    float wcol[16];
#pragma unroll
    for (int j = 0; j < 16; ++j) wcol[j] = wa2[j * 512 + hh * 128 + dk];
    const float bcol = ba[hh * 128 + dk];
#pragma unroll
    for (int i = 0; i < 8; ++i) odef[i] = 0u;
    const int srow = tid >> 4, sch = tid & 15;
    LAS float* Gl = (LAS float*)(F.lds + G_LRAW); LAS bf16* Vraw = (LAS bf16*)(F.lds + G_VRAW); LAS float* ecum = (LAS float*)(F.lds + G_EC);
    bf16* GQw = (bf16*)(F.ws + WS_GLAQ); v4u qd[2] = {{0u, 0u, 0u, 0u}, {0u, 0u, 0u, 0u}};
    const int troff = ((16 * qr + ((lane & 15) >> 2)) * QS_LD + (w & 1) * 64 + 16 * (lane >> 4) + 4 * (lane & 3)) * 2;
#define GLA_LOAD1(chn) do { const size_t _o = ((size_t)b * SEQ + seg * TSEG + (chn) * 64 + srow) * 512 + hh * 128 + 8 * sch; \
        sg = *(const f32x2*)(GAL + ((size_t)b * SEQ + seg * TSEG + (chn) * 64) * 16 + 2 * tid); \
        _Pragma("unroll") for (int i = 0; i < 2; ++i) { sq[i] = *(const v4u*)(GQ + _o + (size_t)i * 16384); sk[i] = *(const v4u*)(GK + _o + (size_t)i * 16384); sv[i] = *(const v4u*)(GV + _o + (size_t)i * 16384); } } while (0)
    GLA_LOAD1(0);
#pragma unroll 1
    for (int ch = 0; ch < TSEG / 64; ++ch) {
        const size_t tokbase = (size_t)b * SEQ + seg * TSEG + ch * 64;
#pragma unroll
        for (int i = 0; i < 2; ++i) { const int o = (srow + 32 * i) * QS_LD + 8 * sch; *(LAS v4u*)(Qs + o) = sq[i]; *(LAS v4u*)(Ks + o) = sk[i]; *(LAS v4u*)(Vraw + o) = sv[i]; }
        *(LAS f32x2*)(Gl + 2 * tid) = sg;
        if (ch > 0 && !dry) { bf16* op = GV + (tokbase - 64 + 4 * g) * 512 + hh * 128 + dv0 + fr;
#pragma unroll
            for (int it = 0; it < 4; ++it) { op[(size_t)(16 * it) * 512] = (bf16)(odef[2 * it] & 0xffffu); op[(size_t)(16 * it + 1) * 512] = (bf16)(odef[2 * it] >> 16); op[(size_t)(16 * it + 2) * 512] = (bf16)(odef[2 * it + 1] & 0xffffu); op[(size_t)(16 * it + 3) * 512] = (bf16)(odef[2 * it + 1] >> 16); } }
        if (ch > 0 && !dry) { const size_t qo = (tokbase - 64 + srow) * 512 + hh * 128 + 8 * sch; *(v4u*)(GQw + qo) = qd[0]; *(v4u*)(GQw + qo + 16384) = qd[1]; }
        if (ch + 1 < TSEG / 64) GLA_LOAD1(ch + 1);
        LDS_BARRIER();
        float la[16], qv[16], kv[16]; bf16 vv[16];
#pragma unroll
        for (int k4 = 0; k4 < 4; ++k4) { const int o = troff + k4 * 4 * QS_LD * 2;
            const s16x4 q4 = __builtin_amdgcn_ds_read_tr16_b64_v4i16((LAS s16x4*)((LAS unsigned char*)Qs + o));
            const s16x4 k4v = __builtin_amdgcn_ds_read_tr16_b64_v4i16((LAS s16x4*)((LAS unsigned char*)Ks + o)), v4v = __builtin_amdgcn_ds_read_tr16_b64_v4i16((LAS s16x4*)((LAS unsigned char*)Vraw + o));
#pragma unroll
            for (int e = 0; e < 4; ++e) { qv[4 * k4 + e] = bf2f((bf16)q4[e]); kv[4 * k4 + e] = bf2f((bf16)k4v[e]); vv[4 * k4 + e] = (bf16)v4v[e]; } }
#pragma unroll
        for (int i = 0; i < 16; ++i) { const LAS f32x4* gp = (const LAS f32x4*)(Gl + (16 * qr + i) * 16); float a = bcol;
#pragma unroll
            for (int jj = 0; jj < 4; ++jj) { const f32x4 gvv = gp[jj]; a += (gvv.x * wcol[4 * jj] + gvv.y * wcol[4 * jj + 1]) + (gvv.z * wcol[4 * jj + 2] + gvv.w * wcol[4 * jj + 3]); }
            la[i] = pg8::logsig16(a); }
#pragma unroll
        for (int i = 1; i < 16; ++i) la[i] += la[i - 1];
        tot[qr * 128 + dk] = la[15];
        { v4u v0, v1; v0.x = vv[0] | ((unsigned)vv[1] << 16); v0.y = vv[2] | ((unsigned)vv[3] << 16); v0.z = vv[4] | ((unsigned)vv[5] << 16); v0.w = vv[6] | ((unsigned)vv[7] << 16);
          v1.x = vv[8] | ((unsigned)vv[9] << 16); v1.y = vv[10] | ((unsigned)vv[11] << 16); v1.z = vv[12] | ((unsigned)vv[13] << 16); v1.w = vv[14] | ((unsigned)vv[15] << 16);
          *(LAS v4u*)(Vt + dk * KT_LD + 16 * qr) = v0; *(LAS v4u*)(Vt + dk * KT_LD + 16 * qr + 8) = v1; }
        LDS_BARRIER();
        const float t0 = tot[dk], t1 = tot[128 + dk], t2 = tot[256 + dk], t3 = tot[384 + dk];
        const float base = (qr > 0 ? t0 : 0.f) + (qr > 1 ? t1 : 0.f) + (qr > 2 ? t2 : 0.f), blast = (t0 + t1) + (t2 + t3);
        Btot += blast;
        const float eblast = pg8::fexp(blast);
        if (qr == 0) { Dl[dk] = eblast; ecum[dk] = pg8::fexp(Btot - blast); }
        { unsigned ke[8];
#pragma unroll
          for (int i = 0; i < 16; i += 2) { const float b0 = base + la[i], b1 = base + la[i + 1]; const float e0 = pg8::fexp(b0), e1 = pg8::fexp(b1), r0 = __builtin_amdgcn_rcpf(e0), r1 = __builtin_amdgcn_rcpf(e1);
              Qs[(16 * qr + i) * QS_LD + dk] = f2bf(qv[i] * 0.08838834764831845f * e0); Qs[(16 * qr + i + 1) * QS_LD + dk] = f2bf(qv[i + 1] * 0.08838834764831845f * e1);
              Ks[(16 * qr + i) * QS_LD + dk] = f2bf(kv[i] * r0); Ks[(16 * qr + i + 1) * QS_LD + dk] = f2bf(kv[i + 1] * r1);
              ke[i >> 1] = pk2(kv[i] * (eblast * r0), kv[i + 1] * (eblast * r1)); }
          v4u k0 = {ke[0], ke[1], ke[2], ke[3]}, k1 = {ke[4], ke[5], ke[6], ke[7]};
          *(LAS v4u*)(KEt + dk * KT_LD + 16 * qr) = k0; *(LAS v4u*)(KEt + dk * KT_LD + 16 * qr + 8) = k1; }
        LDS_BARRIER();
#pragma unroll
        for (int tt = 0; tt < 2; ++tt) { const int n = 2 * w + tt, jt = n >> 2, it = n & 3; f32x4 a4 = {0.f, 0.f, 0.f, 0.f};
#pragma unroll
            for (int s = 0; s < 4; ++s) { const bf16x8 ka = *(const LAS bf16x8*)(Ks + (16 * jt + fr) * QS_LD + 32 * s + 8 * g); const bf16x8 qb = *(const LAS bf16x8*)(Qs + (16 * it + fr) * QS_LD + 32 * s + 8 * g); a4 = MFMA16(ka, qb, a4); }
            const int tj = 16 * jt + 4 * g, ti = 16 * it + fr;
            v2u o; o.x = pk2(tj <= ti ? a4[0] : 0.f, tj + 1 <= ti ? a4[1] : 0.f); o.y = pk2(tj + 2 <= ti ? a4[2] : 0.f, tj + 3 <= ti ? a4[3] : 0.f);
            *(LAS v2u*)(Att + ti * KT_LD + tj) = o; }
        LDS_BARRIER();
        bf16x8 Sb[4];
#pragma unroll
        for (int s = 0; s < 4; ++s) { v4u p; p.x = pk2(S[2 * s][0], S[2 * s][1]); p.y = pk2(S[2 * s][2], S[2 * s][3]); p.z = pk2(S[2 * s + 1][0], S[2 * s + 1][1]); p.w = pk2(S[2 * s + 1][2], S[2 * s + 1][3]); Sb[s] = __builtin_bit_cast(bf16x8, p); }
        bf16x8 Vf[2];
#pragma unroll
        for (int ks = 0; ks < 2; ++ks) Vf[ks] = *(const LAS bf16x8*)(Vt + (dv0 + fr) * KT_LD + 32 * ks + 8 * g);
#pragma unroll
        for (int it = 0; it < 4; ++it) { f32x4 o = {0.f, 0.f, 0.f, 0.f};
#pragma unroll
            for (int s = 0; s < 4; ++s) { const bf16x4 lo = *(const LAS bf16x4*)(Qs + (16 * it + fr) * QS_LD + 32 * s + 4 * g); const bf16x4 hi = *(const LAS bf16x4*)(Qs + (16 * it + fr) * QS_LD + 32 * s + 16 + 4 * g);
                const bf16x8 qa = __builtin_shufflevector(lo, hi, 0, 1, 2, 3, 4, 5, 6, 7); o = MFMA16(qa, Sb[s], o); }
#pragma unroll
            for (int ks = 0; ks < 2; ++ks) { const bf16x8 aa = *(const LAS bf16x8*)(Att + (16 * it + fr) * KT_LD + 32 * ks + 8 * g); o = MFMA16(aa, Vf[ks], o); }
            odef[2 * it] = pk2(o[0], o[1]); odef[2 * it + 1] = pk2(o[2], o[3]); }
#pragma unroll
        for (int a = 0; a < 8; ++a) { const f32x4 dsc = *(const LAS f32x4*)(Dl + 16 * a + 4 * g); S[a] = S[a] * dsc;
#pragma unroll
            for (int ks = 0; ks < 2; ++ks) { const bf16x8 ka = *(const LAS bf16x8*)(KEt + (16 * a + fr) * KT_LD + 32 * ks + 8 * g); S[a] = MFMA16(ka, Vf[ks], S[a]); } }
#pragma unroll
        for (int i = 0; i < 2; ++i) { const v4u qraw = *(const LAS v4u*)(Qs + (srow + 32 * i) * QS_LD + 8 * sch); const f32x4 e0 = *(const LAS f32x4*)(ecum + 8 * sch), e1 = *(const LAS f32x4*)(ecum + 8 * sch + 4);
            v4u o; o.x = pk2(bflo(qraw.x) * e0.x, bfhi(qraw.x) * e0.y); o.y = pk2(bflo(qraw.y) * e0.z, bfhi(qraw.y) * e0.w); o.z = pk2(bflo(qraw.z) * e1.x, bfhi(qraw.z) * e1.y); o.w = pk2(bflo(qraw.w) * e1.z, bfhi(qraw.w) * e1.w); qd[i] = o; }
        LDS_BARRIER();
    }
    if (!dry) { const size_t qo = ((size_t)b * SEQ + seg * TSEG + TSEG - 64 + srow) * 512 + hh * 128 + 8 * sch; *(v4u*)(GQw + qo) = qd[0]; *(v4u*)(GQw + qo + 16384) = qd[1]; }
    if (!dry) { bf16* op = GV + ((size_t)b * SEQ + seg * TSEG + TSEG - 64 + 4 * g) * 512 + hh * 128 + dv0 + fr;
#pragma unroll
        for (int it = 0; it < 4; ++it) { op[(size_t)(16 * it) * 512] = (bf16)(odef[2 * it] & 0xffffu); op[(size_t)(16 * it + 1) * 512] = (bf16)(odef[2 * it] >> 16); op[(size_t)(16 * it + 2) * 512] = (bf16)(odef[2 * it + 1] & 0xffffu); op[(size_t)(16 * it + 3) * 512] = (bf16)(odef[2 * it + 1] >> 16); } }
    v2u* LB = (v2u*)(F.ws + WS_LB) + (size_t)item * 4096 + w * 512 + lane;
#pragma unroll
    for (int a = 0; a < 8; ++a) { v2u o; o.x = pk2(S[a][0], S[a][1]); o.y = pk2(S[a][2], S[a][3]); LB[a * 64] = o; }
    if (qr == 0) ((float*)(F.ws + WS_DSEG))[item * 128 + dk] = pg8::fexp(Btot);
}

DI void gla_pass2(const Frame& F, int item, const float* gnorm, bool dry) {
    const int tid = F.tid, lane = F.lane, w = F.wave, fr = lane & 15, g = lane >> 4;
    const int seg = item & (NSEG - 1), bh = item >> 4, hh = bh & 3, b = bh >> 2;
    const int dv0 = 16 * w;
    LAS bf16* Qs = (LAS bf16*)(F.lds + G_QS); LAS float* Os = (LAS float*)(F.lds + G_OS);
    const bf16* GQ = (const bf16*)(F.ws + WS_GLAQ); bf16* GV = (bf16*)(F.ws + WS_GLAV); const bf16* R = (const bf16*)(F.dout + DO_R);
    f32x4 Sc[8];
#pragma unroll
    for (int a = 0; a < 8; ++a) Sc[a] = (f32x4){0.f, 0.f, 0.f, 0.f};
    { v2u lv[8], lvn[8]; f32x4 dc[8], dcn[8];
#define GLA_CLOAD(LV, DC, spn) do { const int _it2 = bh * NSEG + (spn); const v2u* _LB = (const v2u*)(F.ws + WS_LB) + (size_t)_it2 * 4096 + w * 512 + lane; const float* _DS = (const float*)(F.ws + WS_DSEG) + _it2 * 128 + 4 * g; \
        _Pragma("unroll") for (int a = 0; a < 8; ++a) { DC[a] = *(const f32x4*)(_DS + 16 * a); LV[a] = _LB[a * 64]; } } while (0)
      if (seg > 0) GLA_CLOAD(lv, dc, 0);
#pragma unroll 1
      for (int sp = 0; sp < seg; ++sp) {
          if (sp + 1 < seg) GLA_CLOAD(lvn, dcn, sp + 1);
#pragma unroll
          for (int a = 0; a < 8; ++a) { Sc[a][0] = Sc[a][0] * dc[a][0] + bflo(lv[a].x); Sc[a][1] = Sc[a][1] * dc[a][1] + bfhi(lv[a].x); Sc[a][2] = Sc[a][2] * dc[a][2] + bflo(lv[a].y); Sc[a][3] = Sc[a][3] * dc[a][3] + bfhi(lv[a].y);
              lv[a] = lvn[a]; dc[a] = dcn[a]; } }
#undef GLA_CLOAD
    }
    bf16x8 Sb[4];
#pragma unroll
    for (int s = 0; s < 4; ++s) { v4u p; p.x = pk2(Sc[2 * s][0], Sc[2 * s][1]); p.y = pk2(Sc[2 * s][2], Sc[2 * s][3]); p.z = pk2(Sc[2 * s + 1][0], Sc[2 * s + 1][1]); p.w = pk2(Sc[2 * s + 1][2], Sc[2 * s + 1][3]); Sb[s] = __builtin_bit_cast(bf16x8, p); }
    const int tk = tid >> 3, pc = tid & 7;
    f32x4 gn[4];
#pragma unroll
    for (int j = 0; j < 4; ++j) gn[j] = *(const f32x4*)(gnorm + 16 * pc + 4 * j);
    v4u sq[2], ow0, ow1, r0, r1, od0 = {0u, 0u, 0u, 0u}, od1 = {0u, 0u, 0u, 0u};
    const int srow = tid >> 4, sch = tid & 15;
#define GLA_LOAD2A(chn) do { const size_t _o = ((size_t)b * SEQ + seg * TSEG + (chn) * 64 + srow) * 512 + hh * 128 + 8 * sch; \
        _Pragma("unroll") for (int i = 0; i < 2; ++i) sq[i] = *(const v4u*)(GQ + _o + (size_t)i * 16384); } while (0)
#define GLA_LOAD2B(chn) do { const size_t _o = ((size_t)b * SEQ + seg * TSEG + (chn) * 64 + tk) * 512 + hh * 128 + 16 * pc; \
        ow0 = *(const v4u*)(GV + _o); ow1 = *(const v4u*)(GV + _o + 8); r0 = *(const v4u*)(R + _o); r1 = *(const v4u*)(R + _o + 8); } while (0)
    GLA_LOAD2A(0); GLA_LOAD2B(0);
#pragma unroll 1
    for (int ch = 0; ch < TSEG / 64; ++ch) {
        const size_t tokbase = (size_t)b * SEQ + seg * TSEG + ch * 64;
#pragma unroll
        for (int i = 0; i < 2; ++i) { const int o = (srow + 32 * i) * QS_LD + 8 * sch; *(LAS v4u*)(Qs + o) = sq[i]; }
        if (ch > 0 && !dry) { const size_t pofs = (tokbase - 64 + tk) * 512 + hh * 128 + 16 * pc; *(v4u*)(GV + pofs) = od0; *(v4u*)(GV + pofs + 8) = od1; }
        const v4u cw0 = ow0, cw1 = ow1, cr0 = r0, cr1 = r1;
        if (ch + 1 < TSEG / 64) { GLA_LOAD2A(ch + 1); GLA_LOAD2B(ch + 1); }
        LDS_BARRIER();
#pragma unroll
        for (int it = 0; it < 4; ++it) { f32x4 o = {0.f, 0.f, 0.f, 0.f};
            if (seg > 0) {
#pragma unroll
                for (int s = 0; s < 4; ++s) { const bf16x4 lo = *(const LAS bf16x4*)(Qs + (16 * it + fr) * QS_LD + 32 * s + 4 * g); const bf16x4 hi = *(const LAS bf16x4*)(Qs + (16 * it + fr) * QS_LD + 32 * s + 16 + 4 * g);
                    const bf16x8 qa = __builtin_shufflevector(lo, hi, 0, 1, 2, 3, 4, 5, 6, 7); o = MFMA16(qa, Sb[s], o); } }
#pragma unroll
            for (int rr = 0; rr < 4; ++rr) Os[(16 * it + 4 * g + rr) * OS_LD + dv0 + fr] = o[rr]; }
        LDS_BARRIER();
        { f32x4 v[4]; float ss = 0.f;
#pragma unroll
          for (int j = 0; j < 4; ++j) v[j] = *(const LAS f32x4*)(Os + tk * OS_LD + 16 * pc + 4 * j);
          v[0].x += bflo(cw0.x); v[0].y += bfhi(cw0.x); v[0].z += bflo(cw0.y); v[0].w += bfhi(cw0.y); v[1].x += bflo(cw0.z); v[1].y += bfhi(cw0.z); v[1].z += bflo(cw0.w); v[1].w += bfhi(cw0.w);
          v[2].x += bflo(cw1.x); v[2].y += bfhi(cw1.x); v[2].z += bflo(cw1.y); v[2].w += bfhi(cw1.y); v[3].x += bflo(cw1.z); v[3].y += bfhi(cw1.z); v[3].z += bflo(cw1.w); v[3].w += bfhi(cw1.w);
#pragma unroll
          for (int j = 0; j < 4; ++j) ss += (v[j].x * v[j].x + v[j].y * v[j].y) + (v[j].z * v[j].z + v[j].w * v[j].w);
          ss = grp8_sum(ss);
          const float rinv = __frsqrt_rn(ss * (1.f / 128.f) + EPS);
          const size_t ofs = (tokbase + tk) * 512 + hh * 128 + 16 * pc;
          v4u o0, o1;
          o0.x = pk2(v[0].x * rinv * gn[0].x * bflo(cr0.x), v[0].y * rinv * gn[0].y * bfhi(cr0.x)); o0.y = pk2(v[0].z * rinv * gn[0].z * bflo(cr0.y), v[0].w * rinv * gn[0].w * bfhi(cr0.y));
          o0.z = pk2(v[1].x * rinv * gn[1].x * bflo(cr0.z), v[1].y * rinv * gn[1].y * bfhi(cr0.z)); o0.w = pk2(v[1].z * rinv * gn[1].z * bflo(cr0.w), v[1].w * rinv * gn[1].w * bfhi(cr0.w));
          o1.x = pk2(v[2].x * rinv * gn[2].x * bflo(cr1.x), v[2].y * rinv * gn[2].y * bfhi(cr1.x)); o1.y = pk2(v[2].z * rinv * gn[2].z * bflo(cr1.y), v[2].w * rinv * gn[2].w * bfhi(cr1.y));
          o1.z = pk2(v[3].x * rinv * gn[3].x * bflo(cr1.z), v[3].y * rinv * gn[3].y * bfhi(cr1.z)); o1.w = pk2(v[3].z * rinv * gn[3].z * bflo(cr1.w), v[3].w * rinv * gn[3].w * bfhi(cr1.w));
          od0 = o0; od1 = o1; }
        LDS_BARRIER();
    }
    if (!dry) { const size_t pofs = ((size_t)b * SEQ + seg * TSEG + TSEG - 64 + tk) * 512 + hh * 128 + 16 * pc; *(v4u*)(GV + pofs) = od0; *(v4u*)(GV + pofs + 8) = od1; }
}
DI void attn_merge_phase(const Frame& F, bool dry) {
    const int gw = F.vcu * NWAVES + F.wave, NGW = F.G * NWAVES, lane = F.lane, head = lane >> 4;
    bf16* O0 = (bf16*)(F.ws + WS_DILQ); const float* LSE = (const float*)(F.ws + WS_LSE);
    for (int t = gw; t < T; t += NGW) {
        const float l0 = LSE[(size_t)t * 4 + head], l1 = LSE[(size_t)T * 4 + (size_t)t * 4 + head], l2 = LSE[(size_t)2 * T * 4 + (size_t)t * 4 + head];
        const float M = fmaxf(l0, fmaxf(l1, l2)); float w0 = exp2f(l0 - M), w1 = exp2f(l1 - M), w2 = exp2f(l2 - M); const float inv = 1.f / (w0 + w1 + w2); w0 *= inv; w1 *= inv; w2 *= inv;
        bf16* p = O0 + (size_t)t * 512 + 8 * lane; const v4u a = *(const v4u*)p, bq = *(const v4u*)(p + (size_t)T * 512), c = *(const v4u*)(p + (size_t)2 * T * 512);
        v4u o;
        o.x = pk2(w0 * bflo(a.x) + w1 * bflo(bq.x) + w2 * bflo(c.x), w0 * bfhi(a.x) + w1 * bfhi(bq.x) + w2 * bfhi(c.x));
        o.y = pk2(w0 * bflo(a.y) + w1 * bflo(bq.y) + w2 * bflo(c.y), w0 * bfhi(a.y) + w1 * bfhi(bq.y) + w2 * bfhi(c.y));
        o.z = pk2(w0 * bflo(a.z) + w1 * bflo(bq.z) + w2 * bflo(c.z), w0 * bfhi(a.z) + w1 * bfhi(bq.z) + w2 * bfhi(c.z));
        o.w = pk2(w0 * bflo(a.w) + w1 * bflo(bq.w) + w2 * bflo(c.w), w0 * bfhi(a.w) + w1 * bfhi(bq.w) + w2 * bfhi(c.w));
        if (!dry) *(v4u*)p = o; }
}

DI void router_phase(const Frame& F, const float* brg, const float* bre, unsigned* gcnt, bool dry) {
    const int lane = F.lane, w = F.wave, fr = lane & 15, g = lane >> 4;
    const bf16* X1 = (const bf16*)(F.ws + WS_X1);
    const bf16* WRH = (const bf16*)(F.ws + WS_WRH); const bf16* WRL = WRH + 48 * 1024;
    int* TOKE = (int*)(F.ws + WS_TOKE); float* TOKW = (float*)(F.ws + WS_TOKW); int* TOKR = (int*)(F.ws + WS_TOKR);
    LAS float* lg = (LAS float*)(F.lds + w * 3072);
    LAS int* cnt = (LAS int*)(F.lds + 24576); LAS int* basev = cnt + 32;
    LAS unsigned char* wh = F.lds + 28672;
    __syncthreads();
    for (int e = F.tid; e < 48 * 128; e += NTHR) *(LAS v4u*)(wh + (e >> 7) * 2064 + (e & 127) * 16) = *(const v4u*)(WRH + (size_t)e * 8);
    __syncthreads();
    if (!dry) { int* ROWTOK = (int*)(F.ws + WS_ROWTOK); for (int e = F.vcu * NTHR + F.tid; e < PMAX; e += F.G * NTHR) ROWTOK[e] = 0; }
    for (int it = 0; it * F.G * 128 < T; ++it) {
        const int tok0 = (it * F.G + F.vcu) * 128 + w * 16;
        if (F.tid < 32) cnt[F.tid] = 0;
        __syncthreads();
        f32x4 acc[3]; acc[0] = acc[1] = acc[2] = (f32x4){0.f, 0.f, 0.f, 0.f};
        float ss = 0.f;
        const bf16* xr = X1 + (size_t)(tok0 + fr) * D + 8 * g;
#pragma unroll 4
        for (int s = 0; s < 32; ++s) {
            const v4u xv = *(const v4u*)(xr + 32 * s);
            ss += (bflo(xv.x) * bflo(xv.x) + bfhi(xv.x) * bfhi(xv.x)) + (bflo(xv.y) * bflo(xv.y) + bfhi(xv.y) * bfhi(xv.y)) + (bflo(xv.z) * bflo(xv.z) + bfhi(xv.z) * bfhi(xv.z)) + (bflo(xv.w) * bflo(xv.w) + bfhi(xv.w) * bfhi(xv.w));
            const bf16x8 ah = __builtin_bit_cast(bf16x8, xv);
#pragma unroll
            for (int nt = 0; nt < 3; ++nt) { const bf16x8 bh = *(const LAS bf16x8*)(wh + (16 * nt + fr) * 2064 + 64 * s + 16 * g), bl = *(const bf16x8*)(WRL + (size_t)(16 * nt + fr) * 1024 + 32 * s + 8 * g);
                acc[nt] = MFMA16(ah, bh, acc[nt]); acc[nt] = MFMA16(ah, bl, acc[nt]); }
        }
        ss = xor32_sum(xor16_sum(ss));
        const float rinv = __frsqrt_rn(ss * (1.f / D) + EPS);
#pragma unroll
        for (int rr = 0; rr < 4; ++rr) { const float ri = __shfl(rinv, 4 * g + rr);
#pragma unroll
            for (int nt = 0; nt < 3; ++nt) lg[(4 * g + rr) * 48 + 16 * nt + fr] = acc[nt][rr] * ri; }
        if (lane < 16 && !dry) ((float*)(F.ws + WS_H2))[tok0 + lane] = rinv;
        LDS_WAIT(); asm volatile("" ::: "memory");
        int e1 = 0, e2 = 0, lr1 = 0, lr2 = 0; float w1 = 0.f, w2 = 0.f;
        if (lane < 16) { const LAS float* q = lg + lane * 48;
            float gl[4]; int gs = 0; float gm = -3.0e38f;
#pragma unroll
            for (int j = 0; j < 4; ++j) { gl[j] = q[j] + brg[j]; if (gl[j] > gm) { gm = gl[j]; gs = j; } }
            float gsum = 0.f;
#pragma unroll
            for (int j = 0; j < 4; ++j) gsum += __expf(gl[j] - gm);
            const float gp = 1.f / gsum;
            float el[8]; int i1 = 0; float v1 = -3.0e38f;
#pragma unroll
            for (int j = 0; j < 8; ++j) { el[j] = q[4 + 8 * gs + j] + bre[8 * gs + j]; if (el[j] > v1) { v1 = el[j]; i1 = j; } }
            int i2 = 0; float v2 = -3.0e38f;
#pragma unroll
            for (int j = 0; j < 8; ++j) if (j != i1 && el[j] > v2) { v2 = el[j]; i2 = j; }
            const float p2 = 1.f / (1.f + __expf(v1 - v2)), p1 = 1.f - p2;
            e1 = 8 * gs + i1; e2 = 8 * gs + i2; w1 = p1 * gp; w2 = p2 * gp;
            lr1 = __hip_atomic_fetch_add(&cnt[e1], 1, __ATOMIC_RELAXED, __HIP_MEMORY_SCOPE_WORKGROUP); lr2 = __hip_atomic_fetch_add(&cnt[e2], 1, __ATOMIC_RELAXED, __HIP_MEMORY_SCOPE_WORKGROUP); }
        __syncthreads();
        if (F.tid < 32) basev[F.tid] = dry ? 0 : (int)atomicAdd(&gcnt[64 * F.tid], (unsigned)cnt[F.tid]);
        __syncthreads();
        if (lane < 16 && !dry) { const int t = tok0 + lane; TOKE[2 * t] = e1; TOKE[2 * t + 1] = e2; TOKW[2 * t] = w1; TOKW[2 * t + 1] = w2; TOKR[2 * t] = basev[e1] + lr1; TOKR[2 * t + 1] = basev[e2] + lr2; }
        __syncthreads();
    }
}
DI void moe_assign_phase(const Frame& F, unsigned* gcnt) {
    LAS int* pst = (LAS int*)(F.lds + 65536);
    if (F.wave == 0) { int* BLKE = (int*)(F.ws + WS_BLKE); const int e = F.lane & 31;
        const int c = (int)__hip_atomic_load(&gcnt[64 * e], __ATOMIC_RELAXED, __HIP_MEMORY_SCOPE_AGENT), nb = (c + 255) >> 8;
        int incl = nb;
#pragma unroll
        for (int dlt = 1; dlt < 32; dlt <<= 1) { const int v = __shfl_up(incl, dlt, 32); if (e >= dlt) incl += v; }
        const int excl = incl - nb;
        if (F.lane < 32) { pst[e] = excl << 8;
            if (F.vcu == 0) { for (int j = 0; j < nb; ++j) BLKE[excl + j] = e; if (e == 31) BLKE[NBLK_MAX] = incl; } } }
    __syncthreads();
    const int* TOKE = (const int*)(F.ws + WS_TOKE); const float* TOKW = (const float*)(F.ws + WS_TOKW); const int* TOKR = (const int*)(F.ws + WS_TOKR);
    int* DEST = (int*)(F.ws + WS_DEST); f32x2* ROWW = (f32x2*)(F.ws + WS_ROWW); int* ROWTOK = (int*)(F.ws + WS_ROWTOK); const float* RINV = (const float*)(F.ws + WS_H2);
    for (int t = F.vcu * NTHR + F.tid; t < T; t += F.G * NTHR) {
        const int d0 = pst[TOKE[2 * t]] + TOKR[2 * t], d1 = pst[TOKE[2 * t + 1]] + TOKR[2 * t + 1]; const float rinv = RINV[t];
        DEST[2 * t] = d0; DEST[2 * t + 1] = d1; ROWW[d0] = (f32x2){TOKW[2 * t], rinv}; ROWW[d1] = (f32x2){TOKW[2 * t + 1], rinv}; ROWTOK[d0] = t; ROWTOK[d1] = t; }
}
DI void combine_phase(const Frame& F, float* out) {
    const int gw = F.vcu * NWAVES + F.wave, NGW = F.G * NWAVES, lane = F.lane;
    const bf16* X1 = (const bf16*)(F.ws + WS_X1); const bf16* Y = (const bf16*)(F.ws + WS_Y); const int* DEST = (const int*)(F.ws + WS_DEST);
    for (int t = gw; t < T; t += NGW) { const int d0 = DEST[2 * t], d1 = DEST[2 * t + 1];
#pragma unroll
        for (int j = 0; j < 2; ++j) { const int c = 8 * lane + 512 * j;
            const v4u x = *(const v4u*)(X1 + (size_t)t * D + c), a = *(const v4u*)(Y + (size_t)d0 * D + c), b = *(const v4u*)(Y + (size_t)d1 * D + c);
            f32x4 oa, ob;
            oa.x = bflo(x.x) + bflo(a.x) + bflo(b.x); oa.y = bfhi(x.x) + bfhi(a.x) + bfhi(b.x); oa.z = bflo(x.y) + bflo(a.y) + bflo(b.y); oa.w = bfhi(x.y) + bfhi(a.y) + bfhi(b.y);
            ob.x = bflo(x.z) + bflo(a.z) + bflo(b.z); ob.y = bfhi(x.z) + bfhi(a.z) + bfhi(b.z); ob.z = bflo(x.w) + bflo(a.w) + bflo(b.w); ob.w = bfhi(x.w) + bfhi(a.w) + bfhi(b.w);
            *(f32x4*)(out + (size_t)t * D + c) = oa; *(f32x4*)(out + (size_t)t * D + c + 4) = ob; } }
}

constexpr int PER_PHASE = 13;
#ifndef STAGGER_TICKS
#define STAGGER_TICKS 200
#endif
struct Args { Ins I; float* out; unsigned char* ws; int ph_lo, ph_hi, li, pad; };
__global__ void __launch_bounds__(NTHR, 2) fwd_kernel(Args args) {
    extern __shared__ __attribute__((aligned(16))) unsigned char lds[];
    Frame F;
    F.lds = (LAS unsigned char*)lds;
    F.tid = threadIdx.x; F.lane = F.tid & 63; F.wave = __builtin_amdgcn_readfirstlane(F.tid >> 6);
    F.G = gridDim.x; { const int bx = blockIdx.x; F.vcu = (F.G % 8 == 0) ? (bx % 8) * (F.G / 8) + bx / 8 : bx; }
    F.ws = args.ws; F.dout = (unsigned char*)args.out;
    unsigned* ctl = (unsigned*)(args.ws + WS_CTL);
    volatile LAS unsigned* MISC = (volatile LAS unsigned*)(F.lds + MISC_OFF);
    for (int u = F.tid; u < (LDS_BYTES - LDSCTL_OFF) / 4; u += NTHR) ((LAS unsigned*)(F.lds + LDSCTL_OFF))[u] = 0u;
    __syncthreads();
    XcdBarrier bar; bar.bar = ctl + CW_BAR; bar.x = 0; bar.st = nullptr;
    if (MK_N_LAUNCHES == 1) bar = xcd_barrier_post(ctl + CW_BAR + args.li * 4096, MISC + 8);
    const int lo = args.ph_lo, hi = args.ph_hi;
#ifdef ONLY_PHASE
#define IN(k) ((k) == ONLY_PHASE && lo <= (k) && (k) < hi)
#else
#define IN(k) (lo <= (k) && (k) < hi)
#endif
#define STAGGER() do { const unsigned long long _t0 = __builtin_amdgcn_s_memrealtime(), _dl = (unsigned long long)(blockIdx.x & 3) * STAGGER_TICKS; while (__builtin_amdgcn_s_memrealtime() - _t0 < _dl) __builtin_amdgcn_s_sleep(8); } while (0)
#define SEAM(k) do { if (IN(k) && IN((k) + 1)) xcd_barrier(bar); } while (0)
#ifndef DUP_MASK
#define DUP_MASK 0
#endif
#define REPS(k) (((DUP_MASK >> (k)) & 1) ? 2 : 1)
    const Ins& I = args.I;
    unsigned char* ws = args.ws;
#if defined(PROBE_PLAN)
    const bool pdry = args.li == 1 && args.pad == 77;
#else
    const bool pdry = false;
#endif

    if (IN(0)) { _Pragma("unroll 1") for (int rep = 0; rep < REPS(0); ++rep) { if (rep) xcd_barrier(bar); p0_prologue(F, I, pdry); } SEAM(0); }

    if (IN(1)) { _Pragma("unroll 1") for (int rep = 0; rep < REPS(1); ++rep) { if (rep) xcd_barrier(bar);
        pg8::GemmDesc g{1024, 1024, 1024};
        const int bx = (int)blockIdx.x, iw = bx >> 3; const bool split = p0_split(F), grpB = split && iw >= 16;
        if (grpB) { p0_transpose(F, I, I_IN, NITEMS, ((iw - 16) * 8 + (bx & 7)) * NWAVES + F.wave, 128 * NWAVES); __syncthreads(); }
        pg8::OrderSplit S{T / 256, N1 / 256, grpB ? 128 * 14 : 0, split ? 128 : F.G, split ? (iw & 15) * 8 + (bx & 7) : bx, split ? (grpB ? 12 : 14) : 0x7fffffff, (const char*)(ws + WS_XN), (const char*)(ws + WS_W1T), (size_t)256 * 1024 * 2, (size_t)256 * 1024 * 2};
        pg8::EpiP1 E{ws, F.dout, I.in[6], I.in[7], (LAS float*)(F.lds + LDSCTL_OFF + 1024)};
        pg8::gemm_phase<pg8::EpiP1, pg8::OrderSplit>(F.lds + RING_OFF, g, S, E);
}         SEAM(1);
    }
    if (IN(3)) {
        _Pragma("unroll 1") for (int rep = 0; rep < REPS(3); ++rep) { if (rep) xcd_barrier(bar);
        for (int it = F.vcu; it < 16 * NSEG; it += F.G) gla_pass1(F, it, I.in[3], I.in[4], (rep + 1 < REPS(3)) || pdry); }
        const int gw = F.vcu * NWAVES + F.wave, NGW = F.G * NWAVES;
        _Pragma("unroll 1") for (int rep = 0; rep < REPS(13); ++rep) { if (rep) xcd_barrier(bar);
        for (int jr = F.vcu; jr < 3 * 4096 / 8; jr += F.G) attn_round(F, jr, (rep + 1 < REPS(13)) || pdry); }
        SEAM(3);
    }
    if (IN(4)) {
        _Pragma("unroll 1") for (int rep = 0; rep < REPS(4); ++rep) { if (rep) xcd_barrier(bar);
        for (int it = F.vcu; it < 16 * NSEG; it += F.G) gla_pass2(F, it, I.in[5], (rep + 1 < REPS(4)) || pdry); }
        _Pragma("unroll 1") for (int rep = 0; rep < REPS(14); ++rep) { if (rep) xcd_barrier(bar); attn_merge_phase(F, (rep + 1 < REPS(14)) || pdry); }
        SEAM(4);
    }
    if (IN(5)) { _Pragma("unroll 1") for (int rep = 0; rep < REPS(5); ++rep) { if (rep) xcd_barrier(bar);
        pg8::GemmDesc g{512, 512, 512};
        pg8::OrderProj2 S{T / 256, 4, F.G, (int)blockIdx.x, (const char*)(ws + WS_GLAV), (const char*)(ws + WS_DILQ), (const char*)(ws + WS_WPGT), (const char*)(ws + WS_WPAT), (size_t)256 * 512 * 2, (size_t)256 * 512 * 2};
        pg8::EpiY E{(bf16*)(ws + WS_GATES), 2048, pdry};
        pg8::gemm_phase<pg8::EpiY, pg8::OrderProj2>(F.lds + RING_OFF, g, S, E);
}         SEAM(5);
    }
    if (IN(6)) { _Pragma("unroll 1") for (int rep = 0; rep < REPS(6); ++rep) { if (rep) xcd_barrier(bar);
        pg8::GemmDesc g{1024, 1024, 1024};
        pg8::OrderStd S{T / 256, 2048 / 256, F.G, (int)blockIdx.x, (const char*)(ws + WS_XN), (const char*)(ws + WS_WBGT), (size_t)256 * 1024 * 2, (size_t)256 * 1024 * 2};
        pg8::EpiGateMerge E{(bf16*)(ws + WS_MERGED), (const bf16*)(ws + WS_GATES), I.in[11], args.li == 1 && args.pad == 77};
        pg8::gemm_phase<pg8::EpiGateMerge, pg8::OrderStd>(F.lds + RING_OFF, g, S, E);
}         SEAM(6);
    }
    if (IN(7)) { _Pragma("unroll 1") for (int rep = 0; rep < REPS(7); ++rep) { if (rep) xcd_barrier(bar);
        pg8::GemmDesc g{1024, 1024, 1024};
        pg8::OrderStd S{T / 256, 4, F.G, (int)blockIdx.x, (const char*)(ws + WS_MERGED), (const char*)(ws + WS_WOUTT), (size_t)256 * 1024 * 2, (size_t)256 * 1024 * 2};
        pg8::EpiX1 E{(bf16*)(ws + WS_X1), I.in[0]};
        pg8::gemm_phase<pg8::EpiX1, pg8::OrderStd>(F.lds + RING_OFF, g, S, E);
}         SEAM(7);
    }
    if (IN(8)) { _Pragma("unroll 1") for (int rep = 0; rep < REPS(8); ++rep) { if (rep) xcd_barrier(bar); router_phase(F, I.in[15], I.in[17], ctl + CW_GCNT, rep + 1 < REPS(8)); } SEAM(8); }
    if (IN(9)) { _Pragma("unroll 1") for (int rep = 0; rep < REPS(9); ++rep) { if (rep) xcd_barrier(bar); moe_assign_phase(F, ctl + CW_GCNT); } SEAM(9); }
    const bool tsplit = (F.G & 31) == 0;
    if (IN(10)) { _Pragma("unroll 1") for (int rep = 0; rep < REPS(10); ++rep) { if (rep) xcd_barrier(bar);
        const int* BLKE = (const int*)(ws + WS_BLKE); const int nblk = BLKE[NBLK_MAX], Rf = tsplit ? nblk / (F.G >> 2) : 0x3fffffff, nt = tsplit ? nblk - Rf * (F.G >> 2) : 0;
        const bool isT = F.vcu < 4 * nt; const int n1 = Rf >= 2 ? 2 : 0;
        _Pragma("unroll 1") for (int part = 0; part < 2; ++part) {
            if (part) { if (!tsplit) break; xcd_barrier(bar); if (!isT) break; }
            pg8::GemmDesc g{1024, 1024, 1024};
            pg8::OrderMoe S{nblk, F.G, (int)blockIdx.x, BLKE, (const int*)(ws + WS_ROWTOK), (const char*)(ws + WS_X1), (const char*)(F.dout + DO_EXPGU), (size_t)0, (size_t)1024 * 1024 * 2, (size_t)256 * 1024 * 2, part ? Rf : 0, part ? 1 : Rf};
            pg8::EpiGU E{(bf16*)(ws + WS_HBUF), (const f32x2*)(ws + WS_ROWW)};
            pg8::gemm_phase<pg8::EpiGU, pg8::OrderMoe, true, true, true>(F.lds + RING_OFF, g, S, E);
        }
        if (tsplit && !isT) { const int nR = F.G - 4 * nt;
            pg8::GemmDesc g{512, 512, 512};
            pg8::OrderMoeU S{nblk, F.G, F.vcu - 4 * nt, nR, n1, BLKE, (const char*)(ws + WS_HBUF), (const char*)(F.dout + DO_EXPDN), (size_t)256 * 512 * 2, (size_t)1024 * 512 * 2, (size_t)256 * 512 * 2};
            pg8::EpiY E{(bf16*)(ws + WS_Y), 1024, false};
            pg8::gemm_phase<pg8::EpiY, pg8::OrderMoeU>(F.lds + RING_OFF, g, S, E);
        }
}         SEAM(10);
    }
    if (IN(11)) { _Pragma("unroll 1") for (int rep = 0; rep < REPS(11); ++rep) { if (rep) xcd_barrier(bar);
        const int* BLKE = (const int*)(ws + WS_BLKE); const int nblk = BLKE[NBLK_MAX], Rf = tsplit ? nblk / (F.G >> 2) : 0, nt = tsplit ? nblk - Rf * (F.G >> 2) : 0, nR = F.G - 4 * nt, n1 = Rf >= 2 ? 2 : 0;
        pg8::GemmDesc g{512, 512, 512};
        pg8::OrderMoeU S{nblk, F.G, tsplit ? n1 * nR + F.vcu : (int)blockIdx.x, F.G, 0x3fffffff, BLKE, (const char*)(ws + WS_HBUF), (const char*)(F.dout + DO_EXPDN), (size_t)256 * 512 * 2, (size_t)1024 * 512 * 2, (size_t)256 * 512 * 2};
        pg8::EpiY E{(bf16*)(ws + WS_Y), 1024, false};
        pg8::gemm_phase<pg8::EpiY, pg8::OrderMoeU>(F.lds + RING_OFF, g, S, E);
}         SEAM(11);
    }
    if (IN(12)) { _Pragma("unroll 1") for (int rep = 0; rep < REPS(12); ++rep) { if (rep) xcd_barrier(bar); combine_phase(F, args.out); } }
#undef IN
#undef SEAM
}

extern "C" void kernel_launch(void* const* d_in, const int* in_sizes, int n_in, void* d_out, int out_size, void* d_ws, size_t ws_size, hipStream_t stream) {
    static int grid = 0;
    if (grid == 0) {
        if (n_in != 21 || out_size != T * D || ws_size < WS_END) { fprintf(stderr, "kernel_launch: unexpected shapes (n_in %d out %d ws %zu)\n", n_in, out_size, ws_size); grid = -1; return; }
        int dev = 0, cus = 0, per_cu = 0;
        if (hipGetDevice(&dev) != hipSuccess || hipDeviceGetAttribute(&cus, hipDeviceAttributeMultiprocessorCount, dev) != hipSuccess) { grid = -1; return; }
        if (hipFuncSetAttribute((const void*)fwd_kernel, hipFuncAttributeMaxDynamicSharedMemorySize, LDS_BYTES) != hipSuccess) { fprintf(stderr, "kernel_launch: hipFuncSetAttribute failed\n"); grid = -1; return; }
        if (hipOccupancyMaxActiveBlocksPerMultiprocessor(&per_cu, (const void*)fwd_kernel, NTHR, LDS_BYTES) != hipSuccess || per_cu < 1) fprintf(stderr, "kernel_launch: occupancy query reports %d\n", per_cu);
        (void)hipGetLastError();
        grid = cus;
    }
    if (grid < 0) return;
    if (hipMemsetAsync((char*)d_ws + WS_CTL, 0, CTL_ZERO_BYTES, stream) != hipSuccess) return;
    Args a{};
    for (int i = 0; i < 21; ++i) a.I.in[i] = (const float*)d_in[i];
    a.out = (float*)d_out; a.ws = (unsigned char*)d_ws;
#if defined(PROBE_PLAN)
#ifndef PROBE_DRY
#define PROBE_DRY 0
#endif
    { const int plan[3][2] = {{0, PROBE_DRY == 77 ? PROBE_PLAN : PROBE_PLAN + 1}, {PROBE_PLAN, PROBE_PLAN + 1}, {PROBE_DRY == 77 ? PROBE_PLAN : PROBE_PLAN + 1, PER_PHASE}};
      for (int li = 0; li < 3; ++li) { a.ph_lo = plan[li][0]; a.ph_hi = plan[li][1]; a.li = li; a.pad = PROBE_DRY; hipLaunchKernelGGL(fwd_kernel, dim3(grid), dim3(NTHR), LDS_BYTES, stream, a); } return; }
#endif
    if (MK_N_LAUNCHES == 1) { a.ph_lo = 0; a.ph_hi = PER_PHASE; a.li = 0; hipLaunchKernelGGL(fwd_kernel, dim3(grid), dim3(NTHR), LDS_BYTES, stream, a); }
    else for (int li = 0; li < PER_PHASE; ++li) { a.ph_lo = li; a.ph_hi = li + 1; a.li = li; hipLaunchKernelGGL(fwd_kernel, dim3(grid), dim3(NTHR), LDS_BYTES, stream, a); }
}
```
